# Optimizing an MI355X kernel written in HIP

```python
import math
import jax, jax.numpy as jnp
from jax import lax
import numpy as np

D_MODEL = 1024
BATCH = 8
SEQ = 4096
DEPTH = 4

N_HEADS_A = D_MODEL // 128
HEAD_DIM_A = 64
A_QK_WIDTH = N_HEADS_A * 2 * HEAD_DIM_A
A_V_WIDTH = N_HEADS_A * 2 * HEAD_DIM_A
N_HEADS_B = D_MODEL // 128
DK_B = 128
DV_B = 128
B_QK_WIDTH = N_HEADS_B * DK_B
B_V_WIDTH = N_HEADS_B * DV_B
CONV_B = 4
CHUNK_B = 64
N_BRANCH = 2
D_FF = ((8 * D_MODEL // 3 + 127) // 128) * 128
CONV_FF = 3
D_PLE = 256
N_BUCKETS = 32
MAX_DISTANCE = 128
Q_BLOCK = 128
EPS = 1e-6
NEG_INF = -1e30

SPLITS = (A_QK_WIDTH, A_QK_WIDTH, A_V_WIDTH, B_QK_WIDTH, B_QK_WIDTH, B_V_WIDTH, B_V_WIDTH, N_HEADS_B, N_HEADS_B, N_BRANCH * D_MODEL)
D_IN = sum(SPLITS)

kernel_name = "hybrid_diffattn_gdn_convffn_block"


def rmsnorm(x, g):
    xf = x.astype(jnp.float32)
    y = xf * lax.rsqrt(jnp.mean(xf * xf, axis=-1, keepdims=True) + EPS)
    return (y * g.astype(jnp.float32)).astype(x.dtype)


def l2norm(x):
    xf = x.astype(jnp.float32)
    return xf * lax.rsqrt(jnp.sum(xf * xf, axis=-1, keepdims=True) + EPS)


def causal_dwconv(x, w):
    K = w.shape[0]
    S = x.shape[1]
    xp = jnp.pad(x, ((0, 0), (K - 1, 0), (0, 0)))
    y = xp[:, 0:S] * w[0]
    for j in range(1, K):
        y = y + xp[:, j:j + S] * w[j]
    return y


def rel_bucket(rel):
    n = jnp.maximum(rel, 0)
    max_exact = N_BUCKETS // 2
    nf = jnp.maximum(n, 1).astype(jnp.float32)
    large = max_exact + (jnp.log(nf / max_exact) / math.log(MAX_DISTANCE / max_exact) * (N_BUCKETS - max_exact)).astype(jnp.int32)
    large = jnp.minimum(large, N_BUCKETS - 1)
    return jnp.where(n < max_exact, n, large)


def diff_attention(q, k, v, lam, bias_table):
    B, S, H, _, d = q.shape
    nb = S // Q_BLOCK
    qb = q.reshape(B, nb, Q_BLOCK, H, 2, d).transpose(1, 0, 2, 3, 4, 5)
    k_pos = jnp.arange(S)

    def block(args):
        idx, q_blk = args
        q_pos = idx * Q_BLOCK + jnp.arange(Q_BLOCK)
        rel = q_pos[:, None] - k_pos[None, :]
        bias = bias_table[rel_bucket(rel)].astype(jnp.float32).transpose(2, 0, 1)
        logits = jnp.einsum('bqhjd,bkhjd->bhjqk', q_blk, k, preferred_element_type=jnp.float32)
        logits = logits + bias[None, :, None]
        logits = jnp.where((rel >= 0)[None, None, None], logits, NEG_INF)
        probs = jax.nn.softmax(logits, axis=-1)
        w = probs[:, :, 0] - lam * probs[:, :, 1]
        return jnp.einsum('bhqk,bkhe->bqhe', w.astype(v.dtype), v)

    out = lax.map(block, (jnp.arange(nb), qb))
    return out.transpose(1, 0, 2, 3, 4).reshape(B, S, H, 2 * d)


def gated_delta_rule(q, k, v, g, beta):
    B, S, H, dk = q.shape
    dv = v.shape[-1]
    C = CHUNK_B
    N = S // C

    def to_chunks(t):
        return t.reshape(B, N, C, H, t.shape[-1]).transpose(1, 0, 3, 2, 4)

    q, k, v = to_chunks(q), to_chunks(k), to_chunks(v)
    g = jnp.cumsum(g.reshape(B, N, C, H).transpose(1, 0, 3, 2), axis=-1)
    beta = beta.reshape(B, N, C, H).transpose(1, 0, 3, 2)
    tril = jnp.tril(jnp.ones((C, C), dtype=bool))
    strict = jnp.tril(jnp.ones((C, C), dtype=bool), -1)
    decay = jnp.exp(jnp.where(tril, g[..., :, None] - g[..., None, :], -jnp.inf))
    k_beta = k * beta[..., None]
    v_beta = v * beta[..., None]
    kkT = jnp.einsum('nbhid,nbhjd->nbhij', k_beta, k)
    A = jnp.eye(C, dtype=jnp.float32) + jnp.where(strict, kkT * decay, 0.0)
    rhs = jnp.concatenate([v_beta, k_beta * jnp.exp(g)[..., None]], axis=-1)
    sol = lax.linalg.triangular_solve(A, rhs, left_side=True, lower=True, unit_diagonal=True)
    u = sol[..., :dv]
    w = sol[..., dv:]
    attn_intra = jnp.where(tril, jnp.einsum('nbhid,nbhjd->nbhij', q, k) * decay, 0.0)

    def step(state, inp):
        q_c, k_c, u_c, w_c, g_c, a_c = inp
        v_new = u_c - w_c @ state
        o = (q_c * jnp.exp(g_c)[..., None]) @ state + a_c @ v_new
        g_last = g_c[..., -1]
        k_dec = k_c * jnp.exp(g_last[..., None] - g_c)[..., None]
        state = state * jnp.exp(g_last)[..., None, None] + jnp.swapaxes(k_dec, -1, -2) @ v_new
        return state, o

    s0 = jnp.zeros((B, H, dk, dv), dtype=jnp.float32)
    _, o = lax.scan(step, s0, (q, k, u, w, g, attn_intra))
    return o.transpose(1, 0, 3, 2, 4).reshape(B, S, H, dv)


def setup_inputs(seed: int = 0) -> dict:
    key = jax.random.key(seed)
    ks = jax.random.split(key, 26)
    f32 = jnp.float32
    nrm = lambda k, shape, s: jax.random.normal(k, shape, f32) * s
    gain = lambda k, shape: 1.0 + 0.02 * jax.random.normal(k, shape, f32)
    dt = jnp.exp(jax.random.uniform(ks[10], (DEPTH, N_HEADS_B), f32, math.log(1e-3), math.log(1e-1)))
    return {
        "x": nrm(ks[0], (BATCH, SEQ, D_MODEL), 1.0),
        "p": nrm(ks[1], (DEPTH, BATCH, SEQ, D_PLE), 1.0),
        "w_in": nrm(ks[2], (DEPTH, D_MODEL, D_IN), D_MODEL ** -0.5),
        "attn_norm": gain(ks[3], (DEPTH, D_MODEL)),
        "qnorm_a": gain(ks[4], (DEPTH, HEAD_DIM_A)),
        "knorm_a": gain(ks[5], (DEPTH, HEAD_DIM_A)),
        "lam_a": nrm(ks[6], (DEPTH, 4, HEAD_DIM_A), 0.1),
        "subln_a": gain(ks[7], (DEPTH, 2 * HEAD_DIM_A)),
        "rel_bias": nrm(ks[8], (N_BUCKETS, N_HEADS_A), 0.3),
        "conv_b": nrm(ks[9], (DEPTH, CONV_B, 2 * B_QK_WIDTH + B_V_WIDTH), CONV_B ** -0.5),
        "a_log_b": jnp.log(jax.random.uniform(ks[11], (DEPTH, N_HEADS_B), f32, 1.0, 16.0)),
        "dt_bias_b": dt + jnp.log(-jnp.expm1(-dt)),
        "onorm_b": gain(ks[12], (DEPTH, DV_B)),
        "w_br_a": nrm(ks[13], (DEPTH, A_V_WIDTH, D_MODEL), A_V_WIDTH ** -0.5),
        "w_br_b": nrm(ks[14], (DEPTH, B_V_WIDTH, D_MODEL), B_V_WIDTH ** -0.5),
        "w_out": nrm(ks[15], (DEPTH, D_MODEL, D_MODEL), D_MODEL ** -0.5),
        "ffn_norm": gain(ks[16], (DEPTH, D_MODEL)),
        "w_up": nrm(ks[17], (DEPTH, D_MODEL, 2 * D_FF), D_MODEL ** -0.5),
        "conv_ff": nrm(ks[18], (DEPTH, CONV_FF, 2 * D_FF), CONV_FF ** -0.5),
        "conv_ff_bias": nrm(ks[19], (DEPTH, 2 * D_FF), 0.01),
        "w_down": nrm(ks[20], (DEPTH, D_FF, D_MODEL), D_FF ** -0.5),
        "ple_norm": gain(ks[21], (DEPTH, D_MODEL)),
        "w_ple_gate": nrm(ks[22], (DEPTH, D_MODEL, D_MODEL), D_MODEL ** -0.5),
        "w_ple_proj": nrm(ks[23], (DEPTH, D_PLE, D_MODEL), D_PLE ** -0.5),
    }


def reference(x, p, w_in, attn_norm, qnorm_a, knorm_a, lam_a, subln_a, rel_bias, conv_b, a_log_b, dt_bias_b, onorm_b, w_br_a, w_br_b, w_out, ffn_norm, w_up, conv_ff, conv_ff_bias, w_down, ple_norm, w_ple_gate, w_ple_proj):
    Bsz, S, _ = x.shape
    cuts = np.cumsum(SPLITS)[:-1].tolist()
    for i in range(DEPTH):
        lam_init = 0.8 - 0.6 * math.exp(-0.3 * i)
        h = rmsnorm(x, attn_norm[i])
        proj = h @ w_in[i]
        qa, ka, va, qb, kb, vb, zb, bb, ab, gl = jnp.split(proj, cuts, axis=-1)

        qa = rmsnorm(qa.reshape(Bsz, S, N_HEADS_A, 2, HEAD_DIM_A), qnorm_a[i]) * (HEAD_DIM_A ** -0.5)
        ka = rmsnorm(ka.reshape(Bsz, S, N_HEADS_A, 2, HEAD_DIM_A), knorm_a[i])
        lq = lam_a[i].astype(jnp.float32)
        lam = jnp.exp(jnp.sum(lq[0] * lq[1])) - jnp.exp(jnp.sum(lq[2] * lq[3])) + lam_init
        oa = diff_attention(qa, ka, va.reshape(Bsz, S, N_HEADS_A, 2 * HEAD_DIM_A), lam, rel_bias)
        oa = (rmsnorm(oa, subln_a[i]) * (1.0 - lam_init)).reshape(Bsz, S, A_V_WIDTH)

        qkv = jax.nn.silu(causal_dwconv(jnp.concatenate([qb, kb, vb], axis=-1), conv_b[i]))
        qb, kb, vb = jnp.split(qkv, [B_QK_WIDTH, 2 * B_QK_WIDTH], axis=-1)
        qb = l2norm(qb.reshape(Bsz, S, N_HEADS_B, DK_B)) * (DK_B ** -0.5)
        kb = l2norm(kb.reshape(Bsz, S, N_HEADS_B, DK_B))
        vb = vb.reshape(Bsz, S, N_HEADS_B, DV_B).astype(jnp.float32)
        beta = jax.nn.sigmoid(bb.astype(jnp.float32))
        g = -jnp.exp(a_log_b[i].astype(jnp.float32)) * jax.nn.softplus(ab.astype(jnp.float32) + dt_bias_b[i].astype(jnp.float32))
        ob = gated_delta_rule(qb, kb, vb, g, beta).astype(x.dtype)
        ob = (rmsnorm(ob, onorm_b[i]) * jax.nn.silu(zb.reshape(Bsz, S, N_HEADS_B, DV_B))).reshape(Bsz, S, B_V_WIDTH)

        gates = jax.nn.sigmoid(gl.reshape(Bsz, S, N_BRANCH, D_MODEL))
        mixed = gates[:, :, 0] * (oa @ w_br_a[i]) + gates[:, :, 1] * (ob @ w_br_b[i])
        x = x + mixed @ w_out[i]

        h = rmsnorm(x, ffn_norm[i])
        u = causal_dwconv(h @ w_up[i], conv_ff[i]) + conv_ff_bias[i]
        ug, uv = jnp.split(u, 2, axis=-1)
        x = x + (jax.nn.silu(ug) * uv) @ w_down[i]

        h = rmsnorm(x, ple_norm[i])
        x = x + jax.nn.sigmoid(h @ w_ple_gate[i]) * (p[i] @ w_ple_proj[i])
    return x
```

```cpp
#include <hip/hip_runtime.h>
#include <hip/hip_cooperative_groups.h>
#include <cstdio>
#include <cstdint>
namespace cg = cooperative_groups;
namespace pg8 {
#define PG8_LAS __attribute__((address_space(3)))
typedef unsigned short bf16_t;
typedef short bf16x8 __attribute__((ext_vector_type(8)));
typedef float f32x4 __attribute__((ext_vector_type(4)));
typedef unsigned u32x4 __attribute__((ext_vector_type(4)));
constexpr int BM = 256, BK = 64, HALF = 128, HTB = HALF * BK * 2  , STAGE_BYTES = 8 * HTB, NXCD = 8, WGM = 8;

__host__ __device__ __forceinline__ int lds_byte(int r, int c) { const int st = (r >> 4) * 2 + (c >> 5), rr = r & 15, cc = c & 31, ob = rr * 64 + cc * 2; return st * 1024 + (ob ^ (((ob >> 9) & 1) << 5)); }
__host__ __device__ __forceinline__ void stage_rc(int b, int& R, int& C) { const int st = b / 1024, sb = b % 1024, swz = sb ^ (((sb >> 9) & 1) << 5); R = (st >> 1) * 16 + swz / 64; C = (st & 1) * 32 + (swz % 64) / 2; }
__host__ __device__ __forceinline__ int perm32(int rho) { const int n = rho >> 4, i = rho & 15; return 8 * (i >> 2) + 4 * n + (i & 3); }

struct Unit { int pm, pn; };
struct Gemm { const bf16_t* A; const bf16_t* Bt; int M, N, K; int hmap; };
__device__ __forceinline__ int amap(int pm, int hmap) { return hmap < 0 ? pm : ((pm >> 3) * 16 + 8 * hmap + (pm & 7)); }

struct StaticOrder {
    int nM, nN, nwg, G, c;
    __host__ __device__ void init(int M, int N, int G_, int c_) { nM = M / BM; nN = N / BM; nwg = nM * nN; G = G_; c = c_; }
    __host__ __device__ bool next(int i, Unit& u) const {
        const long L = (long)i * G + c; if (L >= nwg) return false;
        int wgid = (int)L; { const int q = nwg / NXCD, r = nwg % NXCD, xcd = wgid % NXCD, off = wgid / NXCD; wgid = (xcd < r ? xcd * (q + 1) : r * (q + 1) + (xcd - r) * q) + off; }
        const int nig = WGM * nN, gid = wgid / nig, fm = gid * WGM, gsz = (nM - fm) < WGM ? (nM - fm) : WGM;
        u.pm = fm + ((wgid % nig) % gsz); u.pn = (wgid % nig) / gsz; return true;
    }
    __device__ __forceinline__ void a_ready(const Unit&) const {}
    __device__ __forceinline__ void done(const Unit&) const {}
};
__device__ __forceinline__ unsigned cvt_pk_bf16(float lo, float hi) { unsigned r; asm volatile("v_cvt_pk_bf16_f32 %0, %1, %2" : "=v"(r) : "v"(lo), "v"(hi)); return r; }
#ifdef NO_UNI
__device__ __forceinline__ const char* uni(const char* p) { return p; }
#else
__device__ __forceinline__ const char* uni(const char* p) { const unsigned long long v = (unsigned long long)p; const unsigned lo = __builtin_amdgcn_readfirstlane((unsigned)v), hi = __builtin_amdgcn_readfirstlane((unsigned)(v >> 32)); return (const char*)(((unsigned long long)hi << 32) | lo); }
#endif
template <class Epi, class Sched, bool ALIGN_EPI = false, bool SP2 = false>
__device__ __forceinline__ void gemm_phase(PG8_LAS unsigned char* lds, const Gemm g, const Sched& S, const Epi& E) {
    int tid = threadIdx.x;
#ifndef NO_LAUNDER
    asm volatile("" : "+v"(tid));
#endif

    const int wid = __builtin_amdgcn_readfirstlane(tid >> 6), lane = tid & 63, wr = wid >> 2, wc = wid & 3, fr = lane & 15, fq = lane >> 4;
    const int K = g.K, nt = K / BK;
    unsigned voffA[2], voffB[2];
#pragma unroll
    for (int i = 0; i < 2; ++i) { int R, C; stage_rc(tid * 16 + i * 8192, R, C); const int Rb = Epi::PERM ? ((R & ~31) + perm32(R & 31)) : R;
        voffA[i] = (unsigned)(R * K + C) * 2u; voffB[i] = (unsigned)(Rb * K + C) * 2u; }
    const size_t kstep = (size_t)(BK * 2);
    const size_t hstep = (size_t)HALF * K * 2;
    const size_t tstep = 2 * hstep;
    const unsigned ldsw = (unsigned)wid * 1024u;
    const int aoff = lds_byte(wr * 64 + fr, fq * 8), boff = lds_byte(wc * 32 + fr, fq * 8);
#define PG8_SA(b, h) (((b) * 2 + (h)) * HTB)
#define PG8_SB(b, h) ((4 + (b) * 2 + (h)) * HTB)
#define PG8_STAGE(bufoff, gbase, voff) do { _Pragma("unroll") for (int _i = 0; _i < 2; ++_i) \
        __builtin_amdgcn_global_load_lds((const unsigned*)((const char*)(gbase) + (voff)[_i]), (PG8_LAS unsigned*)(lds + (bufoff) + ldsw + _i * 8192), 16, 0, 0); } while (0)
#define PG8_LDA(dst, b, h) do { _Pragma("unroll") for (int m = 0; m < 4; ++m) _Pragma("unroll") for (int k = 0; k < 2; ++k) dst[m][k] = *(const PG8_LAS bf16x8*)(lds + PG8_SA(b, h) + aoff + m * 2048 + k * 1024); } while (0)
#define PG8_LDB(dst, b, h) do { _Pragma("unroll") for (int n = 0; n < 2; ++n) _Pragma("unroll") for (int k = 0; k < 2; ++k) dst[n][k] = *(const PG8_LAS bf16x8*)(lds + PG8_SB(b, h) + boff + n * 2048 + k * 1024); } while (0)
#define PG8_MMA(ai, bj, At, Bt) do { __builtin_amdgcn_s_setprio(1); _Pragma("unroll") for (int m = 0; m < 4; ++m) _Pragma("unroll") for (int n = 0; n < 2; ++n) _Pragma("unroll") for (int k = 0; k < 2; ++k) \
        acc[ai][bj][m][n] = __builtin_amdgcn_mfma_f32_16x16x32_bf16(Bt[n][k], At[m][k], acc[ai][bj][m][n], 0, 0, 0); __builtin_amdgcn_s_setprio(0); } while (0)
#define PG8_WAIT_V(n) asm volatile("s_waitcnt vmcnt(" #n ")" ::: "memory")
#define PG8_WAIT_L(n) asm volatile("s_waitcnt lgkmcnt(" #n ")" ::: "memory")
#define PG8_BAR __builtin_amdgcn_s_barrier()
#define PG8_SCHED __builtin_amdgcn_sched_barrier(0)
    Unit cur, nxt; int ui = 0;
    if (!S.next(0, cur)) return;
    f32x4 acc[2][2][4][2];
#pragma unroll
    for (int a = 0; a < 2; ++a)
#pragma unroll
        for (int b = 0; b < 2; ++b)
#pragma unroll
            for (int m = 0; m < 4; ++m)
#pragma unroll
                for (int n = 0; n < 2; ++n) acc[a][b][m][n] = (f32x4){0.f, 0.f, 0.f, 0.f};
    bf16x8 At[4][2], B0[2][2], B1[2][2];
    const char* cA = uni((const char*)g.A + (size_t)amap(cur.pm, g.hmap) * tstep); const char* cB = uni((const char*)g.Bt + (size_t)cur.pn * tstep);
    S.a_ready(cur);
    if constexpr (SP2) {
        PG8_STAGE(PG8_SB(0, 0), cB, voffB); PG8_STAGE(PG8_SB(0, 1), cB + hstep, voffB); PG8_STAGE(PG8_SA(0, 0), cA, voffA); PG8_STAGE(PG8_SA(0, 1), cA + hstep, voffA);
        if (wr == 1) PG8_BAR;
        PG8_WAIT_V(2); PG8_BAR;
        PG8_STAGE(PG8_SB(1, 0), cB + kstep, voffB); PG8_STAGE(PG8_SA(1, 0), cA + kstep, voffA); PG8_STAGE(PG8_SB(1, 1), cB + hstep + kstep, voffB);
        PG8_WAIT_V(6); PG8_BAR;
    } else {
        PG8_STAGE(PG8_SB(0, 0), cB, voffB); PG8_STAGE(PG8_SA(0, 0), cA, voffA); PG8_STAGE(PG8_SB(0, 1), cB + hstep, voffB); PG8_STAGE(PG8_SA(0, 1), cA + hstep, voffA);
        if (wr == 1) PG8_BAR;
        PG8_WAIT_V(4); PG8_BAR;
        PG8_STAGE(PG8_SB(1, 0), cB + kstep, voffB); PG8_STAGE(PG8_SA(1, 0), cA + kstep, voffA); PG8_STAGE(PG8_SB(1, 1), cB + hstep + kstep, voffB);
        PG8_WAIT_V(6); PG8_BAR;
    }
    for (;;) {
        const bool has_next = S.next(ui + 1, nxt);
        const char* nA = uni(has_next ? (const char*)g.A + (size_t)amap(nxt.pm, g.hmap) * tstep : cA); const char* nB = uni(has_next ? (const char*)g.Bt + (size_t)nxt.pn * tstep : cB);
        for (int t = 0; t < nt; t += 2) {
            const bool last = (t == nt - 2);
            const char* a1 = cA + (size_t)(t + 1) * kstep;
            const char* a2 = last ? nA : cA + (size_t)(t + 2) * kstep; const char* b2 = last ? nB : cB + (size_t)(t + 2) * kstep;
            const char* a3 = a2 + kstep; const char* b3 = b2 + kstep;
            if (last && has_next) S.a_ready(nxt);
            if constexpr (SP2) {
            PG8_LDB(B0, 0, 0); PG8_LDB(B1, 0, 1); PG8_SCHED; PG8_LDA(At, 0, 0); PG8_STAGE(PG8_SA(1, 1), a1 + hstep, voffA);
            PG8_WAIT_V(8); PG8_WAIT_L(0); PG8_BAR; PG8_MMA(0, 0, At, B0); PG8_MMA(0, 1, At, B1); PG8_BAR; PG8_SCHED;
            PG8_LDA(At, 0, 1); PG8_STAGE(PG8_SB(0, 0), b2, voffB); PG8_STAGE(PG8_SB(0, 1), b2 + hstep, voffB); PG8_STAGE(PG8_SA(0, 0), a2, voffA);
            PG8_WAIT_V(8); PG8_WAIT_L(0); PG8_BAR; PG8_MMA(1, 0, At, B0); PG8_MMA(1, 1, At, B1); PG8_BAR; PG8_SCHED;
            PG8_LDB(B0, 1, 0); PG8_LDB(B1, 1, 1); PG8_SCHED; PG8_LDA(At, 1, 0); PG8_STAGE(PG8_SA(0, 1), a2 + hstep, voffA);
            PG8_WAIT_V(8); PG8_WAIT_L(0); PG8_BAR; PG8_MMA(0, 0, At, B0); PG8_MMA(0, 1, At, B1); PG8_BAR; PG8_SCHED;
            PG8_LDA(At, 1, 1); PG8_STAGE(PG8_SB(1, 0), b3, voffB); PG8_STAGE(PG8_SB(1, 1), b3 + hstep, voffB); PG8_STAGE(PG8_SA(1, 0), a3, voffA);
            PG8_WAIT_V(8); PG8_WAIT_L(0); PG8_BAR; PG8_MMA(1, 0, At, B0); PG8_MMA(1, 1, At, B1); PG8_BAR; PG8_SCHED;
            } else {
            PG8_LDB(B0, 0, 0); PG8_SCHED; PG8_LDA(At, 0, 0); PG8_STAGE(PG8_SA(1, 1), a1 + hstep, voffA);
            PG8_WAIT_L(8); PG8_BAR; PG8_WAIT_L(0); PG8_MMA(0, 0, At, B0); PG8_BAR; PG8_SCHED;
            PG8_LDB(B1, 0, 1); PG8_STAGE(PG8_SB(0, 0), b2, voffB);
            PG8_BAR; PG8_WAIT_L(0); PG8_MMA(0, 1, At, B1); PG8_BAR;
            PG8_LDA(At, 0, 1); PG8_STAGE(PG8_SA(0, 0), a2, voffA);
            PG8_BAR; PG8_WAIT_L(0); PG8_MMA(1, 0, At, B0); PG8_BAR; PG8_SCHED;
            PG8_STAGE(PG8_SB(0, 1), b2 + hstep, voffB);
            PG8_WAIT_V(6); PG8_BAR; PG8_MMA(1, 1, At, B1); PG8_BAR;
            PG8_LDB(B0, 1, 0); PG8_SCHED; PG8_LDA(At, 1, 0); PG8_STAGE(PG8_SA(0, 1), a2 + hstep, voffA);
            PG8_WAIT_L(8); PG8_BAR; PG8_WAIT_L(0); PG8_MMA(0, 0, At, B0); PG8_BAR; PG8_SCHED;
            PG8_LDB(B1, 1, 1); PG8_STAGE(PG8_SB(1, 0), b3, voffB);
            PG8_BAR; PG8_WAIT_L(0); PG8_MMA(0, 1, At, B1); PG8_BAR;
            PG8_LDA(At, 1, 1); PG8_STAGE(PG8_SA(1, 0), a3, voffA);
            PG8_BAR; PG8_WAIT_L(0); PG8_MMA(1, 0, At, B0); PG8_BAR; PG8_SCHED;
            PG8_STAGE(PG8_SB(1, 1), b3 + hstep, voffB);
            PG8_WAIT_V(6); PG8_BAR; PG8_MMA(1, 1, At, B1); PG8_BAR;
            }
        }
        if constexpr (ALIGN_EPI) { if (wr == 0) PG8_BAR; }
        if constexpr (!Epi::AFTER_DRAIN) { E(acc, cur, wr, wc, fr, fq); S.done(cur); }
        if (!has_next) break;
#pragma unroll
        for (int a = 0; a < 2; ++a)
#pragma unroll
            for (int b = 0; b < 2; ++b)
#pragma unroll
                for (int m = 0; m < 4; ++m)
#pragma unroll
                    for (int n = 0; n < 2; ++n) acc[a][b][m][n] = (f32x4){0.f, 0.f, 0.f, 0.f};
        cur = nxt; cA = nA; cB = nB; ++ui;
        if constexpr (ALIGN_EPI) { if (wr == 1) PG8_BAR; }
    }
    PG8_WAIT_V(0);
    if constexpr (!ALIGN_EPI) { if (wr == 0) PG8_BAR; }
    PG8_BAR;
    if constexpr (Epi::AFTER_DRAIN) { E.fused(acc, cur, wr, wc, fr, fq, lds, wid, lane); S.done(cur); }
#undef PG8_SA
#undef PG8_SB
#undef PG8_STAGE
#undef PG8_LDA
#undef PG8_LDB
#undef PG8_MMA
#undef PG8_WAIT_V
#undef PG8_WAIT_L
#undef PG8_BAR
#undef PG8_SCHED
}
}

#define GAS __attribute__((address_space(1)))
#define LAS __attribute__((address_space(3)))
typedef unsigned short bf16_t;
typedef float f32x4 __attribute__((ext_vector_type(4)));
typedef float f32x16 __attribute__((ext_vector_type(16)));
typedef short bf16x8 __attribute__((ext_vector_type(8)));
typedef unsigned u32x4 __attribute__((ext_vector_type(4)));
typedef unsigned u32x2 __attribute__((ext_vector_type(2)));

#ifndef NLAYER_V
#define NLAYER_V 4
#endif
constexpr int NW = 8, NTHR = 512;
constexpr int MTOK = 32768, DM = 1024, SEQ = 4096, NB = 8, NLAYER = NLAYER_V, NH = 8;
constexpr int DIN = 9232, DFF = 2816, DPLE = 256;
constexpr float EPS = 1e-6f;
constexpr float LOG2E = 1.4426950408889634f;
constexpr size_t MiB = 1u << 20;
constexpr size_t WS_SS = 0;
constexpr size_t WS_CTL = 1792 * 1024;
constexpr size_t WS_UHALO = 1856 * 1024;
constexpr size_t WS_GB = 2 * MiB;
constexpr size_t WS_HALO = 4 * MiB;
constexpr size_t WS_PB = 14 * MiB;
constexpr size_t WS_W = 30 * MiB;
constexpr size_t W_IN = WS_W, W_V = W_IN + (size_t)6400 * 1024 * 2, W_GL = W_V + 2 * MiB, W_BRA = W_GL + 4 * MiB, W_BRB = W_BRA + 2 * MiB,
                 W_OUT = W_BRB + 2 * MiB, W_UP = W_OUT + 2 * MiB, W_DOWN = W_UP + 11 * MiB, W_PG = W_DOWN + (size_t)1024 * 2816 * 2, W_PP = W_PG + 2 * MiB, W_END = W_PP + (size_t)1024 * 256 * 2;
static_assert(W_END <= 74 * MiB, "weights region");
constexpr size_t WS_XB = 74 * MiB;
constexpr size_t WS_MIX = 138 * MiB;
constexpr size_t S64 = 64 * MiB;
constexpr size_t WS_QA = WS_MIX, WS_KA = WS_MIX + S64, WS_VT = WS_MIX + 2 * S64, WS_QB = WS_MIX + 3 * S64, WS_KB = WS_MIX + 4 * S64, WS_VB = WS_MIX + 5 * S64, WS_ZB = WS_MIX + 6 * S64;
constexpr size_t WS_TOTAL = WS_MIX + 7 * S64;
#ifdef DN_NAIVE
constexpr size_t WS_G = WS_KB, WS_TMPA = WS_KA, WS_MIXED = WS_VT, WS_OSRC = WS_QB;
#else
constexpr size_t WS_G = WS_KA, WS_TMPA = WS_KB, WS_MIXED = WS_VB, WS_OSRC = WS_VB;
#endif
constexpr int LDS_BYTES = 147456, LDS_VB = 140032;

__device__ __forceinline__ float bflo(unsigned w) { return __uint_as_float(w << 16); }
__device__ __forceinline__ float bfhi(unsigned w) { return __uint_as_float(w & 0xffff0000u); }
__device__ __forceinline__ float bf2f(bf16_t v) { return __uint_as_float((unsigned)v << 16); }
typedef float f32x2_t __attribute__((ext_vector_type(2))); typedef __bf16 bf16x2_t __attribute__((ext_vector_type(2)));
__device__ __forceinline__ unsigned pk2(float lo, float hi) { const f32x2_t v = {lo, hi}; const bf16x2_t b = __builtin_convertvector(v, bf16x2_t); return __builtin_bit_cast(unsigned, b); }
__device__ __forceinline__ bf16_t f2bf(float f) { return (bf16_t)(pk2(f, 0.f) & 0xffffu); }
__device__ __forceinline__ float sigmoidf_(float x) { x = fminf(fmaxf(x, -60.f), 60.f); return __builtin_amdgcn_rcpf(1.f + __expf(-x)); }
__device__ __forceinline__ float siluf_(float x) { return x * sigmoidf_(x); }
__device__ __forceinline__ float wave_sum(float v) {
#pragma unroll
    for (int o = 1; o < 64; o <<= 1) v += __shfl_xor(v, o);
    return v;
}
__device__ __forceinline__ float ss_load(const float* p) { const f32x4 a = *(const f32x4*)p, b = *(const f32x4*)(p + 4), c = *(const f32x4*)(p + 8), d = *(const f32x4*)(p + 12);
    float s = (((a[0] + a[1]) + (a[2] + a[3])) + ((b[0] + b[1]) + (b[2] + b[3]))) + (((c[0] + c[1]) + (c[2] + c[3])) + ((d[0] + d[1]) + (d[2] + d[3])));
    asm volatile("" : "+v"(s) :: "memory");
    return s; }
__device__ __forceinline__ u32x4 ldc16(const void* p) { u32x4 v; asm volatile("global_load_dwordx4 %0, %1, off sc0 sc1\n\ts_waitcnt vmcnt(0)" : "=v"(v) : "v"(p) : "memory"); return v; }
__device__ __forceinline__ int crow(int r, int hi) { return (r & 3) + 8 * (r >> 2) + 4 * hi; }

__device__ __forceinline__ int gmap(int row, int h) { return h < 0 ? row : ((row >> 11) * 4096 + 2048 * h + (row & 2047)); }

using pg8::Unit;
typedef f32x4 AccT[2][2][4][2];

template <int ACT> struct EpiRowScale {
    static constexpr bool PERM = true, AFTER_DRAIN = false;
    bf16_t* O; int ldc; const float* ss; int hmap;
    __device__ __forceinline__ void operator()(const AccT& acc, const Unit& u, int wr, int wc, int fr, int fq) const {
        const int row0 = u.pm * 256 + wr * 64 + fr, col0 = u.pn * 256 + wc * 32 + 8 * fq;
#pragma unroll
        for (int ai = 0; ai < 2; ++ai)
#pragma unroll
            for (int m = 0; m < 4; ++m) {
                const int row = row0 + ai * 128 + m * 16;
#ifdef RS_CONST
                const float rs = 1000.f;
#else
                const float rs = rsqrtf(ss_load(ss + (size_t)gmap(row, hmap) * 16) * (1.f / 1024.f) + EPS);
#endif
                bf16_t* rowp = O + (size_t)row * ldc + col0;
#pragma unroll
                for (int bj = 0; bj < 2; ++bj) {
                    f32x4 v0 = acc[ai][bj][m][0] * rs, v1 = acc[ai][bj][m][1] * rs;
                    if (ACT == 1) {
#pragma unroll
                        for (int e = 0; e < 4; ++e) { v0[e] = sigmoidf_(v0[e]); v1[e] = sigmoidf_(v1[e]); }
                    }
                    u32x4 w; w.x = pk2(v0[0], v0[1]); w.y = pk2(v0[2], v0[3]); w.z = pk2(v1[0], v1[1]); w.w = pk2(v1[2], v1[3]);
                    *(u32x4*)(rowp + bj * 128) = w;
                    asm volatile("" ::: "memory");
                }
            }
    }
};

struct EpiVt {
    static constexpr bool PERM = true, AFTER_DRAIN = false;
    bf16_t* O; const float* ss;
    __device__ __forceinline__ void operator()(const AccT& acc, const Unit& u, int wr, int wc, int fr, int fq) const {
        const int row0 = u.pm * 256 + wr * 64 + fr, col0 = u.pn * 256 + wc * 32 + 8 * fq;
        float rs[2][8];
#pragma unroll
        for (int bj = 0; bj < 2; ++bj)
#pragma unroll
            for (int e = 0; e < 8; ++e) rs[bj][e] = rsqrtf(ss_load(ss + (size_t)(col0 + bj * 128 + e) * 16) * (1.f / 1024.f) + EPS);
#pragma unroll
        for (int ai = 0; ai < 2; ++ai)
#pragma unroll
            for (int m = 0; m < 4; ++m) {
                const int row = row0 + ai * 128 + m * 16;
                bf16_t* rowp = O + (size_t)row * MTOK + col0;
#pragma unroll
                for (int bj = 0; bj < 2; ++bj) {
                    const f32x4 v0 = acc[ai][bj][m][0], v1 = acc[ai][bj][m][1];
                    u32x4 w; w.x = pk2(v0[0] * rs[bj][0], v0[1] * rs[bj][1]); w.y = pk2(v0[2] * rs[bj][2], v0[3] * rs[bj][3]);
                    w.z = pk2(v1[0] * rs[bj][4], v1[1] * rs[bj][5]); w.w = pk2(v1[2] * rs[bj][6], v1[3] * rs[bj][7]);
                    *(u32x4*)(rowp + bj * 128) = w;
                }
                asm volatile("" ::: "memory");
            }
    }
};

struct EpiGateMul {
    static constexpr bool PERM = true, AFTER_DRAIN = false;
    bf16_t* O; const bf16_t* G; int ldg, goff; const bf16_t* Add;
    __device__ __forceinline__ void operator()(const AccT& acc, const Unit& u, int wr, int wc, int fr, int fq) const {
        const int row0 = u.pm * 256 + wr * 64 + fr, col0 = u.pn * 256 + wc * 32 + 8 * fq;
#pragma unroll
        for (int ai = 0; ai < 2; ++ai)
#pragma unroll
            for (int m = 0; m < 4; ++m) {
                const int row = row0 + ai * 128 + m * 16;
#pragma unroll
                for (int bj = 0; bj < 2; ++bj) {
                    const int c = col0 + bj * 128;
                    const u32x4 g = *(const u32x4*)(G + (size_t)row * ldg + goff + c);
                    u32x4 a = (u32x4){0u, 0u, 0u, 0u};
                    if (Add) a = *(const u32x4*)(Add + (size_t)row * 1024 + c);
                    const f32x4 v0 = acc[ai][bj][m][0], v1 = acc[ai][bj][m][1];
                    u32x4 w;
                    w.x = pk2(bflo(a.x) + bflo(g.x) * v0[0], bfhi(a.x) + bfhi(g.x) * v0[1]);
                    w.y = pk2(bflo(a.y) + bflo(g.y) * v0[2], bfhi(a.y) + bfhi(g.y) * v0[3]);
                    w.z = pk2(bflo(a.z) + bflo(g.z) * v1[0], bfhi(a.z) + bfhi(g.z) * v1[1]);
                    w.w = pk2(bflo(a.w) + bflo(g.w) * v1[2], bfhi(a.w) + bfhi(g.w) * v1[3]);
                    *(u32x4*)(O + (size_t)row * 1024 + c) = w;
                }
                asm volatile("" ::: "memory");
            }
    }
};

struct EpiResid {
    static constexpr bool PERM = true, AFTER_DRAIN = false;
    float* X; bf16_t* XB; float* ssn; const bf16_t* Mul; int hmap;
    __device__ __forceinline__ void operator()(const AccT& acc, const Unit& u, int wr, int wc, int fr, int fq) const {
        const int row0 = u.pm * 256 + wr * 64 + fr, col0 = u.pn * 256 + wc * 32 + 8 * fq;
#pragma unroll
        for (int ai = 0; ai < 2; ++ai)
#pragma unroll
            for (int m = 0; m < 4; ++m) {
                const int row = gmap(row0 + ai * 128 + m * 16, hmap);
                float sq = 0.f;
#pragma unroll
                for (int bj = 0; bj < 2; ++bj)
#pragma unroll
                    for (int n = 0; n < 2; ++n) {
                        const size_t off = (size_t)row * 1024 + col0 + bj * 128 + 4 * n;
                        f32x4 x0 = *(const f32x4*)(X + off);
                        f32x4 v0 = acc[ai][bj][m][n];
                        if (Mul) { const u32x2 g = *(const u32x2*)(Mul + off); v0[0] *= bflo(g.x); v0[1] *= bfhi(g.x); v0[2] *= bflo(g.y); v0[3] *= bfhi(g.y); }
                        x0 += v0;
                        *(f32x4*)(X + off) = x0;
                        u32x2 w; w.x = pk2(x0[0], x0[1]); w.y = pk2(x0[2], x0[3]);
                        *(u32x2*)(XB + off) = w;
                        sq += (x0[0] * x0[0] + x0[1] * x0[1]) + (x0[2] * x0[2] + x0[3] * x0[3]);
                        asm volatile("" ::: "memory");
                    }
                sq += __shfl_xor(sq, 16); sq += __shfl_xor(sq, 32);
                if (fq == 0) ssn[(size_t)row * 16 + u.pn * 4 + wc] = sq;
                asm volatile("" ::: "memory");
            }
    }
};

struct EpiQK {
    static constexpr bool PERM = true, AFTER_DRAIN = false;
    unsigned char* ws; const float* ss; const float* qg; const float* kg;
    __device__ __forceinline__ void operator()(const AccT& acc, const Unit& u, int wr, int wc, int fr, int fq) const {
        const int row0 = u.pm * 256 + wr * 64 + fr;
        const int seg = u.pn >> 2, tl = u.pn & 3;
        bf16_t* base = (bf16_t*)(ws + (seg == 0 ? WS_QA : WS_KA));
        const float* gp = seg == 0 ? qg : kg; const float osc = seg == 0 ? 0.125f * LOG2E : 1.0f;
        const int col0 = tl * 256 + 64 * wc + 8 * fq;
#pragma unroll
        for (int ai = 0; ai < 2; ++ai)
#pragma unroll
            for (int m = 0; m < 4; ++m) {
                const int row = row0 + ai * 128 + m * 16;
                const float rs = rsqrtf(ss_load(ss + (size_t)row * 16) * (1.f / 1024.f) + EPS);
                f32x4 v[2][2]; float sq = 0.f;
#pragma unroll
                for (int bj = 0; bj < 2; ++bj)
#pragma unroll
                    for (int n = 0; n < 2; ++n) { v[bj][n] = acc[ai][bj][m][n] * rs; const f32x4 t = v[bj][n]; sq += (t[0] * t[0] + t[1] * t[1]) + (t[2] * t[2] + t[3] * t[3]); }
                sq += __shfl_xor(sq, 16); sq += __shfl_xor(sq, 32);
                const float r2o = rsqrtf(sq * (1.f / 64.f) + EPS) * osc;
#pragma unroll
                for (int bj = 0; bj < 2; ++bj) {
                    const f32x4 ga = *(const f32x4*)(gp + 32 * bj + 8 * fq), gb = *(const f32x4*)(gp + 32 * bj + 8 * fq + 4);
                    u32x4 w;
                    w.x = pk2(v[bj][0][0] * r2o * ga[0], v[bj][0][1] * r2o * ga[1]); w.y = pk2(v[bj][0][2] * r2o * ga[2], v[bj][0][3] * r2o * ga[3]);
                    w.z = pk2(v[bj][1][0] * r2o * gb[0], v[bj][1][1] * r2o * gb[1]); w.w = pk2(v[bj][1][2] * r2o * gb[2], v[bj][1][3] * r2o * gb[3]);
                    *(u32x4*)(base + (size_t)row * 1024 + col0 + 32 * bj) = w;
                }
                asm volatile("" ::: "memory");
            }
    }
};
struct EpiSeg {
    static constexpr bool PERM = true, AFTER_DRAIN = false;
    unsigned char* ws; const float* ss;
    __device__ __forceinline__ void operator()(const AccT& acc, const Unit& u, int wr, int wc, int fr, int fq) const {
        const int row0 = u.pm * 256 + wr * 64 + fr;
        bf16_t* base = (bf16_t*)(ws + WS_QB + (size_t)(u.pn >> 2) * S64);
        const int col0 = (u.pn & 3) * 256 + wc * 32 + 8 * fq;
#pragma unroll
        for (int ai = 0; ai < 2; ++ai)
#pragma unroll
            for (int m = 0; m < 4; ++m) {
                const int row = row0 + ai * 128 + m * 16;
                const float rs = rsqrtf(ss_load(ss + (size_t)row * 16) * (1.f / 1024.f) + EPS);
#pragma unroll
                for (int bj = 0; bj < 2; ++bj) {
                    const f32x4 v0 = acc[ai][bj][m][0] * rs, v1 = acc[ai][bj][m][1] * rs;
                    u32x4 w; w.x = pk2(v0[0], v0[1]); w.y = pk2(v0[2], v0[3]); w.z = pk2(v1[0], v1[1]); w.w = pk2(v1[2], v1[3]);
                    *(u32x4*)(base + (size_t)row * 1024 + col0 + bj * 128) = w;
                }
                asm volatile("" ::: "memory");
            }
    }
};
struct EpiGB {
    static constexpr bool PERM = true, AFTER_DRAIN = false;
    unsigned char* ws; const float* ss; const float* a_log; const float* dt_bias;
    __device__ __forceinline__ void operator()(const AccT& acc, const Unit& u, int wr, int wc, int fr, int fq) const {
        const int row0 = u.pm * 256 + wr * 64 + fr;
        if (wc == 0 && fq < 2) {
            float* GBp = (float*)(ws + WS_GB);
#pragma unroll
            for (int ai = 0; ai < 2; ++ai)
#pragma unroll
                for (int m = 0; m < 4; ++m) {
                    const int row = row0 + ai * 128 + m * 16;
                    const float rs = rsqrtf(ss_load(ss + (size_t)row * 16) * (1.f / 1024.f) + EPS);
                    float v[8];
#pragma unroll
                    for (int e = 0; e < 4; ++e) { v[e] = acc[ai][0][m][0][e] * rs; v[4 + e] = acc[ai][0][m][1][e] * rs; }
                    if (fq == 0) {
#pragma unroll
                        for (int e = 0; e < 8; ++e) v[e] = sigmoidf_(v[e]);
                    } else {
#pragma unroll
                        for (int e = 0; e < 8; ++e) { const float z = v[e] + dt_bias[e]; const float sp = fmaxf(z, 0.f) + __logf(1.f + __expf(-fabsf(z))); v[e] = -__expf(a_log[e]) * sp; }
                    }
                    float* dst = GBp + (size_t)row * 16 + 8 * fq;
                    *(f32x4*)dst = (f32x4){v[0], v[1], v[2], v[3]}; *(f32x4*)(dst + 4) = (f32x4){v[4], v[5], v[6], v[7]};
                    asm volatile("" ::: "memory");
                }
        }
    }
};

__device__ __forceinline__ void cvt_item(const float* W, int ldw, int src_col0, int nvalid, const float* gain, bf16_t* WT, int K, int dst_row0, int k0, LAS float* scr, int lane) {
    const int nn = lane & 31;
#pragma unroll 8
    for (int i = 0; i < 32; ++i) {
        const int kk = 2 * i + (lane >> 5);
        float v = 0.f;
        if (nn < nvalid) { v = W[(size_t)(k0 + kk) * ldw + src_col0 + nn]; if (gain) v *= gain[k0 + kk]; }
        scr[kk * 33 + nn] = v;
    }
    asm volatile("s_waitcnt lgkmcnt(0)" ::: "memory");
    const int c = lane & 7;
#pragma unroll
    for (int j = 0; j < 4; ++j) {
        const int n = (lane >> 3) + 8 * j; const LAS float* s = scr + (8 * c) * 33 + n;
        u32x4 o; o.x = pk2(s[0 * 33], s[1 * 33]); o.y = pk2(s[2 * 33], s[3 * 33]); o.z = pk2(s[4 * 33], s[5 * 33]); o.w = pk2(s[6 * 33], s[7 * 33]);
        *(u32x4*)(WT + (size_t)(dst_row0 + n) * K + k0 + 8 * c) = o;
    }
    asm volatile("s_waitcnt lgkmcnt(0)" ::: "memory");
}

struct Params {
    const float* in[24];
    float* out;
    unsigned char* ws;
    int seg_lo, seg_hi;
};
enum { I_X = 0, I_P, I_WIN, I_ATTN_NORM, I_QNORM, I_KNORM, I_LAM, I_SUBLN, I_RELB, I_CONVB, I_ALOG, I_DTB, I_ONORM, I_WBRA, I_WBRB, I_WOUT, I_FFN_NORM, I_WUP, I_CONVFF, I_CONVFFB, I_WDOWN, I_PLE_NORM, I_WPG, I_WPP };

__device__ __forceinline__ void convert_weights(const Params* PQ, int layer, LAS unsigned char* lds, int gw, int NGW, int wave, int lane) {
    LAS float* scr = (LAS float*)(lds + wave * 16384);
    unsigned char* ws = PQ->ws;
    const float* w_in = PQ->in[I_WIN] + (size_t)layer * 1024 * DIN;
    const float* g_attn = PQ->in[I_ATTN_NORM] + layer * 1024;
    const float* g_ffn = PQ->in[I_FFN_NORM] + layer * 1024;
    const float* g_ple = PQ->in[I_PLE_NORM] + layer * 1024;
#define CVT_JOB(NITEMS, KB, SRCW, LDW, GAIN, DST, KK, SRCCOL, NVALID) \
    for (int it = gw; it < (NITEMS); it += NGW) { const int g = it / (KB), kb = it % (KB); (void)g; \
        cvt_item((SRCW), (LDW), (SRCCOL), (NVALID), (GAIN), (bf16_t*)(ws + (DST)), (KK), g * 32, kb * 64, scr, lane); } asm volatile("" ::: "memory");
    for (int it = gw; it < 200 * 16; it += NGW) {
        const int g = it >> 4, kb = it & 15, pn = g >> 3, gi = g & 7;
        int src, nv = 32;
        if (pn < 8) { const int bj = gi >> 2, wc = gi & 3; src = (pn >> 2) * 1024 + (pn & 3) * 256 + 64 * wc + 32 * bj; }
        else if (pn < 24) { src = 3072 + (pn - 8) * 256 + 32 * gi; }
        else { src = 7168; nv = (gi == 0) ? 16 : 0; }
        cvt_item(w_in, DIN, src, nv, g_attn, (bf16_t*)(ws + W_IN), 1024, g * 32, kb * 64, scr, lane);
    }
    asm volatile("" ::: "memory");
    CVT_JOB(32 * 16, 16, w_in, DIN, g_attn, W_V, 1024, 2048 + g * 32, 32)
    CVT_JOB(64 * 16, 16, w_in, DIN, g_attn, W_GL, 1024, 7184 + g * 32, 32)
    CVT_JOB(32 * 16, 16, PQ->in[I_WBRA] + (size_t)layer * 1024 * 1024, 1024, (const float*)nullptr, W_BRA, 1024, g * 32, 32)
    CVT_JOB(32 * 16, 16, PQ->in[I_WBRB] + (size_t)layer * 1024 * 1024, 1024, (const float*)nullptr, W_BRB, 1024, g * 32, 32)
    CVT_JOB(32 * 16, 16, PQ->in[I_WOUT] + (size_t)layer * 1024 * 1024, 1024, (const float*)nullptr, W_OUT, 1024, g * 32, 32)
    CVT_JOB(176 * 16, 16, PQ->in[I_WUP] + (size_t)layer * 1024 * 5632, 5632, g_ffn, W_UP, 1024, g * 32, 32)
    CVT_JOB(32 * 44, 44, PQ->in[I_WDOWN] + (size_t)layer * 2816 * 1024, 1024, (const float*)nullptr, W_DOWN, 2816, g * 32, 32)
    CVT_JOB(32 * 16, 16, PQ->in[I_WPG] + (size_t)layer * 1024 * 1024, 1024, g_ple, W_PG, 1024, g * 32, 32)
    CVT_JOB(32 * 4, 4, PQ->in[I_WPP] + (size_t)layer * 256 * 1024, 1024, (const float*)nullptr, W_PP, 256, g * 32, 32)
#undef CVT_JOB
}

constexpr int AT_KROW = 272, AT_VROW = 144, AT_KBYTES = 64 * AT_KROW, AT_VBYTES = 128 * AT_VROW, AT_STAGE = AT_KBYTES + AT_VBYTES, AT_TB = 2 * AT_STAGE;
static_assert(AT_TB >= 65536 && AT_TB + 1024 <= LDS_BYTES, "attention LDS");
__device__ __forceinline__ void attn_unit(LAS unsigned char* lds, const bf16_t* QA, const bf16_t* KA, const bf16_t* VT, bf16_t* OA, int b, int h, int qb,
                                          float lam, float out_scale, const float* subln, const float* relb, int tid) {
    const int lane = tid & 63, wid = __builtin_amdgcn_readfirstlane(tid >> 6), j = wid >> 2, wq = wid & 3, r32 = lane & 31, hi = lane >> 5;
    const int Q0 = qb * 128, qrow = Q0 + 32 * wq + r32;
    const size_t tok = (size_t)b * SEQ + qrow;
    LAS float* TB = (LAS float*)(lds + AT_TB);
    for (int i = tid; i <= 128; i += NTHR) {
        float v = 0.f;
        if (i < 128) {
            int bk = i;
            if (i >= 16) { int lg = 16 + (int)(__logf((float)i * (1.f / 16.f)) / __logf(8.0f) * 16.f); bk = lg < 31 ? lg : 31; }
            v = (relb[bk * 8 + h] - relb[31 * 8 + h]) * LOG2E;
        }
        TB[i] = v;
    }
    bf16x8 qf[4];
#pragma unroll
    for (int d0 = 0; d0 < 4; ++d0) qf[d0] = *(const bf16x8*)(QA + tok * 1024 + h * 128 + 64 * j + 16 * d0 + 8 * hi);
    const int NT = (Q0 + 128) / 64;
    const int kr0 = tid >> 4, kc = tid & 15;
    const int vr0 = tid >> 3, vc = tid & 7;
    const bf16_t* kg = KA + ((size_t)b * SEQ + kr0) * 1024 + h * 128 + kc * 8;
    const bf16_t* vg = VT + (size_t)(h * 128 + vr0) * MTOK + (size_t)b * SEQ + vc * 8;
    u32x4 kreg0, kreg1, vreg0, vreg1;
#define AT_LOAD(t) do { kreg0 = *(const u32x4*)(kg + (size_t)(t) * 64 * 1024); kreg1 = *(const u32x4*)(kg + (size_t)((t) * 64 + 32) * 1024); \
        vreg0 = *(const u32x4*)(vg + (t) * 64); vreg1 = *(const u32x4*)(vg + (size_t)64 * MTOK + (t) * 64); } while (0)
#define AT_STORE(s) do { LAS unsigned char* kb_ = lds + (s) * AT_STAGE; LAS unsigned char* vb_ = kb_ + AT_KBYTES; \
        *(LAS u32x4*)(kb_ + kr0 * AT_KROW + kc * 16) = kreg0; *(LAS u32x4*)(kb_ + (kr0 + 32) * AT_KROW + kc * 16) = kreg1; \
        *(LAS u32x4*)(vb_ + vr0 * AT_VROW + vc * 16) = vreg0; *(LAS u32x4*)(vb_ + (vr0 + 64) * AT_VROW + vc * 16) = vreg1; } while (0)
    AT_LOAD(0); AT_STORE(0);
    __syncthreads();
    f32x16 o[4];
#pragma unroll
    for (int i = 0; i < 4; ++i)
#pragma unroll
        for (int r = 0; r < 16; ++r) o[i][r] = 0.f;
    float mrun = -INFINITY, lrun = 0.f;
    const int qmax_w = Q0 + 32 * wq + 31, qmin_w = Q0 + 32 * wq;
    for (int t = 0; t < NT; ++t) {
        if (t + 1 < NT) AT_LOAD(t + 1);
        const int kv0 = 64 * t;
        if (kv0 <= qmax_w) {
            const LAS unsigned char* Kb = lds + (t & 1) * AT_STAGE; const LAS unsigned char* Vb = Kb + AT_KBYTES;
            f32x16 s0, s1;
#pragma unroll
            for (int r = 0; r < 16; ++r) { s0[r] = 0.f; s1[r] = 0.f; }
#pragma unroll
            for (int d0 = 0; d0 < 4; ++d0) {
                const bf16x8 a0 = *(const LAS bf16x8*)(Kb + r32 * AT_KROW + (64 * j + 16 * d0 + 8 * hi) * 2);
                const bf16x8 a1 = *(const LAS bf16x8*)(Kb + (32 + r32) * AT_KROW + (64 * j + 16 * d0 + 8 * hi) * 2);
                s0 = __builtin_amdgcn_mfma_f32_32x32x16_bf16(a0, qf[d0], s0, 0, 0, 0);
                s1 = __builtin_amdgcn_mfma_f32_32x32x16_bf16(a1, qf[d0], s1, 0, 0, 0);
            }
            if (kv0 + 63 + 128 > qmin_w) {
#pragma unroll
                for (int r = 0; r < 16; ++r) {
                    const int rel0 = qrow - (kv0 + crow(r, hi)), rel1 = rel0 - 32;
                    s0[r] = rel0 < 0 ? -INFINITY : s0[r] + TB[rel0 < 128 ? rel0 : 128];
                    s1[r] = rel1 < 0 ? -INFINITY : s1[r] + TB[rel1 < 128 ? rel1 : 128];
                }
            }
            float mx = fmaxf(s0[0], s1[0]);
#pragma unroll
            for (int r = 1; r < 16; ++r) mx = fmaxf(mx, fmaxf(s0[r], s1[r]));
            mx = fmaxf(mx, __shfl_xor(mx, 32));
            const float mnew = fmaxf(mrun, mx);
            const float alpha = __builtin_amdgcn_exp2f(mrun - mnew);
            mrun = mnew;
            float ls = 0.f;
#pragma unroll
            for (int r = 0; r < 16; ++r) { s0[r] = __builtin_amdgcn_exp2f(s0[r] - mnew); s1[r] = __builtin_amdgcn_exp2f(s1[r] - mnew); ls += s0[r] + s1[r]; }
            lrun = lrun * alpha + ls;
            if (__builtin_amdgcn_ballot_w64(alpha != 1.f) != 0ull) {
#pragma unroll
                for (int i = 0; i < 4; ++i)
#pragma unroll
                    for (int r = 0; r < 16; ++r) o[i][r] *= alpha;
            }
            bf16x8 pf[4];
            { u32x4 w;
              w.x = pk2(s0[0], s0[1]); w.y = pk2(s0[2], s0[3]); w.z = pk2(s0[4], s0[5]); w.w = pk2(s0[6], s0[7]); pf[0] = __builtin_bit_cast(bf16x8, w);
              w.x = pk2(s0[8], s0[9]); w.y = pk2(s0[10], s0[11]); w.z = pk2(s0[12], s0[13]); w.w = pk2(s0[14], s0[15]); pf[1] = __builtin_bit_cast(bf16x8, w);
              w.x = pk2(s1[0], s1[1]); w.y = pk2(s1[2], s1[3]); w.z = pk2(s1[4], s1[5]); w.w = pk2(s1[6], s1[7]); pf[2] = __builtin_bit_cast(bf16x8, w);
              w.x = pk2(s1[8], s1[9]); w.y = pk2(s1[10], s1[11]); w.z = pk2(s1[12], s1[13]); w.w = pk2(s1[14], s1[15]); pf[3] = __builtin_bit_cast(bf16x8, w); }
#pragma unroll
            for (int blk = 0; blk < 4; ++blk)
#pragma unroll
                for (int s = 0; s < 4; ++s) {
                    const LAS unsigned char* vp = Vb + (32 * blk + r32) * AT_VROW + (16 * s + 4 * hi) * 2;
                    const u32x2 lo = *(const LAS u32x2*)vp, hh = *(const LAS u32x2*)(vp + 16);
                    const u32x4 w = (u32x4){lo.x, lo.y, hh.x, hh.y};
                    o[blk] = __builtin_amdgcn_mfma_f32_32x32x16_bf16(__builtin_bit_cast(bf16x8, w), pf[s], o[blk], 0, 0, 0);
                }
        }
        if (t + 1 < NT) AT_STORE((t + 1) & 1);
        __syncthreads();
    }
#undef AT_LOAD
#undef AT_STORE
    lrun += __shfl_xor(lrun, 32);
    const float inv = 1.f / lrun;
    LAS float* EX = (LAS float*)lds;
    if (j == 1) {
        const float sc = inv * lam;
#pragma unroll
        for (int blk = 0; blk < 4; ++blk)
#pragma unroll
            for (int r = 0; r < 16; ++r) EX[(wq * 64 + blk * 16 + r) * 64 + lane] = o[blk][r] * sc;
    }
    __syncthreads();
    if (j == 0) {
        float sq = 0.f;
#pragma unroll
        for (int blk = 0; blk < 4; ++blk)
#pragma unroll
            for (int r = 0; r < 16; ++r) { const float d = o[blk][r] * inv - EX[(wq * 64 + blk * 16 + r) * 64 + lane]; o[blk][r] = d; sq += d * d; }
        sq += __shfl_xor(sq, 32);
        const float rr = rsqrtf(sq * (1.f / 128.f) + EPS) * out_scale;
#pragma unroll
        for (int blk = 0; blk < 4; ++blk)
#pragma unroll
            for (int rq = 0; rq < 4; ++rq) {
                const int dv0 = 32 * blk + 8 * rq + 4 * hi;
                const f32x4 g = *(const f32x4*)(subln + dv0);
                u32x2 w; w.x = pk2(o[blk][4 * rq + 0] * rr * g[0], o[blk][4 * rq + 1] * rr * g[1]); w.y = pk2(o[blk][4 * rq + 2] * rr * g[2], o[blk][4 * rq + 3] * rr * g[3]);
                *(u32x2*)(OA + tok * 1024 + h * 128 + dv0) = w;
            }
    }
    __syncthreads();
}

__device__ __forceinline__ void dn_naive(LAS unsigned char* lds, unsigned char* ws, const float* convw  , int b, int h, int tid) {
    const int lane = tid & 63, wid = tid >> 6, dv = tid & 127, g4 = tid >> 7;
    LAS float* Y = (LAS float*)lds;
    LAS float* NR = Y + 384;
    LAS float* PT = NR + 8;
    LAS float* OP = PT + 512;
    float S[32];
#pragma unroll
    for (int i = 0; i < 32; ++i) S[i] = 0.f;
    bf16_t* QB = (bf16_t*)(ws + WS_QB); const bf16_t* KB = (const bf16_t*)(ws + WS_KB); const bf16_t* VB = (const bf16_t*)(ws + WS_VB);
    const float* GBp = (const float*)(ws + WS_GB);
    const int arr = tid >> 7;
    const bf16_t* src = (arr == 0 ? (const bf16_t*)QB : arr == 1 ? KB : VB) + h * 128 + dv;
    float w0 = 0.f, w1 = 0.f, w2 = 0.f, w3 = 0.f, x1 = 0.f, x2 = 0.f, x3 = 0.f;
    if (tid < 384) { const int ch = arr * 1024 + h * 128 + dv; w0 = convw[ch]; w1 = convw[3072 + ch]; w2 = convw[2 * 3072 + ch]; w3 = convw[3 * 3072 + ch]; }
    for (int t = 0; t < SEQ; ++t) {
        const size_t tok = (size_t)b * SEQ + t;
        if (tid < 384) {
            const float x0 = bf2f(src[tok * 1024]);
            float y = w0 * x3 + w1 * x2 + w2 * x1 + w3 * x0;
            y = siluf_(y); x3 = x2; x2 = x1; x1 = x0;
            Y[arr * 128 + dv] = y;
            const float sq = wave_sum(y * y);
            if (lane == 0) NR[wid] = sq;
        }
        __syncthreads();
        const float qn = rsqrtf(NR[0] + NR[1] + EPS) * 0.08838834764831845f, kn = rsqrtf(NR[2] + NR[3] + EPS);
        const float bt = GBp[tok * 16 + h], gt = GBp[tok * 16 + 8 + h], eg = __expf(gt);
        const float vv = Y[256 + dv];
        float ks = 0.f;
#pragma unroll
        for (int i = 0; i < 32; ++i) ks += Y[128 + 32 * g4 + i] * S[i];
        PT[g4 * 128 + dv] = ks * kn;
        __syncthreads();
        const float kS = (PT[dv] + PT[128 + dv]) + (PT[256 + dv] + PT[384 + dv]);
        const float c = bt * (vv - eg * kS);
        float op = 0.f;
#pragma unroll
        for (int i = 0; i < 32; ++i) { const float kk = Y[128 + 32 * g4 + i] * kn; S[i] = eg * S[i] + kk * c; op += Y[32 * g4 + i] * S[i]; }
        OP[g4 * 128 + dv] = op * qn;
        __syncthreads();
        if (g4 == 0) { const float ov = (OP[dv] + OP[128 + dv]) + (OP[256 + dv] + OP[384 + dv]); QB[tok * 1024 + h * 128 + dv] = f2bf(ov); }
    }
    __syncthreads();
}

__device__ __forceinline__ float row16_sum(float v) {
    v += __builtin_bit_cast(float, __builtin_amdgcn_update_dpp(0, __builtin_bit_cast(int, v), 0x128, 0xf, 0xf, false));
    v += __builtin_bit_cast(float, __builtin_amdgcn_update_dpp(0, __builtin_bit_cast(int, v), 0x124, 0xf, 0xf, false));
    v += __builtin_bit_cast(float, __builtin_amdgcn_update_dpp(0, __builtin_bit_cast(int, v), 0x122, 0xf, 0xf, false));
    v += __builtin_bit_cast(float, __builtin_amdgcn_update_dpp(0, __builtin_bit_cast(int, v), 0x121, 0xf, 0xf, false));
    return v;
}
__device__ __forceinline__ void dn_fast(LAS unsigned char* lds, unsigned char* ws, const float* convw  , int b, int h, int dvq, int tid) {
    const int lane = tid & 63, wid = tid >> 6, dvl = lane >> 4, grp = lane & 15;
    const int dvloc = 4 * wid + dvl, dv = 32 * dvq + dvloc;
    LAS float* Y = (LAS float*)lds;
    LAS float* NR = Y + 16 * 288;
    LAS float* GBs = NR + 16 * 16;
    LAS float* SC = GBs + 32;
    float S[8];
#pragma unroll
    for (int i = 0; i < 8; ++i) S[i] = 0.f;
    bf16_t* VB = (bf16_t*)(ws + WS_VB);
    const float* GBp = (const float*)(ws + WS_GB);
    const int arr = tid < 128 ? 0 : (tid < 256 ? 1 : 2);
    const int dch = arr == 2 ? 32 * dvq + ((tid - 256) & 31) : (tid & 127);
    const bf16_t* src = (const bf16_t*)(ws + (arr == 0 ? WS_QB : arr == 1 ? WS_KB : WS_VB)) + h * 128 + dch;
    float w0 = 0.f, w1 = 0.f, w2 = 0.f, w3 = 0.f, x1 = 0.f, x2 = 0.f, x3 = 0.f;
    if (tid < 288) { const int ch = arr * 1024 + h * 128 + dch; w0 = convw[ch]; w1 = convw[3072 + ch]; w2 = convw[2 * 3072 + ch]; w3 = convw[3 * 3072 + ch]; }
    bf16_t xr[16];
    if (tid < 288) {
#pragma unroll
        for (int tt = 0; tt < 16; ++tt) xr[tt] = src[((size_t)b * SEQ + tt) * 1024];
    }
    for (int t0 = 0; t0 < SEQ; t0 += 16) {
        const size_t tokb = (size_t)b * SEQ + t0;
        if (tid < 288) {
#pragma unroll
            for (int tt = 0; tt < 16; ++tt) {
                const float x0 = bf2f(xr[tt]);
                float y = w0 * x3 + w1 * x2 + w2 * x1 + w3 * x0;
                y = siluf_(y); x3 = x2; x2 = x1; x1 = x0;
                Y[tt * 288 + tid] = y;
                if (tid < 256) { const float sq = row16_sum(y * y); if ((lane & 15) == 0) NR[tt * 16 + wid * 4 + (lane >> 4)] = sq; }
            }
        }
        if (tid >= 480) { const int i = tid - 480, tt = i >> 1, which = i & 1; GBs[tt * 2 + which] = GBp[(tokb + tt) * 16 + which * 8 + h]; }
        __syncthreads();
        if (tid < 16) {
            const f32x4 a = *(const LAS f32x4*)(NR + tid * 16), b2 = *(const LAS f32x4*)(NR + tid * 16 + 4), c2 = *(const LAS f32x4*)(NR + tid * 16 + 8), d2 = *(const LAS f32x4*)(NR + tid * 16 + 12);
            const float sq_q = ((a[0] + a[1]) + (a[2] + a[3])) + ((b2[0] + b2[1]) + (b2[2] + b2[3])), sq_k = ((c2[0] + c2[1]) + (c2[2] + c2[3])) + ((d2[0] + d2[1]) + (d2[2] + d2[3]));
            *(LAS f32x4*)(SC + tid * 4) = (f32x4){rsqrtf(sq_q + EPS) * 0.08838834764831845f, rsqrtf(sq_k + EPS), __expf(GBs[tid * 2 + 1]), GBs[tid * 2]};
        }
        __syncthreads();
        if (tid < 288 && t0 + 16 < SEQ) {
#pragma unroll
            for (int tt = 0; tt < 16; ++tt) xr[tt] = src[(tokb + 16 + tt) * 1024];
        }
#pragma unroll 4
        for (int tt = 0; tt < 16; ++tt) {
            const f32x4 sc = *(const LAS f32x4*)(SC + tt * 4);
            const float qn = sc[0], kn = sc[1], eg = sc[2], bt = sc[3];
            const f32x4 ka = *(const LAS f32x4*)(Y + tt * 288 + 128 + 8 * grp), kb = *(const LAS f32x4*)(Y + tt * 288 + 128 + 8 * grp + 4);
            const f32x4 qa = *(const LAS f32x4*)(Y + tt * 288 + 8 * grp), qb = *(const LAS f32x4*)(Y + tt * 288 + 8 * grp + 4);
            const float vv = Y[tt * 288 + 256 + dvloc];
            float ks = (ka[0] * S[0] + ka[1] * S[1]) + (ka[2] * S[2] + ka[3] * S[3]) + (kb[0] * S[4] + kb[1] * S[5]) + (kb[2] * S[6] + kb[3] * S[7]);
            ks = row16_sum(ks);
            const float c = bt * (vv - eg * ks * kn) * kn;
            float op = 0.f;
#pragma unroll
            for (int i = 0; i < 4; ++i) { S[i] = eg * S[i] + ka[i] * c; op += qa[i] * S[i]; S[4 + i] = eg * S[4 + i] + kb[i] * c; op += qb[i] * S[4 + i]; }
            op = row16_sum(op);
            if (grp == 0) VB[(tokb + tt) * 1024 + h * 128 + dv] = f2bf(op * qn);
        }
        __syncthreads();
    }
}

#define GEMM_PHASE(EPI, Aptr, Bptr, Mv, Nv, Kv, Eobj, HM) do { int m_ = (Mv), n_ = (Nv), k_ = (Kv); asm volatile("" : "+s"(m_), "+s"(n_), "+s"(k_)); pg8::Gemm g_{(const pg8::bf16_t*)(Aptr), (const pg8::bf16_t*)(Bptr), m_, n_, k_, (HM)}; pg8::StaticOrder S_; S_.init(m_, n_, G, bid); \
        pg8::gemm_phase<EPI, pg8::StaticOrder, true, true>(lds, g_, S_, (Eobj)); } while (0)

__global__ void __launch_bounds__(NTHR, 2) fwd_mega(Params P) {
    extern __shared__ __attribute__((aligned(16))) unsigned char lds_raw[];
    LAS unsigned char* lds = (LAS unsigned char*)lds_raw;
    cg::grid_group grid = cg::this_grid();
    if (threadIdx.x == 0) {
        const unsigned xcc = (unsigned)__builtin_amdgcn_s_getreg((3 << 11) | 20) & 7u;
        const unsigned loc = __hip_atomic_fetch_add((unsigned*)(P.ws + WS_CTL) + xcc, 1u, __ATOMIC_RELAXED, __HIP_MEMORY_SCOPE_AGENT);
        *(LAS int*)(lds + LDS_VB) = (int)((loc & 31u) * 8u + xcc);
    }
    __syncthreads();
    int seg = 0; const int seg_lo = P.seg_lo, seg_hi = P.seg_hi;
#ifdef L2FLUSH
#define L2_FLUSH() do { const Params* PF = (const Params*)__builtin_amdgcn_kernarg_segment_ptr(); asm volatile("" : "+s"(PF)); int tf_ = threadIdx.x; asm volatile("" : "+v"(tf_)); \
        const u32x4* jp = (const u32x4*)(PF->in[I_P]) + (size_t)blockIdx.x * (L2FLUSH * 64) + tf_; unsigned acc_ = 0u; \
        for (int q_ = 0; q_ < L2FLUSH * 64 / 512; ++q_) { const u32x4 v_ = __builtin_nontemporal_load(jp + (size_t)q_ * 512); acc_ |= v_.x & v_.y & v_.z & v_.w; asm volatile("" ::: "memory"); } \
        if (acc_ == 0x12345678u) PF->out[0] = 0.f; } while (0)
#else
#define L2_FLUSH() do {} while (0)
#endif
#ifdef NOSEG
#define SYNCCOND true
#else
#define SYNCCOND (seg >= seg_lo && seg + 1 < seg_hi)
#endif
#define GRID_SYNC() do { if (SYNCCOND) { asm volatile("s_waitcnt vmcnt(0) lgkmcnt(0)" ::: "memory"); __builtin_amdgcn_fence(__ATOMIC_RELEASE, "agent"); grid.sync(); L2_FLUSH(); \
        __builtin_amdgcn_fence(__ATOMIC_ACQUIRE, "agent"); asm volatile("s_waitcnt vmcnt(0)" ::: "memory"); } ++seg; } while (0)
#ifdef NOSEG
#define SEGCOND true
#else
#define SEGCOND (seg >= seg_lo && seg < seg_hi)
#endif
#define PH_BEGIN if (SEGCOND) { const Params* PQ = (const Params*)__builtin_amdgcn_kernarg_segment_ptr(); asm volatile("" : "+s"(PQ)); int tid = threadIdx.x; asm volatile("" : "+v"(tid)); \
    const int lane = tid & 63, wave = __builtin_amdgcn_readfirstlane(tid >> 6); int bid = __builtin_amdgcn_readfirstlane(*(LAS int*)(lds + LDS_VB)), G = gridDim.x; asm volatile("" : "+s"(bid), "+s"(G)); \
    const int xb_ = bid & 7, jb_ = bid >> 3, wj = jb_ * NW + wave;     \
    unsigned char* ws = PQ->ws; float* X = PQ->out; float* SS = (float*)(ws + WS_SS); bf16_t* XB = (bf16_t*)(ws + WS_XB); \
    float* ss_attn = (float*)(ws + WS_HALO); float* ss_ffn = ss_attn + (size_t)MTOK * 16; float* ss_ple = ss_ffn + (size_t)MTOK * 16; float* ss_next = ss_attn; \
    (void)lane; (void)xb_; (void)jb_; (void)wj; (void)X; (void)XB; (void)ss_attn; (void)ss_ffn; (void)ss_ple; (void)ss_next; (void)G;
#define PH_END }
#define U ((bf16_t*)(ws + WS_MIX))
#define ACT ((bf16_t*)(ws + WS_MIX + 176 * MiB))

    { const int layer = 0; PH_BEGIN
      if (bid == 0 && tid == 0) __hip_atomic_store((unsigned*)(ws + WS_CTL) + 16, 0u, __ATOMIC_RELAXED, __HIP_MEMORY_SCOPE_AGENT);
      const float* xin = PQ->in[I_X];
      for (int r = wj; r < SEQ; r += 256) {
          const int m = xb_ * SEQ + r;
          const f32x4* xr = (const f32x4*)(xin + (size_t)m * 1024) + lane;
          f32x4 v[4]; float s = 0.f;
#pragma unroll
          for (int jj = 0; jj < 4; ++jj) { v[jj] = xr[64 * jj]; s += (v[jj][0] * v[jj][0] + v[jj][1] * v[jj][1]) + (v[jj][2] * v[jj][2] + v[jj][3] * v[jj][3]); }
          s = wave_sum(s);
          if (lane < 16) ss_attn[(size_t)m * 16 + lane] = lane == 0 ? s : 0.f;
          f32x4* xo = (f32x4*)(X + (size_t)m * 1024) + lane;
          u32x2* bo = (u32x2*)(XB + (size_t)m * 1024) + lane;
#pragma unroll
          for (int jj = 0; jj < 4; ++jj) { xo[64 * jj] = v[jj]; u32x2 w; w.x = pk2(v[jj][0], v[jj][1]); w.y = pk2(v[jj][2], v[jj][3]); bo[64 * jj] = w; }
      }
    PH_END }

    for (int layer = 0; layer < NLAYER; ++layer) {
        asm volatile("" ::: "memory");
        const float lam_init = 0.8f - 0.6f * __expf(-0.3f * (float)layer);
        PH_BEGIN
        convert_weights(PQ, layer, lds, bid * NW + wave, G * NW, wave, lane);
        { const float* pl = PQ->in[I_P] + ((size_t)layer * MTOK + (size_t)xb_ * SEQ) * DPLE;
          bf16_t* pb = (bf16_t*)(ws + WS_PB) + (size_t)xb_ * SEQ * DPLE;
          for (int i = jb_ * NTHR + tid; i < SEQ * DPLE / 8; i += 32 * NTHR) {
              const f32x4 a = *(const f32x4*)(pl + (size_t)i * 8), b = *(const f32x4*)(pl + (size_t)i * 8 + 4);
              u32x4 w; w.x = pk2(a[0], a[1]); w.y = pk2(a[2], a[3]); w.z = pk2(b[0], b[1]); w.w = pk2(b[2], b[3]);
              *(u32x4*)(pb + (size_t)i * 8) = w;
          }
        }
        PH_END
        GRID_SYNC();
#ifdef DBLTEST
#ifdef DBL_SC
#define DBL_LD(p) ldc16(p)
#else
#define DBL_LD(p) (*(p))
#endif
        if (layer == 0) {
#ifdef DBL_OUTP
        PH_BEGIN
        { EpiResid E{X, XB, ss_ffn, nullptr, -1};
          GEMM_PHASE(EpiResid, ws + WS_VT, ws + W_OUT, MTOK, 1024, 1024, E, -1); }
        PH_END
        GRID_SYNC();
#endif
        for (int rep = 0; rep < 2; ++rep) {
        PH_BEGIN
#ifdef DBL_COPY
            { const u32x4* s4 = (const u32x4*)XB; u32x4* d4 = (u32x4*)(ws + WS_MIX + (size_t)rep * 176 * MiB);
              const size_t per = (size_t)DBL_M * DBL_N * 2 / 16 / 8;
              for (size_t i = (size_t)((jb_ + rep * 13) & 31) * NTHR + tid; i < per; i += (size_t)32 * NTHR) d4[(size_t)xb_ * per + i] = DBL_LD(s4 + (size_t)xb_ * per + i); }
#else
#ifndef DBL_W
#define DBL_W W_UP
#define DBL_ACT 0
#endif
            { EpiRowScale<DBL_ACT> E{(bf16_t*)(ws + WS_MIX + (size_t)rep * DBL_OFF * MiB), DBL_N, ss_attn, DBL_H};
              GEMM_PHASE(EpiRowScale<DBL_ACT>, XB, ws + DBL_W, DBL_M, DBL_N, 1024, E, DBL_H); }
#endif
        PH_END
        GRID_SYNC();
        }
        PH_BEGIN
        { const u32x4* a4 = (const u32x4*)(ws + WS_MIX); const u32x4* b4 = (const u32x4*)(ws + WS_MIX + (size_t)DBL_OFF * MiB); unsigned bad = 0u;
          const size_t per = (size_t)DBL_M * DBL_N * 2 / 16 / 8;
          for (size_t i0 = (size_t)((jb_ + 7) & 31) * NTHR + tid; i0 < per; i0 += (size_t)32 * NTHR) { const size_t i = (size_t)xb_ * per + i0; const u32x4 a = DBL_LD(a4 + i), b = DBL_LD(b4 + i); bad |= ((a.x ^ b.x) | (a.y ^ b.y) | (a.z ^ b.z) | (a.w ^ b.w)) ? 1u : 0u; }
          if (bad) __hip_atomic_fetch_or((unsigned*)(ws + WS_CTL) + 16, 1u, __ATOMIC_RELAXED, __HIP_MEMORY_SCOPE_AGENT); }
        PH_END
        GRID_SYNC();
        }
#endif
#if defined(DBLMIX) && !defined(DBLMIX_AT_GATES)
        for (int rep = 0; rep < 2; ++rep) {
#endif
#ifndef NO_INPROJ
        PH_BEGIN
        { EpiQK E{ws, ss_attn, PQ->in[I_QNORM] + layer * 64, PQ->in[I_KNORM] + layer * 64};
          GEMM_PHASE(EpiQK, XB, ws + W_IN, MTOK, 2048, 1024, E, -1); }
        PH_END
        PH_BEGIN
        { EpiSeg E{ws, ss_attn};
          GEMM_PHASE(EpiSeg, XB, ws + W_IN + (size_t)2048 * 2048, MTOK, 4096, 1024, E, -1); }
        PH_END
        PH_BEGIN
        { EpiGB E{ws, ss_attn, PQ->in[I_ALOG] + layer * 8, PQ->in[I_DTB] + layer * 8};
          GEMM_PHASE(EpiGB, XB, ws + W_IN + (size_t)6144 * 2048, MTOK, 256, 1024, E, -1); }
        PH_END
        PH_BEGIN
        { EpiVt E{(bf16_t*)(ws + WS_VT), ss_attn};
          GEMM_PHASE(EpiVt, ws + W_V, XB, 1024, MTOK, 1024, E, -1); }
        PH_END
#endif
        GRID_SYNC();
#ifndef NO_ATTN
        PH_BEGIN
        { const float* lq = PQ->in[I_LAM] + layer * 256;
          const float a1 = wave_sum(lq[lane] * lq[64 + lane]), a2 = wave_sum(lq[128 + lane] * lq[192 + lane]);
          const float lam = __expf(a1) - __expf(a2) + lam_init;
          for (int k = 0; k < 4; ++k) {
              const int pi = jb_ + 32 * k, hh = pi >> 4, s = pi & 15;
              attn_unit(lds, (const bf16_t*)(ws + WS_QA), (const bf16_t*)(ws + WS_KA), (const bf16_t*)(ws + WS_VT), (bf16_t*)(ws + WS_QA), xb_, hh, 31 - s, lam, 1.f - lam_init, PQ->in[I_SUBLN] + layer * 128, PQ->in[I_RELB], tid);
              attn_unit(lds, (const bf16_t*)(ws + WS_QA), (const bf16_t*)(ws + WS_KA), (const bf16_t*)(ws + WS_VT), (bf16_t*)(ws + WS_QA), xb_, hh, s, lam, 1.f - lam_init, PQ->in[I_SUBLN] + layer * 128, PQ->in[I_RELB], tid);
          }
        }
        PH_END
#endif
#ifndef NO_DN
        PH_BEGIN
#ifdef DN_NAIVE
        if (jb_ < 8) dn_naive(lds, ws, PQ->in[I_CONVB] + (size_t)layer * 4 * 3072, xb_, jb_, tid);
#else
        dn_fast(lds, ws, PQ->in[I_CONVB] + (size_t)layer * 4 * 3072, xb_, jb_ >> 2, jb_ & 3, tid);
#endif
        PH_END
#endif
        GRID_SYNC();
#if defined(DBLMIX) && defined(DBLMIX_AT_GATES)
        for (int rep = 0; rep < 2; ++rep) {
#endif
#ifndef NO_GATES
        PH_BEGIN
        { EpiRowScale<1> E{(bf16_t*)(ws + WS_G), 2048, ss_attn, -1};
          GEMM_PHASE(EpiRowScale<1>, XB, ws + W_GL, MTOK, 2048, 1024, E, -1); }
        PH_END
#endif
#ifndef NO_OBNORM
        PH_BEGIN
        { const float* on = PQ->in[I_ONORM] + layer * 128;
          const float g0 = on[2 * lane], g1 = on[2 * lane + 1];
          unsigned* OB = (unsigned*)(ws + WS_QB) + (size_t)xb_ * SEQ * 512; const unsigned* OI = (const unsigned*)(ws + WS_OSRC) + (size_t)xb_ * SEQ * 512; const unsigned* ZB = (const unsigned*)(ws + WS_ZB) + (size_t)xb_ * SEQ * 512;
          for (int r = wj; r < SEQ * NH; r += 256) {
              const unsigned ov = OI[(size_t)r * 64 + lane], zv = ZB[(size_t)r * 64 + lane];
              const float o0 = bflo(ov), o1 = bfhi(ov);
              const float sq = wave_sum(o0 * o0 + o1 * o1);
              const float rr = rsqrtf(sq * (1.f / 128.f) + EPS);
              OB[(size_t)r * 64 + lane] = pk2(o0 * rr * g0 * siluf_(bflo(zv)), o1 * rr * g1 * siluf_(bfhi(zv)));
          }
        }
        PH_END
#endif
        GRID_SYNC();
#ifndef NO_TMPA
        PH_BEGIN
        { EpiGateMul E{(bf16_t*)(ws + WS_TMPA), (const bf16_t*)(ws + WS_G), 2048, 0, nullptr};
          GEMM_PHASE(EpiGateMul, ws + WS_QA, ws + W_BRA, MTOK, 1024, 1024, E, -1); }
        PH_END
#endif
        GRID_SYNC();
#ifndef NO_MIXED
        PH_BEGIN
        { EpiGateMul E{(bf16_t*)(ws + WS_MIXED), (const bf16_t*)(ws + WS_G), 2048, 1024, (const bf16_t*)(ws + WS_TMPA)};
          GEMM_PHASE(EpiGateMul, ws + WS_QB, ws + W_BRB, MTOK, 1024, 1024, E, -1); }
        PH_END
#endif
        GRID_SYNC();
#ifdef DBLMIX
        PH_BEGIN
        { const u32x4* t4 = (const u32x4*)(ws + (size_t)DBL_TGT + (size_t)xb_ * ((size_t)DBL_TGT_BYTES / 8)); u32x4* s4 = (u32x4*)(ws + WS_PB + (size_t)xb_ * 2 * MiB); unsigned bad = 0u;
          for (size_t i = (size_t)((jb_ + 5 * rep) & 31) * NTHR + tid; i < (size_t)2 * MiB / 16; i += (size_t)32 * NTHR) {
              const u32x4 a = t4[i];
              if (rep == 0) s4[i] = a; else { const u32x4 b = s4[i]; bad |= ((a.x ^ b.x) | (a.y ^ b.y) | (a.z ^ b.z) | (a.w ^ b.w)) ? 1u : 0u; } }
          if (bad) __hip_atomic_fetch_or((unsigned*)(ws + WS_CTL) + 16, 1u, __ATOMIC_RELAXED, __HIP_MEMORY_SCOPE_AGENT); }
        PH_END
        GRID_SYNC();
        }
#endif
#ifndef NO_OUTP
        PH_BEGIN
        { EpiResid E{X, XB, ss_ffn, nullptr, -1};
          GEMM_PHASE(EpiResid, ws + WS_MIXED, ws + W_OUT, MTOK, 1024, 1024, E, -1); }
        PH_END
#endif
        GRID_SYNC();
        for (int half = 0; half < 2; ++half) {
#ifndef NO_UP
        PH_BEGIN
            { EpiRowScale<0> E{U, 5632, ss_ffn, half};
              GEMM_PHASE(EpiRowScale<0>, XB, ws + W_UP, 16384, 5632, 1024, E, half); }
        PH_END
#endif
            GRID_SYNC();
#ifndef NO_ACT
        PH_BEGIN
            { const float* cw = PQ->in[I_CONVFF] + (size_t)layer * 3 * 5632; const float* cb = PQ->in[I_CONVFFB] + (size_t)layer * 5632;
              bf16_t* UH = (bf16_t*)(ws + WS_UHALO) + (size_t)xb_ * 2 * 5632;
              for (int it = jb_ * NTHR + tid; it < 128 * 352; it += 32 * NTHR) {
                  const int cc = it % 352, rg = it / 352, c0 = cc * 8;
                  const int lrow0 = xb_ * 2048 + rg * 16;
                  float wg[3][8], wv[3][8], bg[8], bv[8];
#pragma unroll
                  for (int jj = 0; jj < 3; ++jj)
#pragma unroll
                      for (int e = 0; e < 8; ++e) { wg[jj][e] = cw[jj * 5632 + c0 + e]; wv[jj][e] = cw[jj * 5632 + 2816 + c0 + e]; }
#pragma unroll
                  for (int e = 0; e < 8; ++e) { bg[e] = cb[c0 + e]; bv[e] = cb[2816 + c0 + e]; }
                  float g2[8], g1[8], v2[8], v1[8];
#pragma unroll
                  for (int e = 0; e < 8; ++e) { g2[e] = 0.f; g1[e] = 0.f; v2[e] = 0.f; v1[e] = 0.f; }
                  if (rg > 0 || half == 1) {
                      const bf16_t* r2p = rg > 0 ? U + (size_t)(lrow0 - 2) * 5632 : UH;
                      const bf16_t* r1p = rg > 0 ? U + (size_t)(lrow0 - 1) * 5632 : UH + 5632;
                      const u32x4 a = *(const u32x4*)(r2p + c0), bq = *(const u32x4*)(r1p + c0);
                      const u32x4 c = *(const u32x4*)(r2p + 2816 + c0), d = *(const u32x4*)(r1p + 2816 + c0);
                      g2[0] = bflo(a.x); g2[1] = bfhi(a.x); g2[2] = bflo(a.y); g2[3] = bfhi(a.y); g2[4] = bflo(a.z); g2[5] = bfhi(a.z); g2[6] = bflo(a.w); g2[7] = bfhi(a.w);
                      g1[0] = bflo(bq.x); g1[1] = bfhi(bq.x); g1[2] = bflo(bq.y); g1[3] = bfhi(bq.y); g1[4] = bflo(bq.z); g1[5] = bfhi(bq.z); g1[6] = bflo(bq.w); g1[7] = bfhi(bq.w);
                      v2[0] = bflo(c.x); v2[1] = bfhi(c.x); v2[2] = bflo(c.y); v2[3] = bfhi(c.y); v2[4] = bflo(c.z); v2[5] = bfhi(c.z); v2[6] = bflo(c.w); v2[7] = bfhi(c.w);
                      v1[0] = bflo(d.x); v1[1] = bfhi(d.x); v1[2] = bflo(d.y); v1[3] = bfhi(d.y); v1[4] = bflo(d.z); v1[5] = bfhi(d.z); v1[6] = bflo(d.w); v1[7] = bfhi(d.w);
                  }
                  for (int rr = 0; rr < 16; ++rr) {
                      const size_t row = (size_t)lrow0 + rr;
                      const u32x4 a = *(const u32x4*)(U + row * 5632 + c0), c = *(const u32x4*)(U + row * 5632 + 2816 + c0);
                      if (half == 0 && rg == 127 && rr >= 14) { *(u32x4*)(UH + (size_t)(rr - 14) * 5632 + c0) = a; *(u32x4*)(UH + (size_t)(rr - 14) * 5632 + 2816 + c0) = c; }
                      float g0[8], v0[8], ov[8];
                      g0[0] = bflo(a.x); g0[1] = bfhi(a.x); g0[2] = bflo(a.y); g0[3] = bfhi(a.y); g0[4] = bflo(a.z); g0[5] = bfhi(a.z); g0[6] = bflo(a.w); g0[7] = bfhi(a.w);
                      v0[0] = bflo(c.x); v0[1] = bfhi(c.x); v0[2] = bflo(c.y); v0[3] = bfhi(c.y); v0[4] = bflo(c.z); v0[5] = bfhi(c.z); v0[6] = bflo(c.w); v0[7] = bfhi(c.w);
#pragma unroll
                      for (int e = 0; e < 8; ++e) {
                          const float ug = wg[0][e] * g2[e] + wg[1][e] * g1[e] + wg[2][e] * g0[e] + bg[e];
                          const float uv = wv[0][e] * v2[e] + wv[1][e] * v1[e] + wv[2][e] * v0[e] + bv[e];
                          ov[e] = siluf_(ug) * uv; g2[e] = g1[e]; g1[e] = g0[e]; v2[e] = v1[e]; v1[e] = v0[e];
                      }
                      u32x4 w; w.x = pk2(ov[0], ov[1]); w.y = pk2(ov[2], ov[3]); w.z = pk2(ov[4], ov[5]); w.w = pk2(ov[6], ov[7]);
                      *(u32x4*)(ACT + row * 2816 + c0) = w;
                  }
              }
            }
        PH_END
#endif
            GRID_SYNC();
#ifndef NO_DOWN
        PH_BEGIN
            { EpiResid E{X, XB, ss_ple, nullptr, half};
              GEMM_PHASE(EpiResid, ACT, ws + W_DOWN, 16384, 1024, 2816, E, -1); }
        PH_END
#endif
            GRID_SYNC();
        }
#ifndef NO_PLEG
        PH_BEGIN
        { EpiRowScale<1> E{(bf16_t*)(ws + WS_MIX), 1024, ss_ple, -1};
          GEMM_PHASE(EpiRowScale<1>, XB, ws + W_PG, MTOK, 1024, 1024, E, -1); }
        PH_END
#endif
        GRID_SYNC();
#ifndef NO_PLE
        PH_BEGIN
        { EpiResid E{X, XB, ss_next, (const bf16_t*)(ws + WS_MIX), -1};
          GEMM_PHASE(EpiResid, ws + WS_PB, ws + W_PP, MTOK, 1024, 256, E, -1); }
        PH_END
#endif
        GRID_SYNC();
    }
#ifdef NANCHK
    { const int layer = 0; PH_BEGIN
      unsigned bad = 0u;
      for (size_t i = (size_t)bid * NTHR + tid; i < (size_t)MTOK * 256; i += (size_t)G * NTHR) { const f32x4 v = *(const f32x4*)(X + i * 4);
          for (int e = 0; e < 4; ++e) bad |= ((__float_as_uint(v[e]) & 0x7f800000u) == 0x7f800000u) ? 1u : 0u; }
#ifdef NANCHK_BF_LO
      { const unsigned* bp = (const unsigned*)(ws + (size_t)NANCHK_BF_LO); const size_t nw = ((size_t)NANCHK_BF_HI - (size_t)NANCHK_BF_LO) / 4;
        for (size_t i = (size_t)bid * NTHR + tid; i < nw; i += (size_t)G * NTHR) { const unsigned w = bp[i]; bad |= (((w & 0x7f80u) == 0x7f80u) || ((w & 0x7f800000u) == 0x7f800000u)) ? 1u : 0u; } }
#endif
      if (bad) __hip_atomic_fetch_or((unsigned*)(ws + WS_CTL) + 16, 1u, __ATOMIC_RELAXED, __HIP_MEMORY_SCOPE_AGENT);
      PH_END }
    GRID_SYNC();
    { const int layer = 0; PH_BEGIN
      const unsigned fl = __hip_atomic_fetch_or((unsigned*)(ws + WS_CTL) + 16, 0u, __ATOMIC_RELAXED, __HIP_MEMORY_SCOPE_AGENT);
      if (fl) for (size_t i = (size_t)bid * NTHR + tid; i < (size_t)MTOK * 256; i += (size_t)G * NTHR) *(f32x4*)(X + i * 4) = (f32x4){0.f, 0.f, 0.f, 0.f};
      PH_END }
#endif
#undef U
#undef ACT
}

extern "C" void kernel_launch(void* const* d_in, const int* in_sizes, int n_in, void* d_out, int out_size, void* d_ws, size_t ws_size, hipStream_t stream) {
    static int grid = 0;
    if (grid == 0) {
        if (n_in != 24 || out_size != MTOK * DM || ws_size < WS_TOTAL) { fprintf(stderr, "kernel_launch: unexpected shapes / workspace (n_in %d out %d ws %zu need %zu)\n", n_in, out_size, ws_size, (size_t)WS_TOTAL); grid = -1; return; }
        int dev = 0, cus = 0, per_cu = 0;
        hipGetDevice(&dev);
        hipDeviceGetAttribute(&cus, hipDeviceAttributeMultiprocessorCount, dev);
        hipFuncSetAttribute((const void*)fwd_mega, hipFuncAttributeMaxDynamicSharedMemorySize, LDS_BYTES);
        hipOccupancyMaxActiveBlocksPerMultiprocessor(&per_cu, (const void*)fwd_mega, NTHR, LDS_BYTES);
        if (per_cu < 1) { fprintf(stderr, "kernel_launch: occupancy query says %d blocks per CU\n", per_cu); per_cu = 1; }
        (void)hipGetLastError();
        grid = cus;
    }
    if (grid < 0) return;
    Params p{};
    for (int i = 0; i < 24; ++i) p.in[i] = (const float*)d_in[i];
    p.out = (float*)d_out; p.ws = (unsigned char*)d_ws;
    hipError_t e = hipSuccess;
#ifdef N_SEG_LAUNCH
    for (int sgi = 0; sgi < 60 && e == hipSuccess; sgi += N_SEG_LAUNCH) {
        p.seg_lo = sgi; p.seg_hi = sgi + N_SEG_LAUNCH;
        void* args[] = {&p};
        e = hipLaunchCooperativeKernel((const void*)fwd_mega, dim3(grid), dim3(NTHR), args, LDS_BYTES, stream);
    }
#else
    p.seg_lo = 0; p.seg_hi = 1000;
    void* args[] = {&p};
    e = hipLaunchCooperativeKernel((const void*)fwd_mega, dim3(grid), dim3(NTHR), args, LDS_BYTES, stream);
#endif
    if (e != hipSuccess) fprintf(stderr, "cooperative launch failed: %s (grid %d)\n", hipGetErrorString(e), grid);
}
```

```cpp
#include <hip/hip_runtime.h>
#include <hip/hip_cooperative_groups.h>
#include <cstdio>
#include <cstdint>
namespace cg = cooperative_groups;
namespace pg8 {
#define PG8_LAS __attribute__((address_space(3)))
typedef unsigned short bf16_t;
typedef short bf16x8 __attribute__((ext_vector_type(8)));
typedef float f32x4 __attribute__((ext_vector_type(4)));
typedef unsigned u32x4 __attribute__((ext_vector_type(4)));
constexpr int BM = 256, BK = 64, HALF = 128, HTB = HALF * BK * 2  , STAGE_BYTES = 8 * HTB, NXCD = 8, WGM = 8;

__host__ __device__ __forceinline__ int lds_byte(int r, int c) { const int st = (r >> 4) * 2 + (c >> 5), rr = r & 15, cc = c & 31, ob = rr * 64 + cc * 2; return st * 1024 + (ob ^ (((ob >> 9) & 1) << 5)); }
__host__ __device__ __forceinline__ void stage_rc(int b, int& R, int& C) { const int st = b / 1024, sb = b % 1024, swz = sb ^ (((sb >> 9) & 1) << 5); R = (st >> 1) * 16 + swz / 64; C = (st & 1) * 32 + (swz % 64) / 2; }
__host__ __device__ __forceinline__ int perm32(int rho) { const int n = rho >> 4, i = rho & 15; return 8 * (i >> 2) + 4 * n + (i & 3); }

struct Unit { int pm, pn; };
struct Gemm { const bf16_t* A; const bf16_t* Bt; int M, N, K; int hmap; };
__device__ __forceinline__ int amap(int pm, int hmap) { return hmap < 0 ? pm : ((pm >> 3) * 16 + 8 * hmap + (pm & 7)); }

struct StaticOrder {
    int nM, nN, nwg, G, c;
    __host__ __device__ void init(int M, int N, int G_, int c_) { nM = M / BM; nN = N / BM; nwg = nM * nN; G = G_; c = c_; }
    __host__ __device__ bool next(int i, Unit& u) const {
        const long L = (long)i * G + c; if (L >= nwg) return false;
        int wgid = (int)L; { const int q = nwg / NXCD, r = nwg % NXCD, xcd = wgid % NXCD, off = wgid / NXCD; wgid = (xcd < r ? xcd * (q + 1) : r * (q + 1) + (xcd - r) * q) + off; }
        const int nig = WGM * nN, gid = wgid / nig, fm = gid * WGM, gsz = (nM - fm) < WGM ? (nM - fm) : WGM;
        u.pm = fm + ((wgid % nig) % gsz); u.pn = (wgid % nig) / gsz; return true;
    }
    __device__ __forceinline__ void a_ready(const Unit&) const {}
    __device__ __forceinline__ void done(const Unit&) const {}
};
__device__ __forceinline__ unsigned cvt_pk_bf16(float lo, float hi) { unsigned r; asm volatile("v_cvt_pk_bf16_f32 %0, %1, %2" : "=v"(r) : "v"(lo), "v"(hi)); return r; }
#ifdef NO_UNI
__device__ __forceinline__ const char* uni(const char* p) { return p; }
#else
__device__ __forceinline__ const char* uni(const char* p) { const unsigned long long v = (unsigned long long)p; const unsigned lo = __builtin_amdgcn_readfirstlane((unsigned)v), hi = __builtin_amdgcn_readfirstlane((unsigned)(v >> 32)); return (const char*)(((unsigned long long)hi << 32) | lo); }
#endif
template <class Epi, class Sched, bool ALIGN_EPI = false, bool SP2 = false>
__device__ __forceinline__ void gemm_phase(PG8_LAS unsigned char* lds, const Gemm g, const Sched& S, const Epi& E) {
    int tid = threadIdx.x;
#ifndef NO_LAUNDER
    asm volatile("" : "+v"(tid));
#endif

    const int wid = __builtin_amdgcn_readfirstlane(tid >> 6), lane = tid & 63, wr = wid >> 2, wc = wid & 3, fr = lane & 15, fq = lane >> 4;
    const int K = g.K, nt = K / BK;
    unsigned voffA[2], voffB[2];
#pragma unroll
    for (int i = 0; i < 2; ++i) { int R, C; stage_rc(tid * 16 + i * 8192, R, C); const int Rb = Epi::PERM ? ((R & ~31) + perm32(R & 31)) : R;
        voffA[i] = (unsigned)(R * K + C) * 2u; voffB[i] = (unsigned)(Rb * K + C) * 2u; }
    const size_t kstep = (size_t)(BK * 2);
    const size_t hstep = (size_t)HALF * K * 2;
    const size_t tstep = 2 * hstep;
    const unsigned ldsw = (unsigned)wid * 1024u;
    const int aoff = lds_byte(wr * 64 + fr, fq * 8), boff = lds_byte(wc * 32 + fr, fq * 8);
#define PG8_SA(b, h) (((b) * 2 + (h)) * HTB)
#define PG8_SB(b, h) ((4 + (b) * 2 + (h)) * HTB)
#define PG8_STAGE(bufoff, gbase, voff) do { _Pragma("unroll") for (int _i = 0; _i < 2; ++_i) \
        __builtin_amdgcn_global_load_lds((const unsigned*)((const char*)(gbase) + (voff)[_i]), (PG8_LAS unsigned*)(lds + (bufoff) + ldsw + _i * 8192), 16, 0, 0); } while (0)
#define PG8_LDA(dst, b, h) do { _Pragma("unroll") for (int m = 0; m < 4; ++m) _Pragma("unroll") for (int k = 0; k < 2; ++k) dst[m][k] = *(const PG8_LAS bf16x8*)(lds + PG8_SA(b, h) + aoff + m * 2048 + k * 1024); } while (0)
#define PG8_LDB(dst, b, h) do { _Pragma("unroll") for (int n = 0; n < 2; ++n) _Pragma("unroll") for (int k = 0; k < 2; ++k) dst[n][k] = *(const PG8_LAS bf16x8*)(lds + PG8_SB(b, h) + boff + n * 2048 + k * 1024); } while (0)
#define PG8_MMA(ai, bj, At, Bt) do { __builtin_amdgcn_s_setprio(1); _Pragma("unroll") for (int m = 0; m < 4; ++m) _Pragma("unroll") for (int n = 0; n < 2; ++n) _Pragma("unroll") for (int k = 0; k < 2; ++k) \
        acc[ai][bj][m][n] = __builtin_amdgcn_mfma_f32_16x16x32_bf16(Bt[n][k], At[m][k], acc[ai][bj][m][n], 0, 0, 0); __builtin_amdgcn_s_setprio(0); } while (0)
#define PG8_WAIT_V(n) asm volatile("s_waitcnt vmcnt(" #n ")" ::: "memory")
#define PG8_WAIT_L(n) asm volatile("s_waitcnt lgkmcnt(" #n ")" ::: "memory")
#define PG8_BAR __builtin_amdgcn_s_barrier()
#define PG8_SCHED __builtin_amdgcn_sched_barrier(0)
    Unit cur, nxt; int ui = 0;
    if (!S.next(0, cur)) return;
    f32x4 acc[2][2][4][2];
#pragma unroll
    for (int a = 0; a < 2; ++a)
#pragma unroll
        for (int b = 0; b < 2; ++b)
#pragma unroll
            for (int m = 0; m < 4; ++m)
#pragma unroll
                for (int n = 0; n < 2; ++n) acc[a][b][m][n] = (f32x4){0.f, 0.f, 0.f, 0.f};
    bf16x8 At[4][2], B0[2][2], B1[2][2];
    const char* cA = uni((const char*)g.A + (size_t)amap(cur.pm, g.hmap) * tstep); const char* cB = uni((const char*)g.Bt + (size_t)cur.pn * tstep);
    S.a_ready(cur);
    if constexpr (SP2) {
        PG8_STAGE(PG8_SB(0, 0), cB, voffB); PG8_STAGE(PG8_SB(0, 1), cB + hstep, voffB); PG8_STAGE(PG8_SA(0, 0), cA, voffA); PG8_STAGE(PG8_SA(0, 1), cA + hstep, voffA);
        if (wr == 1) PG8_BAR;
        PG8_WAIT_V(2); PG8_BAR;
        PG8_STAGE(PG8_SB(1, 0), cB + kstep, voffB); PG8_STAGE(PG8_SA(1, 0), cA + kstep, voffA); PG8_STAGE(PG8_SB(1, 1), cB + hstep + kstep, voffB);
        PG8_WAIT_V(6); PG8_BAR;
    } else {
        PG8_STAGE(PG8_SB(0, 0), cB, voffB); PG8_STAGE(PG8_SA(0, 0), cA, voffA); PG8_STAGE(PG8_SB(0, 1), cB + hstep, voffB); PG8_STAGE(PG8_SA(0, 1), cA + hstep, voffA);
        if (wr == 1) PG8_BAR;
        PG8_WAIT_V(4); PG8_BAR;
        PG8_STAGE(PG8_SB(1, 0), cB + kstep, voffB); PG8_STAGE(PG8_SA(1, 0), cA + kstep, voffA); PG8_STAGE(PG8_SB(1, 1), cB + hstep + kstep, voffB);
        PG8_WAIT_V(6); PG8_BAR;
    }
    for (;;) {
        const bool has_next = S.next(ui + 1, nxt);
        const char* nA = uni(has_next ? (const char*)g.A + (size_t)amap(nxt.pm, g.hmap) * tstep : cA); const char* nB = uni(has_next ? (const char*)g.Bt + (size_t)nxt.pn * tstep : cB);
        for (int t = 0; t < nt; t += 2) {
            const bool last = (t == nt - 2);
            const char* a1 = cA + (size_t)(t + 1) * kstep;
            const char* a2 = last ? nA : cA + (size_t)(t + 2) * kstep; const char* b2 = last ? nB : cB + (size_t)(t + 2) * kstep;
            const char* a3 = a2 + kstep; const char* b3 = b2 + kstep;
            if (last && has_next) S.a_ready(nxt);
            if constexpr (SP2) {
            PG8_LDB(B0, 0, 0); PG8_LDB(B1, 0, 1); PG8_SCHED; PG8_LDA(At, 0, 0); PG8_STAGE(PG8_SA(1, 1), a1 + hstep, voffA);
            PG8_WAIT_V(8); PG8_WAIT_L(0); PG8_BAR; PG8_MMA(0, 0, At, B0); PG8_MMA(0, 1, At, B1); PG8_BAR; PG8_SCHED;
            PG8_LDA(At, 0, 1); PG8_STAGE(PG8_SB(0, 0), b2, voffB); PG8_STAGE(PG8_SB(0, 1), b2 + hstep, voffB); PG8_STAGE(PG8_SA(0, 0), a2, voffA);
            PG8_WAIT_V(8); PG8_WAIT_L(0); PG8_BAR; PG8_MMA(1, 0, At, B0); PG8_MMA(1, 1, At, B1); PG8_BAR; PG8_SCHED;
            PG8_LDB(B0, 1, 0); PG8_LDB(B1, 1, 1); PG8_SCHED; PG8_LDA(At, 1, 0); PG8_STAGE(PG8_SA(0, 1), a2 + hstep, voffA);
            PG8_WAIT_V(8); PG8_WAIT_L(0); PG8_BAR; PG8_MMA(0, 0, At, B0); PG8_MMA(0, 1, At, B1); PG8_BAR; PG8_SCHED;
            PG8_LDA(At, 1, 1); PG8_STAGE(PG8_SB(1, 0), b3, voffB); PG8_STAGE(PG8_SB(1, 1), b3 + hstep, voffB); PG8_STAGE(PG8_SA(1, 0), a3, voffA);
            PG8_WAIT_V(8); PG8_WAIT_L(0); PG8_BAR; PG8_MMA(1, 0, At, B0); PG8_MMA(1, 1, At, B1); PG8_BAR; PG8_SCHED;
            } else {
            PG8_LDB(B0, 0, 0); PG8_SCHED; PG8_LDA(At, 0, 0); PG8_STAGE(PG8_SA(1, 1), a1 + hstep, voffA);
            PG8_WAIT_L(8); PG8_BAR; PG8_WAIT_L(0); PG8_MMA(0, 0, At, B0); PG8_BAR; PG8_SCHED;
            PG8_LDB(B1, 0, 1); PG8_STAGE(PG8_SB(0, 0), b2, voffB);
            PG8_BAR; PG8_WAIT_L(0); PG8_MMA(0, 1, At, B1); PG8_BAR;
            PG8_LDA(At, 0, 1); PG8_STAGE(PG8_SA(0, 0), a2, voffA);
            PG8_BAR; PG8_WAIT_L(0); PG8_MMA(1, 0, At, B0); PG8_BAR; PG8_SCHED;
            PG8_STAGE(PG8_SB(0, 1), b2 + hstep, voffB);
            PG8_WAIT_V(6); PG8_BAR; PG8_MMA(1, 1, At, B1); PG8_BAR;
            PG8_LDB(B0, 1, 0); PG8_SCHED; PG8_LDA(At, 1, 0); PG8_STAGE(PG8_SA(0, 1), a2 + hstep, voffA);
            PG8_WAIT_L(8); PG8_BAR; PG8_WAIT_L(0); PG8_MMA(0, 0, At, B0); PG8_BAR; PG8_SCHED;
            PG8_LDB(B1, 1, 1); PG8_STAGE(PG8_SB(1, 0), b3, voffB);
            PG8_BAR; PG8_WAIT_L(0); PG8_MMA(0, 1, At, B1); PG8_BAR;
            PG8_LDA(At, 1, 1); PG8_STAGE(PG8_SA(1, 0), a3, voffA);
            PG8_BAR; PG8_WAIT_L(0); PG8_MMA(1, 0, At, B0); PG8_BAR; PG8_SCHED;
            PG8_STAGE(PG8_SB(1, 1), b3 + hstep, voffB);
            PG8_WAIT_V(6); PG8_BAR; PG8_MMA(1, 1, At, B1); PG8_BAR;
            }
        }
        if constexpr (ALIGN_EPI) { if (wr == 0) PG8_BAR; }
        if constexpr (!Epi::AFTER_DRAIN) { E(acc, cur, wr, wc, fr, fq); S.done(cur); }
        if (!has_next) break;
#pragma unroll
        for (int a = 0; a < 2; ++a)
#pragma unroll
            for (int b = 0; b < 2; ++b)
#pragma unroll
                for (int m = 0; m < 4; ++m)
#pragma unroll
                    for (int n = 0; n < 2; ++n) acc[a][b][m][n] = (f32x4){0.f, 0.f, 0.f, 0.f};
        cur = nxt; cA = nA; cB = nB; ++ui;
        if constexpr (ALIGN_EPI) { if (wr == 1) PG8_BAR; }
    }
    PG8_WAIT_V(0);
    if constexpr (!ALIGN_EPI) { if (wr == 0) PG8_BAR; }
    PG8_BAR;
    if constexpr (Epi::AFTER_DRAIN) { E.fused(acc, cur, wr, wc, fr, fq, lds, wid, lane); S.done(cur); }
#undef PG8_SA
#undef PG8_SB
#undef PG8_STAGE
#undef PG8_LDA
#undef PG8_LDB
#undef PG8_MMA
#undef PG8_WAIT_V
#undef PG8_WAIT_L
#undef PG8_BAR
#undef PG8_SCHED
}
}

#define GAS __attribute__((address_space(1)))
#define LAS __attribute__((address_space(3)))
typedef unsigned short bf16_t;
typedef float f32x4 __attribute__((ext_vector_type(4)));
typedef float f32x16 __attribute__((ext_vector_type(16)));
typedef short bf16x8 __attribute__((ext_vector_type(8)));
typedef unsigned u32x4 __attribute__((ext_vector_type(4)));
typedef unsigned u32x2 __attribute__((ext_vector_type(2)));

#ifndef NLAYER_V
#define NLAYER_V 4
#endif
constexpr int NW = 8, NTHR = 512;
constexpr int MTOK = 32768, DM = 1024, SEQ = 4096, NB = 8, NLAYER = NLAYER_V, NH = 8;
constexpr int DIN = 9232, DFF = 2816, DPLE = 256;
constexpr float EPS = 1e-6f;
constexpr float LOG2E = 1.4426950408889634f;
constexpr size_t MiB = 1u << 20;
constexpr size_t WS_SS = 0;
constexpr size_t WS_CTL = 1792 * 1024;
constexpr size_t WS_UHALO = 1856 * 1024;
constexpr size_t WS_GB = 2 * MiB;
constexpr size_t WS_HALO = 4 * MiB;
constexpr size_t WS_PB = 14 * MiB;
constexpr size_t WS_W = 30 * MiB;
constexpr size_t W_IN = WS_W, W_V = W_IN + (size_t)6400 * 1024 * 2, W_GL = W_V + 2 * MiB, W_BRA = W_GL + 4 * MiB, W_BRB = W_BRA + 2 * MiB,
                 W_OUT = W_BRB + 2 * MiB, W_UP = W_OUT + 2 * MiB, W_DOWN = W_UP + 11 * MiB, W_PG = W_DOWN + (size_t)1024 * 2816 * 2, W_PP = W_PG + 2 * MiB, W_END = W_PP + (size_t)1024 * 256 * 2;
static_assert(W_END <= 74 * MiB, "weights region");
constexpr size_t WS_XB = 74 * MiB;
constexpr size_t WS_MIX = 138 * MiB;
constexpr size_t S64 = 64 * MiB;
constexpr size_t WS_QA = WS_MIX, WS_KA = WS_MIX + S64, WS_VT = WS_MIX + 2 * S64, WS_QB = WS_MIX + 3 * S64, WS_KB = WS_MIX + 4 * S64, WS_VB = WS_MIX + 5 * S64, WS_ZB = WS_MIX + 6 * S64;
constexpr size_t WS_TOTAL = WS_MIX + 7 * S64;
#ifdef DN_NAIVE
constexpr size_t WS_G = WS_KB, WS_TMPA = WS_KA, WS_MIXED = WS_VT, WS_OSRC = WS_QB;
#else
constexpr size_t WS_G = WS_KA, WS_TMPA = WS_KB, WS_MIXED = WS_VB, WS_OSRC = WS_VB;
#endif
constexpr int LDS_BYTES = 147456, LDS_VB = 140032;

__device__ __forceinline__ float bflo(unsigned w) { return __uint_as_float(w << 16); }
__device__ __forceinline__ float bfhi(unsigned w) { return __uint_as_float(w & 0xffff0000u); }
__device__ __forceinline__ float bf2f(bf16_t v) { return __uint_as_float((unsigned)v << 16); }
typedef float f32x2_t __attribute__((ext_vector_type(2))); typedef __bf16 bf16x2_t __attribute__((ext_vector_type(2)));
__device__ __forceinline__ unsigned pk2(float lo, float hi) { const f32x2_t v = {lo, hi}; const bf16x2_t b = __builtin_convertvector(v, bf16x2_t); return __builtin_bit_cast(unsigned, b); }
__device__ __forceinline__ bf16_t f2bf(float f) { return (bf16_t)(pk2(f, 0.f) & 0xffffu); }
__device__ __forceinline__ float sigmoidf_(float x) { x = fminf(fmaxf(x, -60.f), 60.f); return __builtin_amdgcn_rcpf(1.f + __expf(-x)); }
__device__ __forceinline__ float siluf_(float x) { return x * sigmoidf_(x); }
__device__ __forceinline__ float wave_sum(float v) {
#pragma unroll
    for (int o = 1; o < 64; o <<= 1) v += __shfl_xor(v, o);
    return v;
}
__device__ __forceinline__ float ss_load(const float* p) { const f32x4 a = *(const f32x4*)p, b = *(const f32x4*)(p + 4), c = *(const f32x4*)(p + 8), d = *(const f32x4*)(p + 12);
    float s = (((a[0] + a[1]) + (a[2] + a[3])) + ((b[0] + b[1]) + (b[2] + b[3]))) + (((c[0] + c[1]) + (c[2] + c[3])) + ((d[0] + d[1]) + (d[2] + d[3])));
    asm volatile("" : "+v"(s) :: "memory");
    return s; }
__device__ __forceinline__ u32x4 ldc16(const void* p) { u32x4 v; asm volatile("global_load_dwordx4 %0, %1, off sc0 sc1\n\ts_waitcnt vmcnt(0)" : "=v"(v) : "v"(p) : "memory"); return v; }
__device__ __forceinline__ int crow(int r, int hi) { return (r & 3) + 8 * (r >> 2) + 4 * hi; }

__device__ __forceinline__ int gmap(int row, int h) { return h < 0 ? row : ((row >> 11) * 4096 + 2048 * h + (row & 2047)); }

using pg8::Unit;
typedef f32x4 AccT[2][2][4][2];

template <int ACT> struct EpiRowScale {
    static constexpr bool PERM = true, AFTER_DRAIN = false;
    bf16_t* O; int ldc; const float* ss; int hmap;
    __device__ __forceinline__ void operator()(const AccT& acc, const Unit& u, int wr, int wc, int fr, int fq) const {
        const int row0 = u.pm * 256 + wr * 64 + fr, col0 = u.pn * 256 + wc * 32 + 8 * fq;
#pragma unroll
        for (int ai = 0; ai < 2; ++ai)
#pragma unroll
            for (int m = 0; m < 4; ++m) {
                const int row = row0 + ai * 128 + m * 16;
#ifdef RS_CONST
                const float rs = 1000.f;
#else
                const float rs = rsqrtf(ss_load(ss + (size_t)gmap(row, hmap) * 16) * (1.f / 1024.f) + EPS);
#endif
                bf16_t* rowp = O + (size_t)row * ldc + col0;
#pragma unroll
                for (int bj = 0; bj < 2; ++bj) {
                    f32x4 v0 = acc[ai][bj][m][0] * rs, v1 = acc[ai][bj][m][1] * rs;
                    if (ACT == 1) {
#pragma unroll
                        for (int e = 0; e < 4; ++e) { v0[e] = sigmoidf_(v0[e]); v1[e] = sigmoidf_(v1[e]); }
                    }
                    u32x4 w; w.x = pk2(v0[0], v0[1]); w.y = pk2(v0[2], v0[3]); w.z = pk2(v1[0], v1[1]); w.w = pk2(v1[2], v1[3]);
                    *(u32x4*)(rowp + bj * 128) = w;
                    asm volatile("" ::: "memory");
                }
            }
    }
};

struct EpiVt {
    static constexpr bool PERM = true, AFTER_DRAIN = false;
    bf16_t* O; const float* ss;
    __device__ __forceinline__ void operator()(const AccT& acc, const Unit& u, int wr, int wc, int fr, int fq) const {
        const int row0 = u.pm * 256 + wr * 64 + fr, col0 = u.pn * 256 + wc * 32 + 8 * fq;
        float rs[2][8];
#pragma unroll
        for (int bj = 0; bj < 2; ++bj)
#pragma unroll
            for (int e = 0; e < 8; ++e) rs[bj][e] = rsqrtf(ss_load(ss + (size_t)(col0 + bj * 128 + e) * 16) * (1.f / 1024.f) + EPS);
#pragma unroll
        for (int ai = 0; ai < 2; ++ai)
#pragma unroll
            for (int m = 0; m < 4; ++m) {
                const int row = row0 + ai * 128 + m * 16;
                bf16_t* rowp = O + (size_t)row * MTOK + col0;
#pragma unroll
                for (int bj = 0; bj < 2; ++bj) {
                    const f32x4 v0 = acc[ai][bj][m][0], v1 = acc[ai][bj][m][1];
                    u32x4 w; w.x = pk2(v0[0] * rs[bj][0], v0[1] * rs[bj][1]); w.y = pk2(v0[2] * rs[bj][2], v0[3] * rs[bj][3]);
                    w.z = pk2(v1[0] * rs[bj][4], v1[1] * rs[bj][5]); w.w = pk2(v1[2] * rs[bj][6], v1[3] * rs[bj][7]);
                    *(u32x4*)(rowp + bj * 128) = w;
                }
                asm volatile("" ::: "memory");
            }
    }
};

struct EpiGateMul {
    static constexpr bool PERM = true, AFTER_DRAIN = false;
    bf16_t* O; const bf16_t* G; int ldg, goff; const bf16_t* Add;
    __device__ __forceinline__ void operator()(const AccT& acc, const Unit& u, int wr, int wc, int fr, int fq) const {
        const int row0 = u.pm * 256 + wr * 64 + fr, col0 = u.pn * 256 + wc * 32 + 8 * fq;
#pragma unroll
        for (int ai = 0; ai < 2; ++ai)
#pragma unroll
            for (int m = 0; m < 4; ++m) {
                const int row = row0 + ai * 128 + m * 16;
#pragma unroll
                for (int bj = 0; bj < 2; ++bj) {
                    const int c = col0 + bj * 128;
                    const u32x4 g = *(const u32x4*)(G + (size_t)row * ldg + goff + c);
                    u32x4 a = (u32x4){0u, 0u, 0u, 0u};
                    if (Add) a = *(const u32x4*)(Add + (size_t)row * 1024 + c);
                    const f32x4 v0 = acc[ai][bj][m][0], v1 = acc[ai][bj][m][1];
                    u32x4 w;
                    w.x = pk2(bflo(a.x) + bflo(g.x) * v0[0], bfhi(a.x) + bfhi(g.x) * v0[1]);
                    w.y = pk2(bflo(a.y) + bflo(g.y) * v0[2], bfhi(a.y) + bfhi(g.y) * v0[3]);
                    w.z = pk2(bflo(a.z) + bflo(g.z) * v1[0], bfhi(a.z) + bfhi(g.z) * v1[1]);
                    w.w = pk2(bflo(a.w) + bflo(g.w) * v1[2], bfhi(a.w) + bfhi(g.w) * v1[3]);
                    *(u32x4*)(O + (size_t)row * 1024 + c) = w;
                }
                asm volatile("" ::: "memory");
            }
    }
};

struct EpiResid {
    static constexpr bool PERM = true, AFTER_DRAIN = false;
    float* X; bf16_t* XB; float* ssn; const bf16_t* Mul; int hmap;
    __device__ __forceinline__ void operator()(const AccT& acc, const Unit& u, int wr, int wc, int fr, int fq) const {
        const int row0 = u.pm * 256 + wr * 64 + fr, col0 = u.pn * 256 + wc * 32 + 8 * fq;
#pragma unroll
        for (int ai = 0; ai < 2; ++ai)
#pragma unroll
            for (int m = 0; m < 4; ++m) {
                const int row = gmap(row0 + ai * 128 + m * 16, hmap);
                float sq = 0.f;
#pragma unroll
                for (int bj = 0; bj < 2; ++bj)
#pragma unroll
                    for (int n = 0; n < 2; ++n) {
                        const size_t off = (size_t)row * 1024 + col0 + bj * 128 + 4 * n;
                        f32x4 x0 = *(const f32x4*)(X + off);
                        f32x4 v0 = acc[ai][bj][m][n];
                        if (Mul) { const u32x2 g = *(const u32x2*)(Mul + off); v0[0] *= bflo(g.x); v0[1] *= bfhi(g.x); v0[2] *= bflo(g.y); v0[3] *= bfhi(g.y); }
                        x0 += v0;
                        *(f32x4*)(X + off) = x0;
                        u32x2 w; w.x = pk2(x0[0], x0[1]); w.y = pk2(x0[2], x0[3]);
                        *(u32x2*)(XB + off) = w;
                        sq += (x0[0] * x0[0] + x0[1] * x0[1]) + (x0[2] * x0[2] + x0[3] * x0[3]);
                        asm volatile("" ::: "memory");
                    }
                sq += __shfl_xor(sq, 16); sq += __shfl_xor(sq, 32);
                if (fq == 0) ssn[(size_t)row * 16 + u.pn * 4 + wc] = sq;
                asm volatile("" ::: "memory");
            }
    }
};

struct EpiQK {
    static constexpr bool PERM = true, AFTER_DRAIN = false;
    unsigned char* ws; const float* ss; const float* qg; const float* kg;
    __device__ __forceinline__ void operator()(const AccT& acc, const Unit& u, int wr, int wc, int fr, int fq) const {
        const int row0 = u.pm * 256 + wr * 64 + fr;
        const int seg = u.pn >> 2, tl = u.pn & 3;
        bf16_t* base = (bf16_t*)(ws + (seg == 0 ? WS_QA : WS_KA));
        const float* gp = seg == 0 ? qg : kg; const float osc = seg == 0 ? 0.125f * LOG2E : 1.0f;
        const int col0 = tl * 256 + 64 * wc + 8 * fq;
#pragma unroll
        for (int ai = 0; ai < 2; ++ai)
#pragma unroll
            for (int m = 0; m < 4; ++m) {
                const int row = row0 + ai * 128 + m * 16;
                const float rs = rsqrtf(ss_load(ss + (size_t)row * 16) * (1.f / 1024.f) + EPS);
                f32x4 v[2][2]; float sq = 0.f;
#pragma unroll
                for (int bj = 0; bj < 2; ++bj)
#pragma unroll
                    for (int n = 0; n < 2; ++n) { v[bj][n] = acc[ai][bj][m][n] * rs; const f32x4 t = v[bj][n]; sq += (t[0] * t[0] + t[1] * t[1]) + (t[2] * t[2] + t[3] * t[3]); }
                sq += __shfl_xor(sq, 16); sq += __shfl_xor(sq, 32);
                const float r2o = rsqrtf(sq * (1.f / 64.f) + EPS) * osc;
#pragma unroll
                for (int bj = 0; bj < 2; ++bj) {
                    const f32x4 ga = *(const f32x4*)(gp + 32 * bj + 8 * fq), gb = *(const f32x4*)(gp + 32 * bj + 8 * fq + 4);
                    u32x4 w;
                    w.x = pk2(v[bj][0][0] * r2o * ga[0], v[bj][0][1] * r2o * ga[1]); w.y = pk2(v[bj][0][2] * r2o * ga[2], v[bj][0][3] * r2o * ga[3]);
                    w.z = pk2(v[bj][1][0] * r2o * gb[0], v[bj][1][1] * r2o * gb[1]); w.w = pk2(v[bj][1][2] * r2o * gb[2], v[bj][1][3] * r2o * gb[3]);
                    *(u32x4*)(base + (size_t)row * 1024 + col0 + 32 * bj) = w;
                }
                asm volatile("" ::: "memory");
            }
    }
};
struct EpiSeg {
    static constexpr bool PERM = true, AFTER_DRAIN = false;
    unsigned char* ws; const float* ss;
    __device__ __forceinline__ void operator()(const AccT& acc, const Unit& u, int wr, int wc, int fr, int fq) const {
        const int row0 = u.pm * 256 + wr * 64 + fr;
        bf16_t* base = (bf16_t*)(ws + WS_QB + (size_t)(u.pn >> 2) * S64);
        const int col0 = (u.pn & 3) * 256 + wc * 32 + 8 * fq;
#pragma unroll
        for (int ai = 0; ai < 2; ++ai)
#pragma unroll
            for (int m = 0; m < 4; ++m) {
                const int row = row0 + ai * 128 + m * 16;
                const float rs = rsqrtf(ss_load(ss + (size_t)row * 16) * (1.f / 1024.f) + EPS);
#pragma unroll
                for (int bj = 0; bj < 2; ++bj) {
                    const f32x4 v0 = acc[ai][bj][m][0] * rs, v1 = acc[ai][bj][m][1] * rs;
                    u32x4 w; w.x = pk2(v0[0], v0[1]); w.y = pk2(v0[2], v0[3]); w.z = pk2(v1[0], v1[1]); w.w = pk2(v1[2], v1[3]);
                    *(u32x4*)(base + (size_t)row * 1024 + col0 + bj * 128) = w;
                }
                asm volatile("" ::: "memory");
            }
    }
};
struct EpiGB {
    static constexpr bool PERM = true, AFTER_DRAIN = false;
    unsigned char* ws; const float* ss; const float* a_log; const float* dt_bias;
    __device__ __forceinline__ void operator()(const AccT& acc, const Unit& u, int wr, int wc, int fr, int fq) const {
        const int row0 = u.pm * 256 + wr * 64 + fr;
        if (wc == 0 && fq < 2) {
            float* GBp = (float*)(ws + WS_GB);
#pragma unroll
            for (int ai = 0; ai < 2; ++ai)
#pragma unroll
                for (int m = 0; m < 4; ++m) {
                    const int row = row0 + ai * 128 + m * 16;
                    const float rs = rsqrtf(ss_load(ss + (size_t)row * 16) * (1.f / 1024.f) + EPS);
                    float v[8];
#pragma unroll
                    for (int e = 0; e < 4; ++e) { v[e] = acc[ai][0][m][0][e] * rs; v[4 + e] = acc[ai][0][m][1][e] * rs; }
                    if (fq == 0) {
#pragma unroll
                        for (int e = 0; e < 8; ++e) v[e] = sigmoidf_(v[e]);
                    } else {
#pragma unroll
                        for (int e = 0; e < 8; ++e) { const float z = v[e] + dt_bias[e]; const float sp = fmaxf(z, 0.f) + __logf(1.f + __expf(-fabsf(z))); v[e] = -__expf(a_log[e]) * sp; }
                    }
                    float* dst = GBp + (size_t)row * 16 + 8 * fq;
                    *(f32x4*)dst = (f32x4){v[0], v[1], v[2], v[3]}; *(f32x4*)(dst + 4) = (f32x4){v[4], v[5], v[6], v[7]};
                    asm volatile("" ::: "memory");
                }
        }
    }
};

__device__ __forceinline__ void cvt_item(const float* W, int ldw, int src_col0, int nvalid, const float* gain, bf16_t* WT, int K, int dst_row0, int k0, LAS float* scr, int lane) {
    const int nn = lane & 31;
#pragma unroll 8
    for (int i = 0; i < 32; ++i) {
        const int kk = 2 * i + (lane >> 5);
        float v = 0.f;
        if (nn < nvalid) { v = W[(size_t)(k0 + kk) * ldw + src_col0 + nn]; if (gain) v *= gain[k0 + kk]; }
        scr[kk * 33 + nn] = v;
    }
    asm volatile("s_waitcnt lgkmcnt(0)" ::: "memory");
    const int c = lane & 7;
#pragma unroll
    for (int j = 0; j < 4; ++j) {
        const int n = (lane >> 3) + 8 * j; const LAS float* s = scr + (8 * c) * 33 + n;
        u32x4 o; o.x = pk2(s[0 * 33], s[1 * 33]); o.y = pk2(s[2 * 33], s[3 * 33]); o.z = pk2(s[4 * 33], s[5 * 33]); o.w = pk2(s[6 * 33], s[7 * 33]);
        *(u32x4*)(WT + (size_t)(dst_row0 + n) * K + k0 + 8 * c) = o;
    }
    asm volatile("s_waitcnt lgkmcnt(0)" ::: "memory");
}

struct Params {
    const float* in[24];
    float* out;
    unsigned char* ws;
    int seg_lo, seg_hi;
};
enum { I_X = 0, I_P, I_WIN, I_ATTN_NORM, I_QNORM, I_KNORM, I_LAM, I_SUBLN, I_RELB, I_CONVB, I_ALOG, I_DTB, I_ONORM, I_WBRA, I_WBRB, I_WOUT, I_FFN_NORM, I_WUP, I_CONVFF, I_CONVFFB, I_WDOWN, I_PLE_NORM, I_WPG, I_WPP };

__device__ __forceinline__ void convert_weights(const Params* PQ, int layer, LAS unsigned char* lds, int gw, int NGW, int wave, int lane) {
    LAS float* scr = (LAS float*)(lds + wave * 16384);
    unsigned char* ws = PQ->ws;
    const float* w_in = PQ->in[I_WIN] + (size_t)layer * 1024 * DIN;
    const float* g_attn = PQ->in[I_ATTN_NORM] + layer * 1024;
    const float* g_ffn = PQ->in[I_FFN_NORM] + layer * 1024;
    const float* g_ple = PQ->in[I_PLE_NORM] + layer * 1024;
#define CVT_JOB(NITEMS, KB, SRCW, LDW, GAIN, DST, KK, SRCCOL, NVALID) \
    for (int it = gw; it < (NITEMS); it += NGW) { const int g = it / (KB), kb = it % (KB); (void)g; \
        cvt_item((SRCW), (LDW), (SRCCOL), (NVALID), (GAIN), (bf16_t*)(ws + (DST)), (KK), g * 32, kb * 64, scr, lane); } asm volatile("" ::: "memory");
    for (int it = gw; it < 200 * 16; it += NGW) {
        const int g = it >> 4, kb = it & 15, pn = g >> 3, gi = g & 7;
        int src, nv = 32;
        if (pn < 8) { const int bj = gi >> 2, wc = gi & 3; src = (pn >> 2) * 1024 + (pn & 3) * 256 + 64 * wc + 32 * bj; }
        else if (pn < 24) { src = 3072 + (pn - 8) * 256 + 32 * gi; }
        else { src = 7168; nv = (gi == 0) ? 16 : 0; }
        cvt_item(w_in, DIN, src, nv, g_attn, (bf16_t*)(ws + W_IN), 1024, g * 32, kb * 64, scr, lane);
    }
    asm volatile("" ::: "memory");
    CVT_JOB(32 * 16, 16, w_in, DIN, g_attn, W_V, 1024, 2048 + g * 32, 32)
    CVT_JOB(64 * 16, 16, w_in, DIN, g_attn, W_GL, 1024, 7184 + g * 32, 32)
    CVT_JOB(32 * 16, 16, PQ->in[I_WBRA] + (size_t)layer * 1024 * 1024, 1024, (const float*)nullptr, W_BRA, 1024, g * 32, 32)
    CVT_JOB(32 * 16, 16, PQ->in[I_WBRB] + (size_t)layer * 1024 * 1024, 1024, (const float*)nullptr, W_BRB, 1024, g * 32, 32)
    CVT_JOB(32 * 16, 16, PQ->in[I_WOUT] + (size_t)layer * 1024 * 1024, 1024, (const float*)nullptr, W_OUT, 1024, g * 32, 32)
    CVT_JOB(176 * 16, 16, PQ->in[I_WUP] + (size_t)layer * 1024 * 5632, 5632, g_ffn, W_UP, 1024, g * 32, 32)
    CVT_JOB(32 * 44, 44, PQ->in[I_WDOWN] + (size_t)layer * 2816 * 1024, 1024, (const float*)nullptr, W_DOWN, 2816, g * 32, 32)
    CVT_JOB(32 * 16, 16, PQ->in[I_WPG] + (size_t)layer * 1024 * 1024, 1024, g_ple, W_PG, 1024, g * 32, 32)
    CVT_JOB(32 * 4, 4, PQ->in[I_WPP] + (size_t)layer * 256 * 1024, 1024, (const float*)nullptr, W_PP, 256, g * 32, 32)
#undef CVT_JOB
}

constexpr int AT_KROW = 272, AT_VROW = 144, AT_KBYTES = 64 * AT_KROW, AT_VBYTES = 128 * AT_VROW, AT_STAGE = AT_KBYTES + AT_VBYTES, AT_TB = 2 * AT_STAGE;
static_assert(AT_TB >= 65536 && AT_TB + 1024 <= LDS_BYTES, "attention LDS");
__device__ __forceinline__ void attn_unit(LAS unsigned char* lds, const bf16_t* QA, const bf16_t* KA, const bf16_t* VT, bf16_t* OA, int b, int h, int qb,
                                          float lam, float out_scale, const float* subln, const float* relb, int tid) {
    const int lane = tid & 63, wid = __builtin_amdgcn_readfirstlane(tid >> 6), j = wid >> 2, wq = wid & 3, r32 = lane & 31, hi = lane >> 5;
    const int Q0 = qb * 128, qrow = Q0 + 32 * wq + r32;
    const size_t tok = (size_t)b * SEQ + qrow;
    LAS float* TB = (LAS float*)(lds + AT_TB);
    for (int i = tid; i <= 128; i += NTHR) {
        float v = 0.f;
        if (i < 128) {
            int bk = i;
            if (i >= 16) { int lg = 16 + (int)(__logf((float)i * (1.f / 16.f)) / __logf(8.0f) * 16.f); bk = lg < 31 ? lg : 31; }
            v = (relb[bk * 8 + h] - relb[31 * 8 + h]) * LOG2E;
        }
        TB[i] = v;
    }
    bf16x8 qf[4];
#pragma unroll
    for (int d0 = 0; d0 < 4; ++d0) qf[d0] = *(const bf16x8*)(QA + tok * 1024 + h * 128 + 64 * j + 16 * d0 + 8 * hi);
    const int NT = (Q0 + 128) / 64;
    const int kr0 = tid >> 4, kc = tid & 15;
    const int vr0 = tid >> 3, vc = tid & 7;
    const bf16_t* kg = KA + ((size_t)b * SEQ + kr0) * 1024 + h * 128 + kc * 8;
    const bf16_t* vg = VT + (size_t)(h * 128 + vr0) * MTOK + (size_t)b * SEQ + vc * 8;
    u32x4 kreg0, kreg1, vreg0, vreg1;
#define AT_LOAD(t) do { kreg0 = *(const u32x4*)(kg + (size_t)(t) * 64 * 1024); kreg1 = *(const u32x4*)(kg + (size_t)((t) * 64 + 32) * 1024); \
        vreg0 = *(const u32x4*)(vg + (t) * 64); vreg1 = *(const u32x4*)(vg + (size_t)64 * MTOK + (t) * 64); } while (0)
#define AT_STORE(s) do { LAS unsigned char* kb_ = lds + (s) * AT_STAGE; LAS unsigned char* vb_ = kb_ + AT_KBYTES; \
        *(LAS u32x4*)(kb_ + kr0 * AT_KROW + kc * 16) = kreg0; *(LAS u32x4*)(kb_ + (kr0 + 32) * AT_KROW + kc * 16) = kreg1; \
        *(LAS u32x4*)(vb_ + vr0 * AT_VROW + vc * 16) = vreg0; *(LAS u32x4*)(vb_ + (vr0 + 64) * AT_VROW + vc * 16) = vreg1; } while (0)
    AT_LOAD(0); AT_STORE(0);
    __syncthreads();
    f32x16 o[4];
#pragma unroll
    for (int i = 0; i < 4; ++i)
#pragma unroll
        for (int r = 0; r < 16; ++r) o[i][r] = 0.f;
    float mrun = -INFINITY, lrun = 0.f;
    const int qmax_w = Q0 + 32 * wq + 31, qmin_w = Q0 + 32 * wq;
    for (int t = 0; t < NT; ++t) {
        if (t + 1 < NT) AT_LOAD(t + 1);
        const int kv0 = 64 * t;
        if (kv0 <= qmax_w) {
            const LAS unsigned char* Kb = lds + (t & 1) * AT_STAGE; const LAS unsigned char* Vb = Kb + AT_KBYTES;
            f32x16 s0, s1;
#pragma unroll
            for (int r = 0; r < 16; ++r) { s0[r] = 0.f; s1[r] = 0.f; }
#pragma unroll
            for (int d0 = 0; d0 < 4; ++d0) {
                const bf16x8 a0 = *(const LAS bf16x8*)(Kb + r32 * AT_KROW + (64 * j + 16 * d0 + 8 * hi) * 2);
                const bf16x8 a1 = *(const LAS bf16x8*)(Kb + (32 + r32) * AT_KROW + (64 * j + 16 * d0 + 8 * hi) * 2);
                s0 = __builtin_amdgcn_mfma_f32_32x32x16_bf16(a0, qf[d0], s0, 0, 0, 0);
                s1 = __builtin_amdgcn_mfma_f32_32x32x16_bf16(a1, qf[d0], s1, 0, 0, 0);
            }
            if (kv0 + 63 + 128 > qmin_w) {
#pragma unroll
                for (int r = 0; r < 16; ++r) {
                    const int rel0 = qrow - (kv0 + crow(r, hi)), rel1 = rel0 - 32;
                    s0[r] = rel0 < 0 ? -INFINITY : s0[r] + TB[rel0 < 128 ? rel0 : 128];
                    s1[r] = rel1 < 0 ? -INFINITY : s1[r] + TB[rel1 < 128 ? rel1 : 128];
                }
            }
            float mx = fmaxf(s0[0], s1[0]);
#pragma unroll
            for (int r = 1; r < 16; ++r) mx = fmaxf(mx, fmaxf(s0[r], s1[r]));
            mx = fmaxf(mx, __shfl_xor(mx, 32));
            const float mnew = fmaxf(mrun, mx);
            const float alpha = __builtin_amdgcn_exp2f(mrun - mnew);
            mrun = mnew;
            float ls = 0.f;
#pragma unroll
            for (int r = 0; r < 16; ++r) { s0[r] = __builtin_amdgcn_exp2f(s0[r] - mnew); s1[r] = __builtin_amdgcn_exp2f(s1[r] - mnew); ls += s0[r] + s1[r]; }
            lrun = lrun * alpha + ls;
#pragma unroll
            for (int i = 0; i < 4; ++i)
#pragma unroll
                for (int r = 0; r < 16; ++r) o[i][r] *= alpha;
            bf16x8 pf[4];
            { u32x4 w;
              w.x = pk2(s0[0], s0[1]); w.y = pk2(s0[2], s0[3]); w.z = pk2(s0[4], s0[5]); w.w = pk2(s0[6], s0[7]); pf[0] = __builtin_bit_cast(bf16x8, w);
              w.x = pk2(s0[8], s0[9]); w.y = pk2(s0[10], s0[11]); w.z = pk2(s0[12], s0[13]); w.w = pk2(s0[14], s0[15]); pf[1] = __builtin_bit_cast(bf16x8, w);
              w.x = pk2(s1[0], s1[1]); w.y = pk2(s1[2], s1[3]); w.z = pk2(s1[4], s1[5]); w.w = pk2(s1[6], s1[7]); pf[2] = __builtin_bit_cast(bf16x8, w);
              w.x = pk2(s1[8], s1[9]); w.y = pk2(s1[10], s1[11]); w.z = pk2(s1[12], s1[13]); w.w = pk2(s1[14], s1[15]); pf[3] = __builtin_bit_cast(bf16x8, w); }
#pragma unroll
            for (int blk = 0; blk < 4; ++blk)
#pragma unroll
                for (int s = 0; s < 4; ++s) {
                    const LAS unsigned char* vp = Vb + (32 * blk + r32) * AT_VROW + (16 * s + 4 * hi) * 2;
                    const u32x2 lo = *(const LAS u32x2*)vp, hh = *(const LAS u32x2*)(vp + 16);
                    const u32x4 w = (u32x4){lo.x, lo.y, hh.x, hh.y};
                    o[blk] = __builtin_amdgcn_mfma_f32_32x32x16_bf16(__builtin_bit_cast(bf16x8, w), pf[s], o[blk], 0, 0, 0);
                }
        }
        if (t + 1 < NT) AT_STORE((t + 1) & 1);
        __syncthreads();
    }
#undef AT_LOAD
#undef AT_STORE
    lrun += __shfl_xor(lrun, 32);
    const float inv = 1.f / lrun;
    LAS float* EX = (LAS float*)lds;
    if (j == 1) {
        const float sc = inv * lam;
#pragma unroll
        for (int blk = 0; blk < 4; ++blk)
#pragma unroll
            for (int r = 0; r < 16; ++r) EX[(wq * 64 + blk * 16 + r) * 64 + lane] = o[blk][r] * sc;
    }
    __syncthreads();
    if (j == 0) {
        float sq = 0.f;
#pragma unroll
        for (int blk = 0; blk < 4; ++blk)
#pragma unroll
            for (int r = 0; r < 16; ++r) { const float d = o[blk][r] * inv - EX[(wq * 64 + blk * 16 + r) * 64 + lane]; o[blk][r] = d; sq += d * d; }
        sq += __shfl_xor(sq, 32);
        const float rr = rsqrtf(sq * (1.f / 128.f) + EPS) * out_scale;
#pragma unroll
        for (int blk = 0; blk < 4; ++blk)
#pragma unroll
            for (int rq = 0; rq < 4; ++rq) {
                const int dv0 = 32 * blk + 8 * rq + 4 * hi;
                const f32x4 g = *(const f32x4*)(subln + dv0);
                u32x2 w; w.x = pk2(o[blk][4 * rq + 0] * rr * g[0], o[blk][4 * rq + 1] * rr * g[1]); w.y = pk2(o[blk][4 * rq + 2] * rr * g[2], o[blk][4 * rq + 3] * rr * g[3]);
                *(u32x2*)(OA + tok * 1024 + h * 128 + dv0) = w;
            }
    }
    __syncthreads();
}

__device__ __forceinline__ void dn_naive(LAS unsigned char* lds, unsigned char* ws, const float* convw  , int b, int h, int tid) {
    const int lane = tid & 63, wid = tid >> 6, dv = tid & 127, g4 = tid >> 7;
    LAS float* Y = (LAS float*)lds;
    LAS float* NR = Y + 384;
    LAS float* PT = NR + 8;
    LAS float* OP = PT + 512;
    float S[32];
#pragma unroll
    for (int i = 0; i < 32; ++i) S[i] = 0.f;
    bf16_t* QB = (bf16_t*)(ws + WS_QB); const bf16_t* KB = (const bf16_t*)(ws + WS_KB); const bf16_t* VB = (const bf16_t*)(ws + WS_VB);
    const float* GBp = (const float*)(ws + WS_GB);
    const int arr = tid >> 7;
    const bf16_t* src = (arr == 0 ? (const bf16_t*)QB : arr == 1 ? KB : VB) + h * 128 + dv;
    float w0 = 0.f, w1 = 0.f, w2 = 0.f, w3 = 0.f, x1 = 0.f, x2 = 0.f, x3 = 0.f;
    if (tid < 384) { const int ch = arr * 1024 + h * 128 + dv; w0 = convw[ch]; w1 = convw[3072 + ch]; w2 = convw[2 * 3072 + ch]; w3 = convw[3 * 3072 + ch]; }
    for (int t = 0; t < SEQ; ++t) {
        const size_t tok = (size_t)b * SEQ + t;
        if (tid < 384) {
            const float x0 = bf2f(src[tok * 1024]);
            float y = w0 * x3 + w1 * x2 + w2 * x1 + w3 * x0;
            y = siluf_(y); x3 = x2; x2 = x1; x1 = x0;
            Y[arr * 128 + dv] = y;
            const float sq = wave_sum(y * y);
            if (lane == 0) NR[wid] = sq;
        }
        __syncthreads();
        const float qn = rsqrtf(NR[0] + NR[1] + EPS) * 0.08838834764831845f, kn = rsqrtf(NR[2] + NR[3] + EPS);
        const float bt = GBp[tok * 16 + h], gt = GBp[tok * 16 + 8 + h], eg = __expf(gt);
        const float vv = Y[256 + dv];
        float ks = 0.f;
#pragma unroll
        for (int i = 0; i < 32; ++i) ks += Y[128 + 32 * g4 + i] * S[i];
        PT[g4 * 128 + dv] = ks * kn;
        __syncthreads();
        const float kS = (PT[dv] + PT[128 + dv]) + (PT[256 + dv] + PT[384 + dv]);
        const float c = bt * (vv - eg * kS);
        float op = 0.f;
#pragma unroll
        for (int i = 0; i < 32; ++i) { const float kk = Y[128 + 32 * g4 + i] * kn; S[i] = eg * S[i] + kk * c; op += Y[32 * g4 + i] * S[i]; }
        OP[g4 * 128 + dv] = op * qn;
        __syncthreads();
        if (g4 == 0) { const float ov = (OP[dv] + OP[128 + dv]) + (OP[256 + dv] + OP[384 + dv]); QB[tok * 1024 + h * 128 + dv] = f2bf(ov); }
    }
    __syncthreads();
}

__device__ __forceinline__ float row16_sum(float v) {
    v += __builtin_bit_cast(float, __builtin_amdgcn_update_dpp(0, __builtin_bit_cast(int, v), 0x128, 0xf, 0xf, false));
    v += __builtin_bit_cast(float, __builtin_amdgcn_update_dpp(0, __builtin_bit_cast(int, v), 0x124, 0xf, 0xf, false));
    v += __builtin_bit_cast(float, __builtin_amdgcn_update_dpp(0, __builtin_bit_cast(int, v), 0x122, 0xf, 0xf, false));
    v += __builtin_bit_cast(float, __builtin_amdgcn_update_dpp(0, __builtin_bit_cast(int, v), 0x121, 0xf, 0xf, false));
    return v;
}
__device__ __forceinline__ void dn_fast(LAS unsigned char* lds, unsigned char* ws, const float* convw  , int b, int h, int dvq, int tid) {
    const int lane = tid & 63, wid = tid >> 6, dvl = lane >> 4, grp = lane & 15;
    const int dvloc = 4 * wid + dvl, dv = 32 * dvq + dvloc;
    LAS float* Y = (LAS float*)lds;
    LAS float* NR = Y + 16 * 288;
    LAS float* GBs = NR + 16 * 16;
    LAS float* SC = GBs + 32;
    float S[8];
#pragma unroll
    for (int i = 0; i < 8; ++i) S[i] = 0.f;
    bf16_t* VB = (bf16_t*)(ws + WS_VB);
    const float* GBp = (const float*)(ws + WS_GB);
    const int arr = tid < 128 ? 0 : (tid < 256 ? 1 : 2);
    const int dch = arr == 2 ? 32 * dvq + ((tid - 256) & 31) : (tid & 127);
    const bf16_t* src = (const bf16_t*)(ws + (arr == 0 ? WS_QB : arr == 1 ? WS_KB : WS_VB)) + h * 128 + dch;
    float w0 = 0.f, w1 = 0.f, w2 = 0.f, w3 = 0.f, x1 = 0.f, x2 = 0.f, x3 = 0.f;
    if (tid < 288) { const int ch = arr * 1024 + h * 128 + dch; w0 = convw[ch]; w1 = convw[3072 + ch]; w2 = convw[2 * 3072 + ch]; w3 = convw[3 * 3072 + ch]; }
    for (int t0 = 0; t0 < SEQ; t0 += 16) {
        const size_t tokb = (size_t)b * SEQ + t0;
        if (tid < 288) {
            bf16_t xr[16];
#pragma unroll
            for (int tt = 0; tt < 16; ++tt) xr[tt] = src[(tokb + tt) * 1024];
#pragma unroll
            for (int tt = 0; tt < 16; ++tt) {
                const float x0 = bf2f(xr[tt]);
                float y = w0 * x3 + w1 * x2 + w2 * x1 + w3 * x0;
                y = siluf_(y); x3 = x2; x2 = x1; x1 = x0;
                Y[tt * 288 + tid] = y;
                if (tid < 256) { const float sq = row16_sum(y * y); if ((lane & 15) == 0) NR[tt * 16 + wid * 4 + (lane >> 4)] = sq; }
            }
        }
        if (tid >= 480) { const int i = tid - 480, tt = i >> 1, which = i & 1; GBs[tt * 2 + which] = GBp[(tokb + tt) * 16 + which * 8 + h]; }
        __syncthreads();
        if (tid < 16) {
            const f32x4 a = *(const LAS f32x4*)(NR + tid * 16), b2 = *(const LAS f32x4*)(NR + tid * 16 + 4), c2 = *(const LAS f32x4*)(NR + tid * 16 + 8), d2 = *(const LAS f32x4*)(NR + tid * 16 + 12);
            const float sq_q = ((a[0] + a[1]) + (a[2] + a[3])) + ((b2[0] + b2[1]) + (b2[2] + b2[3])), sq_k = ((c2[0] + c2[1]) + (c2[2] + c2[3])) + ((d2[0] + d2[1]) + (d2[2] + d2[3]));
            *(LAS f32x4*)(SC + tid * 4) = (f32x4){rsqrtf(sq_q + EPS) * 0.08838834764831845f, rsqrtf(sq_k + EPS), __expf(GBs[tid * 2 + 1]), GBs[tid * 2]};
        }
        __syncthreads();
#pragma unroll 4
        for (int tt = 0; tt < 16; ++tt) {
            const f32x4 sc = *(const LAS f32x4*)(SC + tt * 4);
            const float qn = sc[0], kn = sc[1], eg = sc[2], bt = sc[3];
            const f32x4 ka = *(const LAS f32x4*)(Y + tt * 288 + 128 + 8 * grp), kb = *(const LAS f32x4*)(Y + tt * 288 + 128 + 8 * grp + 4);
            const f32x4 qa = *(const LAS f32x4*)(Y + tt * 288 + 8 * grp), qb = *(const LAS f32x4*)(Y + tt * 288 + 8 * grp + 4);
            const float vv = Y[tt * 288 + 256 + dvloc];
            float ks = (ka[0] * S[0] + ka[1] * S[1]) + (ka[2] * S[2] + ka[3] * S[3]) + (kb[0] * S[4] + kb[1] * S[5]) + (kb[2] * S[6] + kb[3] * S[7]);
            ks = row16_sum(ks);
            const float c = bt * (vv - eg * ks * kn) * kn;
            float op = 0.f;
#pragma unroll
            for (int i = 0; i < 4; ++i) { S[i] = eg * S[i] + ka[i] * c; op += qa[i] * S[i]; S[4 + i] = eg * S[4 + i] + kb[i] * c; op += qb[i] * S[4 + i]; }
            op = row16_sum(op);
            if (grp == 0) VB[(tokb + tt) * 1024 + h * 128 + dv] = f2bf(op * qn);
        }
        __syncthreads();
    }
}

#define GEMM_PHASE(EPI, Aptr, Bptr, Mv, Nv, Kv, Eobj, HM) do { int m_ = (Mv), n_ = (Nv), k_ = (Kv); asm volatile("" : "+s"(m_), "+s"(n_), "+s"(k_)); pg8::Gemm g_{(const pg8::bf16_t*)(Aptr), (const pg8::bf16_t*)(Bptr), m_, n_, k_, (HM)}; pg8::StaticOrder S_; S_.init(m_, n_, G, bid); \
        pg8::gemm_phase<EPI, pg8::StaticOrder, true, true>(lds, g_, S_, (Eobj)); } while (0)

__global__ void __launch_bounds__(NTHR, 2) fwd_mega(Params P) {
    extern __shared__ __attribute__((aligned(16))) unsigned char lds_raw[];
    LAS unsigned char* lds = (LAS unsigned char*)lds_raw;
    cg::grid_group grid = cg::this_grid();
    if (threadIdx.x == 0) {
        const unsigned xcc = (unsigned)__builtin_amdgcn_s_getreg((3 << 11) | 20) & 7u;
        const unsigned loc = __hip_atomic_fetch_add((unsigned*)(P.ws + WS_CTL) + xcc, 1u, __ATOMIC_RELAXED, __HIP_MEMORY_SCOPE_AGENT);
        *(LAS int*)(lds + LDS_VB) = (int)((loc & 31u) * 8u + xcc);
    }
    __syncthreads();
    int seg = 0; const int seg_lo = P.seg_lo, seg_hi = P.seg_hi;
#ifdef L2FLUSH
#define L2_FLUSH() do { const Params* PF = (const Params*)__builtin_amdgcn_kernarg_segment_ptr(); asm volatile("" : "+s"(PF)); int tf_ = threadIdx.x; asm volatile("" : "+v"(tf_)); \
        const u32x4* jp = (const u32x4*)(PF->in[I_P]) + (size_t)blockIdx.x * (L2FLUSH * 64) + tf_; unsigned acc_ = 0u; \
        for (int q_ = 0; q_ < L2FLUSH * 64 / 512; ++q_) { const u32x4 v_ = __builtin_nontemporal_load(jp + (size_t)q_ * 512); acc_ |= v_.x & v_.y & v_.z & v_.w; asm volatile("" ::: "memory"); } \
        if (acc_ == 0x12345678u) PF->out[0] = 0.f; } while (0)
#else
#define L2_FLUSH() do {} while (0)
#endif
#ifdef NOSEG
#define SYNCCOND true
#else
#define SYNCCOND (seg >= seg_lo && seg + 1 < seg_hi)
#endif
#define GRID_SYNC() do { if (SYNCCOND) { asm volatile("s_waitcnt vmcnt(0) lgkmcnt(0)" ::: "memory");   grid.sync(); L2_FLUSH(); \
        __builtin_amdgcn_fence(__ATOMIC_ACQUIRE, "agent"); asm volatile("s_waitcnt vmcnt(0)" ::: "memory"); } ++seg; } while (0)
#ifdef NOSEG
#define SEGCOND true
#else
#define SEGCOND (seg >= seg_lo && seg < seg_hi)
#endif
#define PH_BEGIN if (SEGCOND) { const Params* PQ = (const Params*)__builtin_amdgcn_kernarg_segment_ptr(); asm volatile("" : "+s"(PQ)); int tid = threadIdx.x; asm volatile("" : "+v"(tid)); \
    const int lane = tid & 63, wave = __builtin_amdgcn_readfirstlane(tid >> 6); int bid = __builtin_amdgcn_readfirstlane(*(LAS int*)(lds + LDS_VB)), G = gridDim.x; asm volatile("" : "+s"(bid), "+s"(G)); \
    const int xb_ = bid & 7, jb_ = bid >> 3, wj = jb_ * NW + wave;     \
    unsigned char* ws = PQ->ws; float* X = PQ->out; float* SS = (float*)(ws + WS_SS); bf16_t* XB = (bf16_t*)(ws + WS_XB); \
    float* ss_attn = (float*)(ws + WS_HALO); float* ss_ffn = ss_attn + (size_t)MTOK * 16; float* ss_ple = ss_ffn + (size_t)MTOK * 16; float* ss_next = ss_attn; \
    (void)lane; (void)xb_; (void)jb_; (void)wj; (void)X; (void)XB; (void)ss_attn; (void)ss_ffn; (void)ss_ple; (void)ss_next; (void)G;
#define PH_END }
#define U ((bf16_t*)(ws + WS_MIX))
#define ACT ((bf16_t*)(ws + WS_MIX + 176 * MiB))

    { const int layer = 0; PH_BEGIN
      if (bid == 0 && tid == 0) __hip_atomic_store((unsigned*)(ws + WS_CTL) + 16, 0u, __ATOMIC_RELAXED, __HIP_MEMORY_SCOPE_AGENT);
      const float* xin = PQ->in[I_X];
      for (int r = wj; r < SEQ; r += 256) {
          const int m = xb_ * SEQ + r;
          const f32x4* xr = (const f32x4*)(xin + (size_t)m * 1024) + lane;
          f32x4 v[4]; float s = 0.f;
#pragma unroll
          for (int jj = 0; jj < 4; ++jj) { v[jj] = xr[64 * jj]; s += (v[jj][0] * v[jj][0] + v[jj][1] * v[jj][1]) + (v[jj][2] * v[jj][2] + v[jj][3] * v[jj][3]); }
          s = wave_sum(s);
          if (lane < 16) ss_attn[(size_t)m * 16 + lane] = lane == 0 ? s : 0.f;
          f32x4* xo = (f32x4*)(X + (size_t)m * 1024) + lane;
          u32x2* bo = (u32x2*)(XB + (size_t)m * 1024) + lane;
#pragma unroll
          for (int jj = 0; jj < 4; ++jj) { xo[64 * jj] = v[jj]; u32x2 w; w.x = pk2(v[jj][0], v[jj][1]); w.y = pk2(v[jj][2], v[jj][3]); bo[64 * jj] = w; }
      }
    PH_END }

    for (int layer = 0; layer < NLAYER; ++layer) {
        asm volatile("" ::: "memory");
        const float lam_init = 0.8f - 0.6f * __expf(-0.3f * (float)layer);
        PH_BEGIN
        convert_weights(PQ, layer, lds, bid * NW + wave, G * NW, wave, lane);
        { const float* pl = PQ->in[I_P] + ((size_t)layer * MTOK + (size_t)xb_ * SEQ) * DPLE;
          bf16_t* pb = (bf16_t*)(ws + WS_PB) + (size_t)xb_ * SEQ * DPLE;
          for (int i = jb_ * NTHR + tid; i < SEQ * DPLE / 8; i += 32 * NTHR) {
              const f32x4 a = *(const f32x4*)(pl + (size_t)i * 8), b = *(const f32x4*)(pl + (size_t)i * 8 + 4);
              u32x4 w; w.x = pk2(a[0], a[1]); w.y = pk2(a[2], a[3]); w.z = pk2(b[0], b[1]); w.w = pk2(b[2], b[3]);
              *(u32x4*)(pb + (size_t)i * 8) = w;
          }
        }
        PH_END
        GRID_SYNC();
#ifdef DBLTEST
#ifdef DBL_SC
#define DBL_LD(p) ldc16(p)
#else
#define DBL_LD(p) (*(p))
#endif
        if (layer == 0) {
#ifdef DBL_OUTP
        PH_BEGIN
        { EpiResid E{X, XB, ss_ffn, nullptr, -1};
          GEMM_PHASE(EpiResid, ws + WS_VT, ws + W_OUT, MTOK, 1024, 1024, E, -1); }
        PH_END
        GRID_SYNC();
#endif
        for (int rep = 0; rep < 2; ++rep) {
        PH_BEGIN
#ifdef DBL_COPY
            { const u32x4* s4 = (const u32x4*)XB; u32x4* d4 = (u32x4*)(ws + WS_MIX + (size_t)rep * 176 * MiB);
              const size_t per = (size_t)DBL_M * DBL_N * 2 / 16 / 8;
              for (size_t i = (size_t)((jb_ + rep * 13) & 31) * NTHR + tid; i < per; i += (size_t)32 * NTHR) d4[(size_t)xb_ * per + i] = DBL_LD(s4 + (size_t)xb_ * per + i); }
#else
#ifndef DBL_W
#define DBL_W W_UP
#define DBL_ACT 0
#endif
            { EpiRowScale<DBL_ACT> E{(bf16_t*)(ws + WS_MIX + (size_t)rep * DBL_OFF * MiB), DBL_N, ss_attn, DBL_H};
              GEMM_PHASE(EpiRowScale<DBL_ACT>, XB, ws + DBL_W, DBL_M, DBL_N, 1024, E, DBL_H); }
#endif
        PH_END
        GRID_SYNC();
        }
        PH_BEGIN
        { const u32x4* a4 = (const u32x4*)(ws + WS_MIX); const u32x4* b4 = (const u32x4*)(ws + WS_MIX + (size_t)DBL_OFF * MiB); unsigned bad = 0u;
          const size_t per = (size_t)DBL_M * DBL_N * 2 / 16 / 8;
          for (size_t i0 = (size_t)((jb_ + 7) & 31) * NTHR + tid; i0 < per; i0 += (size_t)32 * NTHR) { const size_t i = (size_t)xb_ * per + i0; const u32x4 a = DBL_LD(a4 + i), b = DBL_LD(b4 + i); bad |= ((a.x ^ b.x) | (a.y ^ b.y) | (a.z ^ b.z) | (a.w ^ b.w)) ? 1u : 0u; }
          if (bad) __hip_atomic_fetch_or((unsigned*)(ws + WS_CTL) + 16, 1u, __ATOMIC_RELAXED, __HIP_MEMORY_SCOPE_AGENT); }
        PH_END
        GRID_SYNC();
        }
#endif
#if defined(DBLMIX) && !defined(DBLMIX_AT_GATES)
        for (int rep = 0; rep < 2; ++rep) {
#endif
#ifndef NO_INPROJ
        PH_BEGIN
        { EpiQK E{ws, ss_attn, PQ->in[I_QNORM] + layer * 64, PQ->in[I_KNORM] + layer * 64};
          GEMM_PHASE(EpiQK, XB, ws + W_IN, MTOK, 2048, 1024, E, -1); }
        PH_END
        PH_BEGIN
        { EpiSeg E{ws, ss_attn};
          GEMM_PHASE(EpiSeg, XB, ws + W_IN + (size_t)2048 * 2048, MTOK, 4096, 1024, E, -1); }
        PH_END
        PH_BEGIN
        { EpiGB E{ws, ss_attn, PQ->in[I_ALOG] + layer * 8, PQ->in[I_DTB] + layer * 8};
          GEMM_PHASE(EpiGB, XB, ws + W_IN + (size_t)6144 * 2048, MTOK, 256, 1024, E, -1); }
        PH_END
        PH_BEGIN
        { EpiVt E{(bf16_t*)(ws + WS_VT), ss_attn};
          GEMM_PHASE(EpiVt, ws + W_V, XB, 1024, MTOK, 1024, E, -1); }
        PH_END
#endif
        GRID_SYNC();
#ifndef NO_ATTN
        PH_BEGIN
        { const float* lq = PQ->in[I_LAM] + layer * 256;
          const float a1 = wave_sum(lq[lane] * lq[64 + lane]), a2 = wave_sum(lq[128 + lane] * lq[192 + lane]);
          const float lam = __expf(a1) - __expf(a2) + lam_init;
          for (int k = 0; k < 4; ++k) {
              const int pi = jb_ + 32 * k, hh = pi >> 4, s = pi & 15;
              attn_unit(lds, (const bf16_t*)(ws + WS_QA), (const bf16_t*)(ws + WS_KA), (const bf16_t*)(ws + WS_VT), (bf16_t*)(ws + WS_QA), xb_, hh, 31 - s, lam, 1.f - lam_init, PQ->in[I_SUBLN] + layer * 128, PQ->in[I_RELB], tid);
              attn_unit(lds, (const bf16_t*)(ws + WS_QA), (const bf16_t*)(ws + WS_KA), (const bf16_t*)(ws + WS_VT), (bf16_t*)(ws + WS_QA), xb_, hh, s, lam, 1.f - lam_init, PQ->in[I_SUBLN] + layer * 128, PQ->in[I_RELB], tid);
          }
        }
        PH_END
#endif
#ifndef NO_DN
        PH_BEGIN
#ifdef DN_NAIVE
        if (jb_ < 8) dn_naive(lds, ws, PQ->in[I_CONVB] + (size_t)layer * 4 * 3072, xb_, jb_, tid);
#else
        dn_fast(lds, ws, PQ->in[I_CONVB] + (size_t)layer * 4 * 3072, xb_, jb_ >> 2, jb_ & 3, tid);
#endif
        PH_END
#endif
        GRID_SYNC();
#if defined(DBLMIX) && defined(DBLMIX_AT_GATES)
        for (int rep = 0; rep < 2; ++rep) {
#endif
#ifndef NO_GATES
        PH_BEGIN
        { EpiRowScale<1> E{(bf16_t*)(ws + WS_G), 2048, ss_attn, -1};
          GEMM_PHASE(EpiRowScale<1>, XB, ws + W_GL, MTOK, 2048, 1024, E, -1); }
        PH_END
#endif
#ifndef NO_OBNORM
        PH_BEGIN
        { const float* on = PQ->in[I_ONORM] + layer * 128;
          const float g0 = on[2 * lane], g1 = on[2 * lane + 1];
          unsigned* OB = (unsigned*)(ws + WS_QB) + (size_t)xb_ * SEQ * 512; const unsigned* OI = (const unsigned*)(ws + WS_OSRC) + (size_t)xb_ * SEQ * 512; const unsigned* ZB = (const unsigned*)(ws + WS_ZB) + (size_t)xb_ * SEQ * 512;
          for (int r = wj; r < SEQ * NH; r += 256) {
              const unsigned ov = OI[(size_t)r * 64 + lane], zv = ZB[(size_t)r * 64 + lane];
              const float o0 = bflo(ov), o1 = bfhi(ov);
              const float sq = wave_sum(o0 * o0 + o1 * o1);
              const float rr = rsqrtf(sq * (1.f / 128.f) + EPS);
              OB[(size_t)r * 64 + lane] = pk2(o0 * rr * g0 * siluf_(bflo(zv)), o1 * rr * g1 * siluf_(bfhi(zv)));
          }
        }
        PH_END
#endif
        GRID_SYNC();
#ifndef NO_TMPA
        PH_BEGIN
        { EpiGateMul E{(bf16_t*)(ws + WS_TMPA), (const bf16_t*)(ws + WS_G), 2048, 0, nullptr};
          GEMM_PHASE(EpiGateMul, ws + WS_QA, ws + W_BRA, MTOK, 1024, 1024, E, -1); }
        PH_END
#endif
        GRID_SYNC();
#ifndef NO_MIXED
        PH_BEGIN
        { EpiGateMul E{(bf16_t*)(ws + WS_MIXED), (const bf16_t*)(ws + WS_G), 2048, 1024, (const bf16_t*)(ws + WS_TMPA)};
          GEMM_PHASE(EpiGateMul, ws + WS_QB, ws + W_BRB, MTOK, 1024, 1024, E, -1); }
        PH_END
#endif
        GRID_SYNC();
#ifdef DBLMIX
        PH_BEGIN
        { const u32x4* t4 = (const u32x4*)(ws + (size_t)DBL_TGT + (size_t)xb_ * ((size_t)DBL_TGT_BYTES / 8)); u32x4* s4 = (u32x4*)(ws + WS_PB + (size_t)xb_ * 2 * MiB); unsigned bad = 0u;
          for (size_t i = (size_t)((jb_ + 5 * rep) & 31) * NTHR + tid; i < (size_t)2 * MiB / 16; i += (size_t)32 * NTHR) {
              const u32x4 a = t4[i];
              if (rep == 0) s4[i] = a; else { const u32x4 b = s4[i]; bad |= ((a.x ^ b.x) | (a.y ^ b.y) | (a.z ^ b.z) | (a.w ^ b.w)) ? 1u : 0u; } }
          if (bad) __hip_atomic_fetch_or((unsigned*)(ws + WS_CTL) + 16, 1u, __ATOMIC_RELAXED, __HIP_MEMORY_SCOPE_AGENT); }
        PH_END
        GRID_SYNC();
        }
#endif
#ifndef NO_OUTP
        PH_BEGIN
        { EpiResid E{X, XB, ss_ffn, nullptr, -1};
          GEMM_PHASE(EpiResid, ws + WS_MIXED, ws + W_OUT, MTOK, 1024, 1024, E, -1); }
        PH_END
#endif
        GRID_SYNC();
        for (int half = 0; half < 2; ++half) {
#ifndef NO_UP
        PH_BEGIN
            { EpiRowScale<0> E{U, 5632, ss_ffn, half};
              GEMM_PHASE(EpiRowScale<0>, XB, ws + W_UP, 16384, 5632, 1024, E, half); }
        PH_END
#endif
            GRID_SYNC();
#ifndef NO_ACT
        PH_BEGIN
            { const float* cw = PQ->in[I_CONVFF] + (size_t)layer * 3 * 5632; const float* cb = PQ->in[I_CONVFFB] + (size_t)layer * 5632;
              bf16_t* UH = (bf16_t*)(ws + WS_UHALO) + (size_t)xb_ * 2 * 5632;
              for (int it = jb_ * NTHR + tid; it < 128 * 352; it += 32 * NTHR) {
                  const int cc = it % 352, rg = it / 352, c0 = cc * 8;
                  const int lrow0 = xb_ * 2048 + rg * 16;
                  float wg[3][8], wv[3][8], bg[8], bv[8];
#pragma unroll
                  for (int jj = 0; jj < 3; ++jj)
#pragma unroll
                      for (int e = 0; e < 8; ++e) { wg[jj][e] = cw[jj * 5632 + c0 + e]; wv[jj][e] = cw[jj * 5632 + 2816 + c0 + e]; }
#pragma unroll
                  for (int e = 0; e < 8; ++e) { bg[e] = cb[c0 + e]; bv[e] = cb[2816 + c0 + e]; }
                  float g2[8], g1[8], v2[8], v1[8];
#pragma unroll
                  for (int e = 0; e < 8; ++e) { g2[e] = 0.f; g1[e] = 0.f; v2[e] = 0.f; v1[e] = 0.f; }
                  if (rg > 0 || half == 1) {
                      const bf16_t* r2p = rg > 0 ? U + (size_t)(lrow0 - 2) * 5632 : UH;
                      const bf16_t* r1p = rg > 0 ? U + (size_t)(lrow0 - 1) * 5632 : UH + 5632;
                      const u32x4 a = *(const u32x4*)(r2p + c0), bq = *(const u32x4*)(r1p + c0);
                      const u32x4 c = *(const u32x4*)(r2p + 2816 + c0), d = *(const u32x4*)(r1p + 2816 + c0);
                      g2[0] = bflo(a.x); g2[1] = bfhi(a.x); g2[2] = bflo(a.y); g2[3] = bfhi(a.y); g2[4] = bflo(a.z); g2[5] = bfhi(a.z); g2[6] = bflo(a.w); g2[7] = bfhi(a.w);
                      g1[0] = bflo(bq.x); g1[1] = bfhi(bq.x); g1[2] = bflo(bq.y); g1[3] = bfhi(bq.y); g1[4] = bflo(bq.z); g1[5] = bfhi(bq.z); g1[6] = bflo(bq.w); g1[7] = bfhi(bq.w);
                      v2[0] = bflo(c.x); v2[1] = bfhi(c.x); v2[2] = bflo(c.y); v2[3] = bfhi(c.y); v2[4] = bflo(c.z); v2[5] = bfhi(c.z); v2[6] = bflo(c.w); v2[7] = bfhi(c.w);
                      v1[0] = bflo(d.x); v1[1] = bfhi(d.x); v1[2] = bflo(d.y); v1[3] = bfhi(d.y); v1[4] = bflo(d.z); v1[5] = bfhi(d.z); v1[6] = bflo(d.w); v1[7] = bfhi(d.w);
                  }
                  for (int rr = 0; rr < 16; ++rr) {
                      const size_t row = (size_t)lrow0 + rr;
                      const u32x4 a = *(const u32x4*)(U + row * 5632 + c0), c = *(const u32x4*)(U + row * 5632 + 2816 + c0);
                      if (half == 0 && rg == 127 && rr >= 14) { *(u32x4*)(UH + (size_t)(rr - 14) * 5632 + c0) = a; *(u32x4*)(UH + (size_t)(rr - 14) * 5632 + 2816 + c0) = c; }
                      float g0[8], v0[8], ov[8];
                      g0[0] = bflo(a.x); g0[1] = bfhi(a.x); g0[2] = bflo(a.y); g0[3] = bfhi(a.y); g0[4] = bflo(a.z); g0[5] = bfhi(a.z); g0[6] = bflo(a.w); g0[7] = bfhi(a.w);
                      v0[0] = bflo(c.x); v0[1] = bfhi(c.x); v0[2] = bflo(c.y); v0[3] = bfhi(c.y); v0[4] = bflo(c.z); v0[5] = bfhi(c.z); v0[6] = bflo(c.w); v0[7] = bfhi(c.w);
#pragma unroll
                      for (int e = 0; e < 8; ++e) {
                          const float ug = wg[0][e] * g2[e] + wg[1][e] * g1[e] + wg[2][e] * g0[e] + bg[e];
                          const float uv = wv[0][e] * v2[e] + wv[1][e] * v1[e] + wv[2][e] * v0[e] + bv[e];
                          ov[e] = siluf_(ug) * uv; g2[e] = g1[e]; g1[e] = g0[e]; v2[e] = v1[e]; v1[e] = v0[e];
                      }
                      u32x4 w; w.x = pk2(ov[0], ov[1]); w.y = pk2(ov[2], ov[3]); w.z = pk2(ov[4], ov[5]); w.w = pk2(ov[6], ov[7]);
                      *(u32x4*)(ACT + row * 2816 + c0) = w;
                  }
              }
            }
        PH_END
#endif
            GRID_SYNC();
#ifndef NO_DOWN
        PH_BEGIN
            { EpiResid E{X, XB, ss_ple, nullptr, half};
              GEMM_PHASE(EpiResid, ACT, ws + W_DOWN, 16384, 1024, 2816, E, -1); }
        PH_END
#endif
            GRID_SYNC();
        }
#ifndef NO_PLEG
        PH_BEGIN
        { EpiRowScale<1> E{(bf16_t*)(ws + WS_MIX), 1024, ss_ple, -1};
          GEMM_PHASE(EpiRowScale<1>, XB, ws + W_PG, MTOK, 1024, 1024, E, -1); }
        PH_END
#endif
        GRID_SYNC();
#ifndef NO_PLE
        PH_BEGIN
        { EpiResid E{X, XB, ss_next, (const bf16_t*)(ws + WS_MIX), -1};
          GEMM_PHASE(EpiResid, ws + WS_PB, ws + W_PP, MTOK, 1024, 256, E, -1); }
        PH_END
#endif
        GRID_SYNC();
    }
#ifdef NANCHK
    { const int layer = 0; PH_BEGIN
      unsigned bad = 0u;
      for (size_t i = (size_t)bid * NTHR + tid; i < (size_t)MTOK * 256; i += (size_t)G * NTHR) { const f32x4 v = *(const f32x4*)(X + i * 4);
          for (int e = 0; e < 4; ++e) bad |= ((__float_as_uint(v[e]) & 0x7f800000u) == 0x7f800000u) ? 1u : 0u; }
#ifdef NANCHK_BF_LO
      { const unsigned* bp = (const unsigned*)(ws + (size_t)NANCHK_BF_LO); const size_t nw = ((size_t)NANCHK_BF_HI - (size_t)NANCHK_BF_LO) / 4;
        for (size_t i = (size_t)bid * NTHR + tid; i < nw; i += (size_t)G * NTHR) { const unsigned w = bp[i]; bad |= (((w & 0x7f80u) == 0x7f80u) || ((w & 0x7f800000u) == 0x7f800000u)) ? 1u : 0u; } }
#endif
      if (bad) __hip_atomic_fetch_or((unsigned*)(ws + WS_CTL) + 16, 1u, __ATOMIC_RELAXED, __HIP_MEMORY_SCOPE_AGENT);
      PH_END }
    GRID_SYNC();
    { const int layer = 0; PH_BEGIN
      const unsigned fl = __hip_atomic_fetch_or((unsigned*)(ws + WS_CTL) + 16, 0u, __ATOMIC_RELAXED, __HIP_MEMORY_SCOPE_AGENT);
      if (fl) for (size_t i = (size_t)bid * NTHR + tid; i < (size_t)MTOK * 256; i += (size_t)G * NTHR) *(f32x4*)(X + i * 4) = (f32x4){0.f, 0.f, 0.f, 0.f};
      PH_END }
#endif
#undef U
#undef ACT
}

extern "C" void kernel_launch(void* const* d_in, const int* in_sizes, int n_in, void* d_out, int out_size, void* d_ws, size_t ws_size, hipStream_t stream) {
    static int grid = 0;
    if (grid == 0) {
        if (n_in != 24 || out_size != MTOK * DM || ws_size < WS_TOTAL) { fprintf(stderr, "kernel_launch: unexpected shapes / workspace (n_in %d out %d ws %zu need %zu)\n", n_in, out_size, ws_size, (size_t)WS_TOTAL); grid = -1; return; }
        int dev = 0, cus = 0, per_cu = 0;
        hipGetDevice(&dev);
        hipDeviceGetAttribute(&cus, hipDeviceAttributeMultiprocessorCount, dev);
        hipFuncSetAttribute((const void*)fwd_mega, hipFuncAttributeMaxDynamicSharedMemorySize, LDS_BYTES);
        hipOccupancyMaxActiveBlocksPerMultiprocessor(&per_cu, (const void*)fwd_mega, NTHR, LDS_BYTES);
        if (per_cu < 1) { fprintf(stderr, "kernel_launch: occupancy query says %d blocks per CU\n", per_cu); per_cu = 1; }
        (void)hipGetLastError();
        grid = cus;
    }
    if (grid < 0) return;
    Params p{};
    for (int i = 0; i < 24; ++i) p.in[i] = (const float*)d_in[i];
    p.out = (float*)d_out; p.ws = (unsigned char*)d_ws;
    hipError_t e = hipSuccess;
#ifdef N_SEG_LAUNCH
    for (int sgi = 0; sgi < 60 && e == hipSuccess; sgi += N_SEG_LAUNCH) {
        p.seg_lo = sgi; p.seg_hi = sgi + N_SEG_LAUNCH;
        void* args[] = {&p};
        e = hipLaunchCooperativeKernel((const void*)fwd_mega, dim3(grid), dim3(NTHR), args, LDS_BYTES, stream);
    }
#else
    p.seg_lo = 0; p.seg_hi = 1000;
    void* args[] = {&p};
    e = hipLaunchCooperativeKernel((const void*)fwd_mega, dim3(grid), dim3(NTHR), args, LDS_BYTES, stream);
#endif
    if (e != hipSuccess) fprintf(stderr, "cooperative launch failed: %s (grid %d)\n", hipGetErrorString(e), grid);
}
```

```cpp
#include <hip/hip_runtime.h>
#include <hip/hip_cooperative_groups.h>
#include <cstdio>
#include <cstdint>
namespace cg = cooperative_groups;
namespace pg8 {
#define PG8_LAS __attribute__((address_space(3)))
typedef unsigned short bf16_t;
typedef short bf16x8 __attribute__((ext_vector_type(8)));
typedef float f32x4 __attribute__((ext_vector_type(4)));
typedef unsigned u32x4 __attribute__((ext_vector_type(4)));
constexpr int BM = 256, BK = 64, HALF = 128, HTB = HALF * BK * 2  , STAGE_BYTES = 8 * HTB, NXCD = 8, WGM = 8;

__host__ __device__ __forceinline__ int lds_byte(int r, int c) { const int st = (r >> 4) * 2 + (c >> 5), rr = r & 15, cc = c & 31, ob = rr * 64 + cc * 2; return st * 1024 + (ob ^ (((ob >> 9) & 1) << 5)); }
__host__ __device__ __forceinline__ void stage_rc(int b, int& R, int& C) { const int st = b / 1024, sb = b % 1024, swz = sb ^ (((sb >> 9) & 1) << 5); R = (st >> 1) * 16 + swz / 64; C = (st & 1) * 32 + (swz % 64) / 2; }
__host__ __device__ __forceinline__ int perm32(int rho) { const int n = rho >> 4, i = rho & 15; return 8 * (i >> 2) + 4 * n + (i & 3); }

struct Unit { int pm, pn; };
struct Gemm { const bf16_t* A; const bf16_t* Bt; int M, N, K; int hmap; };
__device__ __forceinline__ int amap(int pm, int hmap) { return hmap < 0 ? pm : ((pm >> 3) * 16 + 8 * hmap + (pm & 7)); }

struct StaticOrder {
    int nM, nN, nwg, G, c;
    __host__ __device__ void init(int M, int N, int G_, int c_) { nM = M / BM; nN = N / BM; nwg = nM * nN; G = G_; c = c_; }
    __host__ __device__ bool next(int i, Unit& u) const {
        const long L = (long)i * G + c; if (L >= nwg) return false;
        int wgid = (int)L; { const int q = nwg / NXCD, r = nwg % NXCD, xcd = wgid % NXCD, off = wgid / NXCD; wgid = (xcd < r ? xcd * (q + 1) : r * (q + 1) + (xcd - r) * q) + off; }
        const int nig = WGM * nN, gid = wgid / nig, fm = gid * WGM, gsz = (nM - fm) < WGM ? (nM - fm) : WGM;
        u.pm = fm + ((wgid % nig) % gsz); u.pn = (wgid % nig) / gsz; return true;
    }
    __device__ __forceinline__ void a_ready(const Unit&) const {}
    __device__ __forceinline__ void done(const Unit&) const {}
};
__device__ __forceinline__ unsigned cvt_pk_bf16(float lo, float hi) { unsigned r; asm volatile("v_cvt_pk_bf16_f32 %0, %1, %2" : "=v"(r) : "v"(lo), "v"(hi)); return r; }
#ifdef NO_UNI
__device__ __forceinline__ const char* uni(const char* p) { return p; }
#else
__device__ __forceinline__ const char* uni(const char* p) { const unsigned long long v = (unsigned long long)p; const unsigned lo = __builtin_amdgcn_readfirstlane((unsigned)v), hi = __builtin_amdgcn_readfirstlane((unsigned)(v >> 32)); return (const char*)(((unsigned long long)hi << 32) | lo); }
#endif
template <class Epi, class Sched, bool ALIGN_EPI = false, bool SP2 = false>
__device__ __forceinline__ void gemm_phase(PG8_LAS unsigned char* lds, const Gemm g, const Sched& S, const Epi& E) {
    int tid = threadIdx.x;
#ifndef NO_LAUNDER
    asm volatile("" : "+v"(tid));
#endif

    const int wid = __builtin_amdgcn_readfirstlane(tid >> 6), lane = tid & 63, wr = wid >> 2, wc = wid & 3, fr = lane & 15, fq = lane >> 4;
    const int K = g.K, nt = K / BK;
    unsigned voffA[2], voffB[2];
#pragma unroll
    for (int i = 0; i < 2; ++i) { int R, C; stage_rc(tid * 16 + i * 8192, R, C); const int Rb = Epi::PERM ? ((R & ~31) + perm32(R & 31)) : R;
        voffA[i] = (unsigned)(R * K + C) * 2u; voffB[i] = (unsigned)(Rb * K + C) * 2u; }
    const size_t kstep = (size_t)(BK * 2);
    const size_t hstep = (size_t)HALF * K * 2;
    const size_t tstep = 2 * hstep;
    const unsigned ldsw = (unsigned)wid * 1024u;
    const int aoff = lds_byte(wr * 64 + fr, fq * 8), boff = lds_byte(wc * 32 + fr, fq * 8);
#define PG8_SA(b, h) (((b) * 2 + (h)) * HTB)
#define PG8_SB(b, h) ((4 + (b) * 2 + (h)) * HTB)
#define PG8_STAGE(bufoff, gbase, voff) do { _Pragma("unroll") for (int _i = 0; _i < 2; ++_i) \
        __builtin_amdgcn_global_load_lds((const unsigned*)((const char*)(gbase) + (voff)[_i]), (PG8_LAS unsigned*)(lds + (bufoff) + ldsw + _i * 8192), 16, 0, 0); } while (0)
#define PG8_LDA(dst, b, h) do { _Pragma("unroll") for (int m = 0; m < 4; ++m) _Pragma("unroll") for (int k = 0; k < 2; ++k) dst[m][k] = *(const PG8_LAS bf16x8*)(lds + PG8_SA(b, h) + aoff + m * 2048 + k * 1024); } while (0)
#define PG8_LDB(dst, b, h) do { _Pragma("unroll") for (int n = 0; n < 2; ++n) _Pragma("unroll") for (int k = 0; k < 2; ++k) dst[n][k] = *(const PG8_LAS bf16x8*)(lds + PG8_SB(b, h) + boff + n * 2048 + k * 1024); } while (0)
#define PG8_MMA(ai, bj, At, Bt) do { __builtin_amdgcn_s_setprio(1); _Pragma("unroll") for (int m = 0; m < 4; ++m) _Pragma("unroll") for (int n = 0; n < 2; ++n) _Pragma("unroll") for (int k = 0; k < 2; ++k) \
        acc[ai][bj][m][n] = __builtin_amdgcn_mfma_f32_16x16x32_bf16(Bt[n][k], At[m][k], acc[ai][bj][m][n], 0, 0, 0); __builtin_amdgcn_s_setprio(0); } while (0)
#define PG8_WAIT_V(n) asm volatile("s_waitcnt vmcnt(" #n ")" ::: "memory")
#define PG8_WAIT_L(n) asm volatile("s_waitcnt lgkmcnt(" #n ")" ::: "memory")
#define PG8_BAR __builtin_amdgcn_s_barrier()
#define PG8_SCHED __builtin_amdgcn_sched_barrier(0)
    Unit cur, nxt; int ui = 0;
    if (!S.next(0, cur)) return;
    f32x4 acc[2][2][4][2];
#pragma unroll
    for (int a = 0; a < 2; ++a)
#pragma unroll
        for (int b = 0; b < 2; ++b)
#pragma unroll
            for (int m = 0; m < 4; ++m)
#pragma unroll
                for (int n = 0; n < 2; ++n) acc[a][b][m][n] = (f32x4){0.f, 0.f, 0.f, 0.f};
    bf16x8 At[4][2], B0[2][2], B1[2][2];
    const char* cA = uni((const char*)g.A + (size_t)amap(cur.pm, g.hmap) * tstep); const char* cB = uni((const char*)g.Bt + (size_t)cur.pn * tstep);
    S.a_ready(cur);
    if constexpr (SP2) {
        PG8_STAGE(PG8_SB(0, 0), cB, voffB); PG8_STAGE(PG8_SB(0, 1), cB + hstep, voffB); PG8_STAGE(PG8_SA(0, 0), cA, voffA); PG8_STAGE(PG8_SA(0, 1), cA + hstep, voffA);
        if (wr == 1) PG8_BAR;
        PG8_WAIT_V(2); PG8_BAR;
        PG8_STAGE(PG8_SB(1, 0), cB + kstep, voffB); PG8_STAGE(PG8_SA(1, 0), cA + kstep, voffA); PG8_STAGE(PG8_SB(1, 1), cB + hstep + kstep, voffB);
        PG8_WAIT_V(6); PG8_BAR;
    } else {
        PG8_STAGE(PG8_SB(0, 0), cB, voffB); PG8_STAGE(PG8_SA(0, 0), cA, voffA); PG8_STAGE(PG8_SB(0, 1), cB + hstep, voffB); PG8_STAGE(PG8_SA(0, 1), cA + hstep, voffA);
        if (wr == 1) PG8_BAR;
        PG8_WAIT_V(4); PG8_BAR;
        PG8_STAGE(PG8_SB(1, 0), cB + kstep, voffB); PG8_STAGE(PG8_SA(1, 0), cA + kstep, voffA); PG8_STAGE(PG8_SB(1, 1), cB + hstep + kstep, voffB);
        PG8_WAIT_V(6); PG8_BAR;
    }
    for (;;) {
        const bool has_next = S.next(ui + 1, nxt);
        const char* nA = uni(has_next ? (const char*)g.A + (size_t)amap(nxt.pm, g.hmap) * tstep : cA); const char* nB = uni(has_next ? (const char*)g.Bt + (size_t)nxt.pn * tstep : cB);
        for (int t = 0; t < nt; t += 2) {
            const bool last = (t == nt - 2);
            const char* a1 = cA + (size_t)(t + 1) * kstep;
            const char* a2 = last ? nA : cA + (size_t)(t + 2) * kstep; const char* b2 = last ? nB : cB + (size_t)(t + 2) * kstep;
            const char* a3 = a2 + kstep; const char* b3 = b2 + kstep;
            if (last && has_next) S.a_ready(nxt);
            if constexpr (SP2) {
            PG8_LDB(B0, 0, 0); PG8_LDB(B1, 0, 1); PG8_SCHED; PG8_LDA(At, 0, 0); PG8_STAGE(PG8_SA(1, 1), a1 + hstep, voffA);
            PG8_WAIT_V(8); PG8_WAIT_L(0); PG8_BAR; PG8_MMA(0, 0, At, B0); PG8_MMA(0, 1, At, B1); PG8_BAR; PG8_SCHED;
            PG8_LDA(At, 0, 1); PG8_STAGE(PG8_SB(0, 0), b2, voffB); PG8_STAGE(PG8_SB(0, 1), b2 + hstep, voffB); PG8_STAGE(PG8_SA(0, 0), a2, voffA);
            PG8_WAIT_V(8); PG8_WAIT_L(0); PG8_BAR; PG8_MMA(1, 0, At, B0); PG8_MMA(1, 1, At, B1); PG8_BAR; PG8_SCHED;
            PG8_LDB(B0, 1, 0); PG8_LDB(B1, 1, 1); PG8_SCHED; PG8_LDA(At, 1, 0); PG8_STAGE(PG8_SA(0, 1), a2 + hstep, voffA);
            PG8_WAIT_V(8); PG8_WAIT_L(0); PG8_BAR; PG8_MMA(0, 0, At, B0); PG8_MMA(0, 1, At, B1); PG8_BAR; PG8_SCHED;
            PG8_LDA(At, 1, 1); PG8_STAGE(PG8_SB(1, 0), b3, voffB); PG8_STAGE(PG8_SB(1, 1), b3 + hstep, voffB); PG8_STAGE(PG8_SA(1, 0), a3, voffA);
            PG8_WAIT_V(8); PG8_WAIT_L(0); PG8_BAR; PG8_MMA(1, 0, At, B0); PG8_MMA(1, 1, At, B1); PG8_BAR; PG8_SCHED;
            } else {
            PG8_LDB(B0, 0, 0); PG8_SCHED; PG8_LDA(At, 0, 0); PG8_STAGE(PG8_SA(1, 1), a1 + hstep, voffA);
            PG8_WAIT_L(8); PG8_BAR; PG8_WAIT_L(0); PG8_MMA(0, 0, At, B0); PG8_BAR; PG8_SCHED;
            PG8_LDB(B1, 0, 1); PG8_STAGE(PG8_SB(0, 0), b2, voffB);
            PG8_BAR; PG8_WAIT_L(0); PG8_MMA(0, 1, At, B1); PG8_BAR;
            PG8_LDA(At, 0, 1); PG8_STAGE(PG8_SA(0, 0), a2, voffA);
            PG8_BAR; PG8_WAIT_L(0); PG8_MMA(1, 0, At, B0); PG8_BAR; PG8_SCHED;
            PG8_STAGE(PG8_SB(0, 1), b2 + hstep, voffB);
            PG8_WAIT_V(6); PG8_BAR; PG8_MMA(1, 1, At, B1); PG8_BAR;
            PG8_LDB(B0, 1, 0); PG8_SCHED; PG8_LDA(At, 1, 0); PG8_STAGE(PG8_SA(0, 1), a2 + hstep, voffA);
            PG8_WAIT_L(8); PG8_BAR; PG8_WAIT_L(0); PG8_MMA(0, 0, At, B0); PG8_BAR; PG8_SCHED;
            PG8_LDB(B1, 1, 1); PG8_STAGE(PG8_SB(1, 0), b3, voffB);
            PG8_BAR; PG8_WAIT_L(0); PG8_MMA(0, 1, At, B1); PG8_BAR;
            PG8_LDA(At, 1, 1); PG8_STAGE(PG8_SA(1, 0), a3, voffA);
            PG8_BAR; PG8_WAIT_L(0); PG8_MMA(1, 0, At, B0); PG8_BAR; PG8_SCHED;
            PG8_STAGE(PG8_SB(1, 1), b3 + hstep, voffB);
            PG8_WAIT_V(6); PG8_BAR; PG8_MMA(1, 1, At, B1); PG8_BAR;
            }
        }
        if constexpr (ALIGN_EPI) { if (wr == 0) PG8_BAR; }
        if constexpr (!Epi::AFTER_DRAIN) { E(acc, cur, wr, wc, fr, fq); S.done(cur); }
        if (!has_next) break;
#pragma unroll
        for (int a = 0; a < 2; ++a)
#pragma unroll
            for (int b = 0; b < 2; ++b)
#pragma unroll
                for (int m = 0; m < 4; ++m)
#pragma unroll
                    for (int n = 0; n < 2; ++n) acc[a][b][m][n] = (f32x4){0.f, 0.f, 0.f, 0.f};
        cur = nxt; cA = nA; cB = nB; ++ui;
        if constexpr (ALIGN_EPI) { if (wr == 1) PG8_BAR; }
    }
    PG8_WAIT_V(0);
    if constexpr (!ALIGN_EPI) { if (wr == 0) PG8_BAR; }
    PG8_BAR;
    if constexpr (Epi::AFTER_DRAIN) { E.fused(acc, cur, wr, wc, fr, fq, lds, wid, lane); S.done(cur); }
#undef PG8_SA
#undef PG8_SB
#undef PG8_STAGE
#undef PG8_LDA
#undef PG8_LDB
#undef PG8_MMA
#undef PG8_WAIT_V
#undef PG8_WAIT_L
#undef PG8_BAR
#undef PG8_SCHED
}
}

#define GAS __attribute__((address_space(1)))
#define LAS __attribute__((address_space(3)))
typedef unsigned short bf16_t;
typedef float f32x4 __attribute__((ext_vector_type(4)));
typedef float f32x16 __attribute__((ext_vector_type(16)));
typedef short bf16x8 __attribute__((ext_vector_type(8)));
typedef unsigned u32x4 __attribute__((ext_vector_type(4)));
typedef unsigned u32x2 __attribute__((ext_vector_type(2)));

#ifndef NLAYER_V
#define NLAYER_V 4
#endif
constexpr int NW = 8, NTHR = 512;
constexpr int MTOK = 32768, DM = 1024, SEQ = 4096, NB = 8, NLAYER = NLAYER_V, NH = 8;
constexpr int DIN = 9232, DFF = 2816, DPLE = 256;
constexpr float EPS = 1e-6f;
constexpr float LOG2E = 1.4426950408889634f;
constexpr size_t MiB = 1u << 20;
constexpr size_t WS_SS = 0;
constexpr size_t WS_CTL = 1792 * 1024;
constexpr size_t WS_UHALO = 1856 * 1024;
constexpr size_t WS_GB = 2 * MiB;
constexpr size_t WS_HALO = 4 * MiB;
constexpr size_t WS_PB = 14 * MiB;
constexpr size_t WS_W = 30 * MiB;
constexpr size_t W_IN = WS_W, W_V = W_IN + (size_t)6400 * 1024 * 2, W_GL = W_V + 2 * MiB, W_BRA = W_GL + 4 * MiB, W_BRB = W_BRA + 2 * MiB,
                 W_OUT = W_BRB + 2 * MiB, W_UP = W_OUT + 2 * MiB, W_DOWN = W_UP + 11 * MiB, W_PG = W_DOWN + (size_t)1024 * 2816 * 2, W_PP = W_PG + 2 * MiB, W_END = W_PP + (size_t)1024 * 256 * 2;
static_assert(W_END <= 74 * MiB, "weights region");
constexpr size_t WS_XB = 74 * MiB;
constexpr size_t WS_MIX = 138 * MiB;
constexpr size_t S64 = 64 * MiB;
constexpr size_t WS_QA = WS_MIX, WS_KA = WS_MIX + S64, WS_VT = WS_MIX + 2 * S64, WS_QB = WS_MIX + 3 * S64, WS_KB = WS_MIX + 4 * S64, WS_VB = WS_MIX + 5 * S64, WS_ZB = WS_MIX + 6 * S64;
constexpr size_t WS_TOTAL = WS_MIX + 7 * S64;
#ifdef DN_NAIVE
constexpr size_t WS_G = WS_KB, WS_TMPA = WS_KA, WS_MIXED = WS_VT, WS_OSRC = WS_QB;
#else
constexpr size_t WS_G = WS_KA, WS_TMPA = WS_KB, WS_MIXED = WS_VB, WS_OSRC = WS_VB;
#endif
constexpr int LDS_BYTES = 147456, LDS_VB = 140032;

__device__ __forceinline__ float bflo(unsigned w) { return __uint_as_float(w << 16); }
__device__ __forceinline__ float bfhi(unsigned w) { return __uint_as_float(w & 0xffff0000u); }
__device__ __forceinline__ float bf2f(bf16_t v) { return __uint_as_float((unsigned)v << 16); }
typedef float f32x2_t __attribute__((ext_vector_type(2))); typedef __bf16 bf16x2_t __attribute__((ext_vector_type(2)));
__device__ __forceinline__ unsigned pk2(float lo, float hi) { const f32x2_t v = {lo, hi}; const bf16x2_t b = __builtin_convertvector(v, bf16x2_t); return __builtin_bit_cast(unsigned, b); }
__device__ __forceinline__ bf16_t f2bf(float f) { return (bf16_t)(pk2(f, 0.f) & 0xffffu); }
__device__ __forceinline__ float sigmoidf_(float x) { x = fminf(fmaxf(x, -60.f), 60.f); return __builtin_amdgcn_rcpf(1.f + __expf(-x)); }
__device__ __forceinline__ float siluf_(float x) { return x * sigmoidf_(x); }
__device__ __forceinline__ float wave_sum(float v) {
#pragma unroll
    for (int o = 1; o < 64; o <<= 1) v += __shfl_xor(v, o);
    return v;
}
__device__ __forceinline__ float ss_load(const float* p) { const f32x4 a = *(const f32x4*)p, b = *(const f32x4*)(p + 4), c = *(const f32x4*)(p + 8), d = *(const f32x4*)(p + 12);
    float s = (((a[0] + a[1]) + (a[2] + a[3])) + ((b[0] + b[1]) + (b[2] + b[3]))) + (((c[0] + c[1]) + (c[2] + c[3])) + ((d[0] + d[1]) + (d[2] + d[3])));
    asm volatile("" : "+v"(s) :: "memory");
    return s; }
__device__ __forceinline__ u32x4 ldc16(const void* p) { u32x4 v; asm volatile("global_load_dwordx4 %0, %1, off sc0 sc1\n\ts_waitcnt vmcnt(0)" : "=v"(v) : "v"(p) : "memory"); return v; }
__device__ __forceinline__ int crow(int r, int hi) { return (r & 3) + 8 * (r >> 2) + 4 * hi; }

__device__ __forceinline__ int gmap(int row, int h) { return h < 0 ? row : ((row >> 11) * 4096 + 2048 * h + (row & 2047)); }

using pg8::Unit;
typedef f32x4 AccT[2][2][4][2];

template <int ACT> struct EpiRowScale {
    static constexpr bool PERM = true, AFTER_DRAIN = false;
    bf16_t* O; int ldc; const float* ss; int hmap;
    __device__ __forceinline__ void operator()(const AccT& acc, const Unit& u, int wr, int wc, int fr, int fq) const {
        const int row0 = u.pm * 256 + wr * 64 + fr, col0 = u.pn * 256 + wc * 32 + 8 * fq;
#pragma unroll
        for (int ai = 0; ai < 2; ++ai)
#pragma unroll
            for (int m = 0; m < 4; ++m) {
                const int row = row0 + ai * 128 + m * 16;
#ifdef RS_CONST
                const float rs = 1000.f;
#else
                const float rs = rsqrtf(ss_load(ss + (size_t)gmap(row, hmap) * 16) * (1.f / 1024.f) + EPS);
#endif
                bf16_t* rowp = O + (size_t)row * ldc + col0;
#pragma unroll
                for (int bj = 0; bj < 2; ++bj) {
                    f32x4 v0 = acc[ai][bj][m][0] * rs, v1 = acc[ai][bj][m][1] * rs;
                    if (ACT == 1) {
#pragma unroll
                        for (int e = 0; e < 4; ++e) { v0[e] = sigmoidf_(v0[e]); v1[e] = sigmoidf_(v1[e]); }
                    }
                    u32x4 w; w.x = pk2(v0[0], v0[1]); w.y = pk2(v0[2], v0[3]); w.z = pk2(v1[0], v1[1]); w.w = pk2(v1[2], v1[3]);
                    *(u32x4*)(rowp + bj * 128) = w;
                    asm volatile("" ::: "memory");
                }
            }
    }
};

struct EpiVt {
    static constexpr bool PERM = true, AFTER_DRAIN = false;
    bf16_t* O; const float* ss;
    __device__ __forceinline__ void operator()(const AccT& acc, const Unit& u, int wr, int wc, int fr, int fq) const {
        const int row0 = u.pm * 256 + wr * 64 + fr, col0 = u.pn * 256 + wc * 32 + 8 * fq;
        float rs[2][8];
#pragma unroll
        for (int bj = 0; bj < 2; ++bj)
#pragma unroll
            for (int e = 0; e < 8; ++e) rs[bj][e] = rsqrtf(ss_load(ss + (size_t)(col0 + bj * 128 + e) * 16) * (1.f / 1024.f) + EPS);
#pragma unroll
        for (int ai = 0; ai < 2; ++ai)
#pragma unroll
            for (int m = 0; m < 4; ++m) {
                const int row = row0 + ai * 128 + m * 16;
                bf16_t* rowp = O + (size_t)row * MTOK + col0;
#pragma unroll
                for (int bj = 0; bj < 2; ++bj) {
                    const f32x4 v0 = acc[ai][bj][m][0], v1 = acc[ai][bj][m][1];
                    u32x4 w; w.x = pk2(v0[0] * rs[bj][0], v0[1] * rs[bj][1]); w.y = pk2(v0[2] * rs[bj][2], v0[3] * rs[bj][3]);
                    w.z = pk2(v1[0] * rs[bj][4], v1[1] * rs[bj][5]); w.w = pk2(v1[2] * rs[bj][6], v1[3] * rs[bj][7]);
                    *(u32x4*)(rowp + bj * 128) = w;
                }
                asm volatile("" ::: "memory");
            }
    }
};

struct EpiGateMul {
    static constexpr bool PERM = true, AFTER_DRAIN = false;
    bf16_t* O; const bf16_t* G; int ldg, goff; const bf16_t* Add;
    __device__ __forceinline__ void operator()(const AccT& acc, const Unit& u, int wr, int wc, int fr, int fq) const {
        const int row0 = u.pm * 256 + wr * 64 + fr, col0 = u.pn * 256 + wc * 32 + 8 * fq;
#pragma unroll
        for (int ai = 0; ai < 2; ++ai)
#pragma unroll
            for (int m = 0; m < 4; ++m) {
                const int row = row0 + ai * 128 + m * 16;
#pragma unroll
                for (int bj = 0; bj < 2; ++bj) {
                    const int c = col0 + bj * 128;
                    const u32x4 g = *(const u32x4*)(G + (size_t)row * ldg + goff + c);
                    u32x4 a = (u32x4){0u, 0u, 0u, 0u};
                    if (Add) a = *(const u32x4*)(Add + (size_t)row * 1024 + c);
                    const f32x4 v0 = acc[ai][bj][m][0], v1 = acc[ai][bj][m][1];
                    u32x4 w;
                    w.x = pk2(bflo(a.x) + bflo(g.x) * v0[0], bfhi(a.x) + bfhi(g.x) * v0[1]);
                    w.y = pk2(bflo(a.y) + bflo(g.y) * v0[2], bfhi(a.y) + bfhi(g.y) * v0[3]);
                    w.z = pk2(bflo(a.z) + bflo(g.z) * v1[0], bfhi(a.z) + bfhi(g.z) * v1[1]);
                    w.w = pk2(bflo(a.w) + bflo(g.w) * v1[2], bfhi(a.w) + bfhi(g.w) * v1[3]);
                    *(u32x4*)(O + (size_t)row * 1024 + c) = w;
                }
                asm volatile("" ::: "memory");
            }
    }
};

struct EpiResid {
    static constexpr bool PERM = true, AFTER_DRAIN = false;
    float* X; bf16_t* XB; float* ssn; const bf16_t* Mul; int hmap;
    __device__ __forceinline__ void operator()(const AccT& acc, const Unit& u, int wr, int wc, int fr, int fq) const {
        const int row0 = u.pm * 256 + wr * 64 + fr, col0 = u.pn * 256 + wc * 32 + 8 * fq;
#pragma unroll
        for (int ai = 0; ai < 2; ++ai)
#pragma unroll
            for (int m = 0; m < 4; ++m) {
                const int row = gmap(row0 + ai * 128 + m * 16, hmap);
                float sq = 0.f;
#pragma unroll
                for (int bj = 0; bj < 2; ++bj)
#pragma unroll
                    for (int n = 0; n < 2; ++n) {
                        const size_t off = (size_t)row * 1024 + col0 + bj * 128 + 4 * n;
                        f32x4 x0 = *(const f32x4*)(X + off);
                        f32x4 v0 = acc[ai][bj][m][n];
                        if (Mul) { const u32x2 g = *(const u32x2*)(Mul + off); v0[0] *= bflo(g.x); v0[1] *= bfhi(g.x); v0[2] *= bflo(g.y); v0[3] *= bfhi(g.y); }
                        x0 += v0;
                        *(f32x4*)(X + off) = x0;
                        u32x2 w; w.x = pk2(x0[0], x0[1]); w.y = pk2(x0[2], x0[3]);
                        *(u32x2*)(XB + off) = w;
                        sq += (x0[0] * x0[0] + x0[1] * x0[1]) + (x0[2] * x0[2] + x0[3] * x0[3]);
                        asm volatile("" ::: "memory");
                    }
                sq += __shfl_xor(sq, 16); sq += __shfl_xor(sq, 32);
                if (fq == 0) ssn[(size_t)row * 16 + u.pn * 4 + wc] = sq;
                asm volatile("" ::: "memory");
            }
    }
};

struct EpiQK {
    static constexpr bool PERM = true, AFTER_DRAIN = false;
    unsigned char* ws; const float* ss; const float* qg; const float* kg;
    __device__ __forceinline__ void operator()(const AccT& acc, const Unit& u, int wr, int wc, int fr, int fq) const {
        const int row0 = u.pm * 256 + wr * 64 + fr;
        const int seg = u.pn >> 2, tl = u.pn & 3;
        bf16_t* base = (bf16_t*)(ws + (seg == 0 ? WS_QA : WS_KA));
        const float* gp = seg == 0 ? qg : kg; const float osc = seg == 0 ? 0.125f * LOG2E : 1.0f;
        const int col0 = tl * 256 + 64 * wc + 8 * fq;
#pragma unroll
        for (int ai = 0; ai < 2; ++ai)
#pragma unroll
            for (int m = 0; m < 4; ++m) {
                const int row = row0 + ai * 128 + m * 16;
                const float rs = rsqrtf(ss_load(ss + (size_t)row * 16) * (1.f / 1024.f) + EPS);
                f32x4 v[2][2]; float sq = 0.f;
#pragma unroll
                for (int bj = 0; bj < 2; ++bj)
#pragma unroll
                    for (int n = 0; n < 2; ++n) { v[bj][n] = acc[ai][bj][m][n] * rs; const f32x4 t = v[bj][n]; sq += (t[0] * t[0] + t[1] * t[1]) + (t[2] * t[2] + t[3] * t[3]); }
                sq += __shfl_xor(sq, 16); sq += __shfl_xor(sq, 32);
                const float r2o = rsqrtf(sq * (1.f / 64.f) + EPS) * osc;
#pragma unroll
                for (int bj = 0; bj < 2; ++bj) {
                    const f32x4 ga = *(const f32x4*)(gp + 32 * bj + 8 * fq), gb = *(const f32x4*)(gp + 32 * bj + 8 * fq + 4);
                    u32x4 w;
                    w.x = pk2(v[bj][0][0] * r2o * ga[0], v[bj][0][1] * r2o * ga[1]); w.y = pk2(v[bj][0][2] * r2o * ga[2], v[bj][0][3] * r2o * ga[3]);
                    w.z = pk2(v[bj][1][0] * r2o * gb[0], v[bj][1][1] * r2o * gb[1]); w.w = pk2(v[bj][1][2] * r2o * gb[2], v[bj][1][3] * r2o * gb[3]);
                    *(u32x4*)(base + (size_t)row * 1024 + col0 + 32 * bj) = w;
                }
                asm volatile("" ::: "memory");
            }
    }
};
struct EpiSeg {
    static constexpr bool PERM = true, AFTER_DRAIN = false;
    unsigned char* ws; const float* ss;
    __device__ __forceinline__ void operator()(const AccT& acc, const Unit& u, int wr, int wc, int fr, int fq) const {
        const int row0 = u.pm * 256 + wr * 64 + fr;
        bf16_t* base = (bf16_t*)(ws + WS_QB + (size_t)(u.pn >> 2) * S64);
        const int col0 = (u.pn & 3) * 256 + wc * 32 + 8 * fq;
#pragma unroll
        for (int ai = 0; ai < 2; ++ai)
#pragma unroll
            for (int m = 0; m < 4; ++m) {
                const int row = row0 + ai * 128 + m * 16;
                const float rs = rsqrtf(ss_load(ss + (size_t)row * 16) * (1.f / 1024.f) + EPS);
#pragma unroll
                for (int bj = 0; bj < 2; ++bj) {
                    const f32x4 v0 = acc[ai][bj][m][0] * rs, v1 = acc[ai][bj][m][1] * rs;
                    u32x4 w; w.x = pk2(v0[0], v0[1]); w.y = pk2(v0[2], v0[3]); w.z = pk2(v1[0], v1[1]); w.w = pk2(v1[2], v1[3]);
                    *(u32x4*)(base + (size_t)row * 1024 + col0 + bj * 128) = w;
                }
                asm volatile("" ::: "memory");
            }
    }
};
struct EpiGB {
    static constexpr bool PERM = true, AFTER_DRAIN = false;
    unsigned char* ws; const float* ss; const float* a_log; const float* dt_bias;
    __device__ __forceinline__ void operator()(const AccT& acc, const Unit& u, int wr, int wc, int fr, int fq) const {
        const int row0 = u.pm * 256 + wr * 64 + fr;
        if (wc == 0 && fq < 2) {
            float* GBp = (float*)(ws + WS_GB);
#pragma unroll
            for (int ai = 0; ai < 2; ++ai)
#pragma unroll
                for (int m = 0; m < 4; ++m) {
                    const int row = row0 + ai * 128 + m * 16;
                    const float rs = rsqrtf(ss_load(ss + (size_t)row * 16) * (1.f / 1024.f) + EPS);
                    float v[8];
#pragma unroll
                    for (int e = 0; e < 4; ++e) { v[e] = acc[ai][0][m][0][e] * rs; v[4 + e] = acc[ai][0][m][1][e] * rs; }
                    if (fq == 0) {
#pragma unroll
                        for (int e = 0; e < 8; ++e) v[e] = sigmoidf_(v[e]);
                    } else {
#pragma unroll
                        for (int e = 0; e < 8; ++e) { const float z = v[e] + dt_bias[e]; const float sp = fmaxf(z, 0.f) + __logf(1.f + __expf(-fabsf(z))); v[e] = -__expf(a_log[e]) * sp; }
                    }
                    float* dst = GBp + (size_t)row * 16 + 8 * fq;
                    *(f32x4*)dst = (f32x4){v[0], v[1], v[2], v[3]}; *(f32x4*)(dst + 4) = (f32x4){v[4], v[5], v[6], v[7]};
                    asm volatile("" ::: "memory");
                }
        }
    }
};

__device__ __forceinline__ void cvt_item(const float* W, int ldw, int src_col0, int nvalid, const float* gain, bf16_t* WT, int K, int dst_row0, int k0, LAS float* scr, int lane) {
    const int nn = lane & 31;
#pragma unroll 8
    for (int i = 0; i < 32; ++i) {
        const int kk = 2 * i + (lane >> 5);
        float v = 0.f;
        if (nn < nvalid) { v = W[(size_t)(k0 + kk) * ldw + src_col0 + nn]; if (gain) v *= gain[k0 + kk]; }
        scr[kk * 33 + nn] = v;
    }
    asm volatile("s_waitcnt lgkmcnt(0)" ::: "memory");
    const int c = lane & 7;
#pragma unroll
    for (int j = 0; j < 4; ++j) {
        const int n = (lane >> 3) + 8 * j; const LAS float* s = scr + (8 * c) * 33 + n;
        u32x4 o; o.x = pk2(s[0 * 33], s[1 * 33]); o.y = pk2(s[2 * 33], s[3 * 33]); o.z = pk2(s[4 * 33], s[5 * 33]); o.w = pk2(s[6 * 33], s[7 * 33]);
        *(u32x4*)(WT + (size_t)(dst_row0 + n) * K + k0 + 8 * c) = o;
    }
    asm volatile("s_waitcnt lgkmcnt(0)" ::: "memory");
}

struct Params {
    const float* in[24];
    float* out;
    unsigned char* ws;
    int seg_lo, seg_hi;
};
enum { I_X = 0, I_P, I_WIN, I_ATTN_NORM, I_QNORM, I_KNORM, I_LAM, I_SUBLN, I_RELB, I_CONVB, I_ALOG, I_DTB, I_ONORM, I_WBRA, I_WBRB, I_WOUT, I_FFN_NORM, I_WUP, I_CONVFF, I_CONVFFB, I_WDOWN, I_PLE_NORM, I_WPG, I_WPP };

__device__ __forceinline__ void convert_weights(const Params* PQ, int layer, LAS unsigned char* lds, int gw, int NGW, int wave, int lane) {
    LAS float* scr = (LAS float*)(lds + wave * 16384);
    unsigned char* ws = PQ->ws;
    const float* w_in = PQ->in[I_WIN] + (size_t)layer * 1024 * DIN;
    const float* g_attn = PQ->in[I_ATTN_NORM] + layer * 1024;
    const float* g_ffn = PQ->in[I_FFN_NORM] + layer * 1024;
    const float* g_ple = PQ->in[I_PLE_NORM] + layer * 1024;
#define CVT_JOB(NITEMS, KB, SRCW, LDW, GAIN, DST, KK, SRCCOL, NVALID) \
    for (int it = gw; it < (NITEMS); it += NGW) { const int g = it / (KB), kb = it % (KB); (void)g; \
        cvt_item((SRCW), (LDW), (SRCCOL), (NVALID), (GAIN), (bf16_t*)(ws + (DST)), (KK), g * 32, kb * 64, scr, lane); } asm volatile("" ::: "memory");
    for (int it = gw; it < 200 * 16; it += NGW) {
        const int g = it >> 4, kb = it & 15, pn = g >> 3, gi = g & 7;
        int src, nv = 32;
        if (pn < 8) { const int bj = gi >> 2, wc = gi & 3; src = (pn >> 2) * 1024 + (pn & 3) * 256 + 64 * wc + 32 * bj; }
        else if (pn < 24) { src = 3072 + (pn - 8) * 256 + 32 * gi; }
        else { src = 7168; nv = (gi == 0) ? 16 : 0; }
        cvt_item(w_in, DIN, src, nv, g_attn, (bf16_t*)(ws + W_IN), 1024, g * 32, kb * 64, scr, lane);
    }
    asm volatile("" ::: "memory");
    CVT_JOB(32 * 16, 16, w_in, DIN, g_attn, W_V, 1024, 2048 + g * 32, 32)
    CVT_JOB(64 * 16, 16, w_in, DIN, g_attn, W_GL, 1024, 7184 + g * 32, 32)
    CVT_JOB(32 * 16, 16, PQ->in[I_WBRA] + (size_t)layer * 1024 * 1024, 1024, (const float*)nullptr, W_BRA, 1024, g * 32, 32)
    CVT_JOB(32 * 16, 16, PQ->in[I_WBRB] + (size_t)layer * 1024 * 1024, 1024, (const float*)nullptr, W_BRB, 1024, g * 32, 32)
    CVT_JOB(32 * 16, 16, PQ->in[I_WOUT] + (size_t)layer * 1024 * 1024, 1024, (const float*)nullptr, W_OUT, 1024, g * 32, 32)
    CVT_JOB(176 * 16, 16, PQ->in[I_WUP] + (size_t)layer * 1024 * 5632, 5632, g_ffn, W_UP, 1024, g * 32, 32)
    CVT_JOB(32 * 44, 44, PQ->in[I_WDOWN] + (size_t)layer * 2816 * 1024, 1024, (const float*)nullptr, W_DOWN, 2816, g * 32, 32)
    CVT_JOB(32 * 16, 16, PQ->in[I_WPG] + (size_t)layer * 1024 * 1024, 1024, g_ple, W_PG, 1024, g * 32, 32)
    CVT_JOB(32 * 4, 4, PQ->in[I_WPP] + (size_t)layer * 256 * 1024, 1024, (const float*)nullptr, W_PP, 256, g * 32, 32)
#undef CVT_JOB
}

constexpr int AT_KROW = 272, AT_VROW = 144, AT_KBYTES = 64 * AT_KROW, AT_VBYTES = 128 * AT_VROW, AT_STAGE = AT_KBYTES + AT_VBYTES, AT_TB = 2 * AT_STAGE;
static_assert(AT_TB >= 65536 && AT_TB + 1024 <= LDS_BYTES, "attention LDS");
__device__ __forceinline__ void attn_unit(LAS unsigned char* lds, const bf16_t* QA, const bf16_t* KA, const bf16_t* VT, bf16_t* OA, int b, int h, int qb,
                                          float lam, float out_scale, const float* subln, const float* relb, int tid) {
    const int lane = tid & 63, wid = __builtin_amdgcn_readfirstlane(tid >> 6), j = wid >> 2, wq = wid & 3, r32 = lane & 31, hi = lane >> 5;
    const int Q0 = qb * 128, qrow = Q0 + 32 * wq + r32;
    const size_t tok = (size_t)b * SEQ + qrow;
    LAS float* TB = (LAS float*)(lds + AT_TB);
    for (int i = tid; i <= 128; i += NTHR) {
        float v = 0.f;
        if (i < 128) {
            int bk = i;
            if (i >= 16) { int lg = 16 + (int)(__logf((float)i * (1.f / 16.f)) / __logf(8.0f) * 16.f); bk = lg < 31 ? lg : 31; }
            v = (relb[bk * 8 + h] - relb[31 * 8 + h]) * LOG2E;
        }
        TB[i] = v;
    }
    bf16x8 qf[4];
#pragma unroll
    for (int d0 = 0; d0 < 4; ++d0) qf[d0] = *(const bf16x8*)(QA + tok * 1024 + h * 128 + 64 * j + 16 * d0 + 8 * hi);
    const int NT = (Q0 + 128) / 64;
    const int kr0 = tid >> 4, kc = tid & 15;
    const int vr0 = tid >> 3, vc = tid & 7;
    const bf16_t* kg = KA + ((size_t)b * SEQ + kr0) * 1024 + h * 128 + kc * 8;
    const bf16_t* vg = VT + (size_t)(h * 128 + vr0) * MTOK + (size_t)b * SEQ + vc * 8;
    u32x4 kreg0, kreg1, vreg0, vreg1;
#define AT_LOAD(t) do { kreg0 = *(const u32x4*)(kg + (size_t)(t) * 64 * 1024); kreg1 = *(const u32x4*)(kg + (size_t)((t) * 64 + 32) * 1024); \
        vreg0 = *(const u32x4*)(vg + (t) * 64); vreg1 = *(const u32x4*)(vg + (size_t)64 * MTOK + (t) * 64); } while (0)
#define AT_STORE(s) do { LAS unsigned char* kb_ = lds + (s) * AT_STAGE; LAS unsigned char* vb_ = kb_ + AT_KBYTES; \
        *(LAS u32x4*)(kb_ + kr0 * AT_KROW + kc * 16) = kreg0; *(LAS u32x4*)(kb_ + (kr0 + 32) * AT_KROW + kc * 16) = kreg1; \
        *(LAS u32x4*)(vb_ + vr0 * AT_VROW + vc * 16) = vreg0; *(LAS u32x4*)(vb_ + (vr0 + 64) * AT_VROW + vc * 16) = vreg1; } while (0)
    AT_LOAD(0); AT_STORE(0);
    __syncthreads();
    f32x16 o[4];
#pragma unroll
    for (int i = 0; i < 4; ++i)
#pragma unroll
        for (int r = 0; r < 16; ++r) o[i][r] = 0.f;
    float mrun = -INFINITY, lrun = 0.f;
    const int qmax_w = Q0 + 32 * wq + 31, qmin_w = Q0 + 32 * wq;
    for (int t = 0; t < NT; ++t) {
        if (t + 1 < NT) AT_LOAD(t + 1);
        const int kv0 = 64 * t;
        if (kv0 <= qmax_w) {
            const LAS unsigned char* Kb = lds + (t & 1) * AT_STAGE; const LAS unsigned char* Vb = Kb + AT_KBYTES;
            f32x16 s0, s1;
#pragma unroll
            for (int r = 0; r < 16; ++r) { s0[r] = 0.f; s1[r] = 0.f; }
#pragma unroll
            for (int d0 = 0; d0 < 4; ++d0) {
                const bf16x8 a0 = *(const LAS bf16x8*)(Kb + r32 * AT_KROW + (64 * j + 16 * d0 + 8 * hi) * 2);
                const bf16x8 a1 = *(const LAS bf16x8*)(Kb + (32 + r32) * AT_KROW + (64 * j + 16 * d0 + 8 * hi) * 2);
                s0 = __builtin_amdgcn_mfma_f32_32x32x16_bf16(a0, qf[d0], s0, 0, 0, 0);
                s1 = __builtin_amdgcn_mfma_f32_32x32x16_bf16(a1, qf[d0], s1, 0, 0, 0);
            }
            if (kv0 + 63 + 128 > qmin_w) {
#pragma unroll
                for (int r = 0; r < 16; ++r) {
                    const int rel0 = qrow - (kv0 + crow(r, hi)), rel1 = rel0 - 32;
                    s0[r] = rel0 < 0 ? -INFINITY : s0[r] + TB[rel0 < 128 ? rel0 : 128];
                    s1[r] = rel1 < 0 ? -INFINITY : s1[r] + TB[rel1 < 128 ? rel1 : 128];
                }
            }
            float mx = fmaxf(s0[0], s1[0]);
#pragma unroll
            for (int r = 1; r < 16; ++r) mx = fmaxf(mx, fmaxf(s0[r], s1[r]));
            mx = fmaxf(mx, __shfl_xor(mx, 32));
            const float mnew = fmaxf(mrun, mx);
            const float alpha = __builtin_amdgcn_exp2f(mrun - mnew);
            mrun = mnew;
            float ls = 0.f;
#pragma unroll
            for (int r = 0; r < 16; ++r) { s0[r] = __builtin_amdgcn_exp2f(s0[r] - mnew); s1[r] = __builtin_amdgcn_exp2f(s1[r] - mnew); ls += s0[r] + s1[r]; }
            lrun = lrun * alpha + ls;
#pragma unroll
            for (int i = 0; i < 4; ++i)
#pragma unroll
                for (int r = 0; r < 16; ++r) o[i][r] *= alpha;
            bf16x8 pf[4];
            { u32x4 w;
              w.x = pk2(s0[0], s0[1]); w.y = pk2(s0[2], s0[3]); w.z = pk2(s0[4], s0[5]); w.w = pk2(s0[6], s0[7]); pf[0] = __builtin_bit_cast(bf16x8, w);
              w.x = pk2(s0[8], s0[9]); w.y = pk2(s0[10], s0[11]); w.z = pk2(s0[12], s0[13]); w.w = pk2(s0[14], s0[15]); pf[1] = __builtin_bit_cast(bf16x8, w);
              w.x = pk2(s1[0], s1[1]); w.y = pk2(s1[2], s1[3]); w.z = pk2(s1[4], s1[5]); w.w = pk2(s1[6], s1[7]); pf[2] = __builtin_bit_cast(bf16x8, w);
              w.x = pk2(s1[8], s1[9]); w.y = pk2(s1[10], s1[11]); w.z = pk2(s1[12], s1[13]); w.w = pk2(s1[14], s1[15]); pf[3] = __builtin_bit_cast(bf16x8, w); }
#pragma unroll
            for (int blk = 0; blk < 4; ++blk)
#pragma unroll
                for (int s = 0; s < 4; ++s) {
                    const LAS unsigned char* vp = Vb + (32 * blk + r32) * AT_VROW + (16 * s + 4 * hi) * 2;
                    const u32x2 lo = *(const LAS u32x2*)vp, hh = *(const LAS u32x2*)(vp + 16);
                    const u32x4 w = (u32x4){lo.x, lo.y, hh.x, hh.y};
                    o[blk] = __builtin_amdgcn_mfma_f32_32x32x16_bf16(__builtin_bit_cast(bf16x8, w), pf[s], o[blk], 0, 0, 0);
                }
        }
        if (t + 1 < NT) AT_STORE((t + 1) & 1);
        __syncthreads();
    }
#undef AT_LOAD
#undef AT_STORE
    lrun += __shfl_xor(lrun, 32);
    const float inv = 1.f / lrun;
    LAS float* EX = (LAS float*)lds;
    if (j == 1) {
        const float sc = inv * lam;
#pragma unroll
        for (int blk = 0; blk < 4; ++blk)
#pragma unroll
            for (int r = 0; r < 16; ++r) EX[(wq * 64 + blk * 16 + r) * 64 + lane] = o[blk][r] * sc;
    }
    __syncthreads();
    if (j == 0) {
        float sq = 0.f;
#pragma unroll
        for (int blk = 0; blk < 4; ++blk)
#pragma unroll
            for (int r = 0; r < 16; ++r) { const float d = o[blk][r] * inv - EX[(wq * 64 + blk * 16 + r) * 64 + lane]; o[blk][r] = d; sq += d * d; }
        sq += __shfl_xor(sq, 32);
        const float rr = rsqrtf(sq * (1.f / 128.f) + EPS) * out_scale;
#pragma unroll
        for (int blk = 0; blk < 4; ++blk)
#pragma unroll
            for (int rq = 0; rq < 4; ++rq) {
                const int dv0 = 32 * blk + 8 * rq + 4 * hi;
                const f32x4 g = *(const f32x4*)(subln + dv0);
                u32x2 w; w.x = pk2(o[blk][4 * rq + 0] * rr * g[0], o[blk][4 * rq + 1] * rr * g[1]); w.y = pk2(o[blk][4 * rq + 2] * rr * g[2], o[blk][4 * rq + 3] * rr * g[3]);
                *(u32x2*)(OA + tok * 1024 + h * 128 + dv0) = w;
            }
    }
    __syncthreads();
}

__device__ __forceinline__ void dn_naive(LAS unsigned char* lds, unsigned char* ws, const float* convw  , int b, int h, int tid) {
    const int lane = tid & 63, wid = tid >> 6, dv = tid & 127, g4 = tid >> 7;
    LAS float* Y = (LAS float*)lds;
    LAS float* NR = Y + 384;
    LAS float* PT = NR + 8;
    LAS float* OP = PT + 512;
    float S[32];
#pragma unroll
    for (int i = 0; i < 32; ++i) S[i] = 0.f;
    bf16_t* QB = (bf16_t*)(ws + WS_QB); const bf16_t* KB = (const bf16_t*)(ws + WS_KB); const bf16_t* VB = (const bf16_t*)(ws + WS_VB);
    const float* GBp = (const float*)(ws + WS_GB);
    const int arr = tid >> 7;
    const bf16_t* src = (arr == 0 ? (const bf16_t*)QB : arr == 1 ? KB : VB) + h * 128 + dv;
    float w0 = 0.f, w1 = 0.f, w2 = 0.f, w3 = 0.f, x1 = 0.f, x2 = 0.f, x3 = 0.f;
    if (tid < 384) { const int ch = arr * 1024 + h * 128 + dv; w0 = convw[ch]; w1 = convw[3072 + ch]; w2 = convw[2 * 3072 + ch]; w3 = convw[3 * 3072 + ch]; }
    for (int t = 0; t < SEQ; ++t) {
        const size_t tok = (size_t)b * SEQ + t;
        if (tid < 384) {
            const float x0 = bf2f(src[tok * 1024]);
            float y = w0 * x3 + w1 * x2 + w2 * x1 + w3 * x0;
            y = siluf_(y); x3 = x2; x2 = x1; x1 = x0;
            Y[arr * 128 + dv] = y;
            const float sq = wave_sum(y * y);
            if (lane == 0) NR[wid] = sq;
        }
        __syncthreads();
        const float qn = rsqrtf(NR[0] + NR[1] + EPS) * 0.08838834764831845f, kn = rsqrtf(NR[2] + NR[3] + EPS);
        const float bt = GBp[tok * 16 + h], gt = GBp[tok * 16 + 8 + h], eg = __expf(gt);
        const float vv = Y[256 + dv];
        float ks = 0.f;
#pragma unroll
        for (int i = 0; i < 32; ++i) ks += Y[128 + 32 * g4 + i] * S[i];
        PT[g4 * 128 + dv] = ks * kn;
        __syncthreads();
        const float kS = (PT[dv] + PT[128 + dv]) + (PT[256 + dv] + PT[384 + dv]);
        const float c = bt * (vv - eg * kS);
        float op = 0.f;
#pragma unroll
        for (int i = 0; i < 32; ++i) { const float kk = Y[128 + 32 * g4 + i] * kn; S[i] = eg * S[i] + kk * c; op += Y[32 * g4 + i] * S[i]; }
        OP[g4 * 128 + dv] = op * qn;
        __syncthreads();
        if (g4 == 0) { const float ov = (OP[dv] + OP[128 + dv]) + (OP[256 + dv] + OP[384 + dv]); QB[tok * 1024 + h * 128 + dv] = f2bf(ov); }
    }
    __syncthreads();
}

__device__ __forceinline__ float row16_sum(float v) {
    v += __builtin_bit_cast(float, __builtin_amdgcn_update_dpp(0, __builtin_bit_cast(int, v), 0x128, 0xf, 0xf, false));
    v += __builtin_bit_cast(float, __builtin_amdgcn_update_dpp(0, __builtin_bit_cast(int, v), 0x124, 0xf, 0xf, false));
    v += __builtin_bit_cast(float, __builtin_amdgcn_update_dpp(0, __builtin_bit_cast(int, v), 0x122, 0xf, 0xf, false));
    v += __builtin_bit_cast(float, __builtin_amdgcn_update_dpp(0, __builtin_bit_cast(int, v), 0x121, 0xf, 0xf, false));
    return v;
}
__device__ __forceinline__ void dn_fast(LAS unsigned char* lds, unsigned char* ws, const float* convw  , int b, int h, int dvq, int tid) {
    const int lane = tid & 63, wid = tid >> 6, dvl = lane >> 4, grp = lane & 15;
    const int dvloc = 4 * wid + dvl, dv = 32 * dvq + dvloc;
    LAS float* Y = (LAS float*)lds;
    LAS float* NR = Y + 16 * 288;
    LAS float* GBs = NR + 16 * 16;
    LAS float* SC = GBs + 32;
    float S[8];
#pragma unroll
    for (int i = 0; i < 8; ++i) S[i] = 0.f;
    bf16_t* VB = (bf16_t*)(ws + WS_VB);
    const float* GBp = (const float*)(ws + WS_GB);
    const int arr = tid < 128 ? 0 : (tid < 256 ? 1 : 2);
    const int dch = arr == 2 ? 32 * dvq + ((tid - 256) & 31) : (tid & 127);
    const bf16_t* src = (const bf16_t*)(ws + (arr == 0 ? WS_QB : arr == 1 ? WS_KB : WS_VB)) + h * 128 + dch;
    float w0 = 0.f, w1 = 0.f, w2 = 0.f, w3 = 0.f, x1 = 0.f, x2 = 0.f, x3 = 0.f;
    if (tid < 288) { const int ch = arr * 1024 + h * 128 + dch; w0 = convw[ch]; w1 = convw[3072 + ch]; w2 = convw[2 * 3072 + ch]; w3 = convw[3 * 3072 + ch]; }
    for (int t0 = 0; t0 < SEQ; t0 += 16) {
        const size_t tokb = (size_t)b * SEQ + t0;
        if (tid < 288) {
            bf16_t xr[16];
#pragma unroll
            for (int tt = 0; tt < 16; ++tt) xr[tt] = src[(tokb + tt) * 1024];
#pragma unroll
            for (int tt = 0; tt < 16; ++tt) {
                const float x0 = bf2f(xr[tt]);
                float y = w0 * x3 + w1 * x2 + w2 * x1 + w3 * x0;
                y = siluf_(y); x3 = x2; x2 = x1; x1 = x0;
                Y[tt * 288 + tid] = y;
                if (tid < 256) { const float sq = row16_sum(y * y); if ((lane & 15) == 0) NR[tt * 16 + wid * 4 + (lane >> 4)] = sq; }
            }
        }
        if (tid >= 480) { const int i = tid - 480, tt = i >> 1, which = i & 1; GBs[tt * 2 + which] = GBp[(tokb + tt) * 16 + which * 8 + h]; }
        __syncthreads();
        if (tid < 16) {
            const f32x4 a = *(const LAS f32x4*)(NR + tid * 16), b2 = *(const LAS f32x4*)(NR + tid * 16 + 4), c2 = *(const LAS f32x4*)(NR + tid * 16 + 8), d2 = *(const LAS f32x4*)(NR + tid * 16 + 12);
            const float sq_q = ((a[0] + a[1]) + (a[2] + a[3])) + ((b2[0] + b2[1]) + (b2[2] + b2[3])), sq_k = ((c2[0] + c2[1]) + (c2[2] + c2[3])) + ((d2[0] + d2[1]) + (d2[2] + d2[3]));
            *(LAS f32x4*)(SC + tid * 4) = (f32x4){rsqrtf(sq_q + EPS) * 0.08838834764831845f, rsqrtf(sq_k + EPS), __expf(GBs[tid * 2 + 1]), GBs[tid * 2]};
        }
        __syncthreads();
#pragma unroll 4
        for (int tt = 0; tt < 16; ++tt) {
            const f32x4 sc = *(const LAS f32x4*)(SC + tt * 4);
            const float qn = sc[0], kn = sc[1], eg = sc[2], bt = sc[3];
            const f32x4 ka = *(const LAS f32x4*)(Y + tt * 288 + 128 + 8 * grp), kb = *(const LAS f32x4*)(Y + tt * 288 + 128 + 8 * grp + 4);
            const f32x4 qa = *(const LAS f32x4*)(Y + tt * 288 + 8 * grp), qb = *(const LAS f32x4*)(Y + tt * 288 + 8 * grp + 4);
            const float vv = Y[tt * 288 + 256 + dvloc];
            float ks = (ka[0] * S[0] + ka[1] * S[1]) + (ka[2] * S[2] + ka[3] * S[3]) + (kb[0] * S[4] + kb[1] * S[5]) + (kb[2] * S[6] + kb[3] * S[7]);
            ks = row16_sum(ks);
            const float c = bt * (vv - eg * ks * kn) * kn;
            float op = 0.f;
#pragma unroll
            for (int i = 0; i < 4; ++i) { S[i] = eg * S[i] + ka[i] * c; op += qa[i] * S[i]; S[4 + i] = eg * S[4 + i] + kb[i] * c; op += qb[i] * S[4 + i]; }
            op = row16_sum(op);
            if (grp == 0) VB[(tokb + tt) * 1024 + h * 128 + dv] = f2bf(op * qn);
        }
        __syncthreads();
    }
}

#define GEMM_PHASE(EPI, Aptr, Bptr, Mv, Nv, Kv, Eobj, HM) do { int m_ = (Mv), n_ = (Nv), k_ = (Kv); asm volatile("" : "+s"(m_), "+s"(n_), "+s"(k_)); pg8::Gemm g_{(const pg8::bf16_t*)(Aptr), (const pg8::bf16_t*)(Bptr), m_, n_, k_, (HM)}; pg8::StaticOrder S_; S_.init(m_, n_, G, bid); \
        pg8::gemm_phase<EPI, pg8::StaticOrder, true, true>(lds, g_, S_, (Eobj)); } while (0)

__global__ void __launch_bounds__(NTHR, 2) fwd_mega(Params P) {
    extern __shared__ __attribute__((aligned(16))) unsigned char lds_raw[];
    LAS unsigned char* lds = (LAS unsigned char*)lds_raw;
    cg::grid_group grid = cg::this_grid();
    if (threadIdx.x == 0) {
        const unsigned xcc = (unsigned)__builtin_amdgcn_s_getreg((3 << 11) | 20) & 7u;
        const unsigned loc = __hip_atomic_fetch_add((unsigned*)(P.ws + WS_CTL) + xcc, 1u, __ATOMIC_RELAXED, __HIP_MEMORY_SCOPE_AGENT);
        *(LAS int*)(lds + LDS_VB) = (int)((loc & 31u) * 8u + xcc);
    }
    __syncthreads();
    int seg = 0; const int seg_lo = P.seg_lo, seg_hi = P.seg_hi;
#ifdef L2FLUSH
#define L2_FLUSH() do { const Params* PF = (const Params*)__builtin_amdgcn_kernarg_segment_ptr(); asm volatile("" : "+s"(PF)); int tf_ = threadIdx.x; asm volatile("" : "+v"(tf_)); \
        const u32x4* jp = (const u32x4*)(PF->in[I_P]) + (size_t)blockIdx.x * (L2FLUSH * 64) + tf_; unsigned acc_ = 0u; \
        for (int q_ = 0; q_ < L2FLUSH * 64 / 512; ++q_) { const u32x4 v_ = __builtin_nontemporal_load(jp + (size_t)q_ * 512); acc_ |= v_.x & v_.y & v_.z & v_.w; asm volatile("" ::: "memory"); } \
        if (acc_ == 0x12345678u) PF->out[0] = 0.f; } while (0)
#else
#define L2_FLUSH() do {} while (0)
#endif
#ifdef NOSEG
#define SYNCCOND true
#else
#define SYNCCOND (seg >= seg_lo && seg + 1 < seg_hi)
#endif
#define GRID_SYNC() do { if (SYNCCOND) { asm volatile("s_waitcnt vmcnt(0) lgkmcnt(0)" ::: "memory");   grid.sync(); L2_FLUSH(); \
        if (threadIdx.x < 64) { __builtin_amdgcn_fence(__ATOMIC_ACQUIRE, "agent"); asm volatile("s_waitcnt vmcnt(0)" ::: "memory"); } __syncthreads();     \
        } ++seg; } while (0)
#ifdef NOSEG
#define SEGCOND true
#else
#define SEGCOND (seg >= seg_lo && seg < seg_hi)
#endif
#define PH_BEGIN if (SEGCOND) { const Params* PQ = (const Params*)__builtin_amdgcn_kernarg_segment_ptr(); asm volatile("" : "+s"(PQ)); int tid = threadIdx.x; asm volatile("" : "+v"(tid)); \
    const int lane = tid & 63, wave = __builtin_amdgcn_readfirstlane(tid >> 6); int bid = __builtin_amdgcn_readfirstlane(*(LAS int*)(lds + LDS_VB)), G = gridDim.x; asm volatile("" : "+s"(bid), "+s"(G)); \
    const int xb_ = bid & 7, jb_ = bid >> 3, wj = jb_ * NW + wave;     \
    unsigned char* ws = PQ->ws; float* X = PQ->out; float* SS = (float*)(ws + WS_SS); bf16_t* XB = (bf16_t*)(ws + WS_XB); \
    float* ss_attn = (float*)(ws + WS_HALO); float* ss_ffn = ss_attn + (size_t)MTOK * 16; float* ss_ple = ss_ffn + (size_t)MTOK * 16; float* ss_next = ss_attn; \
    (void)lane; (void)xb_; (void)jb_; (void)wj; (void)X; (void)XB; (void)ss_attn; (void)ss_ffn; (void)ss_ple; (void)ss_next; (void)G;
#define PH_END }
#define U ((bf16_t*)(ws + WS_MIX))
#define ACT ((bf16_t*)(ws + WS_MIX + 176 * MiB))

    { const int layer = 0; PH_BEGIN
      if (bid == 0 && tid == 0) __hip_atomic_store((unsigned*)(ws + WS_CTL) + 16, 0u, __ATOMIC_RELAXED, __HIP_MEMORY_SCOPE_AGENT);
      const float* xin = PQ->in[I_X];
      for (int r = wj; r < SEQ; r += 256) {
          const int m = xb_ * SEQ + r;
          const f32x4* xr = (const f32x4*)(xin + (size_t)m * 1024) + lane;
          f32x4 v[4]; float s = 0.f;
#pragma unroll
          for (int jj = 0; jj < 4; ++jj) { v[jj] = xr[64 * jj]; s += (v[jj][0] * v[jj][0] + v[jj][1] * v[jj][1]) + (v[jj][2] * v[jj][2] + v[jj][3] * v[jj][3]); }
          s = wave_sum(s);
          if (lane < 16) ss_attn[(size_t)m * 16 + lane] = lane == 0 ? s : 0.f;
          f32x4* xo = (f32x4*)(X + (size_t)m * 1024) + lane;
          u32x2* bo = (u32x2*)(XB + (size_t)m * 1024) + lane;
#pragma unroll
          for (int jj = 0; jj < 4; ++jj) { xo[64 * jj] = v[jj]; u32x2 w; w.x = pk2(v[jj][0], v[jj][1]); w.y = pk2(v[jj][2], v[jj][3]); bo[64 * jj] = w; }
      }
    PH_END }

    for (int layer = 0; layer < NLAYER; ++layer) {
        asm volatile("" ::: "memory");
        const float lam_init = 0.8f - 0.6f * __expf(-0.3f * (float)layer);
        PH_BEGIN
        convert_weights(PQ, layer, lds, bid * NW + wave, G * NW, wave, lane);
        { const float* pl = PQ->in[I_P] + ((size_t)layer * MTOK + (size_t)xb_ * SEQ) * DPLE;
          bf16_t* pb = (bf16_t*)(ws + WS_PB) + (size_t)xb_ * SEQ * DPLE;
          for (int i = jb_ * NTHR + tid; i < SEQ * DPLE / 8; i += 32 * NTHR) {
              const f32x4 a = *(const f32x4*)(pl + (size_t)i * 8), b = *(const f32x4*)(pl + (size_t)i * 8 + 4);
              u32x4 w; w.x = pk2(a[0], a[1]); w.y = pk2(a[2], a[3]); w.z = pk2(b[0], b[1]); w.w = pk2(b[2], b[3]);
              *(u32x4*)(pb + (size_t)i * 8) = w;
          }
        }
        PH_END
        GRID_SYNC();
#ifdef DBLTEST
#ifdef DBL_SC
#define DBL_LD(p) ldc16(p)
#else
#define DBL_LD(p) (*(p))
#endif
        if (layer == 0) {
#ifdef DBL_OUTP
        PH_BEGIN
        { EpiResid E{X, XB, ss_ffn, nullptr, -1};
          GEMM_PHASE(EpiResid, ws + WS_VT, ws + W_OUT, MTOK, 1024, 1024, E, -1); }
        PH_END
        GRID_SYNC();
#endif
        for (int rep = 0; rep < 2; ++rep) {
        PH_BEGIN
#ifdef DBL_COPY
            { const u32x4* s4 = (const u32x4*)XB; u32x4* d4 = (u32x4*)(ws + WS_MIX + (size_t)rep * 176 * MiB);
              const size_t per = (size_t)DBL_M * DBL_N * 2 / 16 / 8;
              for (size_t i = (size_t)((jb_ + rep * 13) & 31) * NTHR + tid; i < per; i += (size_t)32 * NTHR) d4[(size_t)xb_ * per + i] = DBL_LD(s4 + (size_t)xb_ * per + i); }
#else
#ifndef DBL_W
#define DBL_W W_UP
#define DBL_ACT 0
#endif
            { EpiRowScale<DBL_ACT> E{(bf16_t*)(ws + WS_MIX + (size_t)rep * DBL_OFF * MiB), DBL_N, ss_attn, DBL_H};
              GEMM_PHASE(EpiRowScale<DBL_ACT>, XB, ws + DBL_W, DBL_M, DBL_N, 1024, E, DBL_H); }
#endif
        PH_END
        GRID_SYNC();
        }
        PH_BEGIN
        { const u32x4* a4 = (const u32x4*)(ws + WS_MIX); const u32x4* b4 = (const u32x4*)(ws + WS_MIX + (size_t)DBL_OFF * MiB); unsigned bad = 0u;
          const size_t per = (size_t)DBL_M * DBL_N * 2 / 16 / 8;
          for (size_t i0 = (size_t)((jb_ + 7) & 31) * NTHR + tid; i0 < per; i0 += (size_t)32 * NTHR) { const size_t i = (size_t)xb_ * per + i0; const u32x4 a = DBL_LD(a4 + i), b = DBL_LD(b4 + i); bad |= ((a.x ^ b.x) | (a.y ^ b.y) | (a.z ^ b.z) | (a.w ^ b.w)) ? 1u : 0u; }
          if (bad) __hip_atomic_fetch_or((unsigned*)(ws + WS_CTL) + 16, 1u, __ATOMIC_RELAXED, __HIP_MEMORY_SCOPE_AGENT); }
        PH_END
        GRID_SYNC();
        }
#endif
#if defined(DBLMIX) && !defined(DBLMIX_AT_GATES)
        for (int rep = 0; rep < 2; ++rep) {
#endif
#ifndef NO_INPROJ
        PH_BEGIN
        { EpiQK E{ws, ss_attn, PQ->in[I_QNORM] + layer * 64, PQ->in[I_KNORM] + layer * 64};
          GEMM_PHASE(EpiQK, XB, ws + W_IN, MTOK, 2048, 1024, E, -1); }
        PH_END
        PH_BEGIN
        { EpiSeg E{ws, ss_attn};
          GEMM_PHASE(EpiSeg, XB, ws + W_IN + (size_t)2048 * 2048, MTOK, 4096, 1024, E, -1); }
        PH_END
        PH_BEGIN
        { EpiGB E{ws, ss_attn, PQ->in[I_ALOG] + layer * 8, PQ->in[I_DTB] + layer * 8};
          GEMM_PHASE(EpiGB, XB, ws + W_IN + (size_t)6144 * 2048, MTOK, 256, 1024, E, -1); }
        PH_END
        PH_BEGIN
        { EpiVt E{(bf16_t*)(ws + WS_VT), ss_attn};
          GEMM_PHASE(EpiVt, ws + W_V, XB, 1024, MTOK, 1024, E, -1); }
        PH_END
#endif
        GRID_SYNC();
#ifndef NO_ATTN
        PH_BEGIN
        { const float* lq = PQ->in[I_LAM] + layer * 256;
          const float a1 = wave_sum(lq[lane] * lq[64 + lane]), a2 = wave_sum(lq[128 + lane] * lq[192 + lane]);
          const float lam = __expf(a1) - __expf(a2) + lam_init;
          for (int k = 0; k < 4; ++k) {
              const int pi = jb_ + 32 * k, hh = pi >> 4, s = pi & 15;
              attn_unit(lds, (const bf16_t*)(ws + WS_QA), (const bf16_t*)(ws + WS_KA), (const bf16_t*)(ws + WS_VT), (bf16_t*)(ws + WS_QA), xb_, hh, 31 - s, lam, 1.f - lam_init, PQ->in[I_SUBLN] + layer * 128, PQ->in[I_RELB], tid);
              attn_unit(lds, (const bf16_t*)(ws + WS_QA), (const bf16_t*)(ws + WS_KA), (const bf16_t*)(ws + WS_VT), (bf16_t*)(ws + WS_QA), xb_, hh, s, lam, 1.f - lam_init, PQ->in[I_SUBLN] + layer * 128, PQ->in[I_RELB], tid);
          }
        }
        PH_END
#endif
#ifndef NO_DN
        PH_BEGIN
#ifdef DN_NAIVE
        if (jb_ < 8) dn_naive(lds, ws, PQ->in[I_CONVB] + (size_t)layer * 4 * 3072, xb_, jb_, tid);
#else
        dn_fast(lds, ws, PQ->in[I_CONVB] + (size_t)layer * 4 * 3072, xb_, jb_ >> 2, jb_ & 3, tid);
#endif
        PH_END
#endif
        GRID_SYNC();
#if defined(DBLMIX) && defined(DBLMIX_AT_GATES)
        for (int rep = 0; rep < 2; ++rep) {
#endif
#ifndef NO_GATES
        PH_BEGIN
        { EpiRowScale<1> E{(bf16_t*)(ws + WS_G), 2048, ss_attn, -1};
          GEMM_PHASE(EpiRowScale<1>, XB, ws + W_GL, MTOK, 2048, 1024, E, -1); }
        PH_END
#endif
#ifndef NO_OBNORM
        PH_BEGIN
        { const float* on = PQ->in[I_ONORM] + layer * 128;
          const float g0 = on[2 * lane], g1 = on[2 * lane + 1];
          unsigned* OB = (unsigned*)(ws + WS_QB) + (size_t)xb_ * SEQ * 512; const unsigned* OI = (const unsigned*)(ws + WS_OSRC) + (size_t)xb_ * SEQ * 512; const unsigned* ZB = (const unsigned*)(ws + WS_ZB) + (size_t)xb_ * SEQ * 512;
          for (int r = wj; r < SEQ * NH; r += 256) {
              const unsigned ov = OI[(size_t)r * 64 + lane], zv = ZB[(size_t)r * 64 + lane];
              const float o0 = bflo(ov), o1 = bfhi(ov);
              const float sq = wave_sum(o0 * o0 + o1 * o1);
              const float rr = rsqrtf(sq * (1.f / 128.f) + EPS);
              OB[(size_t)r * 64 + lane] = pk2(o0 * rr * g0 * siluf_(bflo(zv)), o1 * rr * g1 * siluf_(bfhi(zv)));
          }
        }
        PH_END
#endif
        GRID_SYNC();
#ifndef NO_TMPA
        PH_BEGIN
        { EpiGateMul E{(bf16_t*)(ws + WS_TMPA), (const bf16_t*)(ws + WS_G), 2048, 0, nullptr};
          GEMM_PHASE(EpiGateMul, ws + WS_QA, ws + W_BRA, MTOK, 1024, 1024, E, -1); }
        PH_END
#endif
        GRID_SYNC();
#ifndef NO_MIXED
        PH_BEGIN
        { EpiGateMul E{(bf16_t*)(ws + WS_MIXED), (const bf16_t*)(ws + WS_G), 2048, 1024, (const bf16_t*)(ws + WS_TMPA)};
          GEMM_PHASE(EpiGateMul, ws + WS_QB, ws + W_BRB, MTOK, 1024, 1024, E, -1); }
        PH_END
#endif
        GRID_SYNC();
#ifdef DBLMIX
        PH_BEGIN
        { const u32x4* t4 = (const u32x4*)(ws + (size_t)DBL_TGT + (size_t)xb_ * ((size_t)DBL_TGT_BYTES / 8)); u32x4* s4 = (u32x4*)(ws + WS_PB + (size_t)xb_ * 2 * MiB); unsigned bad = 0u;
          for (size_t i = (size_t)((jb_ + 5 * rep) & 31) * NTHR + tid; i < (size_t)2 * MiB / 16; i += (size_t)32 * NTHR) {
              const u32x4 a = t4[i];
              if (rep == 0) s4[i] = a; else { const u32x4 b = s4[i]; bad |= ((a.x ^ b.x) | (a.y ^ b.y) | (a.z ^ b.z) | (a.w ^ b.w)) ? 1u : 0u; } }
          if (bad) __hip_atomic_fetch_or((unsigned*)(ws + WS_CTL) + 16, 1u, __ATOMIC_RELAXED, __HIP_MEMORY_SCOPE_AGENT); }
        PH_END
        GRID_SYNC();
        }
#endif
#ifndef NO_OUTP
        PH_BEGIN
        { EpiResid E{X, XB, ss_ffn, nullptr, -1};
          GEMM_PHASE(EpiResid, ws + WS_MIXED, ws + W_OUT, MTOK, 1024, 1024, E, -1); }
        PH_END
#endif
        GRID_SYNC();
        for (int half = 0; half < 2; ++half) {
#ifndef NO_UP
        PH_BEGIN
            { EpiRowScale<0> E{U, 5632, ss_ffn, half};
              GEMM_PHASE(EpiRowScale<0>, XB, ws + W_UP, 16384, 5632, 1024, E, half); }
        PH_END
#endif
            GRID_SYNC();
#ifndef NO_ACT
        PH_BEGIN
            { const float* cw = PQ->in[I_CONVFF] + (size_t)layer * 3 * 5632; const float* cb = PQ->in[I_CONVFFB] + (size_t)layer * 5632;
              bf16_t* UH = (bf16_t*)(ws + WS_UHALO) + (size_t)xb_ * 2 * 5632;
              for (int it = jb_ * NTHR + tid; it < 128 * 352; it += 32 * NTHR) {
                  const int cc = it % 352, rg = it / 352, c0 = cc * 8;
                  const int lrow0 = xb_ * 2048 + rg * 16;
                  float wg[3][8], wv[3][8], bg[8], bv[8];
#pragma unroll
                  for (int jj = 0; jj < 3; ++jj)
#pragma unroll
                      for (int e = 0; e < 8; ++e) { wg[jj][e] = cw[jj * 5632 + c0 + e]; wv[jj][e] = cw[jj * 5632 + 2816 + c0 + e]; }
#pragma unroll
                  for (int e = 0; e < 8; ++e) { bg[e] = cb[c0 + e]; bv[e] = cb[2816 + c0 + e]; }
                  float g2[8], g1[8], v2[8], v1[8];
#pragma unroll
                  for (int e = 0; e < 8; ++e) { g2[e] = 0.f; g1[e] = 0.f; v2[e] = 0.f; v1[e] = 0.f; }
                  if (rg > 0 || half == 1) {
                      const bf16_t* r2p = rg > 0 ? U + (size_t)(lrow0 - 2) * 5632 : UH;
                      const bf16_t* r1p = rg > 0 ? U + (size_t)(lrow0 - 1) * 5632 : UH + 5632;
                      const u32x4 a = *(const u32x4*)(r2p + c0), bq = *(const u32x4*)(r1p + c0);
                      const u32x4 c = *(const u32x4*)(r2p + 2816 + c0), d = *(const u32x4*)(r1p + 2816 + c0);
                      g2[0] = bflo(a.x); g2[1] = bfhi(a.x); g2[2] = bflo(a.y); g2[3] = bfhi(a.y); g2[4] = bflo(a.z); g2[5] = bfhi(a.z); g2[6] = bflo(a.w); g2[7] = bfhi(a.w);
                      g1[0] = bflo(bq.x); g1[1] = bfhi(bq.x); g1[2] = bflo(bq.y); g1[3] = bfhi(bq.y); g1[4] = bflo(bq.z); g1[5] = bfhi(bq.z); g1[6] = bflo(bq.w); g1[7] = bfhi(bq.w);
                      v2[0] = bflo(c.x); v2[1] = bfhi(c.x); v2[2] = bflo(c.y); v2[3] = bfhi(c.y); v2[4] = bflo(c.z); v2[5] = bfhi(c.z); v2[6] = bflo(c.w); v2[7] = bfhi(c.w);
                      v1[0] = bflo(d.x); v1[1] = bfhi(d.x); v1[2] = bflo(d.y); v1[3] = bfhi(d.y); v1[4] = bflo(d.z); v1[5] = bfhi(d.z); v1[6] = bflo(d.w); v1[7] = bfhi(d.w);
                  }
                  for (int rr = 0; rr < 16; ++rr) {
                      const size_t row = (size_t)lrow0 + rr;
                      const u32x4 a = *(const u32x4*)(U + row * 5632 + c0), c = *(const u32x4*)(U + row * 5632 + 2816 + c0);
                      if (half == 0 && rg == 127 && rr >= 14) { *(u32x4*)(UH + (size_t)(rr - 14) * 5632 + c0) = a; *(u32x4*)(UH + (size_t)(rr - 14) * 5632 + 2816 + c0) = c; }
                      float g0[8], v0[8], ov[8];
                      g0[0] = bflo(a.x); g0[1] = bfhi(a.x); g0[2] = bflo(a.y); g0[3] = bfhi(a.y); g0[4] = bflo(a.z); g0[5] = bfhi(a.z); g0[6] = bflo(a.w); g0[7] = bfhi(a.w);
                      v0[0] = bflo(c.x); v0[1] = bfhi(c.x); v0[2] = bflo(c.y); v0[3] = bfhi(c.y); v0[4] = bflo(c.z); v0[5] = bfhi(c.z); v0[6] = bflo(c.w); v0[7] = bfhi(c.w);
#pragma unroll
                      for (int e = 0; e < 8; ++e) {
                          const float ug = wg[0][e] * g2[e] + wg[1][e] * g1[e] + wg[2][e] * g0[e] + bg[e];
                          const float uv = wv[0][e] * v2[e] + wv[1][e] * v1[e] + wv[2][e] * v0[e] + bv[e];
                          ov[e] = siluf_(ug) * uv; g2[e] = g1[e]; g1[e] = g0[e]; v2[e] = v1[e]; v1[e] = v0[e];
                      }
                      u32x4 w; w.x = pk2(ov[0], ov[1]); w.y = pk2(ov[2], ov[3]); w.z = pk2(ov[4], ov[5]); w.w = pk2(ov[6], ov[7]);
                      *(u32x4*)(ACT + row * 2816 + c0) = w;
                  }
              }
            }
        PH_END
#endif
            GRID_SYNC();
#ifndef NO_DOWN
        PH_BEGIN
            { EpiResid E{X, XB, ss_ple, nullptr, half};
              GEMM_PHASE(EpiResid, ACT, ws + W_DOWN, 16384, 1024, 2816, E, -1); }
        PH_END
#endif
            GRID_SYNC();
        }
#ifndef NO_PLEG
        PH_BEGIN
        { EpiRowScale<1> E{(bf16_t*)(ws + WS_MIX), 1024, ss_ple, -1};
          GEMM_PHASE(EpiRowScale<1>, XB, ws + W_PG, MTOK, 1024, 1024, E, -1); }
        PH_END
#endif
        GRID_SYNC();
#ifndef NO_PLE
        PH_BEGIN
        { EpiResid E{X, XB, ss_next, (const bf16_t*)(ws + WS_MIX), -1};
          GEMM_PHASE(EpiResid, ws + WS_PB, ws + W_PP, MTOK, 1024, 256, E, -1); }
        PH_END
#endif
        GRID_SYNC();
    }
#ifdef NANCHK
    { const int layer = 0; PH_BEGIN
      unsigned bad = 0u;
      for (size_t i = (size_t)bid * NTHR + tid; i < (size_t)MTOK * 256; i += (size_t)G * NTHR) { const f32x4 v = *(const f32x4*)(X + i * 4);
          for (int e = 0; e < 4; ++e) bad |= ((__float_as_uint(v[e]) & 0x7f800000u) == 0x7f800000u) ? 1u : 0u; }
#ifdef NANCHK_BF_LO
      { const unsigned* bp = (const unsigned*)(ws + (size_t)NANCHK_BF_LO); const size_t nw = ((size_t)NANCHK_BF_HI - (size_t)NANCHK_BF_LO) / 4;
        for (size_t i = (size_t)bid * NTHR + tid; i < nw; i += (size_t)G * NTHR) { const unsigned w = bp[i]; bad |= (((w & 0x7f80u) == 0x7f80u) || ((w & 0x7f800000u) == 0x7f800000u)) ? 1u : 0u; } }
#endif
      if (bad) __hip_atomic_fetch_or((unsigned*)(ws + WS_CTL) + 16, 1u, __ATOMIC_RELAXED, __HIP_MEMORY_SCOPE_AGENT);
      PH_END }
    GRID_SYNC();
    { const int layer = 0; PH_BEGIN
      const unsigned fl = __hip_atomic_fetch_or((unsigned*)(ws + WS_CTL) + 16, 0u, __ATOMIC_RELAXED, __HIP_MEMORY_SCOPE_AGENT);
      if (fl) for (size_t i = (size_t)bid * NTHR + tid; i < (size_t)MTOK * 256; i += (size_t)G * NTHR) *(f32x4*)(X + i * 4) = (f32x4){0.f, 0.f, 0.f, 0.f};
      PH_END }
#endif
#undef U
#undef ACT
}

extern "C" void kernel_launch(void* const* d_in, const int* in_sizes, int n_in, void* d_out, int out_size, void* d_ws, size_t ws_size, hipStream_t stream) {
    static int grid = 0;
    if (grid == 0) {
        if (n_in != 24 || out_size != MTOK * DM || ws_size < WS_TOTAL) { fprintf(stderr, "kernel_launch: unexpected shapes / workspace (n_in %d out %d ws %zu need %zu)\n", n_in, out_size, ws_size, (size_t)WS_TOTAL); grid = -1; return; }
        int dev = 0, cus = 0, per_cu = 0;
        hipGetDevice(&dev);
        hipDeviceGetAttribute(&cus, hipDeviceAttributeMultiprocessorCount, dev);
        hipFuncSetAttribute((const void*)fwd_mega, hipFuncAttributeMaxDynamicSharedMemorySize, LDS_BYTES);
        hipOccupancyMaxActiveBlocksPerMultiprocessor(&per_cu, (const void*)fwd_mega, NTHR, LDS_BYTES);
        if (per_cu < 1) { fprintf(stderr, "kernel_launch: occupancy query says %d blocks per CU\n", per_cu); per_cu = 1; }
        (void)hipGetLastError();
        grid = cus;
    }
    if (grid < 0) return;
    Params p{};
    for (int i = 0; i < 24; ++i) p.in[i] = (const float*)d_in[i];
    p.out = (float*)d_out; p.ws = (unsigned char*)d_ws;
    hipError_t e = hipSuccess;
#ifdef N_SEG_LAUNCH
    for (int sgi = 0; sgi < 60 && e == hipSuccess; sgi += N_SEG_LAUNCH) {
        p.seg_lo = sgi; p.seg_hi = sgi + N_SEG_LAUNCH;
        void* args[] = {&p};
        e = hipLaunchCooperativeKernel((const void*)fwd_mega, dim3(grid), dim3(NTHR), args, LDS_BYTES, stream);
    }
#else
    p.seg_lo = 0; p.seg_hi = 1000;
    void* args[] = {&p};
    e = hipLaunchCooperativeKernel((const void*)fwd_mega, dim3(grid), dim3(NTHR), args, LDS_BYTES, stream);
#endif
    if (e != hipSuccess) fprintf(stderr, "cooperative launch failed: %s (grid %d)\n", hipGetErrorString(e), grid);
}
```

```cpp
#include <hip/hip_runtime.h>
#include <hip/hip_cooperative_groups.h>
#include <cstdio>
#include <cstdint>
namespace cg = cooperative_groups;
namespace pg8 {
#define PG8_LAS __attribute__((address_space(3)))
typedef unsigned short bf16_t;
typedef short bf16x8 __attribute__((ext_vector_type(8)));
typedef float f32x4 __attribute__((ext_vector_type(4)));
typedef unsigned u32x4 __attribute__((ext_vector_type(4)));
constexpr int BM = 256, BK = 64, HALF = 128, HTB = HALF * BK * 2  , STAGE_BYTES = 8 * HTB, NXCD = 8, WGM = 8;

__host__ __device__ __forceinline__ int lds_byte(int r, int c) { const int st = (r >> 4) * 2 + (c >> 5), rr = r & 15, cc = c & 31, ob = rr * 64 + cc * 2; return st * 1024 + (ob ^ (((ob >> 9) & 1) << 5)); }
__host__ __device__ __forceinline__ void stage_rc(int b, int& R, int& C) { const int st = b / 1024, sb = b % 1024, swz = sb ^ (((sb >> 9) & 1) << 5); R = (st >> 1) * 16 + swz / 64; C = (st & 1) * 32 + (swz % 64) / 2; }
__host__ __device__ __forceinline__ int perm32(int rho) { const int n = rho >> 4, i = rho & 15; return 8 * (i >> 2) + 4 * n + (i & 3); }

struct Unit { int pm, pn; };
struct Gemm { const bf16_t* A; const bf16_t* Bt; int M, N, K; int hmap; };
__device__ __forceinline__ int amap(int pm, int hmap) { return hmap < 0 ? pm : ((pm >> 3) * 16 + 8 * hmap + (pm & 7)); }

struct StaticOrder {
    int nM, nN, nwg, G, c;
    __host__ __device__ void init(int M, int N, int G_, int c_) { nM = M / BM; nN = N / BM; nwg = nM * nN; G = G_; c = c_; }
    __host__ __device__ bool next(int i, Unit& u) const {
        const long L = (long)i * G + c; if (L >= nwg) return false;
        int wgid = (int)L; { const int q = nwg / NXCD, r = nwg % NXCD, xcd = wgid % NXCD, off = wgid / NXCD; wgid = (xcd < r ? xcd * (q + 1) : r * (q + 1) + (xcd - r) * q) + off; }
        const int nig = WGM * nN, gid = wgid / nig, fm = gid * WGM, gsz = (nM - fm) < WGM ? (nM - fm) : WGM;
        u.pm = fm + ((wgid % nig) % gsz); u.pn = (wgid % nig) / gsz; return true;
    }
    __device__ __forceinline__ void a_ready(const Unit&) const {}
    __device__ __forceinline__ void done(const Unit&) const {}
};
__device__ __forceinline__ unsigned cvt_pk_bf16(float lo, float hi) { unsigned r; asm volatile("v_cvt_pk_bf16_f32 %0, %1, %2" : "=v"(r) : "v"(lo), "v"(hi)); return r; }
#ifdef NO_UNI
__device__ __forceinline__ const char* uni(const char* p) { return p; }
#else
__device__ __forceinline__ const char* uni(const char* p) { const unsigned long long v = (unsigned long long)p; const unsigned lo = __builtin_amdgcn_readfirstlane((unsigned)v), hi = __builtin_amdgcn_readfirstlane((unsigned)(v >> 32)); return (const char*)(((unsigned long long)hi << 32) | lo); }
#endif
template <class Epi, class Sched, bool ALIGN_EPI = false, bool SP2 = false>
__device__ __forceinline__ void gemm_phase(PG8_LAS unsigned char* lds, const Gemm g, const Sched& S, const Epi& E) {
    int tid = threadIdx.x;
#ifndef NO_LAUNDER
    asm volatile("" : "+v"(tid));
#endif

    const int wid = __builtin_amdgcn_readfirstlane(tid >> 6), lane = tid & 63, wr = wid >> 2, wc = wid & 3, fr = lane & 15, fq = lane >> 4;
    const int K = g.K, nt = K / BK;
    unsigned voffA[2], voffB[2];
#pragma unroll
    for (int i = 0; i < 2; ++i) { int R, C; stage_rc(tid * 16 + i * 8192, R, C); const int Rb = Epi::PERM ? ((R & ~31) + perm32(R & 31)) : R;
        voffA[i] = (unsigned)(R * K + C) * 2u; voffB[i] = (unsigned)(Rb * K + C) * 2u; }
    const size_t kstep = (size_t)(BK * 2);
    const size_t hstep = (size_t)HALF * K * 2;
    const size_t tstep = 2 * hstep;
    const unsigned ldsw = (unsigned)wid * 1024u;
    const int aoff = lds_byte(wr * 64 + fr, fq * 8), boff = lds_byte(wc * 32 + fr, fq * 8);
#define PG8_SA(b, h) (((b) * 2 + (h)) * HTB)
#define PG8_SB(b, h) ((4 + (b) * 2 + (h)) * HTB)
#define PG8_STAGE(bufoff, gbase, voff) do { _Pragma("unroll") for (int _i = 0; _i < 2; ++_i) \
        __builtin_amdgcn_global_load_lds((const unsigned*)((const char*)(gbase) + (voff)[_i]), (PG8_LAS unsigned*)(lds + (bufoff) + ldsw + _i * 8192), 16, 0, 0); } while (0)
#define PG8_LDA(dst, b, h) do { _Pragma("unroll") for (int m = 0; m < 4; ++m) _Pragma("unroll") for (int k = 0; k < 2; ++k) dst[m][k] = *(const PG8_LAS bf16x8*)(lds + PG8_SA(b, h) + aoff + m * 2048 + k * 1024); } while (0)
#define PG8_LDB(dst, b, h) do { _Pragma("unroll") for (int n = 0; n < 2; ++n) _Pragma("unroll") for (int k = 0; k < 2; ++k) dst[n][k] = *(const PG8_LAS bf16x8*)(lds + PG8_SB(b, h) + boff + n * 2048 + k * 1024); } while (0)
#define PG8_MMA(ai, bj, At, Bt) do { __builtin_amdgcn_s_setprio(1); _Pragma("unroll") for (int m = 0; m < 4; ++m) _Pragma("unroll") for (int n = 0; n < 2; ++n) _Pragma("unroll") for (int k = 0; k < 2; ++k) \
        acc[ai][bj][m][n] = __builtin_amdgcn_mfma_f32_16x16x32_bf16(Bt[n][k], At[m][k], acc[ai][bj][m][n], 0, 0, 0); __builtin_amdgcn_s_setprio(0); } while (0)
#define PG8_WAIT_V(n) asm volatile("s_waitcnt vmcnt(" #n ")" ::: "memory")
#define PG8_WAIT_L(n) asm volatile("s_waitcnt lgkmcnt(" #n ")" ::: "memory")
#define PG8_BAR __builtin_amdgcn_s_barrier()
#define PG8_SCHED __builtin_amdgcn_sched_barrier(0)
    Unit cur, nxt; int ui = 0;
    if (!S.next(0, cur)) return;
    f32x4 acc[2][2][4][2];
#pragma unroll
    for (int a = 0; a < 2; ++a)
#pragma unroll
        for (int b = 0; b < 2; ++b)
#pragma unroll
            for (int m = 0; m < 4; ++m)
#pragma unroll
                for (int n = 0; n < 2; ++n) acc[a][b][m][n] = (f32x4){0.f, 0.f, 0.f, 0.f};
    bf16x8 At[4][2], B0[2][2], B1[2][2];
    const char* cA = uni((const char*)g.A + (size_t)amap(cur.pm, g.hmap) * tstep); const char* cB = uni((const char*)g.Bt + (size_t)cur.pn * tstep);
    S.a_ready(cur);
    if constexpr (SP2) {
        PG8_STAGE(PG8_SB(0, 0), cB, voffB); PG8_STAGE(PG8_SB(0, 1), cB + hstep, voffB); PG8_STAGE(PG8_SA(0, 0), cA, voffA); PG8_STAGE(PG8_SA(0, 1), cA + hstep, voffA);
        if (wr == 1) PG8_BAR;
        PG8_WAIT_V(2); PG8_BAR;
        PG8_STAGE(PG8_SB(1, 0), cB + kstep, voffB); PG8_STAGE(PG8_SA(1, 0), cA + kstep, voffA); PG8_STAGE(PG8_SB(1, 1), cB + hstep + kstep, voffB);
        PG8_WAIT_V(6); PG8_BAR;
    } else {
        PG8_STAGE(PG8_SB(0, 0), cB, voffB); PG8_STAGE(PG8_SA(0, 0), cA, voffA); PG8_STAGE(PG8_SB(0, 1), cB + hstep, voffB); PG8_STAGE(PG8_SA(0, 1), cA + hstep, voffA);
        if (wr == 1) PG8_BAR;
        PG8_WAIT_V(4); PG8_BAR;
        PG8_STAGE(PG8_SB(1, 0), cB + kstep, voffB); PG8_STAGE(PG8_SA(1, 0), cA + kstep, voffA); PG8_STAGE(PG8_SB(1, 1), cB + hstep + kstep, voffB);
        PG8_WAIT_V(6); PG8_BAR;
    }
    for (;;) {
        const bool has_next = S.next(ui + 1, nxt);
        const char* nA = uni(has_next ? (const char*)g.A + (size_t)amap(nxt.pm, g.hmap) * tstep : cA); const char* nB = uni(has_next ? (const char*)g.Bt + (size_t)nxt.pn * tstep : cB);
        for (int t = 0; t < nt; t += 2) {
            const bool last = (t == nt - 2);
            const char* a1 = cA + (size_t)(t + 1) * kstep;
            const char* a2 = last ? nA : cA + (size_t)(t + 2) * kstep; const char* b2 = last ? nB : cB + (size_t)(t + 2) * kstep;
            const char* a3 = a2 + kstep; const char* b3 = b2 + kstep;
            if (last && has_next) S.a_ready(nxt);
            if constexpr (SP2) {
            PG8_LDB(B0, 0, 0); PG8_LDB(B1, 0, 1); PG8_SCHED; PG8_LDA(At, 0, 0); PG8_STAGE(PG8_SA(1, 1), a1 + hstep, voffA);
            PG8_WAIT_V(8); PG8_WAIT_L(0); PG8_BAR; PG8_MMA(0, 0, At, B0); PG8_MMA(0, 1, At, B1); PG8_BAR; PG8_SCHED;
            PG8_LDA(At, 0, 1); PG8_STAGE(PG8_SB(0, 0), b2, voffB); PG8_STAGE(PG8_SB(0, 1), b2 + hstep, voffB); PG8_STAGE(PG8_SA(0, 0), a2, voffA);
            PG8_WAIT_V(8); PG8_WAIT_L(0); PG8_BAR; PG8_MMA(1, 0, At, B0); PG8_MMA(1, 1, At, B1); PG8_BAR; PG8_SCHED;
            PG8_LDB(B0, 1, 0); PG8_LDB(B1, 1, 1); PG8_SCHED; PG8_LDA(At, 1, 0); PG8_STAGE(PG8_SA(0, 1), a2 + hstep, voffA);
            PG8_WAIT_V(8); PG8_WAIT_L(0); PG8_BAR; PG8_MMA(0, 0, At, B0); PG8_MMA(0, 1, At, B1); PG8_BAR; PG8_SCHED;
            PG8_LDA(At, 1, 1); PG8_STAGE(PG8_SB(1, 0), b3, voffB); PG8_STAGE(PG8_SB(1, 1), b3 + hstep, voffB); PG8_STAGE(PG8_SA(1, 0), a3, voffA);
            PG8_WAIT_V(8); PG8_WAIT_L(0); PG8_BAR; PG8_MMA(1, 0, At, B0); PG8_MMA(1, 1, At, B1); PG8_BAR; PG8_SCHED;
            } else {
            PG8_LDB(B0, 0, 0); PG8_SCHED; PG8_LDA(At, 0, 0); PG8_STAGE(PG8_SA(1, 1), a1 + hstep, voffA);
            PG8_WAIT_L(8); PG8_BAR; PG8_WAIT_L(0); PG8_MMA(0, 0, At, B0); PG8_BAR; PG8_SCHED;
            PG8_LDB(B1, 0, 1); PG8_STAGE(PG8_SB(0, 0), b2, voffB);
            PG8_BAR; PG8_WAIT_L(0); PG8_MMA(0, 1, At, B1); PG8_BAR;
            PG8_LDA(At, 0, 1); PG8_STAGE(PG8_SA(0, 0), a2, voffA);
            PG8_BAR; PG8_WAIT_L(0); PG8_MMA(1, 0, At, B0); PG8_BAR; PG8_SCHED;
            PG8_STAGE(PG8_SB(0, 1), b2 + hstep, voffB);
            PG8_WAIT_V(6); PG8_BAR; PG8_MMA(1, 1, At, B1); PG8_BAR;
            PG8_LDB(B0, 1, 0); PG8_SCHED; PG8_LDA(At, 1, 0); PG8_STAGE(PG8_SA(0, 1), a2 + hstep, voffA);
            PG8_WAIT_L(8); PG8_BAR; PG8_WAIT_L(0); PG8_MMA(0, 0, At, B0); PG8_BAR; PG8_SCHED;
            PG8_LDB(B1, 1, 1); PG8_STAGE(PG8_SB(1, 0), b3, voffB);
            PG8_BAR; PG8_WAIT_L(0); PG8_MMA(0, 1, At, B1); PG8_BAR;
            PG8_LDA(At, 1, 1); PG8_STAGE(PG8_SA(1, 0), a3, voffA);
            PG8_BAR; PG8_WAIT_L(0); PG8_MMA(1, 0, At, B0); PG8_BAR; PG8_SCHED;
            PG8_STAGE(PG8_SB(1, 1), b3 + hstep, voffB);
            PG8_WAIT_V(6); PG8_BAR; PG8_MMA(1, 1, At, B1); PG8_BAR;
            }
        }
        if constexpr (ALIGN_EPI) { if (wr == 0) PG8_BAR; }
        if constexpr (!Epi::AFTER_DRAIN) { E(acc, cur, wr, wc, fr, fq); S.done(cur); }
        if (!has_next) break;
#pragma unroll
        for (int a = 0; a < 2; ++a)
#pragma unroll
            for (int b = 0; b < 2; ++b)
#pragma unroll
                for (int m = 0; m < 4; ++m)
#pragma unroll
                    for (int n = 0; n < 2; ++n) acc[a][b][m][n] = (f32x4){0.f, 0.f, 0.f, 0.f};
        cur = nxt; cA = nA; cB = nB; ++ui;
        if constexpr (ALIGN_EPI) { if (wr == 1) PG8_BAR; }
    }
    PG8_WAIT_V(0);
    if constexpr (!ALIGN_EPI) { if (wr == 0) PG8_BAR; }
    PG8_BAR;
    if constexpr (Epi::AFTER_DRAIN) { E.fused(acc, cur, wr, wc, fr, fq, lds, wid, lane); S.done(cur); }
#undef PG8_SA
#undef PG8_SB
#undef PG8_STAGE
#undef PG8_LDA
#undef PG8_LDB
#undef PG8_MMA
#undef PG8_WAIT_V
#undef PG8_WAIT_L
#undef PG8_BAR
#undef PG8_SCHED
}
}

#define GAS __attribute__((address_space(1)))
#define LAS __attribute__((address_space(3)))
typedef unsigned short bf16_t;
typedef float f32x4 __attribute__((ext_vector_type(4)));
typedef float f32x16 __attribute__((ext_vector_type(16)));
typedef short bf16x8 __attribute__((ext_vector_type(8)));
typedef unsigned u32x4 __attribute__((ext_vector_type(4)));
typedef unsigned u32x2 __attribute__((ext_vector_type(2)));

#ifndef NLAYER_V
#define NLAYER_V 4
#endif
constexpr int NW = 8, NTHR = 512;
constexpr int MTOK = 32768, DM = 1024, SEQ = 4096, NB = 8, NLAYER = NLAYER_V, NH = 8;
constexpr int DIN = 9232, DFF = 2816, DPLE = 256;
constexpr float EPS = 1e-6f;
constexpr float LOG2E = 1.4426950408889634f;
constexpr size_t MiB = 1u << 20;
constexpr size_t WS_SS = 0;
constexpr size_t WS_CTL = 1792 * 1024;
constexpr size_t WS_UHALO = 1856 * 1024;
constexpr size_t WS_GB = 2 * MiB;
constexpr size_t WS_HALO = 4 * MiB;
constexpr size_t WS_PB = 14 * MiB;
constexpr size_t WS_W = 30 * MiB;
constexpr size_t W_IN = WS_W, W_V = W_IN + (size_t)6400 * 1024 * 2, W_GL = W_V + 2 * MiB, W_BRA = W_GL + 4 * MiB, W_BRB = W_BRA + 2 * MiB,
                 W_OUT = W_BRB + 2 * MiB, W_UP = W_OUT + 2 * MiB, W_DOWN = W_UP + 11 * MiB, W_PG = W_DOWN + (size_t)1024 * 2816 * 2, W_PP = W_PG + 2 * MiB, W_END = W_PP + (size_t)1024 * 256 * 2;
static_assert(W_END <= 74 * MiB, "weights region");
constexpr size_t WS_XB = 74 * MiB;
constexpr size_t WS_MIX = 138 * MiB;
constexpr size_t S64 = 64 * MiB;
constexpr size_t WS_QA = WS_MIX, WS_KA = WS_MIX + S64, WS_VT = WS_MIX + 2 * S64, WS_QB = WS_MIX + 3 * S64, WS_KB = WS_MIX + 4 * S64, WS_VB = WS_MIX + 5 * S64, WS_ZB = WS_MIX + 6 * S64;
constexpr size_t WS_TOTAL = WS_MIX + 7 * S64;
#ifdef DN_NAIVE
constexpr size_t WS_G = WS_KB, WS_TMPA = WS_KA, WS_MIXED = WS_VT, WS_OSRC = WS_QB;
#else
constexpr size_t WS_G = WS_KA, WS_TMPA = WS_KB, WS_MIXED = WS_VB, WS_OSRC = WS_VB;
#endif
constexpr int LDS_BYTES = 147456, LDS_VB = 140032;

__device__ __forceinline__ float bflo(unsigned w) { return __uint_as_float(w << 16); }
__device__ __forceinline__ float bfhi(unsigned w) { return __uint_as_float(w & 0xffff0000u); }
__device__ __forceinline__ float bf2f(bf16_t v) { return __uint_as_float((unsigned)v << 16); }
typedef float f32x2_t __attribute__((ext_vector_type(2))); typedef __bf16 bf16x2_t __attribute__((ext_vector_type(2)));
__device__ __forceinline__ unsigned pk2(float lo, float hi) { const f32x2_t v = {lo, hi}; const bf16x2_t b = __builtin_convertvector(v, bf16x2_t); return __builtin_bit_cast(unsigned, b); }
__device__ __forceinline__ bf16_t f2bf(float f) { return (bf16_t)(pk2(f, 0.f) & 0xffffu); }
__device__ __forceinline__ float sigmoidf_(float x) { x = fminf(fmaxf(x, -60.f), 60.f); return __builtin_amdgcn_rcpf(1.f + __expf(-x)); }
__device__ __forceinline__ float siluf_(float x) { return x * sigmoidf_(x); }
__device__ __forceinline__ float wave_sum(float v) {
#pragma unroll
    for (int o = 1; o < 64; o <<= 1) v += __shfl_xor(v, o);
    return v;
}
__device__ __forceinline__ float ss_load(const float* p) { const f32x4 a = *(const f32x4*)p, b = *(const f32x4*)(p + 4), c = *(const f32x4*)(p + 8), d = *(const f32x4*)(p + 12);
    float s = (((a[0] + a[1]) + (a[2] + a[3])) + ((b[0] + b[1]) + (b[2] + b[3]))) + (((c[0] + c[1]) + (c[2] + c[3])) + ((d[0] + d[1]) + (d[2] + d[3])));
    asm volatile("" : "+v"(s) :: "memory");
    return s; }
__device__ __forceinline__ u32x4 ldc16(const void* p) { u32x4 v; asm volatile("global_load_dwordx4 %0, %1, off sc0 sc1\n\ts_waitcnt vmcnt(0)" : "=v"(v) : "v"(p) : "memory"); return v; }
__device__ __forceinline__ int crow(int r, int hi) { return (r & 3) + 8 * (r >> 2) + 4 * hi; }

__device__ __forceinline__ int gmap(int row, int h) { return h < 0 ? row : ((row >> 11) * 4096 + 2048 * h + (row & 2047)); }

using pg8::Unit;
typedef f32x4 AccT[2][2][4][2];

template <int ACT> struct EpiRowScale {
    static constexpr bool PERM = true, AFTER_DRAIN = false;
    bf16_t* O; int ldc; const float* ss; int hmap;
    __device__ __forceinline__ void operator()(const AccT& acc, const Unit& u, int wr, int wc, int fr, int fq) const {
        const int row0 = u.pm * 256 + wr * 64 + fr, col0 = u.pn * 256 + wc * 32 + 8 * fq;
#pragma unroll
        for (int ai = 0; ai < 2; ++ai)
#pragma unroll
            for (int m = 0; m < 4; ++m) {
                const int row = row0 + ai * 128 + m * 16;
#ifdef RS_CONST
                const float rs = 1000.f;
#else
                const float rs = rsqrtf(ss_load(ss + (size_t)gmap(row, hmap) * 16) * (1.f / 1024.f) + EPS);
#endif
                bf16_t* rowp = O + (size_t)row * ldc + col0;
#pragma unroll
                for (int bj = 0; bj < 2; ++bj) {
                    f32x4 v0 = acc[ai][bj][m][0] * rs, v1 = acc[ai][bj][m][1] * rs;
                    if (ACT == 1) {
#pragma unroll
                        for (int e = 0; e < 4; ++e) { v0[e] = sigmoidf_(v0[e]); v1[e] = sigmoidf_(v1[e]); }
                    }
                    u32x4 w; w.x = pk2(v0[0], v0[1]); w.y = pk2(v0[2], v0[3]); w.z = pk2(v1[0], v1[1]); w.w = pk2(v1[2], v1[3]);
                    *(u32x4*)(rowp + bj * 128) = w;
                    asm volatile("" ::: "memory");
                }
            }
    }
};

struct EpiVt {
    static constexpr bool PERM = true, AFTER_DRAIN = false;
    bf16_t* O; const float* ss;
    __device__ __forceinline__ void operator()(const AccT& acc, const Unit& u, int wr, int wc, int fr, int fq) const {
        const int row0 = u.pm * 256 + wr * 64 + fr, col0 = u.pn * 256 + wc * 32 + 8 * fq;
        float rs[2][8];
#pragma unroll
        for (int bj = 0; bj < 2; ++bj)
#pragma unroll
            for (int e = 0; e < 8; ++e) rs[bj][e] = rsqrtf(ss_load(ss + (size_t)(col0 + bj * 128 + e) * 16) * (1.f / 1024.f) + EPS);
#pragma unroll
        for (int ai = 0; ai < 2; ++ai)
#pragma unroll
            for (int m = 0; m < 4; ++m) {
                const int row = row0 + ai * 128 + m * 16;
                bf16_t* rowp = O + (size_t)row * MTOK + col0;
#pragma unroll
                for (int bj = 0; bj < 2; ++bj) {
                    const f32x4 v0 = acc[ai][bj][m][0], v1 = acc[ai][bj][m][1];
                    u32x4 w; w.x = pk2(v0[0] * rs[bj][0], v0[1] * rs[bj][1]); w.y = pk2(v0[2] * rs[bj][2], v0[3] * rs[bj][3]);
                    w.z = pk2(v1[0] * rs[bj][4], v1[1] * rs[bj][5]); w.w = pk2(v1[2] * rs[bj][6], v1[3] * rs[bj][7]);
                    *(u32x4*)(rowp + bj * 128) = w;
                }
                asm volatile("" ::: "memory");
            }
    }
};

struct EpiGateMul {
    static constexpr bool PERM = true, AFTER_DRAIN = false;
    bf16_t* O; const bf16_t* G; int ldg, goff; const bf16_t* Add;
    __device__ __forceinline__ void operator()(const AccT& acc, const Unit& u, int wr, int wc, int fr, int fq) const {
        const int row0 = u.pm * 256 + wr * 64 + fr, col0 = u.pn * 256 + wc * 32 + 8 * fq;
#pragma unroll
        for (int ai = 0; ai < 2; ++ai)
#pragma unroll
            for (int m = 0; m < 4; ++m) {
                const int row = row0 + ai * 128 + m * 16;
#pragma unroll
                for (int bj = 0; bj < 2; ++bj) {
                    const int c = col0 + bj * 128;
                    const u32x4 g = *(const u32x4*)(G + (size_t)row * ldg + goff + c);
                    u32x4 a = (u32x4){0u, 0u, 0u, 0u};
                    if (Add) a = *(const u32x4*)(Add + (size_t)row * 1024 + c);
                    const f32x4 v0 = acc[ai][bj][m][0], v1 = acc[ai][bj][m][1];
                    u32x4 w;
                    w.x = pk2(bflo(a.x) + bflo(g.x) * v0[0], bfhi(a.x) + bfhi(g.x) * v0[1]);
                    w.y = pk2(bflo(a.y) + bflo(g.y) * v0[2], bfhi(a.y) + bfhi(g.y) * v0[3]);
                    w.z = pk2(bflo(a.z) + bflo(g.z) * v1[0], bfhi(a.z) + bfhi(g.z) * v1[1]);
                    w.w = pk2(bflo(a.w) + bflo(g.w) * v1[2], bfhi(a.w) + bfhi(g.w) * v1[3]);
                    *(u32x4*)(O + (size_t)row * 1024 + c) = w;
                }
                asm volatile("" ::: "memory");
            }
    }
};

struct EpiResid {
    static constexpr bool PERM = true, AFTER_DRAIN = false;
    float* X; bf16_t* XB; float* ssn; const bf16_t* Mul; int hmap;
    __device__ __forceinline__ void operator()(const AccT& acc, const Unit& u, int wr, int wc, int fr, int fq) const {
        const int row0 = u.pm * 256 + wr * 64 + fr, col0 = u.pn * 256 + wc * 32 + 8 * fq;
#pragma unroll
        for (int ai = 0; ai < 2; ++ai)
#pragma unroll
            for (int m = 0; m < 4; ++m) {
                const int row = gmap(row0 + ai * 128 + m * 16, hmap);
                float sq = 0.f;
#pragma unroll
                for (int bj = 0; bj < 2; ++bj)
#pragma unroll
                    for (int n = 0; n < 2; ++n) {
                        const size_t off = (size_t)row * 1024 + col0 + bj * 128 + 4 * n;
                        f32x4 x0 = *(const f32x4*)(X + off);
                        f32x4 v0 = acc[ai][bj][m][n];
                        if (Mul) { const u32x2 g = *(const u32x2*)(Mul + off); v0[0] *= bflo(g.x); v0[1] *= bfhi(g.x); v0[2] *= bflo(g.y); v0[3] *= bfhi(g.y); }
                        x0 += v0;
                        *(f32x4*)(X + off) = x0;
                        u32x2 w; w.x = pk2(x0[0], x0[1]); w.y = pk2(x0[2], x0[3]);
                        *(u32x2*)(XB + off) = w;
                        sq += (x0[0] * x0[0] + x0[1] * x0[1]) + (x0[2] * x0[2] + x0[3] * x0[3]);
                        asm volatile("" ::: "memory");
                    }
                sq += __shfl_xor(sq, 16); sq += __shfl_xor(sq, 32);
                if (fq == 0) ssn[(size_t)row * 16 + u.pn * 4 + wc] = sq;
                asm volatile("" ::: "memory");
            }
    }
};

struct EpiQK {
    static constexpr bool PERM = true, AFTER_DRAIN = false;
    unsigned char* ws; const float* ss; const float* qg; const float* kg;
    __device__ __forceinline__ void operator()(const AccT& acc, const Unit& u, int wr, int wc, int fr, int fq) const {
        const int row0 = u.pm * 256 + wr * 64 + fr;
        const int seg = u.pn >> 2, tl = u.pn & 3;
        bf16_t* base = (bf16_t*)(ws + (seg == 0 ? WS_QA : WS_KA));
        const float* gp = seg == 0 ? qg : kg; const float osc = seg == 0 ? 0.125f * LOG2E : 1.0f;
        const int col0 = tl * 256 + 64 * wc + 8 * fq;
#pragma unroll
        for (int ai = 0; ai < 2; ++ai)
#pragma unroll
            for (int m = 0; m < 4; ++m) {
                const int row = row0 + ai * 128 + m * 16;
                const float rs = rsqrtf(ss_load(ss + (size_t)row * 16) * (1.f / 1024.f) + EPS);
                f32x4 v[2][2]; float sq = 0.f;
#pragma unroll
                for (int bj = 0; bj < 2; ++bj)
#pragma unroll
                    for (int n = 0; n < 2; ++n) { v[bj][n] = acc[ai][bj][m][n] * rs; const f32x4 t = v[bj][n]; sq += (t[0] * t[0] + t[1] * t[1]) + (t[2] * t[2] + t[3] * t[3]); }
                sq += __shfl_xor(sq, 16); sq += __shfl_xor(sq, 32);
                const float r2o = rsqrtf(sq * (1.f / 64.f) + EPS) * osc;
#pragma unroll
                for (int bj = 0; bj < 2; ++bj) {
                    const f32x4 ga = *(const f32x4*)(gp + 32 * bj + 8 * fq), gb = *(const f32x4*)(gp + 32 * bj + 8 * fq + 4);
                    u32x4 w;
                    w.x = pk2(v[bj][0][0] * r2o * ga[0], v[bj][0][1] * r2o * ga[1]); w.y = pk2(v[bj][0][2] * r2o * ga[2], v[bj][0][3] * r2o * ga[3]);
                    w.z = pk2(v[bj][1][0] * r2o * gb[0], v[bj][1][1] * r2o * gb[1]); w.w = pk2(v[bj][1][2] * r2o * gb[2], v[bj][1][3] * r2o * gb[3]);
                    *(u32x4*)(base + (size_t)row * 1024 + col0 + 32 * bj) = w;
                }
                asm volatile("" ::: "memory");
            }
    }
};
struct EpiSeg {
    static constexpr bool PERM = true, AFTER_DRAIN = false;
    unsigned char* ws; const float* ss;
    __device__ __forceinline__ void operator()(const AccT& acc, const Unit& u, int wr, int wc, int fr, int fq) const {
        const int row0 = u.pm * 256 + wr * 64 + fr;
        bf16_t* base = (bf16_t*)(ws + WS_QB + (size_t)(u.pn >> 2) * S64);
        const int col0 = (u.pn & 3) * 256 + wc * 32 + 8 * fq;
#pragma unroll
        for (int ai = 0; ai < 2; ++ai)
#pragma unroll
            for (int m = 0; m < 4; ++m) {
                const int row = row0 + ai * 128 + m * 16;
                const float rs = rsqrtf(ss_load(ss + (size_t)row * 16) * (1.f / 1024.f) + EPS);
#pragma unroll
                for (int bj = 0; bj < 2; ++bj) {
                    const f32x4 v0 = acc[ai][bj][m][0] * rs, v1 = acc[ai][bj][m][1] * rs;
                    u32x4 w; w.x = pk2(v0[0], v0[1]); w.y = pk2(v0[2], v0[3]); w.z = pk2(v1[0], v1[1]); w.w = pk2(v1[2], v1[3]);
                    *(u32x4*)(base + (size_t)row * 1024 + col0 + bj * 128) = w;
                }
                asm volatile("" ::: "memory");
            }
    }
};
struct EpiGB {
    static constexpr bool PERM = true, AFTER_DRAIN = false;
    unsigned char* ws; const float* ss; const float* a_log; const float* dt_bias;
    __device__ __forceinline__ void operator()(const AccT& acc, const Unit& u, int wr, int wc, int fr, int fq) const {
        const int row0 = u.pm * 256 + wr * 64 + fr;
        if (wc == 0 && fq < 2) {
            float* GBp = (float*)(ws + WS_GB);
#pragma unroll
            for (int ai = 0; ai < 2; ++ai)
#pragma unroll
                for (int m = 0; m < 4; ++m) {
                    const int row = row0 + ai * 128 + m * 16;
                    const float rs = rsqrtf(ss_load(ss + (size_t)row * 16) * (1.f / 1024.f) + EPS);
                    float v[8];
#pragma unroll
                    for (int e = 0; e < 4; ++e) { v[e] = acc[ai][0][m][0][e] * rs; v[4 + e] = acc[ai][0][m][1][e] * rs; }
                    if (fq == 0) {
#pragma unroll
                        for (int e = 0; e < 8; ++e) v[e] = sigmoidf_(v[e]);
                    } else {
#pragma unroll
                        for (int e = 0; e < 8; ++e) { const float z = v[e] + dt_bias[e]; const float sp = fmaxf(z, 0.f) + __logf(1.f + __expf(-fabsf(z))); v[e] = -__expf(a_log[e]) * sp; }
                    }
                    float* dst = GBp + (size_t)row * 16 + 8 * fq;
                    *(f32x4*)dst = (f32x4){v[0], v[1], v[2], v[3]}; *(f32x4*)(dst + 4) = (f32x4){v[4], v[5], v[6], v[7]};
                    asm volatile("" ::: "memory");
                }
        }
    }
};

__device__ __forceinline__ void cvt_item(const float* W, int ldw, int src_col0, int nvalid, const float* gain, bf16_t* WT, int K, int dst_row0, int k0, LAS float* scr, int lane) {
    const int nn = lane & 31;
#pragma unroll 8
    for (int i = 0; i < 32; ++i) {
        const int kk = 2 * i + (lane >> 5);
        float v = 0.f;
        if (nn < nvalid) { v = W[(size_t)(k0 + kk) * ldw + src_col0 + nn]; if (gain) v *= gain[k0 + kk]; }
        scr[kk * 33 + nn] = v;
    }
    asm volatile("s_waitcnt lgkmcnt(0)" ::: "memory");
    const int c = lane & 7;
#pragma unroll
    for (int j = 0; j < 4; ++j) {
        const int n = (lane >> 3) + 8 * j; const LAS float* s = scr + (8 * c) * 33 + n;
        u32x4 o; o.x = pk2(s[0 * 33], s[1 * 33]); o.y = pk2(s[2 * 33], s[3 * 33]); o.z = pk2(s[4 * 33], s[5 * 33]); o.w = pk2(s[6 * 33], s[7 * 33]);
        *(u32x4*)(WT + (size_t)(dst_row0 + n) * K + k0 + 8 * c) = o;
    }
    asm volatile("s_waitcnt lgkmcnt(0)" ::: "memory");
}

struct Params {
    const float* in[24];
    float* out;
    unsigned char* ws;
    int seg_lo, seg_hi;
};
enum { I_X = 0, I_P, I_WIN, I_ATTN_NORM, I_QNORM, I_KNORM, I_LAM, I_SUBLN, I_RELB, I_CONVB, I_ALOG, I_DTB, I_ONORM, I_WBRA, I_WBRB, I_WOUT, I_FFN_NORM, I_WUP, I_CONVFF, I_CONVFFB, I_WDOWN, I_PLE_NORM, I_WPG, I_WPP };

__device__ __forceinline__ void convert_weights(const Params* PQ, int layer, LAS unsigned char* lds, int gw, int NGW, int wave, int lane) {
    LAS float* scr = (LAS float*)(lds + wave * 16384);
    unsigned char* ws = PQ->ws;
    const float* w_in = PQ->in[I_WIN] + (size_t)layer * 1024 * DIN;
    const float* g_attn = PQ->in[I_ATTN_NORM] + layer * 1024;
    const float* g_ffn = PQ->in[I_FFN_NORM] + layer * 1024;
    const float* g_ple = PQ->in[I_PLE_NORM] + layer * 1024;
#define CVT_JOB(NITEMS, KB, SRCW, LDW, GAIN, DST, KK, SRCCOL, NVALID) \
    for (int it = gw; it < (NITEMS); it += NGW) { const int g = it / (KB), kb = it % (KB); (void)g; \
        cvt_item((SRCW), (LDW), (SRCCOL), (NVALID), (GAIN), (bf16_t*)(ws + (DST)), (KK), g * 32, kb * 64, scr, lane); } asm volatile("" ::: "memory");
    for (int it = gw; it < 200 * 16; it += NGW) {
        const int g = it >> 4, kb = it & 15, pn = g >> 3, gi = g & 7;
        int src, nv = 32;
        if (pn < 8) { const int bj = gi >> 2, wc = gi & 3; src = (pn >> 2) * 1024 + (pn & 3) * 256 + 64 * wc + 32 * bj; }
        else if (pn < 24) { src = 3072 + (pn - 8) * 256 + 32 * gi; }
        else { src = 7168; nv = (gi == 0) ? 16 : 0; }
        cvt_item(w_in, DIN, src, nv, g_attn, (bf16_t*)(ws + W_IN), 1024, g * 32, kb * 64, scr, lane);
    }
    asm volatile("" ::: "memory");
    CVT_JOB(32 * 16, 16, w_in, DIN, g_attn, W_V, 1024, 2048 + g * 32, 32)
    CVT_JOB(64 * 16, 16, w_in, DIN, g_attn, W_GL, 1024, 7184 + g * 32, 32)
    CVT_JOB(32 * 16, 16, PQ->in[I_WBRA] + (size_t)layer * 1024 * 1024, 1024, (const float*)nullptr, W_BRA, 1024, g * 32, 32)
    CVT_JOB(32 * 16, 16, PQ->in[I_WBRB] + (size_t)layer * 1024 * 1024, 1024, (const float*)nullptr, W_BRB, 1024, g * 32, 32)
    CVT_JOB(32 * 16, 16, PQ->in[I_WOUT] + (size_t)layer * 1024 * 1024, 1024, (const float*)nullptr, W_OUT, 1024, g * 32, 32)
    CVT_JOB(176 * 16, 16, PQ->in[I_WUP] + (size_t)layer * 1024 * 5632, 5632, g_ffn, W_UP, 1024, g * 32, 32)
    CVT_JOB(32 * 44, 44, PQ->in[I_WDOWN] + (size_t)layer * 2816 * 1024, 1024, (const float*)nullptr, W_DOWN, 2816, g * 32, 32)
    CVT_JOB(32 * 16, 16, PQ->in[I_WPG] + (size_t)layer * 1024 * 1024, 1024, g_ple, W_PG, 1024, g * 32, 32)
    CVT_JOB(32 * 4, 4, PQ->in[I_WPP] + (size_t)layer * 256 * 1024, 1024, (const float*)nullptr, W_PP, 256, g * 32, 32)
#undef CVT_JOB
}

constexpr int AT_KROW = 272, AT_VROW = 144, AT_KBYTES = 64 * AT_KROW, AT_VBYTES = 128 * AT_VROW, AT_STAGE = AT_KBYTES + AT_VBYTES, AT_TB = 2 * AT_STAGE;
static_assert(AT_TB >= 65536 && AT_TB + 1024 <= LDS_BYTES, "attention LDS");
__device__ __forceinline__ void attn_unit(LAS unsigned char* lds, const bf16_t* QA, const bf16_t* KA, const bf16_t* VT, bf16_t* OA, int b, int h, int qb,
                                          float lam, float out_scale, const float* subln, const float* relb, int tid) {
    const int lane = tid & 63, wid = __builtin_amdgcn_readfirstlane(tid >> 6), j = wid >> 2, wq = wid & 3, r32 = lane & 31, hi = lane >> 5;
    const int Q0 = qb * 128, qrow = Q0 + 32 * wq + r32;
    const size_t tok = (size_t)b * SEQ + qrow;
    LAS float* TB = (LAS float*)(lds + AT_TB);
    for (int i = tid; i <= 128; i += NTHR) {
        float v = 0.f;
        if (i < 128) {
            int bk = i;
            if (i >= 16) { int lg = 16 + (int)(__logf((float)i * (1.f / 16.f)) / __logf(8.0f) * 16.f); bk = lg < 31 ? lg : 31; }
            v = (relb[bk * 8 + h] - relb[31 * 8 + h]) * LOG2E;
        }
        TB[i] = v;
    }
    bf16x8 qf[4];
#pragma unroll
    for (int d0 = 0; d0 < 4; ++d0) qf[d0] = *(const bf16x8*)(QA + tok * 1024 + h * 128 + 64 * j + 16 * d0 + 8 * hi);
    const int NT = (Q0 + 128) / 64;
    const int kr0 = tid >> 4, kc = tid & 15;
    const int vr0 = tid >> 3, vc = tid & 7;
    const bf16_t* kg = KA + ((size_t)b * SEQ + kr0) * 1024 + h * 128 + kc * 8;
    const bf16_t* vg = VT + (size_t)(h * 128 + vr0) * MTOK + (size_t)b * SEQ + vc * 8;
    u32x4 kreg0, kreg1, vreg0, vreg1;
#define AT_LOAD(t) do { kreg0 = *(const u32x4*)(kg + (size_t)(t) * 64 * 1024); kreg1 = *(const u32x4*)(kg + (size_t)((t) * 64 + 32) * 1024); \
        vreg0 = *(const u32x4*)(vg + (t) * 64); vreg1 = *(const u32x4*)(vg + (size_t)64 * MTOK + (t) * 64); } while (0)
#define AT_STORE(s) do { LAS unsigned char* kb_ = lds + (s) * AT_STAGE; LAS unsigned char* vb_ = kb_ + AT_KBYTES; \
        *(LAS u32x4*)(kb_ + kr0 * AT_KROW + kc * 16) = kreg0; *(LAS u32x4*)(kb_ + (kr0 + 32) * AT_KROW + kc * 16) = kreg1; \
        *(LAS u32x4*)(vb_ + vr0 * AT_VROW + vc * 16) = vreg0; *(LAS u32x4*)(vb_ + (vr0 + 64) * AT_VROW + vc * 16) = vreg1; } while (0)
    AT_LOAD(0); AT_STORE(0);
    __syncthreads();
    f32x16 o[4];
#pragma unroll
    for (int i = 0; i < 4; ++i)
#pragma unroll
        for (int r = 0; r < 16; ++r) o[i][r] = 0.f;
    float mrun = -INFINITY, lrun = 0.f;
    const int qmax_w = Q0 + 32 * wq + 31, qmin_w = Q0 + 32 * wq;
    for (int t = 0; t < NT; ++t) {
        if (t + 1 < NT) AT_LOAD(t + 1);
        const int kv0 = 64 * t;
        if (kv0 <= qmax_w) {
            const LAS unsigned char* Kb = lds + (t & 1) * AT_STAGE; const LAS unsigned char* Vb = Kb + AT_KBYTES;
            f32x16 s0, s1;
#pragma unroll
            for (int r = 0; r < 16; ++r) { s0[r] = 0.f; s1[r] = 0.f; }
#pragma unroll
            for (int d0 = 0; d0 < 4; ++d0) {
                const bf16x8 a0 = *(const LAS bf16x8*)(Kb + r32 * AT_KROW + (64 * j + 16 * d0 + 8 * hi) * 2);
                const bf16x8 a1 = *(const LAS bf16x8*)(Kb + (32 + r32) * AT_KROW + (64 * j + 16 * d0 + 8 * hi) * 2);
                s0 = __builtin_amdgcn_mfma_f32_32x32x16_bf16(a0, qf[d0], s0, 0, 0, 0);
                s1 = __builtin_amdgcn_mfma_f32_32x32x16_bf16(a1, qf[d0], s1, 0, 0, 0);
            }
            if (kv0 + 63 + 128 > qmin_w) {
#pragma unroll
                for (int r = 0; r < 16; ++r) {
                    const int rel0 = qrow - (kv0 + crow(r, hi)), rel1 = rel0 - 32;
                    s0[r] = rel0 < 0 ? -INFINITY : s0[r] + TB[rel0 < 128 ? rel0 : 128];
                    s1[r] = rel1 < 0 ? -INFINITY : s1[r] + TB[rel1 < 128 ? rel1 : 128];
                }
            }
            float mx = fmaxf(s0[0], s1[0]);
#pragma unroll
            for (int r = 1; r < 16; ++r) mx = fmaxf(mx, fmaxf(s0[r], s1[r]));
            mx = fmaxf(mx, __shfl_xor(mx, 32));
            const float mnew = fmaxf(mrun, mx);
            const float alpha = __builtin_amdgcn_exp2f(mrun - mnew);
            mrun = mnew;
            float ls = 0.f;
#pragma unroll
            for (int r = 0; r < 16; ++r) { s0[r] = __builtin_amdgcn_exp2f(s0[r] - mnew); s1[r] = __builtin_amdgcn_exp2f(s1[r] - mnew); ls += s0[r] + s1[r]; }
            lrun = lrun * alpha + ls;
#pragma unroll
            for (int i = 0; i < 4; ++i)
#pragma unroll
                for (int r = 0; r < 16; ++r) o[i][r] *= alpha;
            bf16x8 pf[4];
            { u32x4 w;
              w.x = pk2(s0[0], s0[1]); w.y = pk2(s0[2], s0[3]); w.z = pk2(s0[4], s0[5]); w.w = pk2(s0[6], s0[7]); pf[0] = __builtin_bit_cast(bf16x8, w);
              w.x = pk2(s0[8], s0[9]); w.y = pk2(s0[10], s0[11]); w.z = pk2(s0[12], s0[13]); w.w = pk2(s0[14], s0[15]); pf[1] = __builtin_bit_cast(bf16x8, w);
              w.x = pk2(s1[0], s1[1]); w.y = pk2(s1[2], s1[3]); w.z = pk2(s1[4], s1[5]); w.w = pk2(s1[6], s1[7]); pf[2] = __builtin_bit_cast(bf16x8, w);
              w.x = pk2(s1[8], s1[9]); w.y = pk2(s1[10], s1[11]); w.z = pk2(s1[12], s1[13]); w.w = pk2(s1[14], s1[15]); pf[3] = __builtin_bit_cast(bf16x8, w); }
#pragma unroll
            for (int blk = 0; blk < 4; ++blk)
#pragma unroll
                for (int s = 0; s < 4; ++s) {
                    const LAS unsigned char* vp = Vb + (32 * blk + r32) * AT_VROW + (16 * s + 4 * hi) * 2;
                    const u32x2 lo = *(const LAS u32x2*)vp, hh = *(const LAS u32x2*)(vp + 16);
                    const u32x4 w = (u32x4){lo.x, lo.y, hh.x, hh.y};
                    o[blk] = __builtin_amdgcn_mfma_f32_32x32x16_bf16(__builtin_bit_cast(bf16x8, w), pf[s], o[blk], 0, 0, 0);
                }
        }
        if (t + 1 < NT) AT_STORE((t + 1) & 1);
        __syncthreads();
    }
#undef AT_LOAD
#undef AT_STORE
    lrun += __shfl_xor(lrun, 32);
    const float inv = 1.f / lrun;
    LAS float* EX = (LAS float*)lds;
    if (j == 1) {
        const float sc = inv * lam;
#pragma unroll
        for (int blk = 0; blk < 4; ++blk)
#pragma unroll
            for (int r = 0; r < 16; ++r) EX[(wq * 64 + blk * 16 + r) * 64 + lane] = o[blk][r] * sc;
    }
    __syncthreads();
    if (j == 0) {
        float sq = 0.f;
#pragma unroll
        for (int blk = 0; blk < 4; ++blk)
#pragma unroll
            for (int r = 0; r < 16; ++r) { const float d = o[blk][r] * inv - EX[(wq * 64 + blk * 16 + r) * 64 + lane]; o[blk][r] = d; sq += d * d; }
        sq += __shfl_xor(sq, 32);
        const float rr = rsqrtf(sq * (1.f / 128.f) + EPS) * out_scale;
#pragma unroll
        for (int blk = 0; blk < 4; ++blk)
#pragma unroll
            for (int rq = 0; rq < 4; ++rq) {
                const int dv0 = 32 * blk + 8 * rq + 4 * hi;
                const f32x4 g = *(const f32x4*)(subln + dv0);
                u32x2 w; w.x = pk2(o[blk][4 * rq + 0] * rr * g[0], o[blk][4 * rq + 1] * rr * g[1]); w.y = pk2(o[blk][4 * rq + 2] * rr * g[2], o[blk][4 * rq + 3] * rr * g[3]);
                *(u32x2*)(OA + tok * 1024 + h * 128 + dv0) = w;
            }
    }
    __syncthreads();
}

__device__ __forceinline__ void dn_naive(LAS unsigned char* lds, unsigned char* ws, const float* convw  , int b, int h, int tid) {
    const int lane = tid & 63, wid = tid >> 6, dv = tid & 127, g4 = tid >> 7;
    LAS float* Y = (LAS float*)lds;
    LAS float* NR = Y + 384;
    LAS float* PT = NR + 8;
    LAS float* OP = PT + 512;
    float S[32];
#pragma unroll
    for (int i = 0; i < 32; ++i) S[i] = 0.f;
    bf16_t* QB = (bf16_t*)(ws + WS_QB); const bf16_t* KB = (const bf16_t*)(ws + WS_KB); const bf16_t* VB = (const bf16_t*)(ws + WS_VB);
    const float* GBp = (const float*)(ws + WS_GB);
    const int arr = tid >> 7;
    const bf16_t* src = (arr == 0 ? (const bf16_t*)QB : arr == 1 ? KB : VB) + h * 128 + dv;
    float w0 = 0.f, w1 = 0.f, w2 = 0.f, w3 = 0.f, x1 = 0.f, x2 = 0.f, x3 = 0.f;
    if (tid < 384) { const int ch = arr * 1024 + h * 128 + dv; w0 = convw[ch]; w1 = convw[3072 + ch]; w2 = convw[2 * 3072 + ch]; w3 = convw[3 * 3072 + ch]; }
    for (int t = 0; t < SEQ; ++t) {
        const size_t tok = (size_t)b * SEQ + t;
        if (tid < 384) {
            const float x0 = bf2f(src[tok * 1024]);
            float y = w0 * x3 + w1 * x2 + w2 * x1 + w3 * x0;
            y = siluf_(y); x3 = x2; x2 = x1; x1 = x0;
            Y[arr * 128 + dv] = y;
            const float sq = wave_sum(y * y);
            if (lane == 0) NR[wid] = sq;
        }
        __syncthreads();
        const float qn = rsqrtf(NR[0] + NR[1] + EPS) * 0.08838834764831845f, kn = rsqrtf(NR[2] + NR[3] + EPS);
        const float bt = GBp[tok * 16 + h], gt = GBp[tok * 16 + 8 + h], eg = __expf(gt);
        const float vv = Y[256 + dv];
        float ks = 0.f;
#pragma unroll
        for (int i = 0; i < 32; ++i) ks += Y[128 + 32 * g4 + i] * S[i];
        PT[g4 * 128 + dv] = ks * kn;
        __syncthreads();
        const float kS = (PT[dv] + PT[128 + dv]) + (PT[256 + dv] + PT[384 + dv]);
        const float c = bt * (vv - eg * kS);
        float op = 0.f;
#pragma unroll
        for (int i = 0; i < 32; ++i) { const float kk = Y[128 + 32 * g4 + i] * kn; S[i] = eg * S[i] + kk * c; op += Y[32 * g4 + i] * S[i]; }
        OP[g4 * 128 + dv] = op * qn;
        __syncthreads();
        if (g4 == 0) { const float ov = (OP[dv] + OP[128 + dv]) + (OP[256 + dv] + OP[384 + dv]); QB[tok * 1024 + h * 128 + dv] = f2bf(ov); }
    }
    __syncthreads();
}

__device__ __forceinline__ float row16_sum(float v) {
    v += __builtin_bit_cast(float, __builtin_amdgcn_update_dpp(0, __builtin_bit_cast(int, v), 0x128, 0xf, 0xf, false));
    v += __builtin_bit_cast(float, __builtin_amdgcn_update_dpp(0, __builtin_bit_cast(int, v), 0x124, 0xf, 0xf, false));
    v += __builtin_bit_cast(float, __builtin_amdgcn_update_dpp(0, __builtin_bit_cast(int, v), 0x122, 0xf, 0xf, false));
    v += __builtin_bit_cast(float, __builtin_amdgcn_update_dpp(0, __builtin_bit_cast(int, v), 0x121, 0xf, 0xf, false));
    return v;
}
__device__ __forceinline__ void dn_fast(LAS unsigned char* lds, unsigned char* ws, const float* convw  , int b, int h, int dvq, int tid) {
    const int lane = tid & 63, wid = tid >> 6, dvl = lane >> 4, grp = lane & 15;
    const int dvloc = 4 * wid + dvl, dv = 32 * dvq + dvloc;
    LAS float* Y = (LAS float*)lds;
    LAS float* NR = Y + 16 * 288;
    LAS float* GBs = NR + 16 * 16;
    LAS float* SC = GBs + 32;
    float S[8];
#pragma unroll
    for (int i = 0; i < 8; ++i) S[i] = 0.f;
    bf16_t* VB = (bf16_t*)(ws + WS_VB);
    const float* GBp = (const float*)(ws + WS_GB);
    const int arr = tid < 128 ? 0 : (tid < 256 ? 1 : 2);
    const int dch = arr == 2 ? 32 * dvq + ((tid - 256) & 31) : (tid & 127);
    const bf16_t* src = (const bf16_t*)(ws + (arr == 0 ? WS_QB : arr == 1 ? WS_KB : WS_VB)) + h * 128 + dch;
    float w0 = 0.f, w1 = 0.f, w2 = 0.f, w3 = 0.f, x1 = 0.f, x2 = 0.f, x3 = 0.f;
    if (tid < 288) { const int ch = arr * 1024 + h * 128 + dch; w0 = convw[ch]; w1 = convw[3072 + ch]; w2 = convw[2 * 3072 + ch]; w3 = convw[3 * 3072 + ch]; }
    for (int t0 = 0; t0 < SEQ; t0 += 16) {
        const size_t tokb = (size_t)b * SEQ + t0;
        if (tid < 288) {
            bf16_t xr[16];
#pragma unroll
            for (int tt = 0; tt < 16; ++tt) xr[tt] = src[(tokb + tt) * 1024];
#pragma unroll
            for (int tt = 0; tt < 16; ++tt) {
                const float x0 = bf2f(xr[tt]);
                float y = w0 * x3 + w1 * x2 + w2 * x1 + w3 * x0;
                y = siluf_(y); x3 = x2; x2 = x1; x1 = x0;
                Y[tt * 288 + tid] = y;
                if (tid < 256) { const float sq = row16_sum(y * y); if ((lane & 15) == 0) NR[tt * 16 + wid * 4 + (lane >> 4)] = sq; }
            }
        }
        if (tid >= 480) { const int i = tid - 480, tt = i >> 1, which = i & 1; GBs[tt * 2 + which] = GBp[(tokb + tt) * 16 + which * 8 + h]; }
        __syncthreads();
        if (tid < 16) {
            const f32x4 a = *(const LAS f32x4*)(NR + tid * 16), b2 = *(const LAS f32x4*)(NR + tid * 16 + 4), c2 = *(const LAS f32x4*)(NR + tid * 16 + 8), d2 = *(const LAS f32x4*)(NR + tid * 16 + 12);
            const float sq_q = ((a[0] + a[1]) + (a[2] + a[3])) + ((b2[0] + b2[1]) + (b2[2] + b2[3])), sq_k = ((c2[0] + c2[1]) + (c2[2] + c2[3])) + ((d2[0] + d2[1]) + (d2[2] + d2[3]));
            *(LAS f32x4*)(SC + tid * 4) = (f32x4){rsqrtf(sq_q + EPS) * 0.08838834764831845f, rsqrtf(sq_k + EPS), __expf(GBs[tid * 2 + 1]), GBs[tid * 2]};
        }
        __syncthreads();
#pragma unroll 4
        for (int tt = 0; tt < 16; ++tt) {
            const f32x4 sc = *(const LAS f32x4*)(SC + tt * 4);
            const float qn = sc[0], kn = sc[1], eg = sc[2], bt = sc[3];
            const f32x4 ka = *(const LAS f32x4*)(Y + tt * 288 + 128 + 8 * grp), kb = *(const LAS f32x4*)(Y + tt * 288 + 128 + 8 * grp + 4);
            const f32x4 qa = *(const LAS f32x4*)(Y + tt * 288 + 8 * grp), qb = *(const LAS f32x4*)(Y + tt * 288 + 8 * grp + 4);
            const float vv = Y[tt * 288 + 256 + dvloc];
            float ks = (ka[0] * S[0] + ka[1] * S[1]) + (ka[2] * S[2] + ka[3] * S[3]) + (kb[0] * S[4] + kb[1] * S[5]) + (kb[2] * S[6] + kb[3] * S[7]);
            ks = row16_sum(ks);
            const float c = bt * (vv - eg * ks * kn) * kn;
            float op = 0.f;
#pragma unroll
            for (int i = 0; i < 4; ++i) { S[i] = eg * S[i] + ka[i] * c; op += qa[i] * S[i]; S[4 + i] = eg * S[4 + i] + kb[i] * c; op += qb[i] * S[4 + i]; }
            op = row16_sum(op);
            if (grp == 0) VB[(tokb + tt) * 1024 + h * 128 + dv] = f2bf(op * qn);
        }
        __syncthreads();
    }
}

__device__ __forceinline__ float row8_sum(float v) {
    v += __builtin_bit_cast(float, __builtin_amdgcn_update_dpp(0, __builtin_bit_cast(int, v), 0x141, 0xf, 0xf, false));
    v += __builtin_bit_cast(float, __builtin_amdgcn_update_dpp(0, __builtin_bit_cast(int, v), 0x1B, 0xf, 0xf, false));
    v += __builtin_bit_cast(float, __builtin_amdgcn_update_dpp(0, __builtin_bit_cast(int, v), 0xB1, 0xf, 0xf, false));
    return v;
}
constexpr int DN2_YB = 16 * 288 + 16 * 16 + 32 + 64;
__device__ __forceinline__ void dn_pc(LAS unsigned char* lds, unsigned char* ws, const float* convw  , int b, int h, int dvq, int tid) {
    const int lane = tid & 63, wid = tid >> 6;
    const bool producer = tid >= 256;
    const int pt = tid - 256;
    LAS float* L = (LAS float*)lds;
    bf16_t* VB = (bf16_t*)(ws + WS_VB);
    const float* GBp = (const float*)(ws + WS_GB);
    const int parr = pt < 128 ? 0 : 1, pd = pt & 127;
    const bf16_t* src = (const bf16_t*)(ws + (parr == 0 ? WS_QB : WS_KB)) + h * 128 + pd;
    const bf16_t* srcv = (const bf16_t*)(ws + WS_VB) + h * 128 + 32 * dvq + (pt & 31);
    float w0 = 0.f, w1 = 0.f, w2 = 0.f, w3 = 0.f, x1 = 0.f, x2 = 0.f, x3 = 0.f, u0 = 0.f, u1 = 0.f, u2 = 0.f, u3 = 0.f, z1 = 0.f, z2 = 0.f, z3 = 0.f;
    if (producer) { const int ch = parr * 1024 + h * 128 + pd; w0 = convw[ch]; w1 = convw[3072 + ch]; w2 = convw[2 * 3072 + ch]; w3 = convw[3 * 3072 + ch];
        if (pt < 32) { const int cv = 2048 + h * 128 + 32 * dvq + pt; u0 = convw[cv]; u1 = convw[3072 + cv]; u2 = convw[2 * 3072 + cv]; u3 = convw[3 * 3072 + cv]; } }
    const int col = tid >> 3, grp = tid & 7;
    float S[16];
#pragma unroll
    for (int i = 0; i < 16; ++i) S[i] = 0.f;
#define DN2_PRODUCE(BUF, T0) do { LAS float* Yp = L + (BUF) * DN2_YB; LAS float* NRp = Yp + 16 * 288; LAS float* GBsp = NRp + 256; const size_t tb_ = (size_t)b * SEQ + (T0); \
        bf16_t xr[16]; bf16_t vr[16]; \
        _Pragma("unroll") for (int tt = 0; tt < 16; ++tt) xr[tt] = src[(tb_ + tt) * 1024]; \
        if (pt < 32) { _Pragma("unroll") for (int tt = 0; tt < 16; ++tt) vr[tt] = srcv[(tb_ + tt) * 1024]; } \
        if (pt >= 224) { const int i_ = pt - 224, tt_ = i_ >> 1, wh_ = i_ & 1; GBsp[tt_ * 2 + wh_] = GBp[(tb_ + tt_) * 16 + wh_ * 8 + h]; } \
        _Pragma("unroll") for (int tt = 0; tt < 16; ++tt) { const float x0 = bf2f(xr[tt]); float y = w0 * x3 + w1 * x2 + w2 * x1 + w3 * x0; y = siluf_(y); x3 = x2; x2 = x1; x1 = x0; \
            Yp[tt * 288 + pt] = y; const float sq = row16_sum(y * y); if ((lane & 15) == 0) NRp[tt * 16 + (wid - 4) * 4 + (lane >> 4)] = sq; } \
        if (pt < 32) { _Pragma("unroll") for (int tt = 0; tt < 16; ++tt) { const float x0 = bf2f(vr[tt]); float y = u0 * z3 + u1 * z2 + u2 * z1 + u3 * x0; y = siluf_(y); z3 = z2; z2 = z1; z1 = x0; Yp[tt * 288 + 256 + pt] = y; } } \
    } while (0)
    if (producer) DN2_PRODUCE(0, 0);
    for (int n = 0; n < SEQ / 16; ++n) {
        const int buf = n & 1;
        LAS float* Y = L + buf * DN2_YB; LAS float* NR = Y + 16 * 288; LAS float* GBs = NR + 256; LAS float* SC = GBs + 32;
        __syncthreads();
        if (tid < 16) {
            const f32x4 a = *(const LAS f32x4*)(NR + tid * 16), b2 = *(const LAS f32x4*)(NR + tid * 16 + 4), c2 = *(const LAS f32x4*)(NR + tid * 16 + 8), d2 = *(const LAS f32x4*)(NR + tid * 16 + 12);
            const float sq_q = ((a[0] + a[1]) + (a[2] + a[3])) + ((b2[0] + b2[1]) + (b2[2] + b2[3])), sq_k = ((c2[0] + c2[1]) + (c2[2] + c2[3])) + ((d2[0] + d2[1]) + (d2[2] + d2[3]));
            *(LAS f32x4*)(SC + tid * 4) = (f32x4){rsqrtf(sq_q + EPS) * 0.08838834764831845f, rsqrtf(sq_k + EPS), __expf(GBs[tid * 2 + 1]), GBs[tid * 2]};
        }
        __syncthreads();
        if (producer) { if (n + 1 < SEQ / 16) DN2_PRODUCE(buf ^ 1, 16 * (n + 1)); }
        else {
            const size_t tokb = (size_t)b * SEQ + 16 * n;
#pragma unroll 2
            for (int tt = 0; tt < 16; ++tt) {
                const f32x4 sc = *(const LAS f32x4*)(SC + tt * 4);
                const float qn = sc[0], kn = sc[1], eg = sc[2], bt = sc[3];
                const LAS f32x4* kp = (const LAS f32x4*)(Y + tt * 288 + 128 + 16 * grp); const LAS f32x4* qp = (const LAS f32x4*)(Y + tt * 288 + 16 * grp);
                const f32x4 k0 = kp[0], k1 = kp[1], k2 = kp[2], k3 = kp[3], q0 = qp[0], q1 = qp[1], q2 = qp[2], q3 = qp[3];
                const float vv = Y[tt * 288 + 256 + col];
                float ks = ((k0[0] * S[0] + k0[1] * S[1]) + (k0[2] * S[2] + k0[3] * S[3])) + ((k1[0] * S[4] + k1[1] * S[5]) + (k1[2] * S[6] + k1[3] * S[7]))
                         + ((k2[0] * S[8] + k2[1] * S[9]) + (k2[2] * S[10] + k2[3] * S[11])) + ((k3[0] * S[12] + k3[1] * S[13]) + (k3[2] * S[14] + k3[3] * S[15]));
                ks = row8_sum(ks);
                const float c = bt * (vv - eg * ks * kn) * kn;
                float op0 = 0.f, op1 = 0.f;
#pragma unroll
                for (int i = 0; i < 4; ++i) { S[i] = eg * S[i] + k0[i] * c; op0 += q0[i] * S[i]; S[4 + i] = eg * S[4 + i] + k1[i] * c; op1 += q1[i] * S[4 + i];
                                              S[8 + i] = eg * S[8 + i] + k2[i] * c; op0 += q2[i] * S[8 + i]; S[12 + i] = eg * S[12 + i] + k3[i] * c; op1 += q3[i] * S[12 + i]; }
                const float op = row8_sum(op0 + op1);
                if (grp == 0) VB[(tokb + tt) * 1024 + h * 128 + 32 * dvq + col] = f2bf(op * qn);
            }
        }
    }
    __syncthreads();
#undef DN2_PRODUCE
}

#define GEMM_PHASE(EPI, Aptr, Bptr, Mv, Nv, Kv, Eobj, HM) do { int m_ = (Mv), n_ = (Nv), k_ = (Kv); asm volatile("" : "+s"(m_), "+s"(n_), "+s"(k_)); pg8::Gemm g_{(const pg8::bf16_t*)(Aptr), (const pg8::bf16_t*)(Bptr), m_, n_, k_, (HM)}; pg8::StaticOrder S_; S_.init(m_, n_, G, bid); \
        pg8::gemm_phase<EPI, pg8::StaticOrder, true, true>(lds, g_, S_, (Eobj)); } while (0)

__global__ void __launch_bounds__(NTHR, 2) fwd_mega(Params P) {
    extern __shared__ __attribute__((aligned(16))) unsigned char lds_raw[];
    LAS unsigned char* lds = (LAS unsigned char*)lds_raw;
    cg::grid_group grid = cg::this_grid();
    if (threadIdx.x == 0) {
        const unsigned xcc = (unsigned)__builtin_amdgcn_s_getreg((3 << 11) | 20) & 7u;
        const unsigned loc = __hip_atomic_fetch_add((unsigned*)(P.ws + WS_CTL) + xcc, 1u, __ATOMIC_RELAXED, __HIP_MEMORY_SCOPE_AGENT);
        *(LAS int*)(lds + LDS_VB) = (int)((loc & 31u) * 8u + xcc);
    }
    __syncthreads();
    int seg = 0; const int seg_lo = P.seg_lo, seg_hi = P.seg_hi;
#ifdef L2FLUSH
#define L2_FLUSH() do { const Params* PF = (const Params*)__builtin_amdgcn_kernarg_segment_ptr(); asm volatile("" : "+s"(PF)); int tf_ = threadIdx.x; asm volatile("" : "+v"(tf_)); \
        const u32x4* jp = (const u32x4*)(PF->in[I_P]) + (size_t)blockIdx.x * (L2FLUSH * 64) + tf_; unsigned acc_ = 0u; \
        for (int q_ = 0; q_ < L2FLUSH * 64 / 512; ++q_) { const u32x4 v_ = __builtin_nontemporal_load(jp + (size_t)q_ * 512); acc_ |= v_.x & v_.y & v_.z & v_.w; asm volatile("" ::: "memory"); } \
        if (acc_ == 0x12345678u) PF->out[0] = 0.f; } while (0)
#else
#define L2_FLUSH() do {} while (0)
#endif
#ifdef NOSEG
#define SYNCCOND true
#else
#define SYNCCOND (seg >= seg_lo && seg + 1 < seg_hi)
#endif
#define GRID_SYNC() do { if (SYNCCOND) { asm volatile("s_waitcnt vmcnt(0) lgkmcnt(0)" ::: "memory");   grid.sync(); L2_FLUSH(); \
        if (threadIdx.x < 64) { __builtin_amdgcn_fence(__ATOMIC_ACQUIRE, "agent"); asm volatile("s_waitcnt vmcnt(0)" ::: "memory"); } __syncthreads();     \
        } ++seg; } while (0)
#ifdef NOSEG
#define SEGCOND true
#else
#define SEGCOND (seg >= seg_lo && seg < seg_hi)
#endif
#define PH_BEGIN if (SEGCOND) { const Params* PQ = (const Params*)__builtin_amdgcn_kernarg_segment_ptr(); asm volatile("" : "+s"(PQ)); int tid = threadIdx.x; asm volatile("" : "+v"(tid)); \
    const int lane = tid & 63, wave = __builtin_amdgcn_readfirstlane(tid >> 6); int bid = __builtin_amdgcn_readfirstlane(*(LAS int*)(lds + LDS_VB)), G = gridDim.x; asm volatile("" : "+s"(bid), "+s"(G)); \
    const int xb_ = bid & 7, jb_ = bid >> 3, wj = jb_ * NW + wave;     \
    unsigned char* ws = PQ->ws; float* X = PQ->out; float* SS = (float*)(ws + WS_SS); bf16_t* XB = (bf16_t*)(ws + WS_XB); \
    float* ss_attn = (float*)(ws + WS_HALO); float* ss_ffn = ss_attn + (size_t)MTOK * 16; float* ss_ple = ss_ffn + (size_t)MTOK * 16; float* ss_next = ss_attn; \
    (void)lane; (void)xb_; (void)jb_; (void)wj; (void)X; (void)XB; (void)ss_attn; (void)ss_ffn; (void)ss_ple; (void)ss_next; (void)G;
#define PH_END }
#define U ((bf16_t*)(ws + WS_MIX))
#define ACT ((bf16_t*)(ws + WS_MIX + 176 * MiB))

    { const int layer = 0; PH_BEGIN
      if (bid == 0 && tid == 0) __hip_atomic_store((unsigned*)(ws + WS_CTL) + 16, 0u, __ATOMIC_RELAXED, __HIP_MEMORY_SCOPE_AGENT);
      const float* xin = PQ->in[I_X];
      for (int r = wj; r < SEQ; r += 256) {
          const int m = xb_ * SEQ + r;
          const f32x4* xr = (const f32x4*)(xin + (size_t)m * 1024) + lane;
          f32x4 v[4]; float s = 0.f;
#pragma unroll
          for (int jj = 0; jj < 4; ++jj) { v[jj] = xr[64 * jj]; s += (v[jj][0] * v[jj][0] + v[jj][1] * v[jj][1]) + (v[jj][2] * v[jj][2] + v[jj][3] * v[jj][3]); }
          s = wave_sum(s);
          if (lane < 16) ss_attn[(size_t)m * 16 + lane] = lane == 0 ? s : 0.f;
          f32x4* xo = (f32x4*)(X + (size_t)m * 1024) + lane;
          u32x2* bo = (u32x2*)(XB + (size_t)m * 1024) + lane;
#pragma unroll
          for (int jj = 0; jj < 4; ++jj) { xo[64 * jj] = v[jj]; u32x2 w; w.x = pk2(v[jj][0], v[jj][1]); w.y = pk2(v[jj][2], v[jj][3]); bo[64 * jj] = w; }
      }
    PH_END }

    for (int layer = 0; layer < NLAYER; ++layer) {
        asm volatile("" ::: "memory");
        const float lam_init = 0.8f - 0.6f * __expf(-0.3f * (float)layer);
        PH_BEGIN
        convert_weights(PQ, layer, lds, bid * NW + wave, G * NW, wave, lane);
        { const float* pl = PQ->in[I_P] + ((size_t)layer * MTOK + (size_t)xb_ * SEQ) * DPLE;
          bf16_t* pb = (bf16_t*)(ws + WS_PB) + (size_t)xb_ * SEQ * DPLE;
          for (int i = jb_ * NTHR + tid; i < SEQ * DPLE / 8; i += 32 * NTHR) {
              const f32x4 a = *(const f32x4*)(pl + (size_t)i * 8), b = *(const f32x4*)(pl + (size_t)i * 8 + 4);
              u32x4 w; w.x = pk2(a[0], a[1]); w.y = pk2(a[2], a[3]); w.z = pk2(b[0], b[1]); w.w = pk2(b[2], b[3]);
              *(u32x4*)(pb + (size_t)i * 8) = w;
          }
        }
        PH_END
        GRID_SYNC();
#ifdef DBLTEST
#ifdef DBL_SC
#define DBL_LD(p) ldc16(p)
#else
#define DBL_LD(p) (*(p))
#endif
        if (layer == 0) {
#ifdef DBL_OUTP
        PH_BEGIN
        { EpiResid E{X, XB, ss_ffn, nullptr, -1};
          GEMM_PHASE(EpiResid, ws + WS_VT, ws + W_OUT, MTOK, 1024, 1024, E, -1); }
        PH_END
        GRID_SYNC();
#endif
        for (int rep = 0; rep < 2; ++rep) {
        PH_BEGIN
#ifdef DBL_COPY
            { const u32x4* s4 = (const u32x4*)XB; u32x4* d4 = (u32x4*)(ws + WS_MIX + (size_t)rep * 176 * MiB);
              const size_t per = (size_t)DBL_M * DBL_N * 2 / 16 / 8;
              for (size_t i = (size_t)((jb_ + rep * 13) & 31) * NTHR + tid; i < per; i += (size_t)32 * NTHR) d4[(size_t)xb_ * per + i] = DBL_LD(s4 + (size_t)xb_ * per + i); }
#else
#ifndef DBL_W
#define DBL_W W_UP
#define DBL_ACT 0
#endif
            { EpiRowScale<DBL_ACT> E{(bf16_t*)(ws + WS_MIX + (size_t)rep * DBL_OFF * MiB), DBL_N, ss_attn, DBL_H};
              GEMM_PHASE(EpiRowScale<DBL_ACT>, XB, ws + DBL_W, DBL_M, DBL_N, 1024, E, DBL_H); }
#endif
        PH_END
        GRID_SYNC();
        }
        PH_BEGIN
        { const u32x4* a4 = (const u32x4*)(ws + WS_MIX); const u32x4* b4 = (const u32x4*)(ws + WS_MIX + (size_t)DBL_OFF * MiB); unsigned bad = 0u;
          const size_t per = (size_t)DBL_M * DBL_N * 2 / 16 / 8;
          for (size_t i0 = (size_t)((jb_ + 7) & 31) * NTHR + tid; i0 < per; i0 += (size_t)32 * NTHR) { const size_t i = (size_t)xb_ * per + i0; const u32x4 a = DBL_LD(a4 + i), b = DBL_LD(b4 + i); bad |= ((a.x ^ b.x) | (a.y ^ b.y) | (a.z ^ b.z) | (a.w ^ b.w)) ? 1u : 0u; }
          if (bad) __hip_atomic_fetch_or((unsigned*)(ws + WS_CTL) + 16, 1u, __ATOMIC_RELAXED, __HIP_MEMORY_SCOPE_AGENT); }
        PH_END
        GRID_SYNC();
        }
#endif
#if defined(DBLMIX) && !defined(DBLMIX_AT_GATES)
        for (int rep = 0; rep < 2; ++rep) {
#endif
#ifndef NO_INPROJ
        PH_BEGIN
        { EpiQK E{ws, ss_attn, PQ->in[I_QNORM] + layer * 64, PQ->in[I_KNORM] + layer * 64};
          GEMM_PHASE(EpiQK, XB, ws + W_IN, MTOK, 2048, 1024, E, -1); }
        PH_END
        PH_BEGIN
        { EpiSeg E{ws, ss_attn};
          GEMM_PHASE(EpiSeg, XB, ws + W_IN + (size_t)2048 * 2048, MTOK, 4096, 1024, E, -1); }
        PH_END
        PH_BEGIN
        { EpiGB E{ws, ss_attn, PQ->in[I_ALOG] + layer * 8, PQ->in[I_DTB] + layer * 8};
          GEMM_PHASE(EpiGB, XB, ws + W_IN + (size_t)6144 * 2048, MTOK, 256, 1024, E, -1); }
        PH_END
        PH_BEGIN
        { EpiVt E{(bf16_t*)(ws + WS_VT), ss_attn};
          GEMM_PHASE(EpiVt, ws + W_V, XB, 1024, MTOK, 1024, E, -1); }
        PH_END
#endif
        GRID_SYNC();
#ifndef NO_ATTN
        PH_BEGIN
        { const float* lq = PQ->in[I_LAM] + layer * 256;
          const float a1 = wave_sum(lq[lane] * lq[64 + lane]), a2 = wave_sum(lq[128 + lane] * lq[192 + lane]);
          const float lam = __expf(a1) - __expf(a2) + lam_init;
          for (int k = 0; k < 4; ++k) {
              const int pi = jb_ + 32 * k, hh = pi >> 4, s = pi & 15;
              attn_unit(lds, (const bf16_t*)(ws + WS_QA), (const bf16_t*)(ws + WS_KA), (const bf16_t*)(ws + WS_VT), (bf16_t*)(ws + WS_QA), xb_, hh, 31 - s, lam, 1.f - lam_init, PQ->in[I_SUBLN] + layer * 128, PQ->in[I_RELB], tid);
              attn_unit(lds, (const bf16_t*)(ws + WS_QA), (const bf16_t*)(ws + WS_KA), (const bf16_t*)(ws + WS_VT), (bf16_t*)(ws + WS_QA), xb_, hh, s, lam, 1.f - lam_init, PQ->in[I_SUBLN] + layer * 128, PQ->in[I_RELB], tid);
          }
        }
        PH_END
#endif
#ifndef NO_DN
        PH_BEGIN
#ifdef DN_NAIVE
        if (jb_ < 8) dn_naive(lds, ws, PQ->in[I_CONVB] + (size_t)layer * 4 * 3072, xb_, jb_, tid);
#else
#ifdef DN_FAST1
        dn_fast(lds, ws, PQ->in[I_CONVB] + (size_t)layer * 4 * 3072, xb_, jb_ >> 2, jb_ & 3, tid);
#else
        dn_pc(lds, ws, PQ->in[I_CONVB] + (size_t)layer * 4 * 3072, xb_, jb_ >> 2, jb_ & 3, tid);
#endif
#endif
        PH_END
#endif
        GRID_SYNC();
#if defined(DBLMIX) && defined(DBLMIX_AT_GATES)
        for (int rep = 0; rep < 2; ++rep) {
#endif
#ifndef NO_GATES
        PH_BEGIN
        { EpiRowScale<1> E{(bf16_t*)(ws + WS_G), 2048, ss_attn, -1};
          GEMM_PHASE(EpiRowScale<1>, XB, ws + W_GL, MTOK, 2048, 1024, E, -1); }
        PH_END
#endif
#ifndef NO_OBNORM
        PH_BEGIN
        { const float* on = PQ->in[I_ONORM] + layer * 128;
          const float g0 = on[2 * lane], g1 = on[2 * lane + 1];
          unsigned* OB = (unsigned*)(ws + WS_QB) + (size_t)xb_ * SEQ * 512; const unsigned* OI = (const unsigned*)(ws + WS_OSRC) + (size_t)xb_ * SEQ * 512; const unsigned* ZB = (const unsigned*)(ws + WS_ZB) + (size_t)xb_ * SEQ * 512;
          for (int r = wj; r < SEQ * NH; r += 256) {
              const unsigned ov = OI[(size_t)r * 64 + lane], zv = ZB[(size_t)r * 64 + lane];
              const float o0 = bflo(ov), o1 = bfhi(ov);
              const float sq = wave_sum(o0 * o0 + o1 * o1);
              const float rr = rsqrtf(sq * (1.f / 128.f) + EPS);
              OB[(size_t)r * 64 + lane] = pk2(o0 * rr * g0 * siluf_(bflo(zv)), o1 * rr * g1 * siluf_(bfhi(zv)));
          }
        }
        PH_END
#endif
        GRID_SYNC();
#ifndef NO_TMPA
        PH_BEGIN
        { EpiGateMul E{(bf16_t*)(ws + WS_TMPA), (const bf16_t*)(ws + WS_G), 2048, 0, nullptr};
          GEMM_PHASE(EpiGateMul, ws + WS_QA, ws + W_BRA, MTOK, 1024, 1024, E, -1); }
        PH_END
#endif
        GRID_SYNC();
#ifndef NO_MIXED
        PH_BEGIN
        { EpiGateMul E{(bf16_t*)(ws + WS_MIXED), (const bf16_t*)(ws + WS_G), 2048, 1024, (const bf16_t*)(ws + WS_TMPA)};
          GEMM_PHASE(EpiGateMul, ws + WS_QB, ws + W_BRB, MTOK, 1024, 1024, E, -1); }
        PH_END
#endif
        GRID_SYNC();
#ifdef DBLMIX
        PH_BEGIN
        { const u32x4* t4 = (const u32x4*)(ws + (size_t)DBL_TGT + (size_t)xb_ * ((size_t)DBL_TGT_BYTES / 8)); u32x4* s4 = (u32x4*)(ws + WS_PB + (size_t)xb_ * 2 * MiB); unsigned bad = 0u;
          for (size_t i = (size_t)((jb_ + 5 * rep) & 31) * NTHR + tid; i < (size_t)2 * MiB / 16; i += (size_t)32 * NTHR) {
              const u32x4 a = t4[i];
              if (rep == 0) s4[i] = a; else { const u32x4 b = s4[i]; bad |= ((a.x ^ b.x) | (a.y ^ b.y) | (a.z ^ b.z) | (a.w ^ b.w)) ? 1u : 0u; } }
          if (bad) __hip_atomic_fetch_or((unsigned*)(ws + WS_CTL) + 16, 1u, __ATOMIC_RELAXED, __HIP_MEMORY_SCOPE_AGENT); }
        PH_END
        GRID_SYNC();
        }
#endif
#ifndef NO_OUTP
        PH_BEGIN
        { EpiResid E{X, XB, ss_ffn, nullptr, -1};
          GEMM_PHASE(EpiResid, ws + WS_MIXED, ws + W_OUT, MTOK, 1024, 1024, E, -1); }
        PH_END
#endif
        GRID_SYNC();
        for (int half = 0; half < 2; ++half) {
#ifndef NO_UP
        PH_BEGIN
            { EpiRowScale<0> E{U, 5632, ss_ffn, half};
              GEMM_PHASE(EpiRowScale<0>, XB, ws + W_UP, 16384, 5632, 1024, E, half); }
        PH_END
#endif
            GRID_SYNC();
#ifndef NO_ACT
        PH_BEGIN
            { const float* cw = PQ->in[I_CONVFF] + (size_t)layer * 3 * 5632; const float* cb = PQ->in[I_CONVFFB] + (size_t)layer * 5632;
              bf16_t* UH = (bf16_t*)(ws + WS_UHALO) + (size_t)xb_ * 2 * 5632;
              for (int it = jb_ * NTHR + tid; it < 128 * 352; it += 32 * NTHR) {
                  const int cc = it % 352, rg = it / 352, c0 = cc * 8;
                  const int lrow0 = xb_ * 2048 + rg * 16;
                  float wg[3][8], wv[3][8], bg[8], bv[8];
#pragma unroll
                  for (int jj = 0; jj < 3; ++jj)
#pragma unroll
                      for (int e = 0; e < 8; ++e) { wg[jj][e] = cw[jj * 5632 + c0 + e]; wv[jj][e] = cw[jj * 5632 + 2816 + c0 + e]; }
#pragma unroll
                  for (int e = 0; e < 8; ++e) { bg[e] = cb[c0 + e]; bv[e] = cb[2816 + c0 + e]; }
                  float g2[8], g1[8], v2[8], v1[8];
#pragma unroll
                  for (int e = 0; e < 8; ++e) { g2[e] = 0.f; g1[e] = 0.f; v2[e] = 0.f; v1[e] = 0.f; }
                  if (rg > 0 || half == 1) {
                      const bf16_t* r2p = rg > 0 ? U + (size_t)(lrow0 - 2) * 5632 : UH;
                      const bf16_t* r1p = rg > 0 ? U + (size_t)(lrow0 - 1) * 5632 : UH + 5632;
                      const u32x4 a = *(const u32x4*)(r2p + c0), bq = *(const u32x4*)(r1p + c0);
                      const u32x4 c = *(const u32x4*)(r2p + 2816 + c0), d = *(const u32x4*)(r1p + 2816 + c0);
                      g2[0] = bflo(a.x); g2[1] = bfhi(a.x); g2[2] = bflo(a.y); g2[3] = bfhi(a.y); g2[4] = bflo(a.z); g2[5] = bfhi(a.z); g2[6] = bflo(a.w); g2[7] = bfhi(a.w);
                      g1[0] = bflo(bq.x); g1[1] = bfhi(bq.x); g1[2] = bflo(bq.y); g1[3] = bfhi(bq.y); g1[4] = bflo(bq.z); g1[5] = bfhi(bq.z); g1[6] = bflo(bq.w); g1[7] = bfhi(bq.w);
                      v2[0] = bflo(c.x); v2[1] = bfhi(c.x); v2[2] = bflo(c.y); v2[3] = bfhi(c.y); v2[4] = bflo(c.z); v2[5] = bfhi(c.z); v2[6] = bflo(c.w); v2[7] = bfhi(c.w);
                      v1[0] = bflo(d.x); v1[1] = bfhi(d.x); v1[2] = bflo(d.y); v1[3] = bfhi(d.y); v1[4] = bflo(d.z); v1[5] = bfhi(d.z); v1[6] = bflo(d.w); v1[7] = bfhi(d.w);
                  }
                  for (int rr = 0; rr < 16; ++rr) {
                      const size_t row = (size_t)lrow0 + rr;
                      const u32x4 a = *(const u32x4*)(U + row * 5632 + c0), c = *(const u32x4*)(U + row * 5632 + 2816 + c0);
                      if (half == 0 && rg == 127 && rr >= 14) { *(u32x4*)(UH + (size_t)(rr - 14) * 5632 + c0) = a; *(u32x4*)(UH + (size_t)(rr - 14) * 5632 + 2816 + c0) = c; }
                      float g0[8], v0[8], ov[8];
                      g0[0] = bflo(a.x); g0[1] = bfhi(a.x); g0[2] = bflo(a.y); g0[3] = bfhi(a.y); g0[4] = bflo(a.z); g0[5] = bfhi(a.z); g0[6] = bflo(a.w); g0[7] = bfhi(a.w);
                      v0[0] = bflo(c.x); v0[1] = bfhi(c.x); v0[2] = bflo(c.y); v0[3] = bfhi(c.y); v0[4] = bflo(c.z); v0[5] = bfhi(c.z); v0[6] = bflo(c.w); v0[7] = bfhi(c.w);
#pragma unroll
                      for (int e = 0; e < 8; ++e) {
                          const float ug = wg[0][e] * g2[e] + wg[1][e] * g1[e] + wg[2][e] * g0[e] + bg[e];
                          const float uv = wv[0][e] * v2[e] + wv[1][e] * v1[e] + wv[2][e] * v0[e] + bv[e];
                          ov[e] = siluf_(ug) * uv; g2[e] = g1[e]; g1[e] = g0[e]; v2[e] = v1[e]; v1[e] = v0[e];
                      }
                      u32x4 w; w.x = pk2(ov[0], ov[1]); w.y = pk2(ov[2], ov[3]); w.z = pk2(ov[4], ov[5]); w.w = pk2(ov[6], ov[7]);
                      *(u32x4*)(ACT + row * 2816 + c0) = w;
                  }
              }
            }
        PH_END
#endif
            GRID_SYNC();
#ifndef NO_DOWN
        PH_BEGIN
            { EpiResid E{X, XB, ss_ple, nullptr, half};
              GEMM_PHASE(EpiResid, ACT, ws + W_DOWN, 16384, 1024, 2816, E, -1); }
        PH_END
#endif
            GRID_SYNC();
        }
#ifndef NO_PLEG
        PH_BEGIN
        { EpiRowScale<1> E{(bf16_t*)(ws + WS_MIX), 1024, ss_ple, -1};
          GEMM_PHASE(EpiRowScale<1>, XB, ws + W_PG, MTOK, 1024, 1024, E, -1); }
        PH_END
#endif
        GRID_SYNC();
#ifndef NO_PLE
        PH_BEGIN
        { EpiResid E{X, XB, ss_next, (const bf16_t*)(ws + WS_MIX), -1};
          GEMM_PHASE(EpiResid, ws + WS_PB, ws + W_PP, MTOK, 1024, 256, E, -1); }
        PH_END
#endif
        GRID_SYNC();
    }
#ifdef NANCHK
    { const int layer = 0; PH_BEGIN
      unsigned bad = 0u;
      for (size_t i = (size_t)bid * NTHR + tid; i < (size_t)MTOK * 256; i += (size_t)G * NTHR) { const f32x4 v = *(const f32x4*)(X + i * 4);
          for (int e = 0; e < 4; ++e) bad |= ((__float_as_uint(v[e]) & 0x7f800000u) == 0x7f800000u) ? 1u : 0u; }
#ifdef NANCHK_BF_LO
      { const unsigned* bp = (const unsigned*)(ws + (size_t)NANCHK_BF_LO); const size_t nw = ((size_t)NANCHK_BF_HI - (size_t)NANCHK_BF_LO) / 4;
        for (size_t i = (size_t)bid * NTHR + tid; i < nw; i += (size_t)G * NTHR) { const unsigned w = bp[i]; bad |= (((w & 0x7f80u) == 0x7f80u) || ((w & 0x7f800000u) == 0x7f800000u)) ? 1u : 0u; } }
#endif
      if (bad) __hip_atomic_fetch_or((unsigned*)(ws + WS_CTL) + 16, 1u, __ATOMIC_RELAXED, __HIP_MEMORY_SCOPE_AGENT);
      PH_END }
    GRID_SYNC();
    { const int layer = 0; PH_BEGIN
      const unsigned fl = __hip_atomic_fetch_or((unsigned*)(ws + WS_CTL) + 16, 0u, __ATOMIC_RELAXED, __HIP_MEMORY_SCOPE_AGENT);
      if (fl) for (size_t i = (size_t)bid * NTHR + tid; i < (size_t)MTOK * 256; i += (size_t)G * NTHR) *(f32x4*)(X + i * 4) = (f32x4){0.f, 0.f, 0.f, 0.f};
      PH_END }
#endif
#undef U
#undef ACT
}

extern "C" void kernel_launch(void* const* d_in, const int* in_sizes, int n_in, void* d_out, int out_size, void* d_ws, size_t ws_size, hipStream_t stream) {
    static int grid = 0;
    if (grid == 0) {
        if (n_in != 24 || out_size != MTOK * DM || ws_size < WS_TOTAL) { fprintf(stderr, "kernel_launch: unexpected shapes / workspace (n_in %d out %d ws %zu need %zu)\n", n_in, out_size, ws_size, (size_t)WS_TOTAL); grid = -1; return; }
        int dev = 0, cus = 0, per_cu = 0;
        hipGetDevice(&dev);
        hipDeviceGetAttribute(&cus, hipDeviceAttributeMultiprocessorCount, dev);
        hipFuncSetAttribute((const void*)fwd_mega, hipFuncAttributeMaxDynamicSharedMemorySize, LDS_BYTES);
        hipOccupancyMaxActiveBlocksPerMultiprocessor(&per_cu, (const void*)fwd_mega, NTHR, LDS_BYTES);
        if (per_cu < 1) { fprintf(stderr, "kernel_launch: occupancy query says %d blocks per CU\n", per_cu); per_cu = 1; }
        (void)hipGetLastError();
        grid = cus;
    }
    if (grid < 0) return;
    Params p{};
    for (int i = 0; i < 24; ++i) p.in[i] = (const float*)d_in[i];
    p.out = (float*)d_out; p.ws = (unsigned char*)d_ws;
    hipError_t e = hipSuccess;
#ifdef N_SEG_LAUNCH
    for (int sgi = 0; sgi < 60 && e == hipSuccess; sgi += N_SEG_LAUNCH) {
        p.seg_lo = sgi; p.seg_hi = sgi + N_SEG_LAUNCH;
        void* args[] = {&p};
        e = hipLaunchCooperativeKernel((const void*)fwd_mega, dim3(grid), dim3(NTHR), args, LDS_BYTES, stream);
    }
#else
    p.seg_lo = 0; p.seg_hi = 1000;
    void* args[] = {&p};
    e = hipLaunchCooperativeKernel((const void*)fwd_mega, dim3(grid), dim3(NTHR), args, LDS_BYTES, stream);
#endif
    if (e != hipSuccess) fprintf(stderr, "cooperative launch failed: %s (grid %d)\n", hipGetErrorString(e), grid);
}
```

```cpp
#include <hip/hip_runtime.h>
#include <hip/hip_cooperative_groups.h>
#include <cstdio>
#include <cstdint>
namespace cg = cooperative_groups;
namespace pg8 {
#define PG8_LAS __attribute__((address_space(3)))
typedef unsigned short bf16_t;
typedef short bf16x8 __attribute__((ext_vector_type(8)));
typedef float f32x4 __attribute__((ext_vector_type(4)));
typedef unsigned u32x4 __attribute__((ext_vector_type(4)));
constexpr int BM = 256, BK = 64, HALF = 128, HTB = HALF * BK * 2  , STAGE_BYTES = 8 * HTB, NXCD = 8, WGM = 8;

__host__ __device__ __forceinline__ int lds_byte(int r, int c) { const int st = (r >> 4) * 2 + (c >> 5), rr = r & 15, cc = c & 31, ob = rr * 64 + cc * 2; return st * 1024 + (ob ^ (((ob >> 9) & 1) << 5)); }
__host__ __device__ __forceinline__ void stage_rc(int b, int& R, int& C) { const int st = b / 1024, sb = b % 1024, swz = sb ^ (((sb >> 9) & 1) << 5); R = (st >> 1) * 16 + swz / 64; C = (st & 1) * 32 + (swz % 64) / 2; }
__host__ __device__ __forceinline__ int perm32(int rho) { const int n = rho >> 4, i = rho & 15; return 8 * (i >> 2) + 4 * n + (i & 3); }

struct Unit { int pm, pn; };
struct Gemm { const bf16_t* A; const bf16_t* Bt; int M, N, K; int hmap; };
__device__ __forceinline__ int amap(int pm, int hmap) { return hmap < 0 ? pm : ((pm >> 3) * 16 + 8 * hmap + (pm & 7)); }

struct StaticOrder {
    int nM, nN, nwg, G, c;
    __host__ __device__ void init(int M, int N, int G_, int c_) { nM = M / BM; nN = N / BM; nwg = nM * nN; G = G_; c = c_; }
    __host__ __device__ bool next(int i, Unit& u) const {
        const long L = (long)i * G + c; if (L >= nwg) return false;
        int wgid = (int)L; { const int q = nwg / NXCD, r = nwg % NXCD, xcd = wgid % NXCD, off = wgid / NXCD; wgid = (xcd < r ? xcd * (q + 1) : r * (q + 1) + (xcd - r) * q) + off; }
        const int nig = WGM * nN, gid = wgid / nig, fm = gid * WGM, gsz = (nM - fm) < WGM ? (nM - fm) : WGM;
        u.pm = fm + ((wgid % nig) % gsz); u.pn = (wgid % nig) / gsz; return true;
    }
    __device__ __forceinline__ void a_ready(const Unit&) const {}
    __device__ __forceinline__ void done(const Unit&) const {}
};
__device__ __forceinline__ unsigned cvt_pk_bf16(float lo, float hi) { unsigned r; asm volatile("v_cvt_pk_bf16_f32 %0, %1, %2" : "=v"(r) : "v"(lo), "v"(hi)); return r; }
#ifdef NO_UNI
__device__ __forceinline__ const char* uni(const char* p) { return p; }
#else
__device__ __forceinline__ const char* uni(const char* p) { const unsigned long long v = (unsigned long long)p; const unsigned lo = __builtin_amdgcn_readfirstlane((unsigned)v), hi = __builtin_amdgcn_readfirstlane((unsigned)(v >> 32)); return (const char*)(((unsigned long long)hi << 32) | lo); }
#endif
template <class Epi, class Sched, bool ALIGN_EPI = false, bool SP2 = false>
__device__ __forceinline__ void gemm_phase(PG8_LAS unsigned char* lds, const Gemm g, const Sched& S, const Epi& E) {
    int tid = threadIdx.x;
#ifndef NO_LAUNDER
    asm volatile("" : "+v"(tid));
#endif

    const int wid = __builtin_amdgcn_readfirstlane(tid >> 6), lane = tid & 63, wr = wid >> 2, wc = wid & 3, fr = lane & 15, fq = lane >> 4;
    const int K = g.K, nt = K / BK;
    unsigned voffA[2], voffB[2];
#pragma unroll
    for (int i = 0; i < 2; ++i) { int R, C; stage_rc(tid * 16 + i * 8192, R, C); const int Rb = Epi::PERM ? ((R & ~31) + perm32(R & 31)) : R;
        voffA[i] = (unsigned)(R * K + C) * 2u; voffB[i] = (unsigned)(Rb * K + C) * 2u; }
    const size_t kstep = (size_t)(BK * 2);
    const size_t hstep = (size_t)HALF * K * 2;
    const size_t tstep = 2 * hstep;
    const unsigned ldsw = (unsigned)wid * 1024u;
    const int aoff = lds_byte(wr * 64 + fr, fq * 8), boff = lds_byte(wc * 32 + fr, fq * 8);
#define PG8_SA(b, h) (((b) * 2 + (h)) * HTB)
#define PG8_SB(b, h) ((4 + (b) * 2 + (h)) * HTB)
#define PG8_STAGE(bufoff, gbase, voff) do { _Pragma("unroll") for (int _i = 0; _i < 2; ++_i) \
        __builtin_amdgcn_global_load_lds((const unsigned*)((const char*)(gbase) + (voff)[_i]), (PG8_LAS unsigned*)(lds + (bufoff) + ldsw + _i * 8192), 16, 0, 0); } while (0)
#define PG8_LDA(dst, b, h) do { _Pragma("unroll") for (int m = 0; m < 4; ++m) _Pragma("unroll") for (int k = 0; k < 2; ++k) dst[m][k] = *(const PG8_LAS bf16x8*)(lds + PG8_SA(b, h) + aoff + m * 2048 + k * 1024); } while (0)
#define PG8_LDB(dst, b, h) do { _Pragma("unroll") for (int n = 0; n < 2; ++n) _Pragma("unroll") for (int k = 0; k < 2; ++k) dst[n][k] = *(const PG8_LAS bf16x8*)(lds + PG8_SB(b, h) + boff + n * 2048 + k * 1024); } while (0)
#define PG8_MMA(ai, bj, At, Bt) do { __builtin_amdgcn_s_setprio(1); _Pragma("unroll") for (int m = 0; m < 4; ++m) _Pragma("unroll") for (int n = 0; n < 2; ++n) _Pragma("unroll") for (int k = 0; k < 2; ++k) \
        acc[ai][bj][m][n] = __builtin_amdgcn_mfma_f32_16x16x32_bf16(Bt[n][k], At[m][k], acc[ai][bj][m][n], 0, 0, 0); __builtin_amdgcn_s_setprio(0); } while (0)
#define PG8_WAIT_V(n) asm volatile("s_waitcnt vmcnt(" #n ")" ::: "memory")
#define PG8_WAIT_L(n) asm volatile("s_waitcnt lgkmcnt(" #n ")" ::: "memory")
#define PG8_BAR __builtin_amdgcn_s_barrier()
#define PG8_SCHED __builtin_amdgcn_sched_barrier(0)
    Unit cur, nxt; int ui = 0;
    if (!S.next(0, cur)) return;
    f32x4 acc[2][2][4][2];
#pragma unroll
    for (int a = 0; a < 2; ++a)
#pragma unroll
        for (int b = 0; b < 2; ++b)
#pragma unroll
            for (int m = 0; m < 4; ++m)
#pragma unroll
                for (int n = 0; n < 2; ++n) acc[a][b][m][n] = (f32x4){0.f, 0.f, 0.f, 0.f};
    bf16x8 At[4][2], B0[2][2], B1[2][2];
    const char* cA = uni((const char*)g.A + (size_t)amap(cur.pm, g.hmap) * tstep); const char* cB = uni((const char*)g.Bt + (size_t)cur.pn * tstep);
    S.a_ready(cur);
    if constexpr (SP2) {
        PG8_STAGE(PG8_SB(0, 0), cB, voffB); PG8_STAGE(PG8_SB(0, 1), cB + hstep, voffB); PG8_STAGE(PG8_SA(0, 0), cA, voffA); PG8_STAGE(PG8_SA(0, 1), cA + hstep, voffA);
        if (wr == 1) PG8_BAR;
        PG8_WAIT_V(2); PG8_BAR;
        PG8_STAGE(PG8_SB(1, 0), cB + kstep, voffB); PG8_STAGE(PG8_SA(1, 0), cA + kstep, voffA); PG8_STAGE(PG8_SB(1, 1), cB + hstep + kstep, voffB);
        PG8_WAIT_V(6); PG8_BAR;
    } else {
        PG8_STAGE(PG8_SB(0, 0), cB, voffB); PG8_STAGE(PG8_SA(0, 0), cA, voffA); PG8_STAGE(PG8_SB(0, 1), cB + hstep, voffB); PG8_STAGE(PG8_SA(0, 1), cA + hstep, voffA);
        if (wr == 1) PG8_BAR;
        PG8_WAIT_V(4); PG8_BAR;
        PG8_STAGE(PG8_SB(1, 0), cB + kstep, voffB); PG8_STAGE(PG8_SA(1, 0), cA + kstep, voffA); PG8_STAGE(PG8_SB(1, 1), cB + hstep + kstep, voffB);
        PG8_WAIT_V(6); PG8_BAR;
    }
    for (;;) {
        const bool has_next = S.next(ui + 1, nxt);
        const char* nA = uni(has_next ? (const char*)g.A + (size_t)amap(nxt.pm, g.hmap) * tstep : cA); const char* nB = uni(has_next ? (const char*)g.Bt + (size_t)nxt.pn * tstep : cB);
        for (int t = 0; t < nt; t += 2) {
            const bool last = (t == nt - 2);
            const char* a1 = cA + (size_t)(t + 1) * kstep;
            const char* a2 = last ? nA : cA + (size_t)(t + 2) * kstep; const char* b2 = last ? nB : cB + (size_t)(t + 2) * kstep;
            const char* a3 = a2 + kstep; const char* b3 = b2 + kstep;
            if (last && has_next) S.a_ready(nxt);
            if constexpr (SP2) {
            PG8_LDB(B0, 0, 0); PG8_LDB(B1, 0, 1); PG8_SCHED; PG8_LDA(At, 0, 0); PG8_STAGE(PG8_SA(1, 1), a1 + hstep, voffA);
            PG8_WAIT_V(8); PG8_WAIT_L(0); PG8_BAR; PG8_MMA(0, 0, At, B0); PG8_MMA(0, 1, At, B1); PG8_BAR; PG8_SCHED;
            PG8_LDA(At, 0, 1); PG8_STAGE(PG8_SB(0, 0), b2, voffB); PG8_STAGE(PG8_SB(0, 1), b2 + hstep, voffB); PG8_STAGE(PG8_SA(0, 0), a2, voffA);
            PG8_WAIT_V(8); PG8_WAIT_L(0); PG8_BAR; PG8_MMA(1, 0, At, B0); PG8_MMA(1, 1, At, B1); PG8_BAR; PG8_SCHED;
            PG8_LDB(B0, 1, 0); PG8_LDB(B1, 1, 1); PG8_SCHED; PG8_LDA(At, 1, 0); PG8_STAGE(PG8_SA(0, 1), a2 + hstep, voffA);
            PG8_WAIT_V(8); PG8_WAIT_L(0); PG8_BAR; PG8_MMA(0, 0, At, B0); PG8_MMA(0, 1, At, B1); PG8_BAR; PG8_SCHED;
            PG8_LDA(At, 1, 1); PG8_STAGE(PG8_SB(1, 0), b3, voffB); PG8_STAGE(PG8_SB(1, 1), b3 + hstep, voffB); PG8_STAGE(PG8_SA(1, 0), a3, voffA);
            PG8_WAIT_V(8); PG8_WAIT_L(0); PG8_BAR; PG8_MMA(1, 0, At, B0); PG8_MMA(1, 1, At, B1); PG8_BAR; PG8_SCHED;
            } else {
            PG8_LDB(B0, 0, 0); PG8_SCHED; PG8_LDA(At, 0, 0); PG8_STAGE(PG8_SA(1, 1), a1 + hstep, voffA);
            PG8_WAIT_L(8); PG8_BAR; PG8_WAIT_L(0); PG8_MMA(0, 0, At, B0); PG8_BAR; PG8_SCHED;
            PG8_LDB(B1, 0, 1); PG8_STAGE(PG8_SB(0, 0), b2, voffB);
            PG8_BAR; PG8_WAIT_L(0); PG8_MMA(0, 1, At, B1); PG8_BAR;
            PG8_LDA(At, 0, 1); PG8_STAGE(PG8_SA(0, 0), a2, voffA);
            PG8_BAR; PG8_WAIT_L(0); PG8_MMA(1, 0, At, B0); PG8_BAR; PG8_SCHED;
            PG8_STAGE(PG8_SB(0, 1), b2 + hstep, voffB);
            PG8_WAIT_V(6); PG8_BAR; PG8_MMA(1, 1, At, B1); PG8_BAR;
            PG8_LDB(B0, 1, 0); PG8_SCHED; PG8_LDA(At, 1, 0); PG8_STAGE(PG8_SA(0, 1), a2 + hstep, voffA);
            PG8_WAIT_L(8); PG8_BAR; PG8_WAIT_L(0); PG8_MMA(0, 0, At, B0); PG8_BAR; PG8_SCHED;
            PG8_LDB(B1, 1, 1); PG8_STAGE(PG8_SB(1, 0), b3, voffB);
            PG8_BAR; PG8_WAIT_L(0); PG8_MMA(0, 1, At, B1); PG8_BAR;
            PG8_LDA(At, 1, 1); PG8_STAGE(PG8_SA(1, 0), a3, voffA);
            PG8_BAR; PG8_WAIT_L(0); PG8_MMA(1, 0, At, B0); PG8_BAR; PG8_SCHED;
            PG8_STAGE(PG8_SB(1, 1), b3 + hstep, voffB);
            PG8_WAIT_V(6); PG8_BAR; PG8_MMA(1, 1, At, B1); PG8_BAR;
            }
        }
        if constexpr (ALIGN_EPI) { if (wr == 0) PG8_BAR; }
        if constexpr (!Epi::AFTER_DRAIN) { E(acc, cur, wr, wc, fr, fq); S.done(cur); }
        if (!has_next) break;
#pragma unroll
        for (int a = 0; a < 2; ++a)
#pragma unroll
            for (int b = 0; b < 2; ++b)
#pragma unroll
                for (int m = 0; m < 4; ++m)
#pragma unroll
                    for (int n = 0; n < 2; ++n) acc[a][b][m][n] = (f32x4){0.f, 0.f, 0.f, 0.f};
        cur = nxt; cA = nA; cB = nB; ++ui;
        if constexpr (ALIGN_EPI) { if (wr == 1) PG8_BAR; }
    }
    PG8_WAIT_V(0);
    if constexpr (!ALIGN_EPI) { if (wr == 0) PG8_BAR; }
    PG8_BAR;
    if constexpr (Epi::AFTER_DRAIN) { E.fused(acc, cur, wr, wc, fr, fq, lds, wid, lane); S.done(cur); }
#undef PG8_SA
#undef PG8_SB
#undef PG8_STAGE
#undef PG8_LDA
#undef PG8_LDB
#undef PG8_MMA
#undef PG8_WAIT_V
#undef PG8_WAIT_L
#undef PG8_BAR
#undef PG8_SCHED
}
}

#define GAS __attribute__((address_space(1)))
#define LAS __attribute__((address_space(3)))
typedef unsigned short bf16_t;
typedef float f32x4 __attribute__((ext_vector_type(4)));
typedef float f32x16 __attribute__((ext_vector_type(16)));
typedef short bf16x8 __attribute__((ext_vector_type(8)));
typedef unsigned u32x4 __attribute__((ext_vector_type(4)));
typedef unsigned u32x2 __attribute__((ext_vector_type(2)));

#ifndef NLAYER_V
#define NLAYER_V 4
#endif
constexpr int NW = 8, NTHR = 512;
constexpr int MTOK = 32768, DM = 1024, SEQ = 4096, NB = 8, NLAYER = NLAYER_V, NH = 8;
constexpr int DIN = 9232, DFF = 2816, DPLE = 256;
constexpr float EPS = 1e-6f;
constexpr float LOG2E = 1.4426950408889634f;
constexpr size_t MiB = 1u << 20;
constexpr size_t WS_SS = 0;
constexpr size_t WS_CTL = 1792 * 1024;
constexpr size_t WS_UHALO = 1856 * 1024;
constexpr size_t WS_GB = 2 * MiB;
constexpr size_t WS_HALO = 4 * MiB;
constexpr size_t WS_PB = 14 * MiB;
constexpr size_t WS_W = 30 * MiB;
constexpr size_t W_IN = WS_W, W_V = W_IN + (size_t)6400 * 1024 * 2, W_GL = W_V + 2 * MiB, W_BRA = W_GL + 4 * MiB, W_BRB = W_BRA + 2 * MiB,
                 W_OUT = W_BRB + 2 * MiB, W_UP = W_OUT + 2 * MiB, W_DOWN = W_UP + 11 * MiB, W_PG = W_DOWN + (size_t)1024 * 2816 * 2, W_PP = W_PG + 2 * MiB, W_END = W_PP + (size_t)1024 * 256 * 2;
static_assert(W_END <= 74 * MiB, "weights region");
constexpr size_t WS_XB = 74 * MiB;
constexpr size_t WS_MIX = 138 * MiB;
constexpr size_t S64 = 64 * MiB;
constexpr size_t WS_QA = WS_MIX, WS_KA = WS_MIX + S64, WS_VT = WS_MIX + 2 * S64, WS_QB = WS_MIX + 3 * S64, WS_KB = WS_MIX + 4 * S64, WS_VB = WS_MIX + 5 * S64, WS_ZB = WS_MIX + 6 * S64;
constexpr size_t WS_TOTAL = WS_MIX + 7 * S64;
#ifdef DN_NAIVE
constexpr size_t WS_G = WS_KB, WS_TMPA = WS_KA, WS_MIXED = WS_VT, WS_OSRC = WS_QB;
#else
constexpr size_t WS_G = WS_KA, WS_TMPA = WS_KB, WS_MIXED = WS_VB, WS_OSRC = WS_VB;
#endif
constexpr int LDS_BYTES = 147456, LDS_VB = 140032;

__device__ __forceinline__ float bflo(unsigned w) { return __uint_as_float(w << 16); }
__device__ __forceinline__ float bfhi(unsigned w) { return __uint_as_float(w & 0xffff0000u); }
__device__ __forceinline__ float bf2f(bf16_t v) { return __uint_as_float((unsigned)v << 16); }
typedef float f32x2_t __attribute__((ext_vector_type(2))); typedef __bf16 bf16x2_t __attribute__((ext_vector_type(2)));
__device__ __forceinline__ unsigned pk2(float lo, float hi) { const f32x2_t v = {lo, hi}; const bf16x2_t b = __builtin_convertvector(v, bf16x2_t); return __builtin_bit_cast(unsigned, b); }
__device__ __forceinline__ bf16_t f2bf(float f) { return (bf16_t)(pk2(f, 0.f) & 0xffffu); }
__device__ __forceinline__ float sigmoidf_(float x) { x = fminf(fmaxf(x, -60.f), 60.f); return __builtin_amdgcn_rcpf(1.f + __expf(-x)); }
__device__ __forceinline__ float siluf_(float x) { return x * sigmoidf_(x); }
__device__ __forceinline__ float wave_sum(float v) {
#pragma unroll
    for (int o = 1; o < 64; o <<= 1) v += __shfl_xor(v, o);
    return v;
}
__device__ __forceinline__ float ss_load(const float* p) { const f32x4 a = *(const f32x4*)p, b = *(const f32x4*)(p + 4), c = *(const f32x4*)(p + 8), d = *(const f32x4*)(p + 12);
    float s = (((a[0] + a[1]) + (a[2] + a[3])) + ((b[0] + b[1]) + (b[2] + b[3]))) + (((c[0] + c[1]) + (c[2] + c[3])) + ((d[0] + d[1]) + (d[2] + d[3])));
    asm volatile("" : "+v"(s) :: "memory");
    return s; }
__device__ __forceinline__ u32x4 ldc16(const void* p) { u32x4 v; asm volatile("global_load_dwordx4 %0, %1, off sc0 sc1\n\ts_waitcnt vmcnt(0)" : "=v"(v) : "v"(p) : "memory"); return v; }
__device__ __forceinline__ int crow(int r, int hi) { return (r & 3) + 8 * (r >> 2) + 4 * hi; }

__device__ __forceinline__ int gmap(int row, int h) { return h < 0 ? row : ((row >> 11) * 4096 + 2048 * h + (row & 2047)); }

using pg8::Unit;
typedef f32x4 AccT[2][2][4][2];

template <int ACT> struct EpiRowScale {
    static constexpr bool PERM = true, AFTER_DRAIN = false;
    bf16_t* O; int ldc; const float* ss; int hmap;
    __device__ __forceinline__ void operator()(const AccT& acc, const Unit& u, int wr, int wc, int fr, int fq) const {
        const int row0 = u.pm * 256 + wr * 64 + fr, col0 = u.pn * 256 + wc * 32 + 8 * fq;
#pragma unroll
        for (int ai = 0; ai < 2; ++ai)
#pragma unroll
            for (int m = 0; m < 4; ++m) {
                const int row = row0 + ai * 128 + m * 16;
#ifdef RS_CONST
                const float rs = 1000.f;
#else
                const float rs = rsqrtf(ss_load(ss + (size_t)gmap(row, hmap) * 16) * (1.f / 1024.f) + EPS);
#endif
                bf16_t* rowp = O + (size_t)row * ldc + col0;
#pragma unroll
                for (int bj = 0; bj < 2; ++bj) {
                    f32x4 v0 = acc[ai][bj][m][0] * rs, v1 = acc[ai][bj][m][1] * rs;
                    if (ACT == 1) {
#pragma unroll
                        for (int e = 0; e < 4; ++e) { v0[e] = sigmoidf_(v0[e]); v1[e] = sigmoidf_(v1[e]); }
                    }
                    u32x4 w; w.x = pk2(v0[0], v0[1]); w.y = pk2(v0[2], v0[3]); w.z = pk2(v1[0], v1[1]); w.w = pk2(v1[2], v1[3]);
                    *(u32x4*)(rowp + bj * 128) = w;
                    asm volatile("" ::: "memory");
                }
            }
    }
};

struct EpiVt {
    static constexpr bool PERM = true, AFTER_DRAIN = false;
    bf16_t* O; const float* ss;
    __device__ __forceinline__ void operator()(const AccT& acc, const Unit& u, int wr, int wc, int fr, int fq) const {
        const int row0 = u.pm * 256 + wr * 64 + fr, col0 = u.pn * 256 + wc * 32 + 8 * fq;
        float rs[2][8];
#pragma unroll
        for (int bj = 0; bj < 2; ++bj)
#pragma unroll
            for (int e = 0; e < 8; ++e) rs[bj][e] = rsqrtf(ss_load(ss + (size_t)(col0 + bj * 128 + e) * 16) * (1.f / 1024.f) + EPS);
#pragma unroll
        for (int ai = 0; ai < 2; ++ai)
#pragma unroll
            for (int m = 0; m < 4; ++m) {
                const int row = row0 + ai * 128 + m * 16;
                bf16_t* rowp = O + (size_t)row * MTOK + col0;
#pragma unroll
                for (int bj = 0; bj < 2; ++bj) {
                    const f32x4 v0 = acc[ai][bj][m][0], v1 = acc[ai][bj][m][1];
                    u32x4 w; w.x = pk2(v0[0] * rs[bj][0], v0[1] * rs[bj][1]); w.y = pk2(v0[2] * rs[bj][2], v0[3] * rs[bj][3]);
                    w.z = pk2(v1[0] * rs[bj][4], v1[1] * rs[bj][5]); w.w = pk2(v1[2] * rs[bj][6], v1[3] * rs[bj][7]);
                    *(u32x4*)(rowp + bj * 128) = w;
                }
                asm volatile("" ::: "memory");
            }
    }
};

struct EpiGateMul {
    static constexpr bool PERM = true, AFTER_DRAIN = false;
    bf16_t* O; const bf16_t* G; int ldg, goff; const bf16_t* Add;
    __device__ __forceinline__ void operator()(const AccT& acc, const Unit& u, int wr, int wc, int fr, int fq) const {
        const int row0 = u.pm * 256 + wr * 64 + fr, col0 = u.pn * 256 + wc * 32 + 8 * fq;
#pragma unroll
        for (int ai = 0; ai < 2; ++ai)
#pragma unroll
            for (int m = 0; m < 4; ++m) {
                const int row = row0 + ai * 128 + m * 16;
#pragma unroll
                for (int bj = 0; bj < 2; ++bj) {
                    const int c = col0 + bj * 128;
                    const u32x4 g = *(const u32x4*)(G + (size_t)row * ldg + goff + c);
                    u32x4 a = (u32x4){0u, 0u, 0u, 0u};
                    if (Add) a = *(const u32x4*)(Add + (size_t)row * 1024 + c);
                    const f32x4 v0 = acc[ai][bj][m][0], v1 = acc[ai][bj][m][1];
                    u32x4 w;
                    w.x = pk2(bflo(a.x) + bflo(g.x) * v0[0], bfhi(a.x) + bfhi(g.x) * v0[1]);
                    w.y = pk2(bflo(a.y) + bflo(g.y) * v0[2], bfhi(a.y) + bfhi(g.y) * v0[3]);
                    w.z = pk2(bflo(a.z) + bflo(g.z) * v1[0], bfhi(a.z) + bfhi(g.z) * v1[1]);
                    w.w = pk2(bflo(a.w) + bflo(g.w) * v1[2], bfhi(a.w) + bfhi(g.w) * v1[3]);
                    *(u32x4*)(O + (size_t)row * 1024 + c) = w;
                }
                asm volatile("" ::: "memory");
            }
    }
};

struct EpiResid {
    static constexpr bool PERM = true, AFTER_DRAIN = false;
    float* X; bf16_t* XB; float* ssn; const bf16_t* Mul; int hmap;
    __device__ __forceinline__ void operator()(const AccT& acc, const Unit& u, int wr, int wc, int fr, int fq) const {
        const int row0 = u.pm * 256 + wr * 64 + fr, col0 = u.pn * 256 + wc * 32 + 8 * fq;
#pragma unroll
        for (int ai = 0; ai < 2; ++ai)
#pragma unroll
            for (int m = 0; m < 4; ++m) {
                const int row = gmap(row0 + ai * 128 + m * 16, hmap);
                const size_t off0 = (size_t)row * 1024 + col0;
                f32x4 xa = *(const f32x4*)(X + off0), xb2 = *(const f32x4*)(X + off0 + 4), xc = *(const f32x4*)(X + off0 + 128), xd = *(const f32x4*)(X + off0 + 132);
                f32x4 va = acc[ai][0][m][0], vb2 = acc[ai][0][m][1], vc = acc[ai][1][m][0], vd = acc[ai][1][m][1];
                if (Mul) {
                    const u32x4 g0 = *(const u32x4*)(Mul + off0), g1 = *(const u32x4*)(Mul + off0 + 128);
                    va[0] *= bflo(g0.x); va[1] *= bfhi(g0.x); va[2] *= bflo(g0.y); va[3] *= bfhi(g0.y); vb2[0] *= bflo(g0.z); vb2[1] *= bfhi(g0.z); vb2[2] *= bflo(g0.w); vb2[3] *= bfhi(g0.w);
                    vc[0] *= bflo(g1.x); vc[1] *= bfhi(g1.x); vc[2] *= bflo(g1.y); vc[3] *= bfhi(g1.y); vd[0] *= bflo(g1.z); vd[1] *= bfhi(g1.z); vd[2] *= bflo(g1.w); vd[3] *= bfhi(g1.w);
                }
                xa += va; xb2 += vb2; xc += vc; xd += vd;
                *(f32x4*)(X + off0) = xa; *(f32x4*)(X + off0 + 4) = xb2; *(f32x4*)(X + off0 + 128) = xc; *(f32x4*)(X + off0 + 132) = xd;
                u32x4 w0; w0.x = pk2(xa[0], xa[1]); w0.y = pk2(xa[2], xa[3]); w0.z = pk2(xb2[0], xb2[1]); w0.w = pk2(xb2[2], xb2[3]);
                u32x4 w1; w1.x = pk2(xc[0], xc[1]); w1.y = pk2(xc[2], xc[3]); w1.z = pk2(xd[0], xd[1]); w1.w = pk2(xd[2], xd[3]);
                *(u32x4*)(XB + off0) = w0; *(u32x4*)(XB + off0 + 128) = w1;
                float sq = ((xa[0] * xa[0] + xa[1] * xa[1]) + (xa[2] * xa[2] + xa[3] * xa[3])) + ((xb2[0] * xb2[0] + xb2[1] * xb2[1]) + (xb2[2] * xb2[2] + xb2[3] * xb2[3]))
                         + ((xc[0] * xc[0] + xc[1] * xc[1]) + (xc[2] * xc[2] + xc[3] * xc[3])) + ((xd[0] * xd[0] + xd[1] * xd[1]) + (xd[2] * xd[2] + xd[3] * xd[3]));
                sq += __shfl_xor(sq, 16); sq += __shfl_xor(sq, 32);
                if (fq == 0) ssn[(size_t)row * 16 + u.pn * 4 + wc] = sq;
                asm volatile("" ::: "memory");
            }
    }
};

struct EpiQK {
    static constexpr bool PERM = true, AFTER_DRAIN = false;
    unsigned char* ws; const float* ss; const float* qg; const float* kg;
    __device__ __forceinline__ void operator()(const AccT& acc, const Unit& u, int wr, int wc, int fr, int fq) const {
        const int row0 = u.pm * 256 + wr * 64 + fr;
        const int seg = u.pn >> 2, tl = u.pn & 3;
        bf16_t* base = (bf16_t*)(ws + (seg == 0 ? WS_QA : WS_KA));
        const float* gp = seg == 0 ? qg : kg; const float osc = seg == 0 ? 0.125f * LOG2E : 1.0f;
        const int col0 = tl * 256 + 64 * wc + 8 * fq;
#pragma unroll
        for (int ai = 0; ai < 2; ++ai)
#pragma unroll
            for (int m = 0; m < 4; ++m) {
                const int row = row0 + ai * 128 + m * 16;
                const float rs = rsqrtf(ss_load(ss + (size_t)row * 16) * (1.f / 1024.f) + EPS);
                f32x4 v[2][2]; float sq = 0.f;
#pragma unroll
                for (int bj = 0; bj < 2; ++bj)
#pragma unroll
                    for (int n = 0; n < 2; ++n) { v[bj][n] = acc[ai][bj][m][n] * rs; const f32x4 t = v[bj][n]; sq += (t[0] * t[0] + t[1] * t[1]) + (t[2] * t[2] + t[3] * t[3]); }
                sq += __shfl_xor(sq, 16); sq += __shfl_xor(sq, 32);
                const float r2o = rsqrtf(sq * (1.f / 64.f) + EPS) * osc;
#pragma unroll
                for (int bj = 0; bj < 2; ++bj) {
                    const f32x4 ga = *(const f32x4*)(gp + 32 * bj + 8 * fq), gb = *(const f32x4*)(gp + 32 * bj + 8 * fq + 4);
                    u32x4 w;
                    w.x = pk2(v[bj][0][0] * r2o * ga[0], v[bj][0][1] * r2o * ga[1]); w.y = pk2(v[bj][0][2] * r2o * ga[2], v[bj][0][3] * r2o * ga[3]);
                    w.z = pk2(v[bj][1][0] * r2o * gb[0], v[bj][1][1] * r2o * gb[1]); w.w = pk2(v[bj][1][2] * r2o * gb[2], v[bj][1][3] * r2o * gb[3]);
                    *(u32x4*)(base + (size_t)row * 1024 + col0 + 32 * bj) = w;
                }
                asm volatile("" ::: "memory");
            }
    }
};
struct EpiSeg {
    static constexpr bool PERM = true, AFTER_DRAIN = false;
    unsigned char* ws; const float* ss;
    __device__ __forceinline__ void operator()(const AccT& acc, const Unit& u, int wr, int wc, int fr, int fq) const {
        const int row0 = u.pm * 256 + wr * 64 + fr;
        bf16_t* base = (bf16_t*)(ws + WS_QB + (size_t)(u.pn >> 2) * S64);
        const int col0 = (u.pn & 3) * 256 + wc * 32 + 8 * fq;
#pragma unroll
        for (int ai = 0; ai < 2; ++ai)
#pragma unroll
            for (int m = 0; m < 4; ++m) {
                const int row = row0 + ai * 128 + m * 16;
                const float rs = rsqrtf(ss_load(ss + (size_t)row * 16) * (1.f / 1024.f) + EPS);
#pragma unroll
                for (int bj = 0; bj < 2; ++bj) {
                    const f32x4 v0 = acc[ai][bj][m][0] * rs, v1 = acc[ai][bj][m][1] * rs;
                    u32x4 w; w.x = pk2(v0[0], v0[1]); w.y = pk2(v0[2], v0[3]); w.z = pk2(v1[0], v1[1]); w.w = pk2(v1[2], v1[3]);
                    *(u32x4*)(base + (size_t)row * 1024 + col0 + bj * 128) = w;
                }
                asm volatile("" ::: "memory");
            }
    }
};
struct EpiGB {
    static constexpr bool PERM = true, AFTER_DRAIN = false;
    unsigned char* ws; const float* ss; const float* a_log; const float* dt_bias;
    __device__ __forceinline__ void operator()(const AccT& acc, const Unit& u, int wr, int wc, int fr, int fq) const {
        const int row0 = u.pm * 256 + wr * 64 + fr;
        if (wc == 0 && fq < 2) {
            float* GBp = (float*)(ws + WS_GB);
#pragma unroll
            for (int ai = 0; ai < 2; ++ai)
#pragma unroll
                for (int m = 0; m < 4; ++m) {
                    const int row = row0 + ai * 128 + m * 16;
                    const float rs = rsqrtf(ss_load(ss + (size_t)row * 16) * (1.f / 1024.f) + EPS);
                    float v[8];
#pragma unroll
                    for (int e = 0; e < 4; ++e) { v[e] = acc[ai][0][m][0][e] * rs; v[4 + e] = acc[ai][0][m][1][e] * rs; }
                    if (fq == 0) {
#pragma unroll
                        for (int e = 0; e < 8; ++e) v[e] = sigmoidf_(v[e]);
                    } else {
#pragma unroll
                        for (int e = 0; e < 8; ++e) { const float z = v[e] + dt_bias[e]; const float sp = fmaxf(z, 0.f) + __logf(1.f + __expf(-fabsf(z))); v[e] = -__expf(a_log[e]) * sp; }
                    }
                    float* dst = GBp + (size_t)row * 16 + 8 * fq;
                    *(f32x4*)dst = (f32x4){v[0], v[1], v[2], v[3]}; *(f32x4*)(dst + 4) = (f32x4){v[4], v[5], v[6], v[7]};
                    asm volatile("" ::: "memory");
                }
        }
    }
};

__device__ __forceinline__ void cvt_item(const float* W, int ldw, int src_col0, int nvalid, const float* gain, bf16_t* WT, int K, int dst_row0, int k0, LAS float* scr, int lane) {
    const int nn = lane & 31;
#pragma unroll 8
    for (int i = 0; i < 32; ++i) {
        const int kk = 2 * i + (lane >> 5);
        float v = 0.f;
        if (nn < nvalid) { v = W[(size_t)(k0 + kk) * ldw + src_col0 + nn]; if (gain) v *= gain[k0 + kk]; }
        scr[kk * 33 + nn] = v;
    }
    asm volatile("s_waitcnt lgkmcnt(0)" ::: "memory");
    const int c = lane & 7;
#pragma unroll
    for (int j = 0; j < 4; ++j) {
        const int n = (lane >> 3) + 8 * j; const LAS float* s = scr + (8 * c) * 33 + n;
        u32x4 o; o.x = pk2(s[0 * 33], s[1 * 33]); o.y = pk2(s[2 * 33], s[3 * 33]); o.z = pk2(s[4 * 33], s[5 * 33]); o.w = pk2(s[6 * 33], s[7 * 33]);
        *(u32x4*)(WT + (size_t)(dst_row0 + n) * K + k0 + 8 * c) = o;
    }
    asm volatile("s_waitcnt lgkmcnt(0)" ::: "memory");
}

struct Params {
    const float* in[24];
    float* out;
    unsigned char* ws;
    int seg_lo, seg_hi;
};
enum { I_X = 0, I_P, I_WIN, I_ATTN_NORM, I_QNORM, I_KNORM, I_LAM, I_SUBLN, I_RELB, I_CONVB, I_ALOG, I_DTB, I_ONORM, I_WBRA, I_WBRB, I_WOUT, I_FFN_NORM, I_WUP, I_CONVFF, I_CONVFFB, I_WDOWN, I_PLE_NORM, I_WPG, I_WPP };

__device__ __forceinline__ void convert_weights(const Params* PQ, int layer, LAS unsigned char* lds, int gw, int NGW, int wave, int lane) {
    LAS float* scr = (LAS float*)(lds + wave * 16384);
    unsigned char* ws = PQ->ws;
    const float* w_in = PQ->in[I_WIN] + (size_t)layer * 1024 * DIN;
    const float* g_attn = PQ->in[I_ATTN_NORM] + layer * 1024;
    const float* g_ffn = PQ->in[I_FFN_NORM] + layer * 1024;
    const float* g_ple = PQ->in[I_PLE_NORM] + layer * 1024;
#define CVT_JOB(NITEMS, KB, SRCW, LDW, GAIN, DST, KK, SRCCOL, NVALID) \
    for (int it = gw; it < (NITEMS); it += NGW) { const int g = it / (KB), kb = it % (KB); (void)g; \
        cvt_item((SRCW), (LDW), (SRCCOL), (NVALID), (GAIN), (bf16_t*)(ws + (DST)), (KK), g * 32, kb * 64, scr, lane); } asm volatile("" ::: "memory");
    for (int it = gw; it < 200 * 16; it += NGW) {
        const int g = it >> 4, kb = it & 15, pn = g >> 3, gi = g & 7;
        int src, nv = 32;
        if (pn < 8) { const int bj = gi >> 2, wc = gi & 3; src = (pn >> 2) * 1024 + (pn & 3) * 256 + 64 * wc + 32 * bj; }
        else if (pn < 24) { src = 3072 + (pn - 8) * 256 + 32 * gi; }
        else { src = 7168; nv = (gi == 0) ? 16 : 0; }
        cvt_item(w_in, DIN, src, nv, g_attn, (bf16_t*)(ws + W_IN), 1024, g * 32, kb * 64, scr, lane);
    }
    asm volatile("" ::: "memory");
    CVT_JOB(32 * 16, 16, w_in, DIN, g_attn, W_V, 1024, 2048 + g * 32, 32)
    CVT_JOB(64 * 16, 16, w_in, DIN, g_attn, W_GL, 1024, 7184 + g * 32, 32)
    CVT_JOB(32 * 16, 16, PQ->in[I_WBRA] + (size_t)layer * 1024 * 1024, 1024, (const float*)nullptr, W_BRA, 1024, g * 32, 32)
    CVT_JOB(32 * 16, 16, PQ->in[I_WBRB] + (size_t)layer * 1024 * 1024, 1024, (const float*)nullptr, W_BRB, 1024, g * 32, 32)
    CVT_JOB(32 * 16, 16, PQ->in[I_WOUT] + (size_t)layer * 1024 * 1024, 1024, (const float*)nullptr, W_OUT, 1024, g * 32, 32)
    CVT_JOB(176 * 16, 16, PQ->in[I_WUP] + (size_t)layer * 1024 * 5632, 5632, g_ffn, W_UP, 1024, g * 32, 32)
    CVT_JOB(32 * 44, 44, PQ->in[I_WDOWN] + (size_t)layer * 2816 * 1024, 1024, (const float*)nullptr, W_DOWN, 2816, g * 32, 32)
    CVT_JOB(32 * 16, 16, PQ->in[I_WPG] + (size_t)layer * 1024 * 1024, 1024, g_ple, W_PG, 1024, g * 32, 32)
    CVT_JOB(32 * 4, 4, PQ->in[I_WPP] + (size_t)layer * 256 * 1024, 1024, (const float*)nullptr, W_PP, 256, g * 32, 32)
#undef CVT_JOB
}

constexpr int AT_KROW = 272, AT_VROW = 144, AT_KBYTES = 64 * AT_KROW, AT_VBYTES = 128 * AT_VROW, AT_STAGE = AT_KBYTES + AT_VBYTES, AT_TB = 2 * AT_STAGE;
static_assert(AT_TB >= 65536 && AT_TB + 1024 <= LDS_BYTES, "attention LDS");
__device__ __forceinline__ void attn_unit(LAS unsigned char* lds, const bf16_t* QA, const bf16_t* KA, const bf16_t* VT, bf16_t* OA, int b, int h, int qb,
                                          float lam, float out_scale, const float* subln, const float* relb, int tid) {
    const int lane = tid & 63, wid = __builtin_amdgcn_readfirstlane(tid >> 6), j = wid >> 2, wq = wid & 3, r32 = lane & 31, hi = lane >> 5;
    const int Q0 = qb * 128, qrow = Q0 + 32 * wq + r32;
    const size_t tok = (size_t)b * SEQ + qrow;
    LAS float* TB = (LAS float*)(lds + AT_TB);
    for (int i = tid; i <= 128; i += NTHR) {
        float v = 0.f;
        if (i < 128) {
            int bk = i;
            if (i >= 16) { int lg = 16 + (int)(__logf((float)i * (1.f / 16.f)) / __logf(8.0f) * 16.f); bk = lg < 31 ? lg : 31; }
            v = (relb[bk * 8 + h] - relb[31 * 8 + h]) * LOG2E;
        }
        TB[i] = v;
    }
    bf16x8 qf[4];
#pragma unroll
    for (int d0 = 0; d0 < 4; ++d0) qf[d0] = *(const bf16x8*)(QA + tok * 1024 + h * 128 + 64 * j + 16 * d0 + 8 * hi);
    const int NT = (Q0 + 128) / 64;
    const int kr0 = tid >> 4, kc = tid & 15;
    const int vr0 = tid >> 3, vc = tid & 7;
    const bf16_t* kg = KA + ((size_t)b * SEQ + kr0) * 1024 + h * 128 + kc * 8;
    const bf16_t* vg = VT + (size_t)(h * 128 + vr0) * MTOK + (size_t)b * SEQ + vc * 8;
    u32x4 kreg0, kreg1, vreg0, vreg1;
#define AT_LOAD(t) do { kreg0 = *(const u32x4*)(kg + (size_t)(t) * 64 * 1024); kreg1 = *(const u32x4*)(kg + (size_t)((t) * 64 + 32) * 1024); \
        vreg0 = *(const u32x4*)(vg + (t) * 64); vreg1 = *(const u32x4*)(vg + (size_t)64 * MTOK + (t) * 64); } while (0)
#define AT_STORE(s) do { LAS unsigned char* kb_ = lds + (s) * AT_STAGE; LAS unsigned char* vb_ = kb_ + AT_KBYTES; \
        *(LAS u32x4*)(kb_ + kr0 * AT_KROW + kc * 16) = kreg0; *(LAS u32x4*)(kb_ + (kr0 + 32) * AT_KROW + kc * 16) = kreg1; \
        *(LAS u32x4*)(vb_ + vr0 * AT_VROW + vc * 16) = vreg0; *(LAS u32x4*)(vb_ + (vr0 + 64) * AT_VROW + vc * 16) = vreg1; } while (0)
    AT_LOAD(0); AT_STORE(0);
    __syncthreads();
    f32x16 o[4];
#pragma unroll
    for (int i = 0; i < 4; ++i)
#pragma unroll
        for (int r = 0; r < 16; ++r) o[i][r] = 0.f;
    float mrun = -INFINITY, lrun = 0.f;
    const int qmax_w = Q0 + 32 * wq + 31, qmin_w = Q0 + 32 * wq;
    for (int t = 0; t < NT; ++t) {
        if (t + 1 < NT) AT_LOAD(t + 1);
        const int kv0 = 64 * t;
        if (kv0 <= qmax_w) {
            const LAS unsigned char* Kb = lds + (t & 1) * AT_STAGE; const LAS unsigned char* Vb = Kb + AT_KBYTES;
            f32x16 s0, s1;
#pragma unroll
            for (int r = 0; r < 16; ++r) { s0[r] = 0.f; s1[r] = 0.f; }
#pragma unroll
            for (int d0 = 0; d0 < 4; ++d0) {
                const bf16x8 a0 = *(const LAS bf16x8*)(Kb + r32 * AT_KROW + (64 * j + 16 * d0 + 8 * hi) * 2);
                const bf16x8 a1 = *(const LAS bf16x8*)(Kb + (32 + r32) * AT_KROW + (64 * j + 16 * d0 + 8 * hi) * 2);
                s0 = __builtin_amdgcn_mfma_f32_32x32x16_bf16(a0, qf[d0], s0, 0, 0, 0);
                s1 = __builtin_amdgcn_mfma_f32_32x32x16_bf16(a1, qf[d0], s1, 0, 0, 0);
            }
            if (kv0 + 63 + 128 > qmin_w) {
#pragma unroll
                for (int r = 0; r < 16; ++r) {
                    const int rel0 = qrow - (kv0 + crow(r, hi)), rel1 = rel0 - 32;
                    s0[r] = rel0 < 0 ? -INFINITY : s0[r] + TB[rel0 < 128 ? rel0 : 128];
                    s1[r] = rel1 < 0 ? -INFINITY : s1[r] + TB[rel1 < 128 ? rel1 : 128];
                }
            }
            float mx = fmaxf(s0[0], s1[0]);
#pragma unroll
            for (int r = 1; r < 16; ++r) mx = fmaxf(mx, fmaxf(s0[r], s1[r]));
            mx = fmaxf(mx, __shfl_xor(mx, 32));
            const float mnew = fmaxf(mrun, mx);
            const float alpha = __builtin_amdgcn_exp2f(mrun - mnew);
            mrun = mnew;
            float ls = 0.f;
#pragma unroll
            for (int r = 0; r < 16; ++r) { s0[r] = __builtin_amdgcn_exp2f(s0[r] - mnew); s1[r] = __builtin_amdgcn_exp2f(s1[r] - mnew); ls += s0[r] + s1[r]; }
            lrun = lrun * alpha + ls;
#pragma unroll
            for (int i = 0; i < 4; ++i)
#pragma unroll
                for (int r = 0; r < 16; ++r) o[i][r] *= alpha;
            bf16x8 pf[4];
            { u32x4 w;
              w.x = pk2(s0[0], s0[1]); w.y = pk2(s0[2], s0[3]); w.z = pk2(s0[4], s0[5]); w.w = pk2(s0[6], s0[7]); pf[0] = __builtin_bit_cast(bf16x8, w);
              w.x = pk2(s0[8], s0[9]); w.y = pk2(s0[10], s0[11]); w.z = pk2(s0[12], s0[13]); w.w = pk2(s0[14], s0[15]); pf[1] = __builtin_bit_cast(bf16x8, w);
              w.x = pk2(s1[0], s1[1]); w.y = pk2(s1[2], s1[3]); w.z = pk2(s1[4], s1[5]); w.w = pk2(s1[6], s1[7]); pf[2] = __builtin_bit_cast(bf16x8, w);
              w.x = pk2(s1[8], s1[9]); w.y = pk2(s1[10], s1[11]); w.z = pk2(s1[12], s1[13]); w.w = pk2(s1[14], s1[15]); pf[3] = __builtin_bit_cast(bf16x8, w); }
#pragma unroll
            for (int blk = 0; blk < 4; ++blk)
#pragma unroll
                for (int s = 0; s < 4; ++s) {
                    const LAS unsigned char* vp = Vb + (32 * blk + r32) * AT_VROW + (16 * s + 4 * hi) * 2;
                    const u32x2 lo = *(const LAS u32x2*)vp, hh = *(const LAS u32x2*)(vp + 16);
                    const u32x4 w = (u32x4){lo.x, lo.y, hh.x, hh.y};
                    o[blk] = __builtin_amdgcn_mfma_f32_32x32x16_bf16(__builtin_bit_cast(bf16x8, w), pf[s], o[blk], 0, 0, 0);
                }
        }
        if (t + 1 < NT) AT_STORE((t + 1) & 1);
        __syncthreads();
    }
#undef AT_LOAD
#undef AT_STORE
    lrun += __shfl_xor(lrun, 32);
    const float inv = 1.f / lrun;
    LAS float* EX = (LAS float*)lds;
    if (j == 1) {
        const float sc = inv * lam;
#pragma unroll
        for (int blk = 0; blk < 4; ++blk)
#pragma unroll
            for (int r = 0; r < 16; ++r) EX[(wq * 64 + blk * 16 + r) * 64 + lane] = o[blk][r] * sc;
    }
    __syncthreads();
    if (j == 0) {
        float sq = 0.f;
#pragma unroll
        for (int blk = 0; blk < 4; ++blk)
#pragma unroll
            for (int r = 0; r < 16; ++r) { const float d = o[blk][r] * inv - EX[(wq * 64 + blk * 16 + r) * 64 + lane]; o[blk][r] = d; sq += d * d; }
        sq += __shfl_xor(sq, 32);
        const float rr = rsqrtf(sq * (1.f / 128.f) + EPS) * out_scale;
#pragma unroll
        for (int blk = 0; blk < 4; ++blk)
#pragma unroll
            for (int rq = 0; rq < 4; ++rq) {
                const int dv0 = 32 * blk + 8 * rq + 4 * hi;
                const f32x4 g = *(const f32x4*)(subln + dv0);
                u32x2 w; w.x = pk2(o[blk][4 * rq + 0] * rr * g[0], o[blk][4 * rq + 1] * rr * g[1]); w.y = pk2(o[blk][4 * rq + 2] * rr * g[2], o[blk][4 * rq + 3] * rr * g[3]);
                *(u32x2*)(OA + tok * 1024 + h * 128 + dv0) = w;
            }
    }
    __syncthreads();
}

__device__ __forceinline__ void dn_naive(LAS unsigned char* lds, unsigned char* ws, const float* convw  , int b, int h, int tid) {
    const int lane = tid & 63, wid = tid >> 6, dv = tid & 127, g4 = tid >> 7;
    LAS float* Y = (LAS float*)lds;
    LAS float* NR = Y + 384;
    LAS float* PT = NR + 8;
    LAS float* OP = PT + 512;
    float S[32];
#pragma unroll
    for (int i = 0; i < 32; ++i) S[i] = 0.f;
    bf16_t* QB = (bf16_t*)(ws + WS_QB); const bf16_t* KB = (const bf16_t*)(ws + WS_KB); const bf16_t* VB = (const bf16_t*)(ws + WS_VB);
    const float* GBp = (const float*)(ws + WS_GB);
    const int arr = tid >> 7;
    const bf16_t* src = (arr == 0 ? (const bf16_t*)QB : arr == 1 ? KB : VB) + h * 128 + dv;
    float w0 = 0.f, w1 = 0.f, w2 = 0.f, w3 = 0.f, x1 = 0.f, x2 = 0.f, x3 = 0.f;
    if (tid < 384) { const int ch = arr * 1024 + h * 128 + dv; w0 = convw[ch]; w1 = convw[3072 + ch]; w2 = convw[2 * 3072 + ch]; w3 = convw[3 * 3072 + ch]; }
    for (int t = 0; t < SEQ; ++t) {
        const size_t tok = (size_t)b * SEQ + t;
        if (tid < 384) {
            const float x0 = bf2f(src[tok * 1024]);
            float y = w0 * x3 + w1 * x2 + w2 * x1 + w3 * x0;
            y = siluf_(y); x3 = x2; x2 = x1; x1 = x0;
            Y[arr * 128 + dv] = y;
            const float sq = wave_sum(y * y);
            if (lane == 0) NR[wid] = sq;
        }
        __syncthreads();
        const float qn = rsqrtf(NR[0] + NR[1] + EPS) * 0.08838834764831845f, kn = rsqrtf(NR[2] + NR[3] + EPS);
        const float bt = GBp[tok * 16 + h], gt = GBp[tok * 16 + 8 + h], eg = __expf(gt);
        const float vv = Y[256 + dv];
        float ks = 0.f;
#pragma unroll
        for (int i = 0; i < 32; ++i) ks += Y[128 + 32 * g4 + i] * S[i];
        PT[g4 * 128 + dv] = ks * kn;
        __syncthreads();
        const float kS = (PT[dv] + PT[128 + dv]) + (PT[256 + dv] + PT[384 + dv]);
        const float c = bt * (vv - eg * kS);
        float op = 0.f;
#pragma unroll
        for (int i = 0; i < 32; ++i) { const float kk = Y[128 + 32 * g4 + i] * kn; S[i] = eg * S[i] + kk * c; op += Y[32 * g4 + i] * S[i]; }
        OP[g4 * 128 + dv] = op * qn;
        __syncthreads();
        if (g4 == 0) { const float ov = (OP[dv] + OP[128 + dv]) + (OP[256 + dv] + OP[384 + dv]); QB[tok * 1024 + h * 128 + dv] = f2bf(ov); }
    }
    __syncthreads();
}

__device__ __forceinline__ float row16_sum(float v) {
    v += __builtin_bit_cast(float, __builtin_amdgcn_update_dpp(0, __builtin_bit_cast(int, v), 0x128, 0xf, 0xf, false));
    v += __builtin_bit_cast(float, __builtin_amdgcn_update_dpp(0, __builtin_bit_cast(int, v), 0x124, 0xf, 0xf, false));
    v += __builtin_bit_cast(float, __builtin_amdgcn_update_dpp(0, __builtin_bit_cast(int, v), 0x122, 0xf, 0xf, false));
    v += __builtin_bit_cast(float, __builtin_amdgcn_update_dpp(0, __builtin_bit_cast(int, v), 0x121, 0xf, 0xf, false));
    return v;
}
__device__ __forceinline__ void dn_fast(LAS unsigned char* lds, unsigned char* ws, const float* convw  , int b, int h, int dvq, int tid) {
    const int lane = tid & 63, wid = tid >> 6, dvl = lane >> 4, grp = lane & 15;
    const int dvloc = 4 * wid + dvl, dv = 32 * dvq + dvloc;
    LAS float* Y = (LAS float*)lds;
    LAS float* NR = Y + 16 * 288;
    LAS float* GBs = NR + 16 * 16;
    LAS float* SC = GBs + 32;
    float S[8];
#pragma unroll
    for (int i = 0; i < 8; ++i) S[i] = 0.f;
    bf16_t* VB = (bf16_t*)(ws + WS_VB);
    const float* GBp = (const float*)(ws + WS_GB);
    const int arr = tid < 128 ? 0 : (tid < 256 ? 1 : 2);
    const int dch = arr == 2 ? 32 * dvq + ((tid - 256) & 31) : (tid & 127);
    const bf16_t* src = (const bf16_t*)(ws + (arr == 0 ? WS_QB : arr == 1 ? WS_KB : WS_VB)) + h * 128 + dch;
    float w0 = 0.f, w1 = 0.f, w2 = 0.f, w3 = 0.f, x1 = 0.f, x2 = 0.f, x3 = 0.f;
    if (tid < 288) { const int ch = arr * 1024 + h * 128 + dch; w0 = convw[ch]; w1 = convw[3072 + ch]; w2 = convw[2 * 3072 + ch]; w3 = convw[3 * 3072 + ch]; }
    for (int t0 = 0; t0 < SEQ; t0 += 16) {
        const size_t tokb = (size_t)b * SEQ + t0;
        if (tid < 288) {
            bf16_t xr[16];
#pragma unroll
            for (int tt = 0; tt < 16; ++tt) xr[tt] = src[(tokb + tt) * 1024];
#pragma unroll
            for (int tt = 0; tt < 16; ++tt) {
                const float x0 = bf2f(xr[tt]);
                float y = w0 * x3 + w1 * x2 + w2 * x1 + w3 * x0;
                y = siluf_(y); x3 = x2; x2 = x1; x1 = x0;
                Y[tt * 288 + tid] = y;
                if (tid < 256) { const float sq = row16_sum(y * y); if ((lane & 15) == 0) NR[tt * 16 + wid * 4 + (lane >> 4)] = sq; }
            }
        }
        if (tid >= 480) { const int i = tid - 480, tt = i >> 1, which = i & 1; GBs[tt * 2 + which] = GBp[(tokb + tt) * 16 + which * 8 + h]; }
        __syncthreads();
        if (tid < 16) {
            const f32x4 a = *(const LAS f32x4*)(NR + tid * 16), b2 = *(const LAS f32x4*)(NR + tid * 16 + 4), c2 = *(const LAS f32x4*)(NR + tid * 16 + 8), d2 = *(const LAS f32x4*)(NR + tid * 16 + 12);
            const float sq_q = ((a[0] + a[1]) + (a[2] + a[3])) + ((b2[0] + b2[1]) + (b2[2] + b2[3])), sq_k = ((c2[0] + c2[1]) + (c2[2] + c2[3])) + ((d2[0] + d2[1]) + (d2[2] + d2[3]));
            *(LAS f32x4*)(SC + tid * 4) = (f32x4){rsqrtf(sq_q + EPS) * 0.08838834764831845f, rsqrtf(sq_k + EPS), __expf(GBs[tid * 2 + 1]), GBs[tid * 2]};
        }
        __syncthreads();
#pragma unroll 4
        for (int tt = 0; tt < 16; ++tt) {
            const f32x4 sc = *(const LAS f32x4*)(SC + tt * 4);
            const float qn = sc[0], kn = sc[1], eg = sc[2], bt = sc[3];
            const f32x4 ka = *(const LAS f32x4*)(Y + tt * 288 + 128 + 8 * grp), kb = *(const LAS f32x4*)(Y + tt * 288 + 128 + 8 * grp + 4);
            const f32x4 qa = *(const LAS f32x4*)(Y + tt * 288 + 8 * grp), qb = *(const LAS f32x4*)(Y + tt * 288 + 8 * grp + 4);
            const float vv = Y[tt * 288 + 256 + dvloc];
            float ks = (ka[0] * S[0] + ka[1] * S[1]) + (ka[2] * S[2] + ka[3] * S[3]) + (kb[0] * S[4] + kb[1] * S[5]) + (kb[2] * S[6] + kb[3] * S[7]);
            ks = row16_sum(ks);
            const float c = bt * (vv - eg * ks * kn) * kn;
            float op = 0.f;
#pragma unroll
            for (int i = 0; i < 4; ++i) { S[i] = eg * S[i] + ka[i] * c; op += qa[i] * S[i]; S[4 + i] = eg * S[4 + i] + kb[i] * c; op += qb[i] * S[4 + i]; }
            op = row16_sum(op);
            if (grp == 0) VB[(tokb + tt) * 1024 + h * 128 + dv] = f2bf(op * qn);
        }
        __syncthreads();
    }
}

__device__ __forceinline__ float row8_sum(float v) {
    v += __builtin_bit_cast(float, __builtin_amdgcn_update_dpp(0, __builtin_bit_cast(int, v), 0x141, 0xf, 0xf, false));
    v += __builtin_bit_cast(float, __builtin_amdgcn_update_dpp(0, __builtin_bit_cast(int, v), 0x1B, 0xf, 0xf, false));
    v += __builtin_bit_cast(float, __builtin_amdgcn_update_dpp(0, __builtin_bit_cast(int, v), 0xB1, 0xf, 0xf, false));
    return v;
}
constexpr int DN2_YB = 16 * 288 + 16 * 16 + 32 + 64;
__device__ __forceinline__ void dn_pc(LAS unsigned char* lds, unsigned char* ws, const float* convw  , int b, int h, int dvq, int tid) {
    const int lane = tid & 63, wid = tid >> 6;
    const bool producer = tid >= 256;
    const int pt = tid - 256;
    LAS float* L = (LAS float*)lds;
    bf16_t* VB = (bf16_t*)(ws + WS_VB);
    const float* GBp = (const float*)(ws + WS_GB);
    const int parr = pt < 128 ? 0 : 1, pd = pt & 127;
    const bf16_t* src = (const bf16_t*)(ws + (parr == 0 ? WS_QB : WS_KB)) + h * 128 + pd;
    const bf16_t* srcv = (const bf16_t*)(ws + WS_VB) + h * 128 + 32 * dvq + (pt & 31);
    float w0 = 0.f, w1 = 0.f, w2 = 0.f, w3 = 0.f, x1 = 0.f, x2 = 0.f, x3 = 0.f, u0 = 0.f, u1 = 0.f, u2 = 0.f, u3 = 0.f, z1 = 0.f, z2 = 0.f, z3 = 0.f;
    if (producer) { const int ch = parr * 1024 + h * 128 + pd; w0 = convw[ch]; w1 = convw[3072 + ch]; w2 = convw[2 * 3072 + ch]; w3 = convw[3 * 3072 + ch];
        if (pt < 32) { const int cv = 2048 + h * 128 + 32 * dvq + pt; u0 = convw[cv]; u1 = convw[3072 + cv]; u2 = convw[2 * 3072 + cv]; u3 = convw[3 * 3072 + cv]; } }
    const int col = tid >> 3, grp = tid & 7;
    float S[16];
#pragma unroll
    for (int i = 0; i < 16; ++i) S[i] = 0.f;
#define DN2_PRODUCE(BUF, T0) do { LAS float* Yp = L + (BUF) * DN2_YB; LAS float* NRp = Yp + 16 * 288; LAS float* GBsp = NRp + 256; const size_t tb_ = (size_t)b * SEQ + (T0); \
        bf16_t xr[16]; bf16_t vr[16]; \
        _Pragma("unroll") for (int tt = 0; tt < 16; ++tt) xr[tt] = src[(tb_ + tt) * 1024]; \
        if (pt < 32) { _Pragma("unroll") for (int tt = 0; tt < 16; ++tt) vr[tt] = srcv[(tb_ + tt) * 1024]; } \
        if (pt >= 224) { const int i_ = pt - 224, tt_ = i_ >> 1, wh_ = i_ & 1; GBsp[tt_ * 2 + wh_] = GBp[(tb_ + tt_) * 16 + wh_ * 8 + h]; } \
        _Pragma("unroll") for (int tt = 0; tt < 16; ++tt) { const float x0 = bf2f(xr[tt]); float y = w0 * x3 + w1 * x2 + w2 * x1 + w3 * x0; y = siluf_(y); x3 = x2; x2 = x1; x1 = x0; \
            Yp[tt * 288 + pt] = y; const float sq = row16_sum(y * y); if ((lane & 15) == 0) NRp[tt * 16 + (wid - 4) * 4 + (lane >> 4)] = sq; } \
        if (pt < 32) { _Pragma("unroll") for (int tt = 0; tt < 16; ++tt) { const float x0 = bf2f(vr[tt]); float y = u0 * z3 + u1 * z2 + u2 * z1 + u3 * x0; y = siluf_(y); z3 = z2; z2 = z1; z1 = x0; Yp[tt * 288 + 256 + pt] = y; } } \
    } while (0)
    if (producer) DN2_PRODUCE(0, 0);
    for (int n = 0; n < SEQ / 16; ++n) {
        const int buf = n & 1;
        LAS float* Y = L + buf * DN2_YB; LAS float* NR = Y + 16 * 288; LAS float* GBs = NR + 256; LAS float* SC = GBs + 32;
        __syncthreads();
        if (tid < 16) {
            const f32x4 a = *(const LAS f32x4*)(NR + tid * 16), b2 = *(const LAS f32x4*)(NR + tid * 16 + 4), c2 = *(const LAS f32x4*)(NR + tid * 16 + 8), d2 = *(const LAS f32x4*)(NR + tid * 16 + 12);
            const float sq_q = ((a[0] + a[1]) + (a[2] + a[3])) + ((b2[0] + b2[1]) + (b2[2] + b2[3])), sq_k = ((c2[0] + c2[1]) + (c2[2] + c2[3])) + ((d2[0] + d2[1]) + (d2[2] + d2[3]));
            *(LAS f32x4*)(SC + tid * 4) = (f32x4){rsqrtf(sq_q + EPS) * 0.08838834764831845f, rsqrtf(sq_k + EPS), __expf(GBs[tid * 2 + 1]), GBs[tid * 2]};
        }
        __syncthreads();
        if (producer) { if (n + 1 < SEQ / 16) DN2_PRODUCE(buf ^ 1, 16 * (n + 1)); }
        else {
            const size_t tokb = (size_t)b * SEQ + 16 * n;
#pragma unroll 4
            for (int tt = 0; tt < 16; ++tt) {
                const f32x4 sc = *(const LAS f32x4*)(SC + tt * 4);
                const float qn = sc[0], kn = sc[1], eg = sc[2], bt = sc[3];
                const LAS f32x4* kp = (const LAS f32x4*)(Y + tt * 288 + 128 + 16 * grp); const LAS f32x4* qp = (const LAS f32x4*)(Y + tt * 288 + 16 * grp);
                const f32x4 k0 = kp[0], k1 = kp[1], k2 = kp[2], k3 = kp[3], q0 = qp[0], q1 = qp[1], q2 = qp[2], q3 = qp[3];
                const float vv = Y[tt * 288 + 256 + col];
                float ks = ((k0[0] * S[0] + k0[1] * S[1]) + (k0[2] * S[2] + k0[3] * S[3])) + ((k1[0] * S[4] + k1[1] * S[5]) + (k1[2] * S[6] + k1[3] * S[7]))
                         + ((k2[0] * S[8] + k2[1] * S[9]) + (k2[2] * S[10] + k2[3] * S[11])) + ((k3[0] * S[12] + k3[1] * S[13]) + (k3[2] * S[14] + k3[3] * S[15]));
                ks = row8_sum(ks);
                const float c = bt * (vv - eg * ks * kn) * kn;
                float op0 = 0.f, op1 = 0.f;
#pragma unroll
                for (int i = 0; i < 4; ++i) { S[i] = eg * S[i] + k0[i] * c; op0 += q0[i] * S[i]; S[4 + i] = eg * S[4 + i] + k1[i] * c; op1 += q1[i] * S[4 + i];
                                              S[8 + i] = eg * S[8 + i] + k2[i] * c; op0 += q2[i] * S[8 + i]; S[12 + i] = eg * S[12 + i] + k3[i] * c; op1 += q3[i] * S[12 + i]; }
                const float op = row8_sum(op0 + op1);
                if (grp == 0) VB[(tokb + tt) * 1024 + h * 128 + 32 * dvq + col] = f2bf(op * qn);
            }
        }
    }
    __syncthreads();
#undef DN2_PRODUCE
}

#define GEMM_PHASE(EPI, Aptr, Bptr, Mv, Nv, Kv, Eobj, HM) do { int m_ = (Mv), n_ = (Nv), k_ = (Kv); asm volatile("" : "+s"(m_), "+s"(n_), "+s"(k_)); pg8::Gemm g_{(const pg8::bf16_t*)(Aptr), (const pg8::bf16_t*)(Bptr), m_, n_, k_, (HM)}; pg8::StaticOrder S_; S_.init(m_, n_, G, bid); \
        pg8::gemm_phase<EPI, pg8::StaticOrder, true, true>(lds, g_, S_, (Eobj)); } while (0)

__global__ void __launch_bounds__(NTHR, 2) fwd_mega(Params P) {
    extern __shared__ __attribute__((aligned(16))) unsigned char lds_raw[];
    LAS unsigned char* lds = (LAS unsigned char*)lds_raw;
    cg::grid_group grid = cg::this_grid();
    if (threadIdx.x == 0) {
        const unsigned xcc = (unsigned)__builtin_amdgcn_s_getreg((3 << 11) | 20) & 7u;
        const unsigned loc = __hip_atomic_fetch_add((unsigned*)(P.ws + WS_CTL) + xcc, 1u, __ATOMIC_RELAXED, __HIP_MEMORY_SCOPE_AGENT);
        *(LAS int*)(lds + LDS_VB) = (int)((loc & 31u) * 8u + xcc);
    }
    __syncthreads();
    int seg = 0; const int seg_lo = P.seg_lo, seg_hi = P.seg_hi;
#ifdef L2FLUSH
#define L2_FLUSH() do { const Params* PF = (const Params*)__builtin_amdgcn_kernarg_segment_ptr(); asm volatile("" : "+s"(PF)); int tf_ = threadIdx.x; asm volatile("" : "+v"(tf_)); \
        const u32x4* jp = (const u32x4*)(PF->in[I_P]) + (size_t)blockIdx.x * (L2FLUSH * 64) + tf_; unsigned acc_ = 0u; \
        for (int q_ = 0; q_ < L2FLUSH * 64 / 512; ++q_) { const u32x4 v_ = __builtin_nontemporal_load(jp + (size_t)q_ * 512); acc_ |= v_.x & v_.y & v_.z & v_.w; asm volatile("" ::: "memory"); } \
        if (acc_ == 0x12345678u) PF->out[0] = 0.f; } while (0)
#else
#define L2_FLUSH() do {} while (0)
#endif
#ifdef NOSEG
#define SYNCCOND true
#else
#define SYNCCOND (seg >= seg_lo && seg + 1 < seg_hi)
#endif
#define GRID_SYNC() do { if (SYNCCOND) { asm volatile("s_waitcnt vmcnt(0) lgkmcnt(0)" ::: "memory");   grid.sync(); L2_FLUSH(); \
        if (threadIdx.x < 64) { __builtin_amdgcn_fence(__ATOMIC_ACQUIRE, "agent"); asm volatile("s_waitcnt vmcnt(0)" ::: "memory"); } __syncthreads();     \
        } ++seg; } while (0)
#ifdef NOSEG
#define SEGCOND true
#else
#define SEGCOND (seg >= seg_lo && seg < seg_hi)
#endif
#define PH_BEGIN if (SEGCOND) { const Params* PQ = (const Params*)__builtin_amdgcn_kernarg_segment_ptr(); asm volatile("" : "+s"(PQ)); int tid = threadIdx.x; asm volatile("" : "+v"(tid)); \
    const int lane = tid & 63, wave = __builtin_amdgcn_readfirstlane(tid >> 6); int bid = __builtin_amdgcn_readfirstlane(*(LAS int*)(lds + LDS_VB)), G = gridDim.x; asm volatile("" : "+s"(bid), "+s"(G)); \
    const int xb_ = bid & 7, jb_ = bid >> 3, wj = jb_ * NW + wave;     \
    unsigned char* ws = PQ->ws; float* X = PQ->out; float* SS = (float*)(ws + WS_SS); bf16_t* XB = (bf16_t*)(ws + WS_XB); \
    float* ss_attn = (float*)(ws + WS_HALO); float* ss_ffn = ss_attn + (size_t)MTOK * 16; float* ss_ple = ss_ffn + (size_t)MTOK * 16; float* ss_next = ss_attn; \
    (void)lane; (void)xb_; (void)jb_; (void)wj; (void)X; (void)XB; (void)ss_attn; (void)ss_ffn; (void)ss_ple; (void)ss_next; (void)G;
#define PH_END }
#define U ((bf16_t*)(ws + WS_MIX))
#define ACT ((bf16_t*)(ws + WS_MIX + 176 * MiB))

    { const int layer = 0; PH_BEGIN
      if (bid == 0 && tid == 0) __hip_atomic_store((unsigned*)(ws + WS_CTL) + 16, 0u, __ATOMIC_RELAXED, __HIP_MEMORY_SCOPE_AGENT);
      const float* xin = PQ->in[I_X];
      for (int r = wj; r < SEQ; r += 256) {
          const int m = xb_ * SEQ + r;
          const f32x4* xr = (const f32x4*)(xin + (size_t)m * 1024) + lane;
          f32x4 v[4]; float s = 0.f;
#pragma unroll
          for (int jj = 0; jj < 4; ++jj) { v[jj] = xr[64 * jj]; s += (v[jj][0] * v[jj][0] + v[jj][1] * v[jj][1]) + (v[jj][2] * v[jj][2] + v[jj][3] * v[jj][3]); }
          s = wave_sum(s);
          if (lane < 16) ss_attn[(size_t)m * 16 + lane] = lane == 0 ? s : 0.f;
          f32x4* xo = (f32x4*)(X + (size_t)m * 1024) + lane;
          u32x2* bo = (u32x2*)(XB + (size_t)m * 1024) + lane;
#pragma unroll
          for (int jj = 0; jj < 4; ++jj) { xo[64 * jj] = v[jj]; u32x2 w; w.x = pk2(v[jj][0], v[jj][1]); w.y = pk2(v[jj][2], v[jj][3]); bo[64 * jj] = w; }
      }
    PH_END }

    for (int layer = 0; layer < NLAYER; ++layer) {
        asm volatile("" ::: "memory");
        const float lam_init = 0.8f - 0.6f * __expf(-0.3f * (float)layer);
        PH_BEGIN
        convert_weights(PQ, layer, lds, bid * NW + wave, G * NW, wave, lane);
        { const float* pl = PQ->in[I_P] + ((size_t)layer * MTOK + (size_t)xb_ * SEQ) * DPLE;
          bf16_t* pb = (bf16_t*)(ws + WS_PB) + (size_t)xb_ * SEQ * DPLE;
          for (int i = jb_ * NTHR + tid; i < SEQ * DPLE / 8; i += 32 * NTHR) {
              const f32x4 a = *(const f32x4*)(pl + (size_t)i * 8), b = *(const f32x4*)(pl + (size_t)i * 8 + 4);
              u32x4 w; w.x = pk2(a[0], a[1]); w.y = pk2(a[2], a[3]); w.z = pk2(b[0], b[1]); w.w = pk2(b[2], b[3]);
              *(u32x4*)(pb + (size_t)i * 8) = w;
          }
        }
        PH_END
        GRID_SYNC();
#ifdef DBLTEST
#ifdef DBL_SC
#define DBL_LD(p) ldc16(p)
#else
#define DBL_LD(p) (*(p))
#endif
        if (layer == 0) {
#ifdef DBL_OUTP
        PH_BEGIN
        { EpiResid E{X, XB, ss_ffn, nullptr, -1};
          GEMM_PHASE(EpiResid, ws + WS_VT, ws + W_OUT, MTOK, 1024, 1024, E, -1); }
        PH_END
        GRID_SYNC();
#endif
        for (int rep = 0; rep < 2; ++rep) {
        PH_BEGIN
#ifdef DBL_COPY
            { const u32x4* s4 = (const u32x4*)XB; u32x4* d4 = (u32x4*)(ws + WS_MIX + (size_t)rep * 176 * MiB);
              const size_t per = (size_t)DBL_M * DBL_N * 2 / 16 / 8;
              for (size_t i = (size_t)((jb_ + rep * 13) & 31) * NTHR + tid; i < per; i += (size_t)32 * NTHR) d4[(size_t)xb_ * per + i] = DBL_LD(s4 + (size_t)xb_ * per + i); }
#else
#ifndef DBL_W
#define DBL_W W_UP
#define DBL_ACT 0
#endif
            { EpiRowScale<DBL_ACT> E{(bf16_t*)(ws + WS_MIX + (size_t)rep * DBL_OFF * MiB), DBL_N, ss_attn, DBL_H};
              GEMM_PHASE(EpiRowScale<DBL_ACT>, XB, ws + DBL_W, DBL_M, DBL_N, 1024, E, DBL_H); }
#endif
        PH_END
        GRID_SYNC();
        }
        PH_BEGIN
        { const u32x4* a4 = (const u32x4*)(ws + WS_MIX); const u32x4* b4 = (const u32x4*)(ws + WS_MIX + (size_t)DBL_OFF * MiB); unsigned bad = 0u;
          const size_t per = (size_t)DBL_M * DBL_N * 2 / 16 / 8;
          for (size_t i0 = (size_t)((jb_ + 7) & 31) * NTHR + tid; i0 < per; i0 += (size_t)32 * NTHR) { const size_t i = (size_t)xb_ * per + i0; const u32x4 a = DBL_LD(a4 + i), b = DBL_LD(b4 + i); bad |= ((a.x ^ b.x) | (a.y ^ b.y) | (a.z ^ b.z) | (a.w ^ b.w)) ? 1u : 0u; }
          if (bad) __hip_atomic_fetch_or((unsigned*)(ws + WS_CTL) + 16, 1u, __ATOMIC_RELAXED, __HIP_MEMORY_SCOPE_AGENT); }
        PH_END
        GRID_SYNC();
        }
#endif
#if defined(DBLMIX) && !defined(DBLMIX_AT_GATES)
        for (int rep = 0; rep < 2; ++rep) {
#endif
#ifndef NO_INPROJ
        PH_BEGIN
        { EpiQK E{ws, ss_attn, PQ->in[I_QNORM] + layer * 64, PQ->in[I_KNORM] + layer * 64};
          GEMM_PHASE(EpiQK, XB, ws + W_IN, MTOK, 2048, 1024, E, -1); }
        PH_END
        PH_BEGIN
        { EpiSeg E{ws, ss_attn};
          GEMM_PHASE(EpiSeg, XB, ws + W_IN + (size_t)2048 * 2048, MTOK, 4096, 1024, E, -1); }
        PH_END
        PH_BEGIN
        { EpiGB E{ws, ss_attn, PQ->in[I_ALOG] + layer * 8, PQ->in[I_DTB] + layer * 8};
          GEMM_PHASE(EpiGB, XB, ws + W_IN + (size_t)6144 * 2048, MTOK, 256, 1024, E, -1); }
        PH_END
        PH_BEGIN
        { EpiVt E{(bf16_t*)(ws + WS_VT), ss_attn};
          GEMM_PHASE(EpiVt, ws + W_V, XB, 1024, MTOK, 1024, E, -1); }
        PH_END
#endif
        GRID_SYNC();
#ifndef NO_ATTN
        PH_BEGIN
        { const float* lq = PQ->in[I_LAM] + layer * 256;
          const float a1 = wave_sum(lq[lane] * lq[64 + lane]), a2 = wave_sum(lq[128 + lane] * lq[192 + lane]);
          const float lam = __expf(a1) - __expf(a2) + lam_init;
          for (int k = 0; k < 4; ++k) {
              const int pi = jb_ + 32 * k, hh = pi >> 4, s = pi & 15;
              attn_unit(lds, (const bf16_t*)(ws + WS_QA), (const bf16_t*)(ws + WS_KA), (const bf16_t*)(ws + WS_VT), (bf16_t*)(ws + WS_QA), xb_, hh, 31 - s, lam, 1.f - lam_init, PQ->in[I_SUBLN] + layer * 128, PQ->in[I_RELB], tid);
              attn_unit(lds, (const bf16_t*)(ws + WS_QA), (const bf16_t*)(ws + WS_KA), (const bf16_t*)(ws + WS_VT), (bf16_t*)(ws + WS_QA), xb_, hh, s, lam, 1.f - lam_init, PQ->in[I_SUBLN] + layer * 128, PQ->in[I_RELB], tid);
          }
        }
        PH_END
#endif
#ifndef NO_DN
        PH_BEGIN
#ifdef DN_NAIVE
        if (jb_ < 8) dn_naive(lds, ws, PQ->in[I_CONVB] + (size_t)layer * 4 * 3072, xb_, jb_, tid);
#else
#ifdef DN_FAST1
        dn_fast(lds, ws, PQ->in[I_CONVB] + (size_t)layer * 4 * 3072, xb_, jb_ >> 2, jb_ & 3, tid);
#else
        dn_pc(lds, ws, PQ->in[I_CONVB] + (size_t)layer * 4 * 3072, xb_, jb_ >> 2, jb_ & 3, tid);
#endif
#endif
        PH_END
#endif
        GRID_SYNC();
#if defined(DBLMIX) && defined(DBLMIX_AT_GATES)
        for (int rep = 0; rep < 2; ++rep) {
#endif
#ifndef NO_GATES
        PH_BEGIN
        { EpiRowScale<1> E{(bf16_t*)(ws + WS_G), 2048, ss_attn, -1};
          GEMM_PHASE(EpiRowScale<1>, XB, ws + W_GL, MTOK, 2048, 1024, E, -1); }
        PH_END
#endif
#ifndef NO_OBNORM
        PH_BEGIN
        { const float* on = PQ->in[I_ONORM] + layer * 128;
          const float g0 = on[2 * lane], g1 = on[2 * lane + 1];
          unsigned* OB = (unsigned*)(ws + WS_QB) + (size_t)xb_ * SEQ * 512; const unsigned* OI = (const unsigned*)(ws + WS_OSRC) + (size_t)xb_ * SEQ * 512; const unsigned* ZB = (const unsigned*)(ws + WS_ZB) + (size_t)xb_ * SEQ * 512;
          for (int r = wj; r < SEQ * NH; r += 256) {
              const unsigned ov = OI[(size_t)r * 64 + lane], zv = ZB[(size_t)r * 64 + lane];
              const float o0 = bflo(ov), o1 = bfhi(ov);
              const float sq = wave_sum(o0 * o0 + o1 * o1);
              const float rr = rsqrtf(sq * (1.f / 128.f) + EPS);
              OB[(size_t)r * 64 + lane] = pk2(o0 * rr * g0 * siluf_(bflo(zv)), o1 * rr * g1 * siluf_(bfhi(zv)));
          }
        }
        PH_END
#endif
        GRID_SYNC();
#ifndef NO_TMPA
        PH_BEGIN
        { EpiGateMul E{(bf16_t*)(ws + WS_TMPA), (const bf16_t*)(ws + WS_G), 2048, 0, nullptr};
          GEMM_PHASE(EpiGateMul, ws + WS_QA, ws + W_BRA, MTOK, 1024, 1024, E, -1); }
        PH_END
#endif
        GRID_SYNC();
#ifndef NO_MIXED
        PH_BEGIN
        { EpiGateMul E{(bf16_t*)(ws + WS_MIXED), (const bf16_t*)(ws + WS_G), 2048, 1024, (const bf16_t*)(ws + WS_TMPA)};
          GEMM_PHASE(EpiGateMul, ws + WS_QB, ws + W_BRB, MTOK, 1024, 1024, E, -1); }
        PH_END
#endif
        GRID_SYNC();
#ifdef DBLMIX
        PH_BEGIN
        { const u32x4* t4 = (const u32x4*)(ws + (size_t)DBL_TGT + (size_t)xb_ * ((size_t)DBL_TGT_BYTES / 8)); u32x4* s4 = (u32x4*)(ws + WS_PB + (size_t)xb_ * 2 * MiB); unsigned bad = 0u;
          for (size_t i = (size_t)((jb_ + 5 * rep) & 31) * NTHR + tid; i < (size_t)2 * MiB / 16; i += (size_t)32 * NTHR) {
              const u32x4 a = t4[i];
              if (rep == 0) s4[i] = a; else { const u32x4 b = s4[i]; bad |= ((a.x ^ b.x) | (a.y ^ b.y) | (a.z ^ b.z) | (a.w ^ b.w)) ? 1u : 0u; } }
          if (bad) __hip_atomic_fetch_or((unsigned*)(ws + WS_CTL) + 16, 1u, __ATOMIC_RELAXED, __HIP_MEMORY_SCOPE_AGENT); }
        PH_END
        GRID_SYNC();
        }
#endif
#ifndef NO_OUTP
        PH_BEGIN
        { EpiResid E{X, XB, ss_ffn, nullptr, -1};
          GEMM_PHASE(EpiResid, ws + WS_MIXED, ws + W_OUT, MTOK, 1024, 1024, E, -1); }
        PH_END
#endif
        GRID_SYNC();
        for (int half = 0; half < 2; ++half) {
#ifndef NO_UP
        PH_BEGIN
            { EpiRowScale<0> E{U, 5632, ss_ffn, half};
              GEMM_PHASE(EpiRowScale<0>, XB, ws + W_UP, 16384, 5632, 1024, E, half); }
        PH_END
#endif
            GRID_SYNC();
#ifndef NO_ACT
        PH_BEGIN
            { const float* cw = PQ->in[I_CONVFF] + (size_t)layer * 3 * 5632; const float* cb = PQ->in[I_CONVFFB] + (size_t)layer * 5632;
              bf16_t* UH = (bf16_t*)(ws + WS_UHALO) + (size_t)xb_ * 2 * 5632;
              for (int it = jb_ * NTHR + tid; it < 128 * 352; it += 32 * NTHR) {
                  const int cc = it % 352, rg = it / 352, c0 = cc * 8;
                  const int lrow0 = xb_ * 2048 + rg * 16;
                  float wg[3][8], wv[3][8], bg[8], bv[8];
#pragma unroll
                  for (int jj = 0; jj < 3; ++jj)
#pragma unroll
                      for (int e = 0; e < 8; ++e) { wg[jj][e] = cw[jj * 5632 + c0 + e]; wv[jj][e] = cw[jj * 5632 + 2816 + c0 + e]; }
#pragma unroll
                  for (int e = 0; e < 8; ++e) { bg[e] = cb[c0 + e]; bv[e] = cb[2816 + c0 + e]; }
                  float g2[8], g1[8], v2[8], v1[8];
#pragma unroll
                  for (int e = 0; e < 8; ++e) { g2[e] = 0.f; g1[e] = 0.f; v2[e] = 0.f; v1[e] = 0.f; }
                  if (rg > 0 || half == 1) {
                      const bf16_t* r2p = rg > 0 ? U + (size_t)(lrow0 - 2) * 5632 : UH;
                      const bf16_t* r1p = rg > 0 ? U + (size_t)(lrow0 - 1) * 5632 : UH + 5632;
                      const u32x4 a = *(const u32x4*)(r2p + c0), bq = *(const u32x4*)(r1p + c0);
                      const u32x4 c = *(const u32x4*)(r2p + 2816 + c0), d = *(const u32x4*)(r1p + 2816 + c0);
                      g2[0] = bflo(a.x); g2[1] = bfhi(a.x); g2[2] = bflo(a.y); g2[3] = bfhi(a.y); g2[4] = bflo(a.z); g2[5] = bfhi(a.z); g2[6] = bflo(a.w); g2[7] = bfhi(a.w);
                      g1[0] = bflo(bq.x); g1[1] = bfhi(bq.x); g1[2] = bflo(bq.y); g1[3] = bfhi(bq.y); g1[4] = bflo(bq.z); g1[5] = bfhi(bq.z); g1[6] = bflo(bq.w); g1[7] = bfhi(bq.w);
                      v2[0] = bflo(c.x); v2[1] = bfhi(c.x); v2[2] = bflo(c.y); v2[3] = bfhi(c.y); v2[4] = bflo(c.z); v2[5] = bfhi(c.z); v2[6] = bflo(c.w); v2[7] = bfhi(c.w);
                      v1[0] = bflo(d.x); v1[1] = bfhi(d.x); v1[2] = bflo(d.y); v1[3] = bfhi(d.y); v1[4] = bflo(d.z); v1[5] = bfhi(d.z); v1[6] = bflo(d.w); v1[7] = bfhi(d.w);
                  }
                  for (int rr = 0; rr < 16; ++rr) {
                      const size_t row = (size_t)lrow0 + rr;
                      const u32x4 a = *(const u32x4*)(U + row * 5632 + c0), c = *(const u32x4*)(U + row * 5632 + 2816 + c0);
                      if (half == 0 && rg == 127 && rr >= 14) { *(u32x4*)(UH + (size_t)(rr - 14) * 5632 + c0) = a; *(u32x4*)(UH + (size_t)(rr - 14) * 5632 + 2816 + c0) = c; }
                      float g0[8], v0[8], ov[8];
                      g0[0] = bflo(a.x); g0[1] = bfhi(a.x); g0[2] = bflo(a.y); g0[3] = bfhi(a.y); g0[4] = bflo(a.z); g0[5] = bfhi(a.z); g0[6] = bflo(a.w); g0[7] = bfhi(a.w);
                      v0[0] = bflo(c.x); v0[1] = bfhi(c.x); v0[2] = bflo(c.y); v0[3] = bfhi(c.y); v0[4] = bflo(c.z); v0[5] = bfhi(c.z); v0[6] = bflo(c.w); v0[7] = bfhi(c.w);
#pragma unroll
                      for (int e = 0; e < 8; ++e) {
                          const float ug = wg[0][e] * g2[e] + wg[1][e] * g1[e] + wg[2][e] * g0[e] + bg[e];
                          const float uv = wv[0][e] * v2[e] + wv[1][e] * v1[e] + wv[2][e] * v0[e] + bv[e];
                          ov[e] = siluf_(ug) * uv; g2[e] = g1[e]; g1[e] = g0[e]; v2[e] = v1[e]; v1[e] = v0[e];
                      }
                      u32x4 w; w.x = pk2(ov[0], ov[1]); w.y = pk2(ov[2], ov[3]); w.z = pk2(ov[4], ov[5]); w.w = pk2(ov[6], ov[7]);
                      *(u32x4*)(ACT + row * 2816 + c0) = w;
                  }
              }
            }
        PH_END
#endif
            GRID_SYNC();
#ifndef NO_DOWN
        PH_BEGIN
            { EpiResid E{X, XB, ss_ple, nullptr, half};
              GEMM_PHASE(EpiResid, ACT, ws + W_DOWN, 16384, 1024, 2816, E, -1); }
        PH_END
#endif
            GRID_SYNC();
        }
#ifndef NO_PLEG
        PH_BEGIN
        { EpiRowScale<1> E{(bf16_t*)(ws + WS_MIX), 1024, ss_ple, -1};
          GEMM_PHASE(EpiRowScale<1>, XB, ws + W_PG, MTOK, 1024, 1024, E, -1); }
        PH_END
#endif
        GRID_SYNC();
#ifndef NO_PLE
        PH_BEGIN
        { EpiResid E{X, XB, ss_next, (const bf16_t*)(ws + WS_MIX), -1};
          GEMM_PHASE(EpiResid, ws + WS_PB, ws + W_PP, MTOK, 1024, 256, E, -1); }
        PH_END
#endif
        GRID_SYNC();
    }
#ifdef NANCHK
    { const int layer = 0; PH_BEGIN
      unsigned bad = 0u;
      for (size_t i = (size_t)bid * NTHR + tid; i < (size_t)MTOK * 256; i += (size_t)G * NTHR) { const f32x4 v = *(const f32x4*)(X + i * 4);
          for (int e = 0; e < 4; ++e) bad |= ((__float_as_uint(v[e]) & 0x7f800000u) == 0x7f800000u) ? 1u : 0u; }
#ifdef NANCHK_BF_LO
      { const unsigned* bp = (const unsigned*)(ws + (size_t)NANCHK_BF_LO); const size_t nw = ((size_t)NANCHK_BF_HI - (size_t)NANCHK_BF_LO) / 4;
        for (size_t i = (size_t)bid * NTHR + tid; i < nw; i += (size_t)G * NTHR) { const unsigned w = bp[i]; bad |= (((w & 0x7f80u) == 0x7f80u) || ((w & 0x7f800000u) == 0x7f800000u)) ? 1u : 0u; } }
#endif
      if (bad) __hip_atomic_fetch_or((unsigned*)(ws + WS_CTL) + 16, 1u, __ATOMIC_RELAXED, __HIP_MEMORY_SCOPE_AGENT);
      PH_END }
    GRID_SYNC();
    { const int layer = 0; PH_BEGIN
      const unsigned fl = __hip_atomic_fetch_or((unsigned*)(ws + WS_CTL) + 16, 0u, __ATOMIC_RELAXED, __HIP_MEMORY_SCOPE_AGENT);
      if (fl) for (size_t i = (size_t)bid * NTHR + tid; i < (size_t)MTOK * 256; i += (size_t)G * NTHR) *(f32x4*)(X + i * 4) = (f32x4){0.f, 0.f, 0.f, 0.f};
      PH_END }
#endif
#undef U
#undef ACT
}

extern "C" void kernel_launch(void* const* d_in, const int* in_sizes, int n_in, void* d_out, int out_size, void* d_ws, size_t ws_size, hipStream_t stream) {
    static int grid = 0;
    if (grid == 0) {
        if (n_in != 24 || out_size != MTOK * DM || ws_size < WS_TOTAL) { fprintf(stderr, "kernel_launch: unexpected shapes / workspace (n_in %d out %d ws %zu need %zu)\n", n_in, out_size, ws_size, (size_t)WS_TOTAL); grid = -1; return; }
        int dev = 0, cus = 0, per_cu = 0;
        hipGetDevice(&dev);
        hipDeviceGetAttribute(&cus, hipDeviceAttributeMultiprocessorCount, dev);
        hipFuncSetAttribute((const void*)fwd_mega, hipFuncAttributeMaxDynamicSharedMemorySize, LDS_BYTES);
        hipOccupancyMaxActiveBlocksPerMultiprocessor(&per_cu, (const void*)fwd_mega, NTHR, LDS_BYTES);
        if (per_cu < 1) { fprintf(stderr, "kernel_launch: occupancy query says %d blocks per CU\n", per_cu); per_cu = 1; }
        (void)hipGetLastError();
        grid = cus;
    }
    if (grid < 0) return;
    Params p{};
    for (int i = 0; i < 24; ++i) p.in[i] = (const float*)d_in[i];
    p.out = (float*)d_out; p.ws = (unsigned char*)d_ws;
    hipError_t e = hipSuccess;
#ifdef N_SEG_LAUNCH
    for (int sgi = 0; sgi < 60 && e == hipSuccess; sgi += N_SEG_LAUNCH) {
        p.seg_lo = sgi; p.seg_hi = sgi + N_SEG_LAUNCH;
        void* args[] = {&p};
        e = hipLaunchCooperativeKernel((const void*)fwd_mega, dim3(grid), dim3(NTHR), args, LDS_BYTES, stream);
    }
#else
    p.seg_lo = 0; p.seg_hi = 1000;
    void* args[] = {&p};
    e = hipLaunchCooperativeKernel((const void*)fwd_mega, dim3(grid), dim3(NTHR), args, LDS_BYTES, stream);
#endif
    if (e != hipSuccess) fprintf(stderr, "cooperative launch failed: %s (grid %d)\n", hipGetErrorString(e), grid);
}
```

```cpp
#include <hip/hip_runtime.h>
#include <hip/hip_cooperative_groups.h>
#include <cstdio>
#include <cstdint>
namespace cg = cooperative_groups;
namespace pg8 {
#define PG8_LAS __attribute__((address_space(3)))
typedef unsigned short bf16_t;
typedef short bf16x8 __attribute__((ext_vector_type(8)));
typedef float f32x4 __attribute__((ext_vector_type(4)));
typedef unsigned u32x4 __attribute__((ext_vector_type(4)));
constexpr int BM = 256, BK = 64, HALF = 128, HTB = HALF * BK * 2  , STAGE_BYTES = 8 * HTB, NXCD = 8, WGM = 8;

__host__ __device__ __forceinline__ int lds_byte(int r, int c) { const int st = (r >> 4) * 2 + (c >> 5), rr = r & 15, cc = c & 31, ob = rr * 64 + cc * 2; return st * 1024 + (ob ^ (((ob >> 9) & 1) << 5)); }
__host__ __device__ __forceinline__ void stage_rc(int b, int& R, int& C) { const int st = b / 1024, sb = b % 1024, swz = sb ^ (((sb >> 9) & 1) << 5); R = (st >> 1) * 16 + swz / 64; C = (st & 1) * 32 + (swz % 64) / 2; }
__host__ __device__ __forceinline__ int perm32(int rho) { const int n = rho >> 4, i = rho & 15; return 8 * (i >> 2) + 4 * n + (i & 3); }

struct Unit { int pm, pn; };
struct Gemm { const bf16_t* A; const bf16_t* Bt; int M, N, K; int hmap; };
__device__ __forceinline__ int amap(int pm, int hmap) { return hmap < 0 ? pm : ((pm >> 3) * 16 + 8 * hmap + (pm & 7)); }

struct StaticOrder {
    int nM, nN, nwg, G, c;
    __host__ __device__ void init(int M, int N, int G_, int c_) { nM = M / BM; nN = N / BM; nwg = nM * nN; G = G_; c = c_; }
    __host__ __device__ bool next(int i, Unit& u) const {
        const long L = (long)i * G + c; if (L >= nwg) return false;
        int wgid = (int)L; { const int q = nwg / NXCD, r = nwg % NXCD, xcd = wgid % NXCD, off = wgid / NXCD; wgid = (xcd < r ? xcd * (q + 1) : r * (q + 1) + (xcd - r) * q) + off; }
        const int nig = WGM * nN, gid = wgid / nig, fm = gid * WGM, gsz = (nM - fm) < WGM ? (nM - fm) : WGM;
        u.pm = fm + ((wgid % nig) % gsz); u.pn = (wgid % nig) / gsz; return true;
    }
    __device__ __forceinline__ void a_ready(const Unit&) const {}
    __device__ __forceinline__ void done(const Unit&) const {}
};
__device__ __forceinline__ unsigned cvt_pk_bf16(float lo, float hi) { unsigned r; asm volatile("v_cvt_pk_bf16_f32 %0, %1, %2" : "=v"(r) : "v"(lo), "v"(hi)); return r; }
#ifdef NO_UNI
__device__ __forceinline__ const char* uni(const char* p) { return p; }
#else
__device__ __forceinline__ const char* uni(const char* p) { const unsigned long long v = (unsigned long long)p; const unsigned lo = __builtin_amdgcn_readfirstlane((unsigned)v), hi = __builtin_amdgcn_readfirstlane((unsigned)(v >> 32)); return (const char*)(((unsigned long long)hi << 32) | lo); }
#endif
template <class Epi, class Sched, bool ALIGN_EPI = false, bool SP2 = false>
__device__ __forceinline__ void gemm_phase(PG8_LAS unsigned char* lds, const Gemm g, const Sched& S, const Epi& E) {
    int tid = threadIdx.x;
#ifndef NO_LAUNDER
    asm volatile("" : "+v"(tid));
#endif

    const int wid = __builtin_amdgcn_readfirstlane(tid >> 6), lane = tid & 63, wr = wid >> 2, wc = wid & 3, fr = lane & 15, fq = lane >> 4;
    const int K = g.K, nt = K / BK;
    unsigned voffA[2], voffB[2];
#pragma unroll
    for (int i = 0; i < 2; ++i) { int R, C; stage_rc(tid * 16 + i * 8192, R, C); const int Rb = Epi::PERM ? ((R & ~31) + perm32(R & 31)) : R;
        voffA[i] = (unsigned)(R * K + C) * 2u; voffB[i] = (unsigned)(Rb * K + C) * 2u; }
    const size_t kstep = (size_t)(BK * 2);
    const size_t hstep = (size_t)HALF * K * 2;
    const size_t tstep = 2 * hstep;
    const unsigned ldsw = (unsigned)wid * 1024u;
    const int aoff = lds_byte(wr * 64 + fr, fq * 8), boff = lds_byte(wc * 32 + fr, fq * 8);
#define PG8_SA(b, h) (((b) * 2 + (h)) * HTB)
#define PG8_SB(b, h) ((4 + (b) * 2 + (h)) * HTB)
#define PG8_STAGE(bufoff, gbase, voff) do { _Pragma("unroll") for (int _i = 0; _i < 2; ++_i) \
        __builtin_amdgcn_global_load_lds((const unsigned*)((const char*)(gbase) + (voff)[_i]), (PG8_LAS unsigned*)(lds + (bufoff) + ldsw + _i * 8192), 16, 0, 0); } while (0)
#define PG8_LDA(dst, b, h) do { _Pragma("unroll") for (int m = 0; m < 4; ++m) _Pragma("unroll") for (int k = 0; k < 2; ++k) dst[m][k] = *(const PG8_LAS bf16x8*)(lds + PG8_SA(b, h) + aoff + m * 2048 + k * 1024); } while (0)
#define PG8_LDB(dst, b, h) do { _Pragma("unroll") for (int n = 0; n < 2; ++n) _Pragma("unroll") for (int k = 0; k < 2; ++k) dst[n][k] = *(const PG8_LAS bf16x8*)(lds + PG8_SB(b, h) + boff + n * 2048 + k * 1024); } while (0)
#define PG8_MMA(ai, bj, At, Bt) do { __builtin_amdgcn_s_setprio(1); _Pragma("unroll") for (int m = 0; m < 4; ++m) _Pragma("unroll") for (int n = 0; n < 2; ++n) _Pragma("unroll") for (int k = 0; k < 2; ++k) \
        acc[ai][bj][m][n] = __builtin_amdgcn_mfma_f32_16x16x32_bf16(Bt[n][k], At[m][k], acc[ai][bj][m][n], 0, 0, 0); __builtin_amdgcn_s_setprio(0); } while (0)
#define PG8_WAIT_V(n) asm volatile("s_waitcnt vmcnt(" #n ")" ::: "memory")
#define PG8_WAIT_L(n) asm volatile("s_waitcnt lgkmcnt(" #n ")" ::: "memory")
#define PG8_BAR __builtin_amdgcn_s_barrier()
#define PG8_SCHED __builtin_amdgcn_sched_barrier(0)
    Unit cur, nxt; int ui = 0;
    if (!S.next(0, cur)) return;
    f32x4 acc[2][2][4][2];
#pragma unroll
    for (int a = 0; a < 2; ++a)
#pragma unroll
        for (int b = 0; b < 2; ++b)
#pragma unroll
            for (int m = 0; m < 4; ++m)
#pragma unroll
                for (int n = 0; n < 2; ++n) acc[a][b][m][n] = (f32x4){0.f, 0.f, 0.f, 0.f};
    bf16x8 At[4][2], B0[2][2], B1[2][2];
    const char* cA = uni((const char*)g.A + (size_t)amap(cur.pm, g.hmap) * tstep); const char* cB = uni((const char*)g.Bt + (size_t)cur.pn * tstep);
    S.a_ready(cur);
    if constexpr (SP2) {
        PG8_STAGE(PG8_SB(0, 0), cB, voffB); PG8_STAGE(PG8_SB(0, 1), cB + hstep, voffB); PG8_STAGE(PG8_SA(0, 0), cA, voffA); PG8_STAGE(PG8_SA(0, 1), cA + hstep, voffA);
        if (wr == 1) PG8_BAR;
        PG8_WAIT_V(2); PG8_BAR;
        PG8_STAGE(PG8_SB(1, 0), cB + kstep, voffB); PG8_STAGE(PG8_SA(1, 0), cA + kstep, voffA); PG8_STAGE(PG8_SB(1, 1), cB + hstep + kstep, voffB);
        PG8_WAIT_V(6); PG8_BAR;
    } else {
        PG8_STAGE(PG8_SB(0, 0), cB, voffB); PG8_STAGE(PG8_SA(0, 0), cA, voffA); PG8_STAGE(PG8_SB(0, 1), cB + hstep, voffB); PG8_STAGE(PG8_SA(0, 1), cA + hstep, voffA);
        if (wr == 1) PG8_BAR;
        PG8_WAIT_V(4); PG8_BAR;
        PG8_STAGE(PG8_SB(1, 0), cB + kstep, voffB); PG8_STAGE(PG8_SA(1, 0), cA + kstep, voffA); PG8_STAGE(PG8_SB(1, 1), cB + hstep + kstep, voffB);
        PG8_WAIT_V(6); PG8_BAR;
    }
    for (;;) {
        const bool has_next = S.next(ui + 1, nxt);
        const char* nA = uni(has_next ? (const char*)g.A + (size_t)amap(nxt.pm, g.hmap) * tstep : cA); const char* nB = uni(has_next ? (const char*)g.Bt + (size_t)nxt.pn * tstep : cB);
        for (int t = 0; t < nt; t += 2) {
            const bool last = (t == nt - 2);
            const char* a1 = cA + (size_t)(t + 1) * kstep;
            const char* a2 = last ? nA : cA + (size_t)(t + 2) * kstep; const char* b2 = last ? nB : cB + (size_t)(t + 2) * kstep;
            const char* a3 = a2 + kstep; const char* b3 = b2 + kstep;
            if (last && has_next) S.a_ready(nxt);
            if constexpr (SP2) {
            PG8_LDB(B0, 0, 0); PG8_LDB(B1, 0, 1); PG8_SCHED; PG8_LDA(At, 0, 0); PG8_STAGE(PG8_SA(1, 1), a1 + hstep, voffA);
            PG8_WAIT_V(8); PG8_WAIT_L(0); PG8_BAR; PG8_MMA(0, 0, At, B0); PG8_MMA(0, 1, At, B1); PG8_BAR; PG8_SCHED;
            PG8_LDA(At, 0, 1); PG8_STAGE(PG8_SB(0, 0), b2, voffB); PG8_STAGE(PG8_SB(0, 1), b2 + hstep, voffB); PG8_STAGE(PG8_SA(0, 0), a2, voffA);
            PG8_WAIT_V(8); PG8_WAIT_L(0); PG8_BAR; PG8_MMA(1, 0, At, B0); PG8_MMA(1, 1, At, B1); PG8_BAR; PG8_SCHED;
            PG8_LDB(B0, 1, 0); PG8_LDB(B1, 1, 1); PG8_SCHED; PG8_LDA(At, 1, 0); PG8_STAGE(PG8_SA(0, 1), a2 + hstep, voffA);
            PG8_WAIT_V(8); PG8_WAIT_L(0); PG8_BAR; PG8_MMA(0, 0, At, B0); PG8_MMA(0, 1, At, B1); PG8_BAR; PG8_SCHED;
            PG8_LDA(At, 1, 1); PG8_STAGE(PG8_SB(1, 0), b3, voffB); PG8_STAGE(PG8_SB(1, 1), b3 + hstep, voffB); PG8_STAGE(PG8_SA(1, 0), a3, voffA);
            PG8_WAIT_V(8); PG8_WAIT_L(0); PG8_BAR; PG8_MMA(1, 0, At, B0); PG8_MMA(1, 1, At, B1); PG8_BAR; PG8_SCHED;
            } else {
            PG8_LDB(B0, 0, 0); PG8_SCHED; PG8_LDA(At, 0, 0); PG8_STAGE(PG8_SA(1, 1), a1 + hstep, voffA);
            PG8_WAIT_L(8); PG8_BAR; PG8_WAIT_L(0); PG8_MMA(0, 0, At, B0); PG8_BAR; PG8_SCHED;
            PG8_LDB(B1, 0, 1); PG8_STAGE(PG8_SB(0, 0), b2, voffB);
            PG8_BAR; PG8_WAIT_L(0); PG8_MMA(0, 1, At, B1); PG8_BAR;
            PG8_LDA(At, 0, 1); PG8_STAGE(PG8_SA(0, 0), a2, voffA);
            PG8_BAR; PG8_WAIT_L(0); PG8_MMA(1, 0, At, B0); PG8_BAR; PG8_SCHED;
            PG8_STAGE(PG8_SB(0, 1), b2 + hstep, voffB);
            PG8_WAIT_V(6); PG8_BAR; PG8_MMA(1, 1, At, B1); PG8_BAR;
            PG8_LDB(B0, 1, 0); PG8_SCHED; PG8_LDA(At, 1, 0); PG8_STAGE(PG8_SA(0, 1), a2 + hstep, voffA);
            PG8_WAIT_L(8); PG8_BAR; PG8_WAIT_L(0); PG8_MMA(0, 0, At, B0); PG8_BAR; PG8_SCHED;
            PG8_LDB(B1, 1, 1); PG8_STAGE(PG8_SB(1, 0), b3, voffB);
            PG8_BAR; PG8_WAIT_L(0); PG8_MMA(0, 1, At, B1); PG8_BAR;
            PG8_LDA(At, 1, 1); PG8_STAGE(PG8_SA(1, 0), a3, voffA);
            PG8_BAR; PG8_WAIT_L(0); PG8_MMA(1, 0, At, B0); PG8_BAR; PG8_SCHED;
            PG8_STAGE(PG8_SB(1, 1), b3 + hstep, voffB);
            PG8_WAIT_V(6); PG8_BAR; PG8_MMA(1, 1, At, B1); PG8_BAR;
            }
        }
        if constexpr (ALIGN_EPI) { if (wr == 0) PG8_BAR; }
        if constexpr (!Epi::AFTER_DRAIN) { E(acc, cur, wr, wc, fr, fq); S.done(cur); }
        if (!has_next) break;
#pragma unroll
        for (int a = 0; a < 2; ++a)
#pragma unroll
            for (int b = 0; b < 2; ++b)
#pragma unroll
                for (int m = 0; m < 4; ++m)
#pragma unroll
                    for (int n = 0; n < 2; ++n) acc[a][b][m][n] = (f32x4){0.f, 0.f, 0.f, 0.f};
        cur = nxt; cA = nA; cB = nB; ++ui;
        if constexpr (ALIGN_EPI) { if (wr == 1) PG8_BAR; }
    }
    PG8_WAIT_V(0);
    if constexpr (!ALIGN_EPI) { if (wr == 0) PG8_BAR; }
    PG8_BAR;
    if constexpr (Epi::AFTER_DRAIN) { E.fused(acc, cur, wr, wc, fr, fq, lds, wid, lane); S.done(cur); }
#undef PG8_SA
#undef PG8_SB
#undef PG8_STAGE
#undef PG8_LDA
#undef PG8_LDB
#undef PG8_MMA
#undef PG8_WAIT_V
#undef PG8_WAIT_L
#undef PG8_BAR
#undef PG8_SCHED
}
}

#define GAS __attribute__((address_space(1)))
#define LAS __attribute__((address_space(3)))
typedef unsigned short bf16_t;
typedef float f32x4 __attribute__((ext_vector_type(4)));
typedef float f32x16 __attribute__((ext_vector_type(16)));
typedef short bf16x8 __attribute__((ext_vector_type(8)));
typedef unsigned u32x4 __attribute__((ext_vector_type(4)));
typedef unsigned u32x2 __attribute__((ext_vector_type(2)));

#ifndef NLAYER_V
#define NLAYER_V 4
#endif
constexpr int NW = 8, NTHR = 512;
constexpr int MTOK = 32768, DM = 1024, SEQ = 4096, NB = 8, NLAYER = NLAYER_V, NH = 8;
constexpr int DIN = 9232, DFF = 2816, DPLE = 256;
constexpr float EPS = 1e-6f;
constexpr float LOG2E = 1.4426950408889634f;
constexpr size_t MiB = 1u << 20;
constexpr size_t WS_SS = 0;
constexpr size_t WS_CTL = 1792 * 1024;
constexpr size_t WS_UHALO = 1856 * 1024;
constexpr size_t WS_GB = 2 * MiB;
constexpr size_t WS_HALO = 4 * MiB;
constexpr size_t WS_PB = 14 * MiB;
constexpr size_t WS_W = 30 * MiB;
constexpr size_t W_IN = WS_W, W_V = W_IN + (size_t)6400 * 1024 * 2, W_GL = W_V + 2 * MiB, W_BRA = W_GL + 4 * MiB, W_BRB = W_BRA + 2 * MiB,
                 W_OUT = W_BRB + 2 * MiB, W_UP = W_OUT + 2 * MiB, W_DOWN = W_UP + 11 * MiB, W_PG = W_DOWN + (size_t)1024 * 2816 * 2, W_PP = W_PG + 2 * MiB, W_END = W_PP + (size_t)1024 * 256 * 2;
static_assert(W_END <= 74 * MiB, "weights region");
constexpr size_t WS_XB = 74 * MiB;
constexpr size_t WS_MIX = 138 * MiB;
constexpr size_t S64 = 64 * MiB;
constexpr size_t WS_QA = WS_MIX, WS_KA = WS_MIX + S64, WS_VT = WS_MIX + 2 * S64, WS_QB = WS_MIX + 3 * S64, WS_KB = WS_MIX + 4 * S64, WS_VB = WS_MIX + 5 * S64, WS_ZB = WS_MIX + 6 * S64;
constexpr size_t WS_TOTAL = WS_MIX + 7 * S64;
#ifdef DN_NAIVE
constexpr size_t WS_G = WS_KB, WS_TMPA = WS_KA, WS_MIXED = WS_VT, WS_OSRC = WS_QB;
#else
constexpr size_t WS_G = WS_KA, WS_TMPA = WS_KB, WS_MIXED = WS_VB, WS_OSRC = WS_VB;
#endif
constexpr int LDS_BYTES = 147456, LDS_VB = 140032;

__device__ __forceinline__ float bflo(unsigned w) { return __uint_as_float(w << 16); }
__device__ __forceinline__ float bfhi(unsigned w) { return __uint_as_float(w & 0xffff0000u); }
__device__ __forceinline__ float bf2f(bf16_t v) { return __uint_as_float((unsigned)v << 16); }
typedef float f32x2_t __attribute__((ext_vector_type(2))); typedef __bf16 bf16x2_t __attribute__((ext_vector_type(2)));
__device__ __forceinline__ unsigned pk2(float lo, float hi) { const f32x2_t v = {lo, hi}; const bf16x2_t b = __builtin_convertvector(v, bf16x2_t); return __builtin_bit_cast(unsigned, b); }
__device__ __forceinline__ bf16_t f2bf(float f) { return (bf16_t)(pk2(f, 0.f) & 0xffffu); }
__device__ __forceinline__ float sigmoidf_(float x) { x = fminf(fmaxf(x, -60.f), 60.f); return __builtin_amdgcn_rcpf(1.f + __expf(-x)); }
__device__ __forceinline__ float siluf_(float x) { return x * sigmoidf_(x); }
__device__ __forceinline__ float wave_sum(float v) {
#pragma unroll
    for (int o = 1; o < 64; o <<= 1) v += __shfl_xor(v, o);
    return v;
}
__device__ __forceinline__ float ss_load(const float* p) { const f32x4 a = *(const f32x4*)p, b = *(const f32x4*)(p + 4), c = *(const f32x4*)(p + 8), d = *(const f32x4*)(p + 12);
    float s = (((a[0] + a[1]) + (a[2] + a[3])) + ((b[0] + b[1]) + (b[2] + b[3]))) + (((c[0] + c[1]) + (c[2] + c[3])) + ((d[0] + d[1]) + (d[2] + d[3])));
    asm volatile("" : "+v"(s) :: "memory");
    return s; }
__device__ __forceinline__ u32x4 ldc16(const void* p) { u32x4 v; asm volatile("global_load_dwordx4 %0, %1, off sc0 sc1\n\ts_waitcnt vmcnt(0)" : "=v"(v) : "v"(p) : "memory"); return v; }
__device__ __forceinline__ int crow(int r, int hi) { return (r & 3) + 8 * (r >> 2) + 4 * hi; }

__device__ __forceinline__ int gmap(int row, int h) { return h < 0 ? row : ((row >> 11) * 4096 + 2048 * h + (row & 2047)); }

using pg8::Unit;
typedef f32x4 AccT[2][2][4][2];

template <int ACT> struct EpiRowScale {
    static constexpr bool PERM = true, AFTER_DRAIN = false;
    bf16_t* O; int ldc; const float* ss; int hmap;
    __device__ __forceinline__ void operator()(const AccT& acc, const Unit& u, int wr, int wc, int fr, int fq) const {
        const int row0 = u.pm * 256 + wr * 64 + fr, col0 = u.pn * 256 + wc * 32 + 8 * fq;
#pragma unroll
        for (int ai = 0; ai < 2; ++ai)
#pragma unroll
            for (int m = 0; m < 4; ++m) {
                const int row = row0 + ai * 128 + m * 16;
#ifdef RS_CONST
                const float rs = 1000.f;
#else
                const float rs = rsqrtf(ss_load(ss + (size_t)gmap(row, hmap) * 16) * (1.f / 1024.f) + EPS);
#endif
                bf16_t* rowp = O + (size_t)row * ldc + col0;
#pragma unroll
                for (int bj = 0; bj < 2; ++bj) {
                    f32x4 v0 = acc[ai][bj][m][0] * rs, v1 = acc[ai][bj][m][1] * rs;
                    if (ACT == 1) {
#pragma unroll
                        for (int e = 0; e < 4; ++e) { v0[e] = sigmoidf_(v0[e]); v1[e] = sigmoidf_(v1[e]); }
                    }
                    u32x4 w; w.x = pk2(v0[0], v0[1]); w.y = pk2(v0[2], v0[3]); w.z = pk2(v1[0], v1[1]); w.w = pk2(v1[2], v1[3]);
                    *(u32x4*)(rowp + bj * 128) = w;
                    asm volatile("" ::: "memory");
                }
            }
    }
};

struct EpiVt {
    static constexpr bool PERM = true, AFTER_DRAIN = false;
    bf16_t* O; const float* ss;
    __device__ __forceinline__ void operator()(const AccT& acc, const Unit& u, int wr, int wc, int fr, int fq) const {
        const int row0 = u.pm * 256 + wr * 64 + fr, col0 = u.pn * 256 + wc * 32 + 8 * fq;
        float rs[2][8];
#pragma unroll
        for (int bj = 0; bj < 2; ++bj)
#pragma unroll
            for (int e = 0; e < 8; ++e) rs[bj][e] = rsqrtf(ss_load(ss + (size_t)(col0 + bj * 128 + e) * 16) * (1.f / 1024.f) + EPS);
#pragma unroll
        for (int ai = 0; ai < 2; ++ai)
#pragma unroll
            for (int m = 0; m < 4; ++m) {
                const int row = row0 + ai * 128 + m * 16;
                bf16_t* rowp = O + (size_t)row * MTOK + col0;
#pragma unroll
                for (int bj = 0; bj < 2; ++bj) {
                    const f32x4 v0 = acc[ai][bj][m][0], v1 = acc[ai][bj][m][1];
                    u32x4 w; w.x = pk2(v0[0] * rs[bj][0], v0[1] * rs[bj][1]); w.y = pk2(v0[2] * rs[bj][2], v0[3] * rs[bj][3]);
                    w.z = pk2(v1[0] * rs[bj][4], v1[1] * rs[bj][5]); w.w = pk2(v1[2] * rs[bj][6], v1[3] * rs[bj][7]);
                    *(u32x4*)(rowp + bj * 128) = w;
                }
                asm volatile("" ::: "memory");
            }
    }
};

struct EpiGateMul {
    static constexpr bool PERM = true, AFTER_DRAIN = false;
    bf16_t* O; const bf16_t* G; int ldg, goff; const bf16_t* Add;
    __device__ __forceinline__ void operator()(const AccT& acc, const Unit& u, int wr, int wc, int fr, int fq) const {
        const int row0 = u.pm * 256 + wr * 64 + fr, col0 = u.pn * 256 + wc * 32 + 8 * fq;
#pragma unroll
        for (int ai = 0; ai < 2; ++ai)
#pragma unroll
            for (int m = 0; m < 4; ++m) {
                const int row = row0 + ai * 128 + m * 16;
#pragma unroll
                for (int bj = 0; bj < 2; ++bj) {
                    const int c = col0 + bj * 128;
                    const u32x4 g = *(const u32x4*)(G + (size_t)row * ldg + goff + c);
                    u32x4 a = (u32x4){0u, 0u, 0u, 0u};
                    if (Add) a = *(const u32x4*)(Add + (size_t)row * 1024 + c);
                    const f32x4 v0 = acc[ai][bj][m][0], v1 = acc[ai][bj][m][1];
                    u32x4 w;
                    w.x = pk2(bflo(a.x) + bflo(g.x) * v0[0], bfhi(a.x) + bfhi(g.x) * v0[1]);
                    w.y = pk2(bflo(a.y) + bflo(g.y) * v0[2], bfhi(a.y) + bfhi(g.y) * v0[3]);
                    w.z = pk2(bflo(a.z) + bflo(g.z) * v1[0], bfhi(a.z) + bfhi(g.z) * v1[1]);
                    w.w = pk2(bflo(a.w) + bflo(g.w) * v1[2], bfhi(a.w) + bfhi(g.w) * v1[3]);
                    *(u32x4*)(O + (size_t)row * 1024 + c) = w;
                }
                asm volatile("" ::: "memory");
            }
    }
};

struct EpiResid {
    static constexpr bool PERM = true, AFTER_DRAIN = false;
    float* X; bf16_t* XB; float* ssn; const bf16_t* Mul; int hmap;
    __device__ __forceinline__ void operator()(const AccT& acc, const Unit& u, int wr, int wc, int fr, int fq) const {
        const int row0 = u.pm * 256 + wr * 64 + fr, col0 = u.pn * 256 + wc * 32 + 8 * fq;
#pragma unroll
        for (int ai = 0; ai < 2; ++ai)
#pragma unroll
            for (int m = 0; m < 4; ++m) {
                const int row = gmap(row0 + ai * 128 + m * 16, hmap);
                const size_t off0 = (size_t)row * 1024 + col0;
                f32x4 xa = *(const f32x4*)(X + off0), xb2 = *(const f32x4*)(X + off0 + 4), xc = *(const f32x4*)(X + off0 + 128), xd = *(const f32x4*)(X + off0 + 132);
                f32x4 va = acc[ai][0][m][0], vb2 = acc[ai][0][m][1], vc = acc[ai][1][m][0], vd = acc[ai][1][m][1];
                if (Mul) {
                    const u32x4 g0 = *(const u32x4*)(Mul + off0), g1 = *(const u32x4*)(Mul + off0 + 128);
                    va[0] *= bflo(g0.x); va[1] *= bfhi(g0.x); va[2] *= bflo(g0.y); va[3] *= bfhi(g0.y); vb2[0] *= bflo(g0.z); vb2[1] *= bfhi(g0.z); vb2[2] *= bflo(g0.w); vb2[3] *= bfhi(g0.w);
                    vc[0] *= bflo(g1.x); vc[1] *= bfhi(g1.x); vc[2] *= bflo(g1.y); vc[3] *= bfhi(g1.y); vd[0] *= bflo(g1.z); vd[1] *= bfhi(g1.z); vd[2] *= bflo(g1.w); vd[3] *= bfhi(g1.w);
                }
                xa += va; xb2 += vb2; xc += vc; xd += vd;
                *(f32x4*)(X + off0) = xa; *(f32x4*)(X + off0 + 4) = xb2; *(f32x4*)(X + off0 + 128) = xc; *(f32x4*)(X + off0 + 132) = xd;
                u32x4 w0; w0.x = pk2(xa[0], xa[1]); w0.y = pk2(xa[2], xa[3]); w0.z = pk2(xb2[0], xb2[1]); w0.w = pk2(xb2[2], xb2[3]);
                u32x4 w1; w1.x = pk2(xc[0], xc[1]); w1.y = pk2(xc[2], xc[3]); w1.z = pk2(xd[0], xd[1]); w1.w = pk2(xd[2], xd[3]);
                *(u32x4*)(XB + off0) = w0; *(u32x4*)(XB + off0 + 128) = w1;
                float sq = ((xa[0] * xa[0] + xa[1] * xa[1]) + (xa[2] * xa[2] + xa[3] * xa[3])) + ((xb2[0] * xb2[0] + xb2[1] * xb2[1]) + (xb2[2] * xb2[2] + xb2[3] * xb2[3]))
                         + ((xc[0] * xc[0] + xc[1] * xc[1]) + (xc[2] * xc[2] + xc[3] * xc[3])) + ((xd[0] * xd[0] + xd[1] * xd[1]) + (xd[2] * xd[2] + xd[3] * xd[3]));
                sq += __shfl_xor(sq, 16); sq += __shfl_xor(sq, 32);
                if (fq == 0) ssn[(size_t)row * 16 + u.pn * 4 + wc] = sq;
                asm volatile("" ::: "memory");
            }
    }
};

struct EpiQK {
    static constexpr bool PERM = true, AFTER_DRAIN = false;
    unsigned char* ws; const float* ss; const float* qg; const float* kg;
    __device__ __forceinline__ void operator()(const AccT& acc, const Unit& u, int wr, int wc, int fr, int fq) const {
        const int row0 = u.pm * 256 + wr * 64 + fr;
        const int seg = u.pn >> 2, tl = u.pn & 3;
        bf16_t* base = (bf16_t*)(ws + (seg == 0 ? WS_QA : WS_KA));
        const float* gp = seg == 0 ? qg : kg; const float osc = seg == 0 ? 0.125f * LOG2E : 1.0f;
        const int col0 = tl * 256 + 64 * wc + 8 * fq;
#pragma unroll
        for (int ai = 0; ai < 2; ++ai)
#pragma unroll
            for (int m = 0; m < 4; ++m) {
                const int row = row0 + ai * 128 + m * 16;
                const float rs = rsqrtf(ss_load(ss + (size_t)row * 16) * (1.f / 1024.f) + EPS);
                f32x4 v[2][2]; float sq = 0.f;
#pragma unroll
                for (int bj = 0; bj < 2; ++bj)
#pragma unroll
                    for (int n = 0; n < 2; ++n) { v[bj][n] = acc[ai][bj][m][n] * rs; const f32x4 t = v[bj][n]; sq += (t[0] * t[0] + t[1] * t[1]) + (t[2] * t[2] + t[3] * t[3]); }
                sq += __shfl_xor(sq, 16); sq += __shfl_xor(sq, 32);
                const float r2o = rsqrtf(sq * (1.f / 64.f) + EPS) * osc;
#pragma unroll
                for (int bj = 0; bj < 2; ++bj) {
                    const f32x4 ga = *(const f32x4*)(gp + 32 * bj + 8 * fq), gb = *(const f32x4*)(gp + 32 * bj + 8 * fq + 4);
                    u32x4 w;
                    w.x = pk2(v[bj][0][0] * r2o * ga[0], v[bj][0][1] * r2o * ga[1]); w.y = pk2(v[bj][0][2] * r2o * ga[2], v[bj][0][3] * r2o * ga[3]);
                    w.z = pk2(v[bj][1][0] * r2o * gb[0], v[bj][1][1] * r2o * gb[1]); w.w = pk2(v[bj][1][2] * r2o * gb[2], v[bj][1][3] * r2o * gb[3]);
                    *(u32x4*)(base + (size_t)row * 1024 + col0 + 32 * bj) = w;
                }
                asm volatile("" ::: "memory");
            }
    }
};
struct EpiSeg {
    static constexpr bool PERM = true, AFTER_DRAIN = false;
    unsigned char* ws; const float* ss;
    __device__ __forceinline__ void operator()(const AccT& acc, const Unit& u, int wr, int wc, int fr, int fq) const {
        const int row0 = u.pm * 256 + wr * 64 + fr;
        bf16_t* base = (bf16_t*)(ws + WS_QB + (size_t)(u.pn >> 2) * S64);
        const int col0 = (u.pn & 3) * 256 + wc * 32 + 8 * fq;
#pragma unroll
        for (int ai = 0; ai < 2; ++ai)
#pragma unroll
            for (int m = 0; m < 4; ++m) {
                const int row = row0 + ai * 128 + m * 16;
                const float rs = rsqrtf(ss_load(ss + (size_t)row * 16) * (1.f / 1024.f) + EPS);
#pragma unroll
                for (int bj = 0; bj < 2; ++bj) {
                    const f32x4 v0 = acc[ai][bj][m][0] * rs, v1 = acc[ai][bj][m][1] * rs;
                    u32x4 w; w.x = pk2(v0[0], v0[1]); w.y = pk2(v0[2], v0[3]); w.z = pk2(v1[0], v1[1]); w.w = pk2(v1[2], v1[3]);
                    *(u32x4*)(base + (size_t)row * 1024 + col0 + bj * 128) = w;
                }
                asm volatile("" ::: "memory");
            }
    }
};
struct EpiGB {
    static constexpr bool PERM = true, AFTER_DRAIN = false;
    unsigned char* ws; const float* ss; const float* a_log; const float* dt_bias;
    __device__ __forceinline__ void operator()(const AccT& acc, const Unit& u, int wr, int wc, int fr, int fq) const {
        const int row0 = u.pm * 256 + wr * 64 + fr;
        if (wc == 0 && fq < 2) {
            float* GBp = (float*)(ws + WS_GB);
#pragma unroll
            for (int ai = 0; ai < 2; ++ai)
#pragma unroll
                for (int m = 0; m < 4; ++m) {
                    const int row = row0 + ai * 128 + m * 16;
                    const float rs = rsqrtf(ss_load(ss + (size_t)row * 16) * (1.f / 1024.f) + EPS);
                    float v[8];
#pragma unroll
                    for (int e = 0; e < 4; ++e) { v[e] = acc[ai][0][m][0][e] * rs; v[4 + e] = acc[ai][0][m][1][e] * rs; }
                    if (fq == 0) {
#pragma unroll
                        for (int e = 0; e < 8; ++e) v[e] = sigmoidf_(v[e]);
                    } else {
#pragma unroll
                        for (int e = 0; e < 8; ++e) { const float z = v[e] + dt_bias[e]; const float sp = fmaxf(z, 0.f) + __logf(1.f + __expf(-fabsf(z))); v[e] = -__expf(a_log[e]) * sp; }
                    }
                    float* dst = GBp + (size_t)row * 16 + 8 * fq;
                    *(f32x4*)dst = (f32x4){v[0], v[1], v[2], v[3]}; *(f32x4*)(dst + 4) = (f32x4){v[4], v[5], v[6], v[7]};
                    asm volatile("" ::: "memory");
                }
        }
    }
};

__device__ __forceinline__ void cvt_item(const float* W, int ldw, int src_col0, int nvalid, const float* gain, bf16_t* WT, int K, int dst_row0, int k0, LAS float* scr, int lane) {
    const int nn = lane & 31;
#pragma unroll 8
    for (int i = 0; i < 32; ++i) {
        const int kk = 2 * i + (lane >> 5);
        float v = 0.f;
        if (nn < nvalid) { v = W[(size_t)(k0 + kk) * ldw + src_col0 + nn]; if (gain) v *= gain[k0 + kk]; }
        scr[kk * 33 + nn] = v;
    }
    asm volatile("s_waitcnt lgkmcnt(0)" ::: "memory");
    const int c = lane & 7;
#pragma unroll
    for (int j = 0; j < 4; ++j) {
        const int n = (lane >> 3) + 8 * j; const LAS float* s = scr + (8 * c) * 33 + n;
        u32x4 o; o.x = pk2(s[0 * 33], s[1 * 33]); o.y = pk2(s[2 * 33], s[3 * 33]); o.z = pk2(s[4 * 33], s[5 * 33]); o.w = pk2(s[6 * 33], s[7 * 33]);
        *(u32x4*)(WT + (size_t)(dst_row0 + n) * K + k0 + 8 * c) = o;
    }
    asm volatile("s_waitcnt lgkmcnt(0)" ::: "memory");
}

struct Params {
    const float* in[24];
    float* out;
    unsigned char* ws;
    int seg_lo, seg_hi;
};
enum { I_X = 0, I_P, I_WIN, I_ATTN_NORM, I_QNORM, I_KNORM, I_LAM, I_SUBLN, I_RELB, I_CONVB, I_ALOG, I_DTB, I_ONORM, I_WBRA, I_WBRB, I_WOUT, I_FFN_NORM, I_WUP, I_CONVFF, I_CONVFFB, I_WDOWN, I_PLE_NORM, I_WPG, I_WPP };

__device__ __forceinline__ void convert_weights(const Params* PQ, int layer, LAS unsigned char* lds, int gw, int NGW, int wave, int lane) {
    LAS float* scr = (LAS float*)(lds + wave * 16384);
    unsigned char* ws = PQ->ws;
    const float* w_in = PQ->in[I_WIN] + (size_t)layer * 1024 * DIN;
    const float* g_attn = PQ->in[I_ATTN_NORM] + layer * 1024;
    const float* g_ffn = PQ->in[I_FFN_NORM] + layer * 1024;
    const float* g_ple = PQ->in[I_PLE_NORM] + layer * 1024;
#define CVT_JOB(NITEMS, KB, SRCW, LDW, GAIN, DST, KK, SRCCOL, NVALID) \
    for (int it = gw; it < (NITEMS); it += NGW) { const int g = it / (KB), kb = it % (KB); (void)g; \
        cvt_item((SRCW), (LDW), (SRCCOL), (NVALID), (GAIN), (bf16_t*)(ws + (DST)), (KK), g * 32, kb * 64, scr, lane); } asm volatile("" ::: "memory");
    for (int it = gw; it < 200 * 16; it += NGW) {
        const int g = it >> 4, kb = it & 15, pn = g >> 3, gi = g & 7;
        int src, nv = 32;
        if (pn < 8) { const int bj = gi >> 2, wc = gi & 3; src = (pn >> 2) * 1024 + (pn & 3) * 256 + 64 * wc + 32 * bj; }
        else if (pn < 24) { src = 3072 + (pn - 8) * 256 + 32 * gi; }
        else { src = 7168; nv = (gi == 0) ? 16 : 0; }
        cvt_item(w_in, DIN, src, nv, g_attn, (bf16_t*)(ws + W_IN), 1024, g * 32, kb * 64, scr, lane);
    }
    asm volatile("" ::: "memory");
    CVT_JOB(32 * 16, 16, w_in, DIN, g_attn, W_V, 1024, 2048 + g * 32, 32)
    CVT_JOB(64 * 16, 16, w_in, DIN, g_attn, W_GL, 1024, 7184 + g * 32, 32)
    CVT_JOB(32 * 16, 16, PQ->in[I_WBRA] + (size_t)layer * 1024 * 1024, 1024, (const float*)nullptr, W_BRA, 1024, g * 32, 32)
    CVT_JOB(32 * 16, 16, PQ->in[I_WBRB] + (size_t)layer * 1024 * 1024, 1024, (const float*)nullptr, W_BRB, 1024, g * 32, 32)
    CVT_JOB(32 * 16, 16, PQ->in[I_WOUT] + (size_t)layer * 1024 * 1024, 1024, (const float*)nullptr, W_OUT, 1024, g * 32, 32)
    CVT_JOB(176 * 16, 16, PQ->in[I_WUP] + (size_t)layer * 1024 * 5632, 5632, g_ffn, W_UP, 1024, g * 32, 32)
    CVT_JOB(32 * 44, 44, PQ->in[I_WDOWN] + (size_t)layer * 2816 * 1024, 1024, (const float*)nullptr, W_DOWN, 2816, g * 32, 32)
    CVT_JOB(32 * 16, 16, PQ->in[I_WPG] + (size_t)layer * 1024 * 1024, 1024, g_ple, W_PG, 1024, g * 32, 32)
    CVT_JOB(32 * 4, 4, PQ->in[I_WPP] + (size_t)layer * 256 * 1024, 1024, (const float*)nullptr, W_PP, 256, g * 32, 32)
#undef CVT_JOB
}

constexpr int AT_KROW = 272, AT_VROW = 136  , AT_KBYTES = 64 * AT_KROW, AT_VBYTES = 128 * AT_VROW, AT_STAGE = AT_KBYTES + AT_VBYTES, AT_TB = 2 * AT_STAGE;
static_assert(AT_TB >= 65536 && AT_TB + 1024 <= LDS_BYTES, "attention LDS");
__device__ __forceinline__ void attn_unit(LAS unsigned char* lds, const bf16_t* QA, const bf16_t* KA, const bf16_t* VT, bf16_t* OA, int b, int h, int qb,
                                          float lam, float out_scale, const float* subln, const float* relb, int tid) {
    const int lane = tid & 63, wid = __builtin_amdgcn_readfirstlane(tid >> 6), j = wid >> 2, wq = wid & 3, r32 = lane & 31, hi = lane >> 5;
    const int Q0 = qb * 128, qrow = Q0 + 32 * wq + r32;
    const size_t tok = (size_t)b * SEQ + qrow;
    LAS float* TB = (LAS float*)(lds + AT_TB);
    for (int i = tid; i <= 128; i += NTHR) {
        float v = 0.f;
        if (i < 128) {
            int bk = i;
            if (i >= 16) { int lg = 16 + (int)(__logf((float)i * (1.f / 16.f)) / __logf(8.0f) * 16.f); bk = lg < 31 ? lg : 31; }
            v = (relb[bk * 8 + h] - relb[31 * 8 + h]) * LOG2E;
        }
        TB[i] = v;
    }
    bf16x8 qf[4];
#pragma unroll
    for (int d0 = 0; d0 < 4; ++d0) qf[d0] = *(const bf16x8*)(QA + tok * 1024 + h * 128 + 64 * j + 16 * d0 + 8 * hi);
    const int NT = (Q0 + 128) / 64;
    const int kr0 = tid >> 4, kc = tid & 15;
    const int vr0 = tid >> 3, vc = tid & 7;
    const bf16_t* kg = KA + ((size_t)b * SEQ + kr0) * 1024 + h * 128 + kc * 8;
    const bf16_t* vg = VT + (size_t)(h * 128 + vr0) * MTOK + (size_t)b * SEQ + vc * 8;
    u32x4 kreg0, kreg1, vreg0, vreg1;
#define AT_LOAD(t) do { kreg0 = *(const u32x4*)(kg + (size_t)(t) * 64 * 1024); kreg1 = *(const u32x4*)(kg + (size_t)((t) * 64 + 32) * 1024); \
        vreg0 = *(const u32x4*)(vg + (t) * 64); vreg1 = *(const u32x4*)(vg + (size_t)64 * MTOK + (t) * 64); } while (0)
#define AT_STORE(s) do { LAS unsigned char* kb_ = lds + (s) * AT_STAGE; LAS unsigned char* vb_ = kb_ + AT_KBYTES; \
        *(LAS u32x4*)(kb_ + kr0 * AT_KROW + kc * 16) = kreg0; *(LAS u32x4*)(kb_ + (kr0 + 32) * AT_KROW + kc * 16) = kreg1; \
        *(LAS u32x2*)(vb_ + vr0 * AT_VROW + vc * 16) = (u32x2){vreg0.x, vreg0.y}; *(LAS u32x2*)(vb_ + vr0 * AT_VROW + vc * 16 + 8) = (u32x2){vreg0.z, vreg0.w}; \
        *(LAS u32x2*)(vb_ + (vr0 + 64) * AT_VROW + vc * 16) = (u32x2){vreg1.x, vreg1.y}; *(LAS u32x2*)(vb_ + (vr0 + 64) * AT_VROW + vc * 16 + 8) = (u32x2){vreg1.z, vreg1.w}; } while (0)
    AT_LOAD(0); AT_STORE(0);
    __syncthreads();
    f32x16 o[4];
#pragma unroll
    for (int i = 0; i < 4; ++i)
#pragma unroll
        for (int r = 0; r < 16; ++r) o[i][r] = 0.f;
    float mrun = -INFINITY, lrun = 0.f;
    const int qmax_w = Q0 + 32 * wq + 31, qmin_w = Q0 + 32 * wq;
    for (int t = 0; t < NT; ++t) {
        if (t + 1 < NT) AT_LOAD(t + 1);
        const int kv0 = 64 * t;
        if (kv0 <= qmax_w) {
            const LAS unsigned char* Kb = lds + (t & 1) * AT_STAGE; const LAS unsigned char* Vb = Kb + AT_KBYTES;
            f32x16 s0, s1;
#pragma unroll
            for (int r = 0; r < 16; ++r) { s0[r] = 0.f; s1[r] = 0.f; }
#pragma unroll
            for (int d0 = 0; d0 < 4; ++d0) {
                const bf16x8 a0 = *(const LAS bf16x8*)(Kb + r32 * AT_KROW + (64 * j + 16 * d0 + 8 * hi) * 2);
                const bf16x8 a1 = *(const LAS bf16x8*)(Kb + (32 + r32) * AT_KROW + (64 * j + 16 * d0 + 8 * hi) * 2);
                s0 = __builtin_amdgcn_mfma_f32_32x32x16_bf16(a0, qf[d0], s0, 0, 0, 0);
                s1 = __builtin_amdgcn_mfma_f32_32x32x16_bf16(a1, qf[d0], s1, 0, 0, 0);
            }
            if (kv0 + 63 + 128 > qmin_w) {
#pragma unroll
                for (int r = 0; r < 16; ++r) {
                    const int rel0 = qrow - (kv0 + crow(r, hi)), rel1 = rel0 - 32;
                    s0[r] = rel0 < 0 ? -INFINITY : s0[r] + TB[rel0 < 128 ? rel0 : 128];
                    s1[r] = rel1 < 0 ? -INFINITY : s1[r] + TB[rel1 < 128 ? rel1 : 128];
                }
            }
            float mx = fmaxf(s0[0], s1[0]);
#pragma unroll
            for (int r = 1; r < 16; ++r) mx = fmaxf(mx, fmaxf(s0[r], s1[r]));
            mx = fmaxf(mx, __shfl_xor(mx, 32));
            const float mnew = fmaxf(mrun, mx);
            const float alpha = __builtin_amdgcn_exp2f(mrun - mnew);
            mrun = mnew;
            float ls = 0.f;
#pragma unroll
            for (int r = 0; r < 16; ++r) { s0[r] = __builtin_amdgcn_exp2f(s0[r] - mnew); s1[r] = __builtin_amdgcn_exp2f(s1[r] - mnew); ls += s0[r] + s1[r]; }
            lrun = lrun * alpha + ls;
#pragma unroll
            for (int i = 0; i < 4; ++i)
#pragma unroll
                for (int r = 0; r < 16; ++r) o[i][r] *= alpha;
            bf16x8 pf[4];
            { u32x4 w;
              w.x = pk2(s0[0], s0[1]); w.y = pk2(s0[2], s0[3]); w.z = pk2(s0[4], s0[5]); w.w = pk2(s0[6], s0[7]); pf[0] = __builtin_bit_cast(bf16x8, w);
              w.x = pk2(s0[8], s0[9]); w.y = pk2(s0[10], s0[11]); w.z = pk2(s0[12], s0[13]); w.w = pk2(s0[14], s0[15]); pf[1] = __builtin_bit_cast(bf16x8, w);
              w.x = pk2(s1[0], s1[1]); w.y = pk2(s1[2], s1[3]); w.z = pk2(s1[4], s1[5]); w.w = pk2(s1[6], s1[7]); pf[2] = __builtin_bit_cast(bf16x8, w);
              w.x = pk2(s1[8], s1[9]); w.y = pk2(s1[10], s1[11]); w.z = pk2(s1[12], s1[13]); w.w = pk2(s1[14], s1[15]); pf[3] = __builtin_bit_cast(bf16x8, w); }
#pragma unroll
            for (int blk = 0; blk < 4; ++blk)
#pragma unroll
                for (int s = 0; s < 4; ++s) {
                    const LAS unsigned char* vp = Vb + (32 * blk + r32) * AT_VROW + (16 * s + 4 * hi) * 2;
                    const u32x2 lo = *(const LAS u32x2*)vp, hh = *(const LAS u32x2*)(vp + 16);
                    const u32x4 w = (u32x4){lo.x, lo.y, hh.x, hh.y};
                    o[blk] = __builtin_amdgcn_mfma_f32_32x32x16_bf16(__builtin_bit_cast(bf16x8, w), pf[s], o[blk], 0, 0, 0);
                }
        }
        if (t + 1 < NT) AT_STORE((t + 1) & 1);
        __syncthreads();
    }
#undef AT_LOAD
#undef AT_STORE
    lrun += __shfl_xor(lrun, 32);
    const float inv = 1.f / lrun;
    LAS float* EX = (LAS float*)lds;
    if (j == 1) {
        const float sc = inv * lam;
#pragma unroll
        for (int blk = 0; blk < 4; ++blk)
#pragma unroll
            for (int r = 0; r < 16; ++r) EX[(wq * 64 + blk * 16 + r) * 64 + lane] = o[blk][r] * sc;
    }
    __syncthreads();
    if (j == 0) {
        float sq = 0.f;
#pragma unroll
        for (int blk = 0; blk < 4; ++blk)
#pragma unroll
            for (int r = 0; r < 16; ++r) { const float d = o[blk][r] * inv - EX[(wq * 64 + blk * 16 + r) * 64 + lane]; o[blk][r] = d; sq += d * d; }
        sq += __shfl_xor(sq, 32);
        const float rr = rsqrtf(sq * (1.f / 128.f) + EPS) * out_scale;
#pragma unroll
        for (int blk = 0; blk < 4; ++blk)
#pragma unroll
            for (int rq = 0; rq < 4; ++rq) {
                const int dv0 = 32 * blk + 8 * rq + 4 * hi;
                const f32x4 g = *(const f32x4*)(subln + dv0);
                u32x2 w; w.x = pk2(o[blk][4 * rq + 0] * rr * g[0], o[blk][4 * rq + 1] * rr * g[1]); w.y = pk2(o[blk][4 * rq + 2] * rr * g[2], o[blk][4 * rq + 3] * rr * g[3]);
                *(u32x2*)(OA + tok * 1024 + h * 128 + dv0) = w;
            }
    }
    __syncthreads();
}

__device__ __forceinline__ void dn_naive(LAS unsigned char* lds, unsigned char* ws, const float* convw  , int b, int h, int tid) {
    const int lane = tid & 63, wid = tid >> 6, dv = tid & 127, g4 = tid >> 7;
    LAS float* Y = (LAS float*)lds;
    LAS float* NR = Y + 384;
    LAS float* PT = NR + 8;
    LAS float* OP = PT + 512;
    float S[32];
#pragma unroll
    for (int i = 0; i < 32; ++i) S[i] = 0.f;
    bf16_t* QB = (bf16_t*)(ws + WS_QB); const bf16_t* KB = (const bf16_t*)(ws + WS_KB); const bf16_t* VB = (const bf16_t*)(ws + WS_VB);
    const float* GBp = (const float*)(ws + WS_GB);
    const int arr = tid >> 7;
    const bf16_t* src = (arr == 0 ? (const bf16_t*)QB : arr == 1 ? KB : VB) + h * 128 + dv;
    float w0 = 0.f, w1 = 0.f, w2 = 0.f, w3 = 0.f, x1 = 0.f, x2 = 0.f, x3 = 0.f;
    if (tid < 384) { const int ch = arr * 1024 + h * 128 + dv; w0 = convw[ch]; w1 = convw[3072 + ch]; w2 = convw[2 * 3072 + ch]; w3 = convw[3 * 3072 + ch]; }
    for (int t = 0; t < SEQ; ++t) {
        const size_t tok = (size_t)b * SEQ + t;
        if (tid < 384) {
            const float x0 = bf2f(src[tok * 1024]);
            float y = w0 * x3 + w1 * x2 + w2 * x1 + w3 * x0;
            y = siluf_(y); x3 = x2; x2 = x1; x1 = x0;
            Y[arr * 128 + dv] = y;
            const float sq = wave_sum(y * y);
            if (lane == 0) NR[wid] = sq;
        }
        __syncthreads();
        const float qn = rsqrtf(NR[0] + NR[1] + EPS) * 0.08838834764831845f, kn = rsqrtf(NR[2] + NR[3] + EPS);
        const float bt = GBp[tok * 16 + h], gt = GBp[tok * 16 + 8 + h], eg = __expf(gt);
        const float vv = Y[256 + dv];
        float ks = 0.f;
#pragma unroll
        for (int i = 0; i < 32; ++i) ks += Y[128 + 32 * g4 + i] * S[i];
        PT[g4 * 128 + dv] = ks * kn;
        __syncthreads();
        const float kS = (PT[dv] + PT[128 + dv]) + (PT[256 + dv] + PT[384 + dv]);
        const float c = bt * (vv - eg * kS);
        float op = 0.f;
#pragma unroll
        for (int i = 0; i < 32; ++i) { const float kk = Y[128 + 32 * g4 + i] * kn; S[i] = eg * S[i] + kk * c; op += Y[32 * g4 + i] * S[i]; }
        OP[g4 * 128 + dv] = op * qn;
        __syncthreads();
        if (g4 == 0) { const float ov = (OP[dv] + OP[128 + dv]) + (OP[256 + dv] + OP[384 + dv]); QB[tok * 1024 + h * 128 + dv] = f2bf(ov); }
    }
    __syncthreads();
}

__device__ __forceinline__ float row16_sum(float v) {
    v += __builtin_bit_cast(float, __builtin_amdgcn_update_dpp(0, __builtin_bit_cast(int, v), 0x128, 0xf, 0xf, false));
    v += __builtin_bit_cast(float, __builtin_amdgcn_update_dpp(0, __builtin_bit_cast(int, v), 0x124, 0xf, 0xf, false));
    v += __builtin_bit_cast(float, __builtin_amdgcn_update_dpp(0, __builtin_bit_cast(int, v), 0x122, 0xf, 0xf, false));
    v += __builtin_bit_cast(float, __builtin_amdgcn_update_dpp(0, __builtin_bit_cast(int, v), 0x121, 0xf, 0xf, false));
    return v;
}
__device__ __forceinline__ void dn_fast(LAS unsigned char* lds, unsigned char* ws, const float* convw  , int b, int h, int dvq, int tid) {
    const int lane = tid & 63, wid = tid >> 6, dvl = lane >> 4, grp = lane & 15;
    const int dvloc = 4 * wid + dvl, dv = 32 * dvq + dvloc;
    LAS float* Y = (LAS float*)lds;
    LAS float* NR = Y + 16 * 288;
    LAS float* GBs = NR + 16 * 16;
    LAS float* SC = GBs + 32;
    float S[8];
#pragma unroll
    for (int i = 0; i < 8; ++i) S[i] = 0.f;
    bf16_t* VB = (bf16_t*)(ws + WS_VB);
    const float* GBp = (const float*)(ws + WS_GB);
    const int arr = tid < 128 ? 0 : (tid < 256 ? 1 : 2);
    const int dch = arr == 2 ? 32 * dvq + ((tid - 256) & 31) : (tid & 127);
    const bf16_t* src = (const bf16_t*)(ws + (arr == 0 ? WS_QB : arr == 1 ? WS_KB : WS_VB)) + h * 128 + dch;
    float w0 = 0.f, w1 = 0.f, w2 = 0.f, w3 = 0.f, x1 = 0.f, x2 = 0.f, x3 = 0.f;
    if (tid < 288) { const int ch = arr * 1024 + h * 128 + dch; w0 = convw[ch]; w1 = convw[3072 + ch]; w2 = convw[2 * 3072 + ch]; w3 = convw[3 * 3072 + ch]; }
    for (int t0 = 0; t0 < SEQ; t0 += 16) {
        const size_t tokb = (size_t)b * SEQ + t0;
        if (tid < 288) {
            bf16_t xr[16];
#pragma unroll
            for (int tt = 0; tt < 16; ++tt) xr[tt] = src[(tokb + tt) * 1024];
#pragma unroll
            for (int tt = 0; tt < 16; ++tt) {
                const float x0 = bf2f(xr[tt]);
                float y = w0 * x3 + w1 * x2 + w2 * x1 + w3 * x0;
                y = siluf_(y); x3 = x2; x2 = x1; x1 = x0;
                Y[tt * 288 + tid] = y;
                if (tid < 256) { const float sq = row16_sum(y * y); if ((lane & 15) == 0) NR[tt * 16 + wid * 4 + (lane >> 4)] = sq; }
            }
        }
        if (tid >= 480) { const int i = tid - 480, tt = i >> 1, which = i & 1; GBs[tt * 2 + which] = GBp[(tokb + tt) * 16 + which * 8 + h]; }
        __syncthreads();
        if (tid < 16) {
            const f32x4 a = *(const LAS f32x4*)(NR + tid * 16), b2 = *(const LAS f32x4*)(NR + tid * 16 + 4), c2 = *(const LAS f32x4*)(NR + tid * 16 + 8), d2 = *(const LAS f32x4*)(NR + tid * 16 + 12);
            const float sq_q = ((a[0] + a[1]) + (a[2] + a[3])) + ((b2[0] + b2[1]) + (b2[2] + b2[3])), sq_k = ((c2[0] + c2[1]) + (c2[2] + c2[3])) + ((d2[0] + d2[1]) + (d2[2] + d2[3]));
            *(LAS f32x4*)(SC + tid * 4) = (f32x4){rsqrtf(sq_q + EPS) * 0.08838834764831845f, rsqrtf(sq_k + EPS), __expf(GBs[tid * 2 + 1]), GBs[tid * 2]};
        }
        __syncthreads();
#pragma unroll 4
        for (int tt = 0; tt < 16; ++tt) {
            const f32x4 sc = *(const LAS f32x4*)(SC + tt * 4);
            const float qn = sc[0], kn = sc[1], eg = sc[2], bt = sc[3];
            const f32x4 ka = *(const LAS f32x4*)(Y + tt * 288 + 128 + 8 * grp), kb = *(const LAS f32x4*)(Y + tt * 288 + 128 + 8 * grp + 4);
            const f32x4 qa = *(const LAS f32x4*)(Y + tt * 288 + 8 * grp), qb = *(const LAS f32x4*)(Y + tt * 288 + 8 * grp + 4);
            const float vv = Y[tt * 288 + 256 + dvloc];
            float ks = (ka[0] * S[0] + ka[1] * S[1]) + (ka[2] * S[2] + ka[3] * S[3]) + (kb[0] * S[4] + kb[1] * S[5]) + (kb[2] * S[6] + kb[3] * S[7]);
            ks = row16_sum(ks);
            const float c = bt * (vv - eg * ks * kn) * kn;
            float op = 0.f;
#pragma unroll
            for (int i = 0; i < 4; ++i) { S[i] = eg * S[i] + ka[i] * c; op += qa[i] * S[i]; S[4 + i] = eg * S[4 + i] + kb[i] * c; op += qb[i] * S[4 + i]; }
            op = row16_sum(op);
            if (grp == 0) VB[(tokb + tt) * 1024 + h * 128 + dv] = f2bf(op * qn);
        }
        __syncthreads();
    }
}

__device__ __forceinline__ float row8_sum(float v) {
    v += __builtin_bit_cast(float, __builtin_amdgcn_update_dpp(0, __builtin_bit_cast(int, v), 0x141, 0xf, 0xf, false));
    v += __builtin_bit_cast(float, __builtin_amdgcn_update_dpp(0, __builtin_bit_cast(int, v), 0x1B, 0xf, 0xf, false));
    v += __builtin_bit_cast(float, __builtin_amdgcn_update_dpp(0, __builtin_bit_cast(int, v), 0xB1, 0xf, 0xf, false));
    return v;
}
constexpr int DN2_YB = 16 * 288 + 16 * 16 + 32 + 64;
__device__ __forceinline__ void dn_pc(LAS unsigned char* lds, unsigned char* ws, const float* convw  , int b, int h, int dvq, int tid) {
    const int lane = tid & 63, wid = tid >> 6;
    const bool producer = tid >= 256;
    const int pt = tid - 256;
    LAS float* L = (LAS float*)lds;
    bf16_t* VB = (bf16_t*)(ws + WS_VB);
    const float* GBp = (const float*)(ws + WS_GB);
    const int parr = pt < 128 ? 0 : 1, pd = pt & 127;
    const bf16_t* src = (const bf16_t*)(ws + (parr == 0 ? WS_QB : WS_KB)) + h * 128 + pd;
    const bf16_t* srcv = (const bf16_t*)(ws + WS_VB) + h * 128 + 32 * dvq + (pt & 31);
    float w0 = 0.f, w1 = 0.f, w2 = 0.f, w3 = 0.f, x1 = 0.f, x2 = 0.f, x3 = 0.f, u0 = 0.f, u1 = 0.f, u2 = 0.f, u3 = 0.f, z1 = 0.f, z2 = 0.f, z3 = 0.f;
    if (producer) { const int ch = parr * 1024 + h * 128 + pd; w0 = convw[ch]; w1 = convw[3072 + ch]; w2 = convw[2 * 3072 + ch]; w3 = convw[3 * 3072 + ch];
        if (pt < 32) { const int cv = 2048 + h * 128 + 32 * dvq + pt; u0 = convw[cv]; u1 = convw[3072 + cv]; u2 = convw[2 * 3072 + cv]; u3 = convw[3 * 3072 + cv]; } }
    const int col = tid >> 3, grp = tid & 7;
    float S[16];
#pragma unroll
    for (int i = 0; i < 16; ++i) S[i] = 0.f;
#define DN2_PRODUCE(BUF, T0) do { LAS float* Yp = L + (BUF) * DN2_YB; LAS float* NRp = Yp + 16 * 288; LAS float* GBsp = NRp + 256; const size_t tb_ = (size_t)b * SEQ + (T0); \
        bf16_t xr[16]; bf16_t vr[16]; \
        _Pragma("unroll") for (int tt = 0; tt < 16; ++tt) xr[tt] = src[(tb_ + tt) * 1024]; \
        if (pt < 32) { _Pragma("unroll") for (int tt = 0; tt < 16; ++tt) vr[tt] = srcv[(tb_ + tt) * 1024]; } \
        if (pt >= 224) { const int i_ = pt - 224, tt_ = i_ >> 1, wh_ = i_ & 1; GBsp[tt_ * 2 + wh_] = GBp[(tb_ + tt_) * 16 + wh_ * 8 + h]; } \
        _Pragma("unroll") for (int tt = 0; tt < 16; ++tt) { const float x0 = bf2f(xr[tt]); float y = w0 * x3 + w1 * x2 + w2 * x1 + w3 * x0; y = siluf_(y); x3 = x2; x2 = x1; x1 = x0; \
            Yp[tt * 288 + pt] = y; const float sq = row16_sum(y * y); if ((lane & 15) == 0) NRp[tt * 16 + (wid - 4) * 4 + (lane >> 4)] = sq; } \
        if (pt < 32) { _Pragma("unroll") for (int tt = 0; tt < 16; ++tt) { const float x0 = bf2f(vr[tt]); float y = u0 * z3 + u1 * z2 + u2 * z1 + u3 * x0; y = siluf_(y); z3 = z2; z2 = z1; z1 = x0; Yp[tt * 288 + 256 + pt] = y; } } \
    } while (0)
    if (producer) DN2_PRODUCE(0, 0);
    for (int n = 0; n < SEQ / 16; ++n) {
        const int buf = n & 1;
        LAS float* Y = L + buf * DN2_YB; LAS float* NR = Y + 16 * 288; LAS float* GBs = NR + 256; LAS float* SC = GBs + 32;
        __syncthreads();
        if (tid < 16) {
            const f32x4 a = *(const LAS f32x4*)(NR + tid * 16), b2 = *(const LAS f32x4*)(NR + tid * 16 + 4), c2 = *(const LAS f32x4*)(NR + tid * 16 + 8), d2 = *(const LAS f32x4*)(NR + tid * 16 + 12);
            const float sq_q = ((a[0] + a[1]) + (a[2] + a[3])) + ((b2[0] + b2[1]) + (b2[2] + b2[3])), sq_k = ((c2[0] + c2[1]) + (c2[2] + c2[3])) + ((d2[0] + d2[1]) + (d2[2] + d2[3]));
            *(LAS f32x4*)(SC + tid * 4) = (f32x4){rsqrtf(sq_q + EPS) * 0.08838834764831845f, rsqrtf(sq_k + EPS), __expf(GBs[tid * 2 + 1]), GBs[tid * 2]};
        }
        __syncthreads();
        if (producer) { if (n + 1 < SEQ / 16) DN2_PRODUCE(buf ^ 1, 16 * (n + 1)); }
        else {
            const size_t tokb = (size_t)b * SEQ + 16 * n;
#pragma unroll 4
            for (int tt = 0; tt < 16; ++tt) {
                const f32x4 sc = *(const LAS f32x4*)(SC + tt * 4);
                const float qn = sc[0], kn = sc[1], eg = sc[2], bt = sc[3];
                const LAS f32x4* kp = (const LAS f32x4*)(Y + tt * 288 + 128 + 16 * grp); const LAS f32x4* qp = (const LAS f32x4*)(Y + tt * 288 + 16 * grp);
                const f32x4 k0 = kp[0], k1 = kp[1], k2 = kp[2], k3 = kp[3], q0 = qp[0], q1 = qp[1], q2 = qp[2], q3 = qp[3];
                const float vv = Y[tt * 288 + 256 + col];
                float ks = ((k0[0] * S[0] + k0[1] * S[1]) + (k0[2] * S[2] + k0[3] * S[3])) + ((k1[0] * S[4] + k1[1] * S[5]) + (k1[2] * S[6] + k1[3] * S[7]))
                         + ((k2[0] * S[8] + k2[1] * S[9]) + (k2[2] * S[10] + k2[3] * S[11])) + ((k3[0] * S[12] + k3[1] * S[13]) + (k3[2] * S[14] + k3[3] * S[15]));
                ks = row8_sum(ks);
                const float c = bt * (vv - eg * ks * kn) * kn;
                float op0 = 0.f, op1 = 0.f;
#pragma unroll
                for (int i = 0; i < 4; ++i) { S[i] = eg * S[i] + k0[i] * c; op0 += q0[i] * S[i]; S[4 + i] = eg * S[4 + i] + k1[i] * c; op1 += q1[i] * S[4 + i];
                                              S[8 + i] = eg * S[8 + i] + k2[i] * c; op0 += q2[i] * S[8 + i]; S[12 + i] = eg * S[12 + i] + k3[i] * c; op1 += q3[i] * S[12 + i]; }
                const float op = row8_sum(op0 + op1);
                if (grp == 0) VB[(tokb + tt) * 1024 + h * 128 + 32 * dvq + col] = f2bf(op * qn);
            }
        }
    }
    __syncthreads();
#undef DN2_PRODUCE
}

#define GEMM_PHASE(EPI, Aptr, Bptr, Mv, Nv, Kv, Eobj, HM) do { int m_ = (Mv), n_ = (Nv), k_ = (Kv); asm volatile("" : "+s"(m_), "+s"(n_), "+s"(k_)); pg8::Gemm g_{(const pg8::bf16_t*)(Aptr), (const pg8::bf16_t*)(Bptr), m_, n_, k_, (HM)}; pg8::StaticOrder S_; S_.init(m_, n_, G, bid); \
        pg8::gemm_phase<EPI, pg8::StaticOrder, true, true>(lds, g_, S_, (Eobj)); } while (0)

__global__ void __launch_bounds__(NTHR, 2) fwd_mega(Params P) {
    extern __shared__ __attribute__((aligned(16))) unsigned char lds_raw[];
    LAS unsigned char* lds = (LAS unsigned char*)lds_raw;
    cg::grid_group grid = cg::this_grid();
    if (threadIdx.x == 0) {
        const unsigned xcc = (unsigned)__builtin_amdgcn_s_getreg((3 << 11) | 20) & 7u;
        const unsigned loc = __hip_atomic_fetch_add((unsigned*)(P.ws + WS_CTL) + xcc, 1u, __ATOMIC_RELAXED, __HIP_MEMORY_SCOPE_AGENT);
        *(LAS int*)(lds + LDS_VB) = (int)((loc & 31u) * 8u + xcc);
    }
    __syncthreads();
    int seg = 0; const int seg_lo = P.seg_lo, seg_hi = P.seg_hi;
#ifdef L2FLUSH
#define L2_FLUSH() do { const Params* PF = (const Params*)__builtin_amdgcn_kernarg_segment_ptr(); asm volatile("" : "+s"(PF)); int tf_ = threadIdx.x; asm volatile("" : "+v"(tf_)); \
        const u32x4* jp = (const u32x4*)(PF->in[I_P]) + (size_t)blockIdx.x * (L2FLUSH * 64) + tf_; unsigned acc_ = 0u; \
        for (int q_ = 0; q_ < L2FLUSH * 64 / 512; ++q_) { const u32x4 v_ = __builtin_nontemporal_load(jp + (size_t)q_ * 512); acc_ |= v_.x & v_.y & v_.z & v_.w; asm volatile("" ::: "memory"); } \
        if (acc_ == 0x12345678u) PF->out[0] = 0.f; } while (0)
#else
#define L2_FLUSH() do {} while (0)
#endif
#ifdef NOSEG
#define SYNCCOND true
#else
#define SYNCCOND (seg >= seg_lo && seg + 1 < seg_hi)
#endif
#define GRID_SYNC() do { if (SYNCCOND) { asm volatile("s_waitcnt vmcnt(0) lgkmcnt(0)" ::: "memory");   grid.sync(); L2_FLUSH(); \
        if (threadIdx.x < 64) { __builtin_amdgcn_fence(__ATOMIC_ACQUIRE, "agent"); asm volatile("s_waitcnt vmcnt(0)" ::: "memory"); } __syncthreads();     \
        } ++seg; } while (0)
#ifdef NOSEG
#define SEGCOND true
#else
#define SEGCOND (seg >= seg_lo && seg < seg_hi)
#endif
#define PH_BEGIN if (SEGCOND) { const Params* PQ = (const Params*)__builtin_amdgcn_kernarg_segment_ptr(); asm volatile("" : "+s"(PQ)); int tid = threadIdx.x; asm volatile("" : "+v"(tid)); \
    const int lane = tid & 63, wave = __builtin_amdgcn_readfirstlane(tid >> 6); int bid = __builtin_amdgcn_readfirstlane(*(LAS int*)(lds + LDS_VB)), G = gridDim.x; asm volatile("" : "+s"(bid), "+s"(G)); \
    const int xb_ = bid & 7, jb_ = bid >> 3, wj = jb_ * NW + wave;     \
    unsigned char* ws = PQ->ws; float* X = PQ->out; float* SS = (float*)(ws + WS_SS); bf16_t* XB = (bf16_t*)(ws + WS_XB); \
    float* ss_attn = (float*)(ws + WS_HALO); float* ss_ffn = ss_attn + (size_t)MTOK * 16; float* ss_ple = ss_ffn + (size_t)MTOK * 16; float* ss_next = ss_attn; \
    (void)lane; (void)xb_; (void)jb_; (void)wj; (void)X; (void)XB; (void)ss_attn; (void)ss_ffn; (void)ss_ple; (void)ss_next; (void)G;
#define PH_END }
#define U ((bf16_t*)(ws + WS_MIX))
#define ACT ((bf16_t*)(ws + WS_MIX + 176 * MiB))

    { const int layer = 0; PH_BEGIN
      if (bid == 0 && tid == 0) __hip_atomic_store((unsigned*)(ws + WS_CTL) + 16, 0u, __ATOMIC_RELAXED, __HIP_MEMORY_SCOPE_AGENT);
      const float* xin = PQ->in[I_X];
      for (int r = wj; r < SEQ; r += 256) {
          const int m = xb_ * SEQ + r;
          const f32x4* xr = (const f32x4*)(xin + (size_t)m * 1024) + lane;
          f32x4 v[4]; float s = 0.f;
#pragma unroll
          for (int jj = 0; jj < 4; ++jj) { v[jj] = xr[64 * jj]; s += (v[jj][0] * v[jj][0] + v[jj][1] * v[jj][1]) + (v[jj][2] * v[jj][2] + v[jj][3] * v[jj][3]); }
          s = wave_sum(s);
          if (lane < 16) ss_attn[(size_t)m * 16 + lane] = lane == 0 ? s : 0.f;
          f32x4* xo = (f32x4*)(X + (size_t)m * 1024) + lane;
          u32x2* bo = (u32x2*)(XB + (size_t)m * 1024) + lane;
#pragma unroll
          for (int jj = 0; jj < 4; ++jj) { xo[64 * jj] = v[jj]; u32x2 w; w.x = pk2(v[jj][0], v[jj][1]); w.y = pk2(v[jj][2], v[jj][3]); bo[64 * jj] = w; }
      }
    PH_END }

    for (int layer = 0; layer < NLAYER; ++layer) {
        asm volatile("" ::: "memory");
        const float lam_init = 0.8f - 0.6f * __expf(-0.3f * (float)layer);
        PH_BEGIN
        convert_weights(PQ, layer, lds, bid * NW + wave, G * NW, wave, lane);
        { const float* pl = PQ->in[I_P] + ((size_t)layer * MTOK + (size_t)xb_ * SEQ) * DPLE;
          bf16_t* pb = (bf16_t*)(ws + WS_PB) + (size_t)xb_ * SEQ * DPLE;
          for (int i = jb_ * NTHR + tid; i < SEQ * DPLE / 8; i += 32 * NTHR) {
              const f32x4 a = *(const f32x4*)(pl + (size_t)i * 8), b = *(const f32x4*)(pl + (size_t)i * 8 + 4);
              u32x4 w; w.x = pk2(a[0], a[1]); w.y = pk2(a[2], a[3]); w.z = pk2(b[0], b[1]); w.w = pk2(b[2], b[3]);
              *(u32x4*)(pb + (size_t)i * 8) = w;
          }
        }
        PH_END
        GRID_SYNC();
#ifdef DBLTEST
#ifdef DBL_SC
#define DBL_LD(p) ldc16(p)
#else
#define DBL_LD(p) (*(p))
#endif
        if (layer == 0) {
#ifdef DBL_OUTP
        PH_BEGIN
        { EpiResid E{X, XB, ss_ffn, nullptr, -1};
          GEMM_PHASE(EpiResid, ws + WS_VT, ws + W_OUT, MTOK, 1024, 1024, E, -1); }
        PH_END
        GRID_SYNC();
#endif
        for (int rep = 0; rep < 2; ++rep) {
        PH_BEGIN
#ifdef DBL_COPY
            { const u32x4* s4 = (const u32x4*)XB; u32x4* d4 = (u32x4*)(ws + WS_MIX + (size_t)rep * 176 * MiB);
              const size_t per = (size_t)DBL_M * DBL_N * 2 / 16 / 8;
              for (size_t i = (size_t)((jb_ + rep * 13) & 31) * NTHR + tid; i < per; i += (size_t)32 * NTHR) d4[(size_t)xb_ * per + i] = DBL_LD(s4 + (size_t)xb_ * per + i); }
#else
#ifndef DBL_W
#define DBL_W W_UP
#define DBL_ACT 0
#endif
            { EpiRowScale<DBL_ACT> E{(bf16_t*)(ws + WS_MIX + (size_t)rep * DBL_OFF * MiB), DBL_N, ss_attn, DBL_H};
              GEMM_PHASE(EpiRowScale<DBL_ACT>, XB, ws + DBL_W, DBL_M, DBL_N, 1024, E, DBL_H); }
#endif
        PH_END
        GRID_SYNC();
        }
        PH_BEGIN
        { const u32x4* a4 = (const u32x4*)(ws + WS_MIX); const u32x4* b4 = (const u32x4*)(ws + WS_MIX + (size_t)DBL_OFF * MiB); unsigned bad = 0u;
          const size_t per = (size_t)DBL_M * DBL_N * 2 / 16 / 8;
          for (size_t i0 = (size_t)((jb_ + 7) & 31) * NTHR + tid; i0 < per; i0 += (size_t)32 * NTHR) { const size_t i = (size_t)xb_ * per + i0; const u32x4 a = DBL_LD(a4 + i), b = DBL_LD(b4 + i); bad |= ((a.x ^ b.x) | (a.y ^ b.y) | (a.z ^ b.z) | (a.w ^ b.w)) ? 1u : 0u; }
          if (bad) __hip_atomic_fetch_or((unsigned*)(ws + WS_CTL) + 16, 1u, __ATOMIC_RELAXED, __HIP_MEMORY_SCOPE_AGENT); }
        PH_END
        GRID_SYNC();
        }
#endif
#if defined(DBLMIX) && !defined(DBLMIX_AT_GATES)
        for (int rep = 0; rep < 2; ++rep) {
#endif
#ifndef NO_INPROJ
        PH_BEGIN
        { EpiQK E{ws, ss_attn, PQ->in[I_QNORM] + layer * 64, PQ->in[I_KNORM] + layer * 64};
          GEMM_PHASE(EpiQK, XB, ws + W_IN, MTOK, 2048, 1024, E, -1); }
        PH_END
        PH_BEGIN
        { EpiSeg E{ws, ss_attn};
          GEMM_PHASE(EpiSeg, XB, ws + W_IN + (size_t)2048 * 2048, MTOK, 4096, 1024, E, -1); }
        PH_END
        PH_BEGIN
        { EpiGB E{ws, ss_attn, PQ->in[I_ALOG] + layer * 8, PQ->in[I_DTB] + layer * 8};
          GEMM_PHASE(EpiGB, XB, ws + W_IN + (size_t)6144 * 2048, MTOK, 256, 1024, E, -1); }
        PH_END
        PH_BEGIN
        { EpiVt E{(bf16_t*)(ws + WS_VT), ss_attn};
          GEMM_PHASE(EpiVt, ws + W_V, XB, 1024, MTOK, 1024, E, -1); }
        PH_END
#endif
        GRID_SYNC();
#ifndef NO_ATTN
        PH_BEGIN
        { const float* lq = PQ->in[I_LAM] + layer * 256;
          const float a1 = wave_sum(lq[lane] * lq[64 + lane]), a2 = wave_sum(lq[128 + lane] * lq[192 + lane]);
          const float lam = __expf(a1) - __expf(a2) + lam_init;
          for (int k = 0; k < 4; ++k) {
              const int pi = jb_ + 32 * k, hh = pi >> 4, s = pi & 15;
              attn_unit(lds, (const bf16_t*)(ws + WS_QA), (const bf16_t*)(ws + WS_KA), (const bf16_t*)(ws + WS_VT), (bf16_t*)(ws + WS_QA), xb_, hh, 31 - s, lam, 1.f - lam_init, PQ->in[I_SUBLN] + layer * 128, PQ->in[I_RELB], tid);
              attn_unit(lds, (const bf16_t*)(ws + WS_QA), (const bf16_t*)(ws + WS_KA), (const bf16_t*)(ws + WS_VT), (bf16_t*)(ws + WS_QA), xb_, hh, s, lam, 1.f - lam_init, PQ->in[I_SUBLN] + layer * 128, PQ->in[I_RELB], tid);
          }
        }
        PH_END
#endif
#ifndef NO_DN
        PH_BEGIN
#ifdef DN_NAIVE
        if (jb_ < 8) dn_naive(lds, ws, PQ->in[I_CONVB] + (size_t)layer * 4 * 3072, xb_, jb_, tid);
#else
#ifdef DN_FAST1
        dn_fast(lds, ws, PQ->in[I_CONVB] + (size_t)layer * 4 * 3072, xb_, jb_ >> 2, jb_ & 3, tid);
#else
        dn_pc(lds, ws, PQ->in[I_CONVB] + (size_t)layer * 4 * 3072, xb_, jb_ >> 2, jb_ & 3, tid);
#endif
#endif
        PH_END
#endif
        GRID_SYNC();
#if defined(DBLMIX) && defined(DBLMIX_AT_GATES)
        for (int rep = 0; rep < 2; ++rep) {
#endif
#ifndef NO_GATES
        PH_BEGIN
        { EpiRowScale<1> E{(bf16_t*)(ws + WS_G), 2048, ss_attn, -1};
          GEMM_PHASE(EpiRowScale<1>, XB, ws + W_GL, MTOK, 2048, 1024, E, -1); }
        PH_END
#endif
#ifndef NO_OBNORM
        PH_BEGIN
        { const float* on = PQ->in[I_ONORM] + layer * 128;
          const float g0 = on[2 * lane], g1 = on[2 * lane + 1];
          unsigned* OB = (unsigned*)(ws + WS_QB) + (size_t)xb_ * SEQ * 512; const unsigned* OI = (const unsigned*)(ws + WS_OSRC) + (size_t)xb_ * SEQ * 512; const unsigned* ZB = (const unsigned*)(ws + WS_ZB) + (size_t)xb_ * SEQ * 512;
          for (int r = wj; r < SEQ * NH; r += 256) {
              const unsigned ov = OI[(size_t)r * 64 + lane], zv = ZB[(size_t)r * 64 + lane];
              const float o0 = bflo(ov), o1 = bfhi(ov);
              const float sq = wave_sum(o0 * o0 + o1 * o1);
              const float rr = rsqrtf(sq * (1.f / 128.f) + EPS);
              OB[(size_t)r * 64 + lane] = pk2(o0 * rr * g0 * siluf_(bflo(zv)), o1 * rr * g1 * siluf_(bfhi(zv)));
          }
        }
        PH_END
#endif
        GRID_SYNC();
#ifndef NO_TMPA
        PH_BEGIN
        { EpiGateMul E{(bf16_t*)(ws + WS_TMPA), (const bf16_t*)(ws + WS_G), 2048, 0, nullptr};
          GEMM_PHASE(EpiGateMul, ws + WS_QA, ws + W_BRA, MTOK, 1024, 1024, E, -1); }
        PH_END
#endif
        GRID_SYNC();
#ifndef NO_MIXED
        PH_BEGIN
        { EpiGateMul E{(bf16_t*)(ws + WS_MIXED), (const bf16_t*)(ws + WS_G), 2048, 1024, (const bf16_t*)(ws + WS_TMPA)};
          GEMM_PHASE(EpiGateMul, ws + WS_QB, ws + W_BRB, MTOK, 1024, 1024, E, -1); }
        PH_END
#endif
        GRID_SYNC();
#ifdef DBLMIX
        PH_BEGIN
        { const u32x4* t4 = (const u32x4*)(ws + (size_t)DBL_TGT + (size_t)xb_ * ((size_t)DBL_TGT_BYTES / 8)); u32x4* s4 = (u32x4*)(ws + WS_PB + (size_t)xb_ * 2 * MiB); unsigned bad = 0u;
          for (size_t i = (size_t)((jb_ + 5 * rep) & 31) * NTHR + tid; i < (size_t)2 * MiB / 16; i += (size_t)32 * NTHR) {
              const u32x4 a = t4[i];
              if (rep == 0) s4[i] = a; else { const u32x4 b = s4[i]; bad |= ((a.x ^ b.x) | (a.y ^ b.y) | (a.z ^ b.z) | (a.w ^ b.w)) ? 1u : 0u; } }
          if (bad) __hip_atomic_fetch_or((unsigned*)(ws + WS_CTL) + 16, 1u, __ATOMIC_RELAXED, __HIP_MEMORY_SCOPE_AGENT); }
        PH_END
        GRID_SYNC();
        }
#endif
#ifndef NO_OUTP
        PH_BEGIN
        { EpiResid E{X, XB, ss_ffn, nullptr, -1};
          GEMM_PHASE(EpiResid, ws + WS_MIXED, ws + W_OUT, MTOK, 1024, 1024, E, -1); }
        PH_END
#endif
        GRID_SYNC();
        for (int half = 0; half < 2; ++half) {
#ifndef NO_UP
        PH_BEGIN
            { EpiRowScale<0> E{U, 5632, ss_ffn, half};
              GEMM_PHASE(EpiRowScale<0>, XB, ws + W_UP, 16384, 5632, 1024, E, half); }
        PH_END
#endif
            GRID_SYNC();
#ifndef NO_ACT
        PH_BEGIN
            { const float* cw = PQ->in[I_CONVFF] + (size_t)layer * 3 * 5632; const float* cb = PQ->in[I_CONVFFB] + (size_t)layer * 5632;
              bf16_t* UH = (bf16_t*)(ws + WS_UHALO) + (size_t)xb_ * 2 * 5632;
              for (int it = jb_ * NTHR + tid; it < 128 * 352; it += 32 * NTHR) {
                  const int cc = it % 352, rg = it / 352, c0 = cc * 8;
                  const int lrow0 = xb_ * 2048 + rg * 16;
                  float wg[3][8], wv[3][8], bg[8], bv[8];
#pragma unroll
                  for (int jj = 0; jj < 3; ++jj)
#pragma unroll
                      for (int e = 0; e < 8; ++e) { wg[jj][e] = cw[jj * 5632 + c0 + e]; wv[jj][e] = cw[jj * 5632 + 2816 + c0 + e]; }
#pragma unroll
                  for (int e = 0; e < 8; ++e) { bg[e] = cb[c0 + e]; bv[e] = cb[2816 + c0 + e]; }
                  float g2[8], g1[8], v2[8], v1[8];
#pragma unroll
                  for (int e = 0; e < 8; ++e) { g2[e] = 0.f; g1[e] = 0.f; v2[e] = 0.f; v1[e] = 0.f; }
                  if (rg > 0 || half == 1) {
                      const bf16_t* r2p = rg > 0 ? U + (size_t)(lrow0 - 2) * 5632 : UH;
                      const bf16_t* r1p = rg > 0 ? U + (size_t)(lrow0 - 1) * 5632 : UH + 5632;
                      const u32x4 a = *(const u32x4*)(r2p + c0), bq = *(const u32x4*)(r1p + c0);
                      const u32x4 c = *(const u32x4*)(r2p + 2816 + c0), d = *(const u32x4*)(r1p + 2816 + c0);
                      g2[0] = bflo(a.x); g2[1] = bfhi(a.x); g2[2] = bflo(a.y); g2[3] = bfhi(a.y); g2[4] = bflo(a.z); g2[5] = bfhi(a.z); g2[6] = bflo(a.w); g2[7] = bfhi(a.w);
                      g1[0] = bflo(bq.x); g1[1] = bfhi(bq.x); g1[2] = bflo(bq.y); g1[3] = bfhi(bq.y); g1[4] = bflo(bq.z); g1[5] = bfhi(bq.z); g1[6] = bflo(bq.w); g1[7] = bfhi(bq.w);
                      v2[0] = bflo(c.x); v2[1] = bfhi(c.x); v2[2] = bflo(c.y); v2[3] = bfhi(c.y); v2[4] = bflo(c.z); v2[5] = bfhi(c.z); v2[6] = bflo(c.w); v2[7] = bfhi(c.w);
                      v1[0] = bflo(d.x); v1[1] = bfhi(d.x); v1[2] = bflo(d.y); v1[3] = bfhi(d.y); v1[4] = bflo(d.z); v1[5] = bfhi(d.z); v1[6] = bflo(d.w); v1[7] = bfhi(d.w);
                  }
                  for (int rr = 0; rr < 16; ++rr) {
                      const size_t row = (size_t)lrow0 + rr;
                      const u32x4 a = *(const u32x4*)(U + row * 5632 + c0), c = *(const u32x4*)(U + row * 5632 + 2816 + c0);
                      if (half == 0 && rg == 127 && rr >= 14) { *(u32x4*)(UH + (size_t)(rr - 14) * 5632 + c0) = a; *(u32x4*)(UH + (size_t)(rr - 14) * 5632 + 2816 + c0) = c; }
                      float g0[8], v0[8], ov[8];
                      g0[0] = bflo(a.x); g0[1] = bfhi(a.x); g0[2] = bflo(a.y); g0[3] = bfhi(a.y); g0[4] = bflo(a.z); g0[5] = bfhi(a.z); g0[6] = bflo(a.w); g0[7] = bfhi(a.w);
                      v0[0] = bflo(c.x); v0[1] = bfhi(c.x); v0[2] = bflo(c.y); v0[3] = bfhi(c.y); v0[4] = bflo(c.z); v0[5] = bfhi(c.z); v0[6] = bflo(c.w); v0[7] = bfhi(c.w);
#pragma unroll
                      for (int e = 0; e < 8; ++e) {
                          const float ug = wg[0][e] * g2[e] + wg[1][e] * g1[e] + wg[2][e] * g0[e] + bg[e];
                          const float uv = wv[0][e] * v2[e] + wv[1][e] * v1[e] + wv[2][e] * v0[e] + bv[e];
                          ov[e] = siluf_(ug) * uv; g2[e] = g1[e]; g1[e] = g0[e]; v2[e] = v1[e]; v1[e] = v0[e];
                      }
                      u32x4 w; w.x = pk2(ov[0], ov[1]); w.y = pk2(ov[2], ov[3]); w.z = pk2(ov[4], ov[5]); w.w = pk2(ov[6], ov[7]);
                      *(u32x4*)(ACT + row * 2816 + c0) = w;
                  }
              }
            }
        PH_END
#endif
            GRID_SYNC();
#ifndef NO_DOWN
        PH_BEGIN
            { EpiResid E{X, XB, ss_ple, nullptr, half};
              GEMM_PHASE(EpiResid, ACT, ws + W_DOWN, 16384, 1024, 2816, E, -1); }
        PH_END
#endif
            GRID_SYNC();
        }
#ifndef NO_PLEG
        PH_BEGIN
        { EpiRowScale<1> E{(bf16_t*)(ws + WS_MIX), 1024, ss_ple, -1};
          GEMM_PHASE(EpiRowScale<1>, XB, ws + W_PG, MTOK, 1024, 1024, E, -1); }
        PH_END
#endif
        GRID_SYNC();
#ifndef NO_PLE
        PH_BEGIN
        { EpiResid E{X, XB, ss_next, (const bf16_t*)(ws + WS_MIX), -1};
          GEMM_PHASE(EpiResid, ws + WS_PB, ws + W_PP, MTOK, 1024, 256, E, -1); }
        PH_END
#endif
        GRID_SYNC();
    }
#ifdef NANCHK
    { const int layer = 0; PH_BEGIN
      unsigned bad = 0u;
      for (size_t i = (size_t)bid * NTHR + tid; i < (size_t)MTOK * 256; i += (size_t)G * NTHR) { const f32x4 v = *(const f32x4*)(X + i * 4);
          for (int e = 0; e < 4; ++e) bad |= ((__float_as_uint(v[e]) & 0x7f800000u) == 0x7f800000u) ? 1u : 0u; }
#ifdef NANCHK_BF_LO
      { const unsigned* bp = (const unsigned*)(ws + (size_t)NANCHK_BF_LO); const size_t nw = ((size_t)NANCHK_BF_HI - (size_t)NANCHK_BF_LO) / 4;
        for (size_t i = (size_t)bid * NTHR + tid; i < nw; i += (size_t)G * NTHR) { const unsigned w = bp[i]; bad |= (((w & 0x7f80u) == 0x7f80u) || ((w & 0x7f800000u) == 0x7f800000u)) ? 1u : 0u; } }
#endif
      if (bad) __hip_atomic_fetch_or((unsigned*)(ws + WS_CTL) + 16, 1u, __ATOMIC_RELAXED, __HIP_MEMORY_SCOPE_AGENT);
      PH_END }
    GRID_SYNC();
    { const int layer = 0; PH_BEGIN
      const unsigned fl = __hip_atomic_fetch_or((unsigned*)(ws + WS_CTL) + 16, 0u, __ATOMIC_RELAXED, __HIP_MEMORY_SCOPE_AGENT);
      if (fl) for (size_t i = (size_t)bid * NTHR + tid; i < (size_t)MTOK * 256; i += (size_t)G * NTHR) *(f32x4*)(X + i * 4) = (f32x4){0.f, 0.f, 0.f, 0.f};
      PH_END }
#endif
#undef U
#undef ACT
}

extern "C" void kernel_launch(void* const* d_in, const int* in_sizes, int n_in, void* d_out, int out_size, void* d_ws, size_t ws_size, hipStream_t stream) {
    static int grid = 0;
    if (grid == 0) {
        if (n_in != 24 || out_size != MTOK * DM || ws_size < WS_TOTAL) { fprintf(stderr, "kernel_launch: unexpected shapes / workspace (n_in %d out %d ws %zu need %zu)\n", n_in, out_size, ws_size, (size_t)WS_TOTAL); grid = -1; return; }
        int dev = 0, cus = 0, per_cu = 0;
        hipGetDevice(&dev);
        hipDeviceGetAttribute(&cus, hipDeviceAttributeMultiprocessorCount, dev);
        hipFuncSetAttribute((const void*)fwd_mega, hipFuncAttributeMaxDynamicSharedMemorySize, LDS_BYTES);
        hipOccupancyMaxActiveBlocksPerMultiprocessor(&per_cu, (const void*)fwd_mega, NTHR, LDS_BYTES);
        if (per_cu < 1) { fprintf(stderr, "kernel_launch: occupancy query says %d blocks per CU\n", per_cu); per_cu = 1; }
        (void)hipGetLastError();
        grid = cus;
    }
    if (grid < 0) return;
    Params p{};
    for (int i = 0; i < 24; ++i) p.in[i] = (const float*)d_in[i];
    p.out = (float*)d_out; p.ws = (unsigned char*)d_ws;
    hipError_t e = hipSuccess;
#ifdef N_SEG_LAUNCH
    for (int sgi = 0; sgi < 60 && e == hipSuccess; sgi += N_SEG_LAUNCH) {
        p.seg_lo = sgi; p.seg_hi = sgi + N_SEG_LAUNCH;
        void* args[] = {&p};
        e = hipLaunchCooperativeKernel((const void*)fwd_mega, dim3(grid), dim3(NTHR), args, LDS_BYTES, stream);
    }
#else
    p.seg_lo = 0; p.seg_hi = 1000;
    void* args[] = {&p};
    e = hipLaunchCooperativeKernel((const void*)fwd_mega, dim3(grid), dim3(NTHR), args, LDS_BYTES, stream);
#endif
    if (e != hipSuccess) fprintf(stderr, "cooperative launch failed: %s (grid %d)\n", hipGetErrorString(e), grid);
}
```

```cpp
#include <hip/hip_runtime.h>
#include <hip/hip_cooperative_groups.h>
#include <cstdio>
#include <cstdint>
namespace cg = cooperative_groups;
namespace pg8 {
#define PG8_LAS __attribute__((address_space(3)))
typedef unsigned short bf16_t;
typedef short bf16x8 __attribute__((ext_vector_type(8)));
typedef float f32x4 __attribute__((ext_vector_type(4)));
typedef unsigned u32x4 __attribute__((ext_vector_type(4)));
constexpr int BM = 256, BK = 64, HALF = 128, HTB = HALF * BK * 2  , STAGE_BYTES = 8 * HTB, NXCD = 8, WGM = 8;

__host__ __device__ __forceinline__ int lds_byte(int r, int c) { const int st = (r >> 4) * 2 + (c >> 5), rr = r & 15, cc = c & 31, ob = rr * 64 + cc * 2; return st * 1024 + (ob ^ (((ob >> 9) & 1) << 5)); }
__host__ __device__ __forceinline__ void stage_rc(int b, int& R, int& C) { const int st = b / 1024, sb = b % 1024, swz = sb ^ (((sb >> 9) & 1) << 5); R = (st >> 1) * 16 + swz / 64; C = (st & 1) * 32 + (swz % 64) / 2; }
__host__ __device__ __forceinline__ int perm32(int rho) { const int n = rho >> 4, i = rho & 15; return 8 * (i >> 2) + 4 * n + (i & 3); }

struct Unit { int pm, pn; };
struct Gemm { const bf16_t* A; const bf16_t* Bt; int M, N, K; int hmap; };
__device__ __forceinline__ int amap(int pm, int hmap) { return hmap < 0 ? pm : ((pm >> 3) * 16 + 8 * hmap + (pm & 7)); }

struct StaticOrder {
    int nM, nN, nwg, G, c;
    __host__ __device__ void init(int M, int N, int G_, int c_) { nM = M / BM; nN = N / BM; nwg = nM * nN; G = G_; c = c_; }
    __host__ __device__ bool next(int i, Unit& u) const {
        const long L = (long)i * G + c; if (L >= nwg) return false;
        int wgid = (int)L; { const int q = nwg / NXCD, r = nwg % NXCD, xcd = wgid % NXCD, off = wgid / NXCD; wgid = (xcd < r ? xcd * (q + 1) : r * (q + 1) + (xcd - r) * q) + off; }
        const int nig = WGM * nN, gid = wgid / nig, fm = gid * WGM, gsz = (nM - fm) < WGM ? (nM - fm) : WGM;
        u.pm = fm + ((wgid % nig) % gsz); u.pn = (wgid % nig) / gsz; return true;
    }
    __device__ __forceinline__ void a_ready(const Unit&) const {}
    __device__ __forceinline__ void done(const Unit&) const {}
};
__device__ __forceinline__ unsigned cvt_pk_bf16(float lo, float hi) { unsigned r; asm volatile("v_cvt_pk_bf16_f32 %0, %1, %2" : "=v"(r) : "v"(lo), "v"(hi)); return r; }
#ifdef NO_UNI
__device__ __forceinline__ const char* uni(const char* p) { return p; }
#else
__device__ __forceinline__ const char* uni(const char* p) { const unsigned long long v = (unsigned long long)p; const unsigned lo = __builtin_amdgcn_readfirstlane((unsigned)v), hi = __builtin_amdgcn_readfirstlane((unsigned)(v >> 32)); return (const char*)(((unsigned long long)hi << 32) | lo); }
#endif
template <class Epi, class Sched, bool ALIGN_EPI = false, bool SP2 = false>
__device__ __forceinline__ void gemm_phase(PG8_LAS unsigned char* lds, const Gemm g, const Sched& S, const Epi& E) {
    int tid = threadIdx.x;
#ifndef NO_LAUNDER
    asm volatile("" : "+v"(tid));
#endif

    const int wid = __builtin_amdgcn_readfirstlane(tid >> 6), lane = tid & 63, wr = wid >> 2, wc = wid & 3, fr = lane & 15, fq = lane >> 4;
    const int K = g.K, nt = K / BK;
    unsigned voffA[2], voffB[2];
#pragma unroll
    for (int i = 0; i < 2; ++i) { int R, C; stage_rc(tid * 16 + i * 8192, R, C); const int Rb = Epi::PERM ? ((R & ~31) + perm32(R & 31)) : R;
        voffA[i] = (unsigned)(R * K + C) * 2u; voffB[i] = (unsigned)(Rb * K + C) * 2u; }
    const size_t kstep = (size_t)(BK * 2);
    const size_t hstep = (size_t)HALF * K * 2;
    const size_t tstep = 2 * hstep;
    const unsigned ldsw = (unsigned)wid * 1024u;
    const int aoff = lds_byte(wr * 64 + fr, fq * 8), boff = lds_byte(wc * 32 + fr, fq * 8);
#define PG8_SA(b, h) (((b) * 2 + (h)) * HTB)
#define PG8_SB(b, h) ((4 + (b) * 2 + (h)) * HTB)
#define PG8_STAGE(bufoff, gbase, voff) do { _Pragma("unroll") for (int _i = 0; _i < 2; ++_i) \
        __builtin_amdgcn_global_load_lds((const unsigned*)((const char*)(gbase) + (voff)[_i]), (PG8_LAS unsigned*)(lds + (bufoff) + ldsw + _i * 8192), 16, 0, 0); } while (0)
#define PG8_LDA(dst, b, h) do { _Pragma("unroll") for (int m = 0; m < 4; ++m) _Pragma("unroll") for (int k = 0; k < 2; ++k) dst[m][k] = *(const PG8_LAS bf16x8*)(lds + PG8_SA(b, h) + aoff + m * 2048 + k * 1024); } while (0)
#define PG8_LDB(dst, b, h) do { _Pragma("unroll") for (int n = 0; n < 2; ++n) _Pragma("unroll") for (int k = 0; k < 2; ++k) dst[n][k] = *(const PG8_LAS bf16x8*)(lds + PG8_SB(b, h) + boff + n * 2048 + k * 1024); } while (0)
#define PG8_MMA(ai, bj, At, Bt) do { __builtin_amdgcn_s_setprio(1); _Pragma("unroll") for (int m = 0; m < 4; ++m) _Pragma("unroll") for (int n = 0; n < 2; ++n) _Pragma("unroll") for (int k = 0; k < 2; ++k) \
        acc[ai][bj][m][n] = __builtin_amdgcn_mfma_f32_16x16x32_bf16(Bt[n][k], At[m][k], acc[ai][bj][m][n], 0, 0, 0); __builtin_amdgcn_s_setprio(0); } while (0)
#define PG8_WAIT_V(n) asm volatile("s_waitcnt vmcnt(" #n ")" ::: "memory")
#define PG8_WAIT_L(n) asm volatile("s_waitcnt lgkmcnt(" #n ")" ::: "memory")
#define PG8_BAR __builtin_amdgcn_s_barrier()
#define PG8_SCHED __builtin_amdgcn_sched_barrier(0)
    Unit cur, nxt; int ui = 0;
    if (!S.next(0, cur)) return;
    f32x4 acc[2][2][4][2];
#pragma unroll
    for (int a = 0; a < 2; ++a)
#pragma unroll
        for (int b = 0; b < 2; ++b)
#pragma unroll
            for (int m = 0; m < 4; ++m)
#pragma unroll
                for (int n = 0; n < 2; ++n) acc[a][b][m][n] = (f32x4){0.f, 0.f, 0.f, 0.f};
    bf16x8 At[4][2], B0[2][2], B1[2][2];
    const char* cA = uni((const char*)g.A + (size_t)amap(cur.pm, g.hmap) * tstep); const char* cB = uni((const char*)g.Bt + (size_t)cur.pn * tstep);
    S.a_ready(cur);
    if constexpr (SP2) {
        PG8_STAGE(PG8_SB(0, 0), cB, voffB); PG8_STAGE(PG8_SB(0, 1), cB + hstep, voffB); PG8_STAGE(PG8_SA(0, 0), cA, voffA); PG8_STAGE(PG8_SA(0, 1), cA + hstep, voffA);
        if (wr == 1) PG8_BAR;
        PG8_WAIT_V(2); PG8_BAR;
        PG8_STAGE(PG8_SB(1, 0), cB + kstep, voffB); PG8_STAGE(PG8_SA(1, 0), cA + kstep, voffA); PG8_STAGE(PG8_SB(1, 1), cB + hstep + kstep, voffB);
        PG8_WAIT_V(6); PG8_BAR;
    } else {
        PG8_STAGE(PG8_SB(0, 0), cB, voffB); PG8_STAGE(PG8_SA(0, 0), cA, voffA); PG8_STAGE(PG8_SB(0, 1), cB + hstep, voffB); PG8_STAGE(PG8_SA(0, 1), cA + hstep, voffA);
        if (wr == 1) PG8_BAR;
        PG8_WAIT_V(4); PG8_BAR;
        PG8_STAGE(PG8_SB(1, 0), cB + kstep, voffB); PG8_STAGE(PG8_SA(1, 0), cA + kstep, voffA); PG8_STAGE(PG8_SB(1, 1), cB + hstep + kstep, voffB);
        PG8_WAIT_V(6); PG8_BAR;
    }
    for (;;) {
        const bool has_next = S.next(ui + 1, nxt);
        const char* nA = uni(has_next ? (const char*)g.A + (size_t)amap(nxt.pm, g.hmap) * tstep : cA); const char* nB = uni(has_next ? (const char*)g.Bt + (size_t)nxt.pn * tstep : cB);
        for (int t = 0; t < nt; t += 2) {
            const bool last = (t == nt - 2);
            const char* a1 = cA + (size_t)(t + 1) * kstep;
            const char* a2 = last ? nA : cA + (size_t)(t + 2) * kstep; const char* b2 = last ? nB : cB + (size_t)(t + 2) * kstep;
            const char* a3 = a2 + kstep; const char* b3 = b2 + kstep;
            if (last && has_next) S.a_ready(nxt);
            if constexpr (SP2) {
            PG8_LDB(B0, 0, 0); PG8_LDB(B1, 0, 1); PG8_SCHED; PG8_LDA(At, 0, 0); PG8_STAGE(PG8_SA(1, 1), a1 + hstep, voffA);
            PG8_WAIT_V(8); PG8_WAIT_L(0); PG8_BAR; PG8_MMA(0, 0, At, B0); PG8_MMA(0, 1, At, B1); PG8_BAR; PG8_SCHED;
            PG8_LDA(At, 0, 1); PG8_STAGE(PG8_SB(0, 0), b2, voffB); PG8_STAGE(PG8_SB(0, 1), b2 + hstep, voffB); PG8_STAGE(PG8_SA(0, 0), a2, voffA);
            PG8_WAIT_V(8); PG8_WAIT_L(0); PG8_BAR; PG8_MMA(1, 0, At, B0); PG8_MMA(1, 1, At, B1); PG8_BAR; PG8_SCHED;
            PG8_LDB(B0, 1, 0); PG8_LDB(B1, 1, 1); PG8_SCHED; PG8_LDA(At, 1, 0); PG8_STAGE(PG8_SA(0, 1), a2 + hstep, voffA);
            PG8_WAIT_V(8); PG8_WAIT_L(0); PG8_BAR; PG8_MMA(0, 0, At, B0); PG8_MMA(0, 1, At, B1); PG8_BAR; PG8_SCHED;
            PG8_LDA(At, 1, 1); PG8_STAGE(PG8_SB(1, 0), b3, voffB); PG8_STAGE(PG8_SB(1, 1), b3 + hstep, voffB); PG8_STAGE(PG8_SA(1, 0), a3, voffA);
            PG8_WAIT_V(8); PG8_WAIT_L(0); PG8_BAR; PG8_MMA(1, 0, At, B0); PG8_MMA(1, 1, At, B1); PG8_BAR; PG8_SCHED;
            } else {
            PG8_LDB(B0, 0, 0); PG8_SCHED; PG8_LDA(At, 0, 0); PG8_STAGE(PG8_SA(1, 1), a1 + hstep, voffA);
            PG8_WAIT_L(8); PG8_BAR; PG8_WAIT_L(0); PG8_MMA(0, 0, At, B0); PG8_BAR; PG8_SCHED;
            PG8_LDB(B1, 0, 1); PG8_STAGE(PG8_SB(0, 0), b2, voffB);
            PG8_BAR; PG8_WAIT_L(0); PG8_MMA(0, 1, At, B1); PG8_BAR;
            PG8_LDA(At, 0, 1); PG8_STAGE(PG8_SA(0, 0), a2, voffA);
            PG8_BAR; PG8_WAIT_L(0); PG8_MMA(1, 0, At, B0); PG8_BAR; PG8_SCHED;
            PG8_STAGE(PG8_SB(0, 1), b2 + hstep, voffB);
            PG8_WAIT_V(6); PG8_BAR; PG8_MMA(1, 1, At, B1); PG8_BAR;
            PG8_LDB(B0, 1, 0); PG8_SCHED; PG8_LDA(At, 1, 0); PG8_STAGE(PG8_SA(0, 1), a2 + hstep, voffA);
            PG8_WAIT_L(8); PG8_BAR; PG8_WAIT_L(0); PG8_MMA(0, 0, At, B0); PG8_BAR; PG8_SCHED;
            PG8_LDB(B1, 1, 1); PG8_STAGE(PG8_SB(1, 0), b3, voffB);
            PG8_BAR; PG8_WAIT_L(0); PG8_MMA(0, 1, At, B1); PG8_BAR;
            PG8_LDA(At, 1, 1); PG8_STAGE(PG8_SA(1, 0), a3, voffA);
            PG8_BAR; PG8_WAIT_L(0); PG8_MMA(1, 0, At, B0); PG8_BAR; PG8_SCHED;
            PG8_STAGE(PG8_SB(1, 1), b3 + hstep, voffB);
            PG8_WAIT_V(6); PG8_BAR; PG8_MMA(1, 1, At, B1); PG8_BAR;
            }
        }
        if constexpr (ALIGN_EPI) { if (wr == 0) PG8_BAR; }
        if constexpr (!Epi::AFTER_DRAIN) { E(acc, cur, wr, wc, fr, fq); S.done(cur); }
        if (!has_next) break;
#pragma unroll
        for (int a = 0; a < 2; ++a)
#pragma unroll
            for (int b = 0; b < 2; ++b)
#pragma unroll
                for (int m = 0; m < 4; ++m)
#pragma unroll
                    for (int n = 0; n < 2; ++n) acc[a][b][m][n] = (f32x4){0.f, 0.f, 0.f, 0.f};
        cur = nxt; cA = nA; cB = nB; ++ui;
        if constexpr (ALIGN_EPI) { if (wr == 1) PG8_BAR; }
    }
    PG8_WAIT_V(0);
    if constexpr (!ALIGN_EPI) { if (wr == 0) PG8_BAR; }
    PG8_BAR;
    if constexpr (Epi::AFTER_DRAIN) { E.fused(acc, cur, wr, wc, fr, fq, lds, wid, lane); S.done(cur); }
#undef PG8_SA
#undef PG8_SB
#undef PG8_STAGE
#undef PG8_LDA
#undef PG8_LDB
#undef PG8_MMA
#undef PG8_WAIT_V
#undef PG8_WAIT_L
#undef PG8_BAR
#undef PG8_SCHED
}
}

#define GAS __attribute__((address_space(1)))
#define LAS __attribute__((address_space(3)))
typedef unsigned short bf16_t;
typedef float f32x4 __attribute__((ext_vector_type(4)));
typedef float f32x16 __attribute__((ext_vector_type(16)));
typedef short bf16x8 __attribute__((ext_vector_type(8)));
typedef unsigned u32x4 __attribute__((ext_vector_type(4)));
typedef unsigned u32x2 __attribute__((ext_vector_type(2)));

#ifndef NLAYER_V
#define NLAYER_V 4
#endif
constexpr int NW = 8, NTHR = 512;
constexpr int MTOK = 32768, DM = 1024, SEQ = 4096, NB = 8, NLAYER = NLAYER_V, NH = 8;
constexpr int DIN = 9232, DFF = 2816, DPLE = 256;
constexpr float EPS = 1e-6f;
constexpr float LOG2E = 1.4426950408889634f;
constexpr size_t MiB = 1u << 20;
constexpr size_t WS_SS = 0;
constexpr size_t WS_CTL = 1792 * 1024;
constexpr size_t WS_UHALO = 1856 * 1024;
constexpr size_t WS_GB = 2 * MiB;
constexpr size_t WS_HALO = 4 * MiB;
constexpr size_t WS_PB = 14 * MiB;
constexpr size_t WS_W = 30 * MiB;
constexpr size_t W_IN = WS_W, W_V = W_IN + (size_t)6400 * 1024 * 2, W_GL = W_V + 2 * MiB, W_BRA = W_GL + 4 * MiB, W_BRB = W_BRA + 2 * MiB,
                 W_OUT = W_BRB + 2 * MiB, W_UP = W_OUT + 2 * MiB, W_DOWN = W_UP + 11 * MiB, W_PG = W_DOWN + (size_t)1024 * 2816 * 2, W_PP = W_PG + 2 * MiB, W_END = W_PP + (size_t)1024 * 256 * 2;
static_assert(W_END <= 74 * MiB, "weights region");
constexpr size_t WS_XB = 74 * MiB;
constexpr size_t WS_MIX = 138 * MiB;
constexpr size_t S64 = 64 * MiB;
constexpr size_t WS_QA = WS_MIX, WS_KA = WS_MIX + S64, WS_VT = WS_MIX + 2 * S64, WS_QB = WS_MIX + 3 * S64, WS_KB = WS_MIX + 4 * S64, WS_VB = WS_MIX + 5 * S64, WS_ZB = WS_MIX + 6 * S64;
constexpr size_t WS_TOTAL = WS_MIX + 7 * S64;
#ifdef DN_NAIVE
constexpr size_t WS_G = WS_KB, WS_TMPA = WS_KA, WS_MIXED = WS_VT, WS_OSRC = WS_QB;
#else
constexpr size_t WS_G = WS_KA, WS_TMPA = WS_KB, WS_MIXED = WS_VB, WS_OSRC = WS_VB;
#endif
constexpr int LDS_BYTES = 147456, LDS_VB = 140032;

__device__ __forceinline__ float bflo(unsigned w) { return __uint_as_float(w << 16); }
__device__ __forceinline__ float bfhi(unsigned w) { return __uint_as_float(w & 0xffff0000u); }
__device__ __forceinline__ float bf2f(bf16_t v) { return __uint_as_float((unsigned)v << 16); }
typedef float f32x2_t __attribute__((ext_vector_type(2))); typedef __bf16 bf16x2_t __attribute__((ext_vector_type(2)));
__device__ __forceinline__ unsigned pk2(float lo, float hi) { const f32x2_t v = {lo, hi}; const bf16x2_t b = __builtin_convertvector(v, bf16x2_t); return __builtin_bit_cast(unsigned, b); }
__device__ __forceinline__ bf16_t f2bf(float f) { return (bf16_t)(pk2(f, 0.f) & 0xffffu); }
__device__ __forceinline__ float sigmoidf_(float x) { x = fminf(fmaxf(x, -60.f), 60.f); return __builtin_amdgcn_rcpf(1.f + __expf(-x)); }
__device__ __forceinline__ float siluf_(float x) { return x * sigmoidf_(x); }
__device__ __forceinline__ float wave_sum(float v) {
#pragma unroll
    for (int o = 1; o < 64; o <<= 1) v += __shfl_xor(v, o);
    return v;
}
__device__ __forceinline__ float ss_load(const float* p) { const f32x4 a = *(const f32x4*)p, b = *(const f32x4*)(p + 4), c = *(const f32x4*)(p + 8), d = *(const f32x4*)(p + 12);
    float s = (((a[0] + a[1]) + (a[2] + a[3])) + ((b[0] + b[1]) + (b[2] + b[3]))) + (((c[0] + c[1]) + (c[2] + c[3])) + ((d[0] + d[1]) + (d[2] + d[3])));
    asm volatile("" : "+v"(s) :: "memory");
    return s; }
__device__ __forceinline__ u32x4 ldc16(const void* p) { u32x4 v; asm volatile("global_load_dwordx4 %0, %1, off sc0 sc1\n\ts_waitcnt vmcnt(0)" : "=v"(v) : "v"(p) : "memory"); return v; }
__device__ __forceinline__ int crow(int r, int hi) { return (r & 3) + 8 * (r >> 2) + 4 * hi; }

__device__ __forceinline__ float ss_sum16(const f32x4 a, const f32x4 b, const f32x4 c, const f32x4 d) {
    return (((a[0] + a[1]) + (a[2] + a[3])) + ((b[0] + b[1]) + (b[2] + b[3]))) + (((c[0] + c[1]) + (c[2] + c[3])) + ((d[0] + d[1]) + (d[2] + d[3]))); }
__device__ __forceinline__ int gmap(int row, int h) { return h < 0 ? row : ((row >> 11) * 4096 + 2048 * h + (row & 2047)); }

__device__ __forceinline__ void load_rs8(const float* ss, int rowbase, int hmap, int lane, int fr, float (&rs)[2][4]) {
    const float* p0 = ss + (size_t)gmap(rowbase + lane, hmap) * 16; const float* p1 = ss + (size_t)gmap(rowbase + 128 + lane, hmap) * 16;
    const f32x4 a0 = *(const f32x4*)p0, b0 = *(const f32x4*)(p0 + 4), c0 = *(const f32x4*)(p0 + 8), d0 = *(const f32x4*)(p0 + 12);
    const f32x4 a1 = *(const f32x4*)p1, b1 = *(const f32x4*)(p1 + 4), c1 = *(const f32x4*)(p1 + 8), d1 = *(const f32x4*)(p1 + 12);
    const float r0 = rsqrtf(ss_sum16(a0, b0, c0, d0) * (1.f / 1024.f) + EPS), r1 = rsqrtf(ss_sum16(a1, b1, c1, d1) * (1.f / 1024.f) + EPS);
#pragma unroll
    for (int m = 0; m < 4; ++m) { rs[0][m] = __shfl(r0, m * 16 + fr); rs[1][m] = __shfl(r1, m * 16 + fr); }
    asm volatile("" ::: "memory");
}

using pg8::Unit;
typedef f32x4 AccT[2][2][4][2];

template <int ACT> struct EpiRowScale {
    static constexpr bool PERM = true, AFTER_DRAIN = false;
    bf16_t* O; int ldc; const float* ss; int hmap;
    __device__ __forceinline__ void operator()(const AccT& acc, const Unit& u, int wr, int wc, int fr, int fq) const {
        const int row0 = u.pm * 256 + wr * 64 + fr, col0 = u.pn * 256 + wc * 32 + 8 * fq;
        float rsv[2][4]; load_rs8(ss, u.pm * 256 + wr * 64, hmap, (int)(threadIdx.x & 63), fr, rsv);
#pragma unroll
        for (int ai = 0; ai < 2; ++ai)
#pragma unroll
            for (int m = 0; m < 4; ++m) {
                const int row = row0 + ai * 128 + m * 16;
                const float rs = rsv[ai][m];
                bf16_t* rowp = O + (size_t)row * ldc + col0;
#pragma unroll
                for (int bj = 0; bj < 2; ++bj) {
                    f32x4 v0 = acc[ai][bj][m][0] * rs, v1 = acc[ai][bj][m][1] * rs;
                    if (ACT == 1) {
#pragma unroll
                        for (int e = 0; e < 4; ++e) { v0[e] = sigmoidf_(v0[e]); v1[e] = sigmoidf_(v1[e]); }
                    }
                    u32x4 w; w.x = pk2(v0[0], v0[1]); w.y = pk2(v0[2], v0[3]); w.z = pk2(v1[0], v1[1]); w.w = pk2(v1[2], v1[3]);
                    *(u32x4*)(rowp + bj * 128) = w;
                    asm volatile("" ::: "memory");
                }
            }
    }
};

struct EpiVt {
    static constexpr bool PERM = true, AFTER_DRAIN = false;
    bf16_t* O; const float* ss;
    __device__ __forceinline__ void operator()(const AccT& acc, const Unit& u, int wr, int wc, int fr, int fq) const {
        const int row0 = u.pm * 256 + wr * 64 + fr, col0 = u.pn * 256 + wc * 32 + 8 * fq;
        float rs[2][8];
        { const int L = (int)(threadIdx.x & 63); const float* pc = ss + (size_t)(u.pn * 256 + (L >> 5) * 128 + wc * 32 + (L & 31)) * 16;
          const f32x4 a = *(const f32x4*)pc, b = *(const f32x4*)(pc + 4), c = *(const f32x4*)(pc + 8), d = *(const f32x4*)(pc + 12);
          const float r = rsqrtf(ss_sum16(a, b, c, d) * (1.f / 1024.f) + EPS);
#pragma unroll
          for (int bj = 0; bj < 2; ++bj)
#pragma unroll
              for (int e = 0; e < 8; ++e) rs[bj][e] = __shfl(r, bj * 32 + 8 * fq + e); }
#pragma unroll
        for (int ai = 0; ai < 2; ++ai)
#pragma unroll
            for (int m = 0; m < 4; ++m) {
                const int row = row0 + ai * 128 + m * 16;
                bf16_t* rowp = O + (size_t)row * MTOK + col0;
#pragma unroll
                for (int bj = 0; bj < 2; ++bj) {
                    const f32x4 v0 = acc[ai][bj][m][0], v1 = acc[ai][bj][m][1];
                    u32x4 w; w.x = pk2(v0[0] * rs[bj][0], v0[1] * rs[bj][1]); w.y = pk2(v0[2] * rs[bj][2], v0[3] * rs[bj][3]);
                    w.z = pk2(v1[0] * rs[bj][4], v1[1] * rs[bj][5]); w.w = pk2(v1[2] * rs[bj][6], v1[3] * rs[bj][7]);
                    *(u32x4*)(rowp + bj * 128) = w;
                }
                asm volatile("" ::: "memory");
            }
    }
};

struct EpiGateMul {
    static constexpr bool PERM = true, AFTER_DRAIN = false;
    bf16_t* O; const bf16_t* G; int ldg, goff; const bf16_t* Add;
    __device__ __forceinline__ void operator()(const AccT& acc, const Unit& u, int wr, int wc, int fr, int fq) const {
        const int row0 = u.pm * 256 + wr * 64 + fr, col0 = u.pn * 256 + wc * 32 + 8 * fq;
#pragma unroll
        for (int ai = 0; ai < 2; ++ai)
#pragma unroll
            for (int m = 0; m < 4; ++m) {
                const int row = row0 + ai * 128 + m * 16;
#pragma unroll
                for (int bj = 0; bj < 2; ++bj) {
                    const int c = col0 + bj * 128;
                    const u32x4 g = *(const u32x4*)(G + (size_t)row * ldg + goff + c);
                    u32x4 a = (u32x4){0u, 0u, 0u, 0u};
                    if (Add) a = *(const u32x4*)(Add + (size_t)row * 1024 + c);
                    const f32x4 v0 = acc[ai][bj][m][0], v1 = acc[ai][bj][m][1];
                    u32x4 w;
                    w.x = pk2(bflo(a.x) + bflo(g.x) * v0[0], bfhi(a.x) + bfhi(g.x) * v0[1]);
                    w.y = pk2(bflo(a.y) + bflo(g.y) * v0[2], bfhi(a.y) + bfhi(g.y) * v0[3]);
                    w.z = pk2(bflo(a.z) + bflo(g.z) * v1[0], bfhi(a.z) + bfhi(g.z) * v1[1]);
                    w.w = pk2(bflo(a.w) + bflo(g.w) * v1[2], bfhi(a.w) + bfhi(g.w) * v1[3]);
                    *(u32x4*)(O + (size_t)row * 1024 + c) = w;
                }
                asm volatile("" ::: "memory");
            }
    }
};

struct EpiResid {
    static constexpr bool PERM = true, AFTER_DRAIN = false;
    float* X; bf16_t* XB; float* ssn; const bf16_t* Mul; int hmap;
    __device__ __forceinline__ void operator()(const AccT& acc, const Unit& u, int wr, int wc, int fr, int fq) const {
        const int row0 = u.pm * 256 + wr * 64 + fr, col0 = u.pn * 256 + wc * 32 + 8 * fq;
#pragma unroll
        for (int ai = 0; ai < 2; ++ai)
#pragma unroll
            for (int m = 0; m < 4; ++m) {
                const int row = gmap(row0 + ai * 128 + m * 16, hmap);
                const size_t off0 = (size_t)row * 1024 + col0;
                f32x4 xa = *(const f32x4*)(X + off0), xb2 = *(const f32x4*)(X + off0 + 4), xc = *(const f32x4*)(X + off0 + 128), xd = *(const f32x4*)(X + off0 + 132);
                f32x4 va = acc[ai][0][m][0], vb2 = acc[ai][0][m][1], vc = acc[ai][1][m][0], vd = acc[ai][1][m][1];
                if (Mul) {
                    const u32x4 g0 = *(const u32x4*)(Mul + off0), g1 = *(const u32x4*)(Mul + off0 + 128);
                    va[0] *= bflo(g0.x); va[1] *= bfhi(g0.x); va[2] *= bflo(g0.y); va[3] *= bfhi(g0.y); vb2[0] *= bflo(g0.z); vb2[1] *= bfhi(g0.z); vb2[2] *= bflo(g0.w); vb2[3] *= bfhi(g0.w);
                    vc[0] *= bflo(g1.x); vc[1] *= bfhi(g1.x); vc[2] *= bflo(g1.y); vc[3] *= bfhi(g1.y); vd[0] *= bflo(g1.z); vd[1] *= bfhi(g1.z); vd[2] *= bflo(g1.w); vd[3] *= bfhi(g1.w);
                }
                xa += va; xb2 += vb2; xc += vc; xd += vd;
                *(f32x4*)(X + off0) = xa; *(f32x4*)(X + off0 + 4) = xb2; *(f32x4*)(X + off0 + 128) = xc; *(f32x4*)(X + off0 + 132) = xd;
                u32x4 w0; w0.x = pk2(xa[0], xa[1]); w0.y = pk2(xa[2], xa[3]); w0.z = pk2(xb2[0], xb2[1]); w0.w = pk2(xb2[2], xb2[3]);
                u32x4 w1; w1.x = pk2(xc[0], xc[1]); w1.y = pk2(xc[2], xc[3]); w1.z = pk2(xd[0], xd[1]); w1.w = pk2(xd[2], xd[3]);
                *(u32x4*)(XB + off0) = w0; *(u32x4*)(XB + off0 + 128) = w1;
                float sq = ((xa[0] * xa[0] + xa[1] * xa[1]) + (xa[2] * xa[2] + xa[3] * xa[3])) + ((xb2[0] * xb2[0] + xb2[1] * xb2[1]) + (xb2[2] * xb2[2] + xb2[3] * xb2[3]))
                         + ((xc[0] * xc[0] + xc[1] * xc[1]) + (xc[2] * xc[2] + xc[3] * xc[3])) + ((xd[0] * xd[0] + xd[1] * xd[1]) + (xd[2] * xd[2] + xd[3] * xd[3]));
                sq += __shfl_xor(sq, 16); sq += __shfl_xor(sq, 32);
                if (fq == 0) ssn[(size_t)row * 16 + u.pn * 4 + wc] = sq;
                asm volatile("" ::: "memory");
            }
    }
};

struct EpiQK {
    static constexpr bool PERM = true, AFTER_DRAIN = false;
    unsigned char* ws; const float* ss; const float* qg; const float* kg;
    __device__ __forceinline__ void operator()(const AccT& acc, const Unit& u, int wr, int wc, int fr, int fq) const {
        const int row0 = u.pm * 256 + wr * 64 + fr;
        const int seg = u.pn >> 2, tl = u.pn & 3;
        bf16_t* base = (bf16_t*)(ws + (seg == 0 ? WS_QA : WS_KA));
        const float* gp = seg == 0 ? qg : kg; const float osc = seg == 0 ? 0.125f * LOG2E : 1.0f;
        const int col0 = tl * 256 + 64 * wc + 8 * fq;
        float rsv[2][4]; load_rs8(ss, u.pm * 256 + wr * 64, -1, (int)(threadIdx.x & 63), fr, rsv);
#pragma unroll
        for (int ai = 0; ai < 2; ++ai)
#pragma unroll
            for (int m = 0; m < 4; ++m) {
                const int row = row0 + ai * 128 + m * 16;
                const float rs = rsv[ai][m];
                f32x4 v[2][2]; float sq = 0.f;
#pragma unroll
                for (int bj = 0; bj < 2; ++bj)
#pragma unroll
                    for (int n = 0; n < 2; ++n) { v[bj][n] = acc[ai][bj][m][n] * rs; const f32x4 t = v[bj][n]; sq += (t[0] * t[0] + t[1] * t[1]) + (t[2] * t[2] + t[3] * t[3]); }
                sq += __shfl_xor(sq, 16); sq += __shfl_xor(sq, 32);
                const float r2o = rsqrtf(sq * (1.f / 64.f) + EPS) * osc;
#pragma unroll
                for (int bj = 0; bj < 2; ++bj) {
                    const f32x4 ga = *(const f32x4*)(gp + 32 * bj + 8 * fq), gb = *(const f32x4*)(gp + 32 * bj + 8 * fq + 4);
                    u32x4 w;
                    w.x = pk2(v[bj][0][0] * r2o * ga[0], v[bj][0][1] * r2o * ga[1]); w.y = pk2(v[bj][0][2] * r2o * ga[2], v[bj][0][3] * r2o * ga[3]);
                    w.z = pk2(v[bj][1][0] * r2o * gb[0], v[bj][1][1] * r2o * gb[1]); w.w = pk2(v[bj][1][2] * r2o * gb[2], v[bj][1][3] * r2o * gb[3]);
                    *(u32x4*)(base + (size_t)row * 1024 + col0 + 32 * bj) = w;
                }
                asm volatile("" ::: "memory");
            }
    }
};
struct EpiSeg {
    static constexpr bool PERM = true, AFTER_DRAIN = false;
    unsigned char* ws; const float* ss;
    __device__ __forceinline__ void operator()(const AccT& acc, const Unit& u, int wr, int wc, int fr, int fq) const {
        const int row0 = u.pm * 256 + wr * 64 + fr;
        bf16_t* base = (bf16_t*)(ws + WS_QB + (size_t)(u.pn >> 2) * S64);
        const int col0 = (u.pn & 3) * 256 + wc * 32 + 8 * fq;
        float rsv[2][4]; load_rs8(ss, u.pm * 256 + wr * 64, -1, (int)(threadIdx.x & 63), fr, rsv);
#pragma unroll
        for (int ai = 0; ai < 2; ++ai)
#pragma unroll
            for (int m = 0; m < 4; ++m) {
                const int row = row0 + ai * 128 + m * 16;
                const float rs = rsv[ai][m];
#pragma unroll
                for (int bj = 0; bj < 2; ++bj) {
                    const f32x4 v0 = acc[ai][bj][m][0] * rs, v1 = acc[ai][bj][m][1] * rs;
                    u32x4 w; w.x = pk2(v0[0], v0[1]); w.y = pk2(v0[2], v0[3]); w.z = pk2(v1[0], v1[1]); w.w = pk2(v1[2], v1[3]);
                    *(u32x4*)(base + (size_t)row * 1024 + col0 + bj * 128) = w;
                }
                asm volatile("" ::: "memory");
            }
    }
};
struct EpiGB {
    static constexpr bool PERM = true, AFTER_DRAIN = false;
    unsigned char* ws; const float* ss; const float* a_log; const float* dt_bias;
    __device__ __forceinline__ void operator()(const AccT& acc, const Unit& u, int wr, int wc, int fr, int fq) const {
        const int row0 = u.pm * 256 + wr * 64 + fr;
        float rsv[2][4]; load_rs8(ss, u.pm * 256 + wr * 64, -1, (int)(threadIdx.x & 63), fr, rsv);
        if (wc == 0 && fq < 2) {
            float* GBp = (float*)(ws + WS_GB);
#pragma unroll
            for (int ai = 0; ai < 2; ++ai)
#pragma unroll
                for (int m = 0; m < 4; ++m) {
                    const int row = row0 + ai * 128 + m * 16;
                    const float rs = rsv[ai][m];
                    float v[8];
#pragma unroll
                    for (int e = 0; e < 4; ++e) { v[e] = acc[ai][0][m][0][e] * rs; v[4 + e] = acc[ai][0][m][1][e] * rs; }
                    if (fq == 0) {
#pragma unroll
                        for (int e = 0; e < 8; ++e) v[e] = sigmoidf_(v[e]);
                    } else {
#pragma unroll
                        for (int e = 0; e < 8; ++e) { const float z = v[e] + dt_bias[e]; const float sp = fmaxf(z, 0.f) + __logf(1.f + __expf(-fabsf(z))); v[e] = -__expf(a_log[e]) * sp; }
                    }
                    float* dst = GBp + (size_t)row * 16 + 8 * fq;
                    *(f32x4*)dst = (f32x4){v[0], v[1], v[2], v[3]}; *(f32x4*)(dst + 4) = (f32x4){v[4], v[5], v[6], v[7]};
                    asm volatile("" ::: "memory");
                }
        }
    }
};

__device__ __forceinline__ void cvt_item(const float* W, int ldw, int src_col0, int nvalid, const float* gain, bf16_t* WT, int K, int dst_row0, int k0, LAS float* scr, int lane) {
    const int nn = lane & 31;
#pragma unroll 8
    for (int i = 0; i < 32; ++i) {
        const int kk = 2 * i + (lane >> 5);
        float v = 0.f;
        if (nn < nvalid) { v = W[(size_t)(k0 + kk) * ldw + src_col0 + nn]; if (gain) v *= gain[k0 + kk]; }
        scr[kk * 33 + nn] = v;
    }
    asm volatile("s_waitcnt lgkmcnt(0)" ::: "memory");
    const int c = lane & 7;
#pragma unroll
    for (int j = 0; j < 4; ++j) {
        const int n = (lane >> 3) + 8 * j; const LAS float* s = scr + (8 * c) * 33 + n;
        u32x4 o; o.x = pk2(s[0 * 33], s[1 * 33]); o.y = pk2(s[2 * 33], s[3 * 33]); o.z = pk2(s[4 * 33], s[5 * 33]); o.w = pk2(s[6 * 33], s[7 * 33]);
        *(u32x4*)(WT + (size_t)(dst_row0 + n) * K + k0 + 8 * c) = o;
    }
    asm volatile("s_waitcnt lgkmcnt(0)" ::: "memory");
}

struct Params {
    const float* in[24];
    float* out;
    unsigned char* ws;
    int seg_lo, seg_hi;
};
enum { I_X = 0, I_P, I_WIN, I_ATTN_NORM, I_QNORM, I_KNORM, I_LAM, I_SUBLN, I_RELB, I_CONVB, I_ALOG, I_DTB, I_ONORM, I_WBRA, I_WBRB, I_WOUT, I_FFN_NORM, I_WUP, I_CONVFF, I_CONVFFB, I_WDOWN, I_PLE_NORM, I_WPG, I_WPP };

__device__ __forceinline__ void convert_weights(const Params* PQ, int layer, LAS unsigned char* lds, int gw, int NGW, int wave, int lane) {
    LAS float* scr = (LAS float*)(lds + wave * 16384);
    unsigned char* ws = PQ->ws;
    const float* w_in = PQ->in[I_WIN] + (size_t)layer * 1024 * DIN;
    const float* g_attn = PQ->in[I_ATTN_NORM] + layer * 1024;
    const float* g_ffn = PQ->in[I_FFN_NORM] + layer * 1024;
    const float* g_ple = PQ->in[I_PLE_NORM] + layer * 1024;
#define CVT_JOB(NITEMS, KB, SRCW, LDW, GAIN, DST, KK, SRCCOL, NVALID) \
    for (int it = gw; it < (NITEMS); it += NGW) { const int g = it / (KB), kb = it % (KB); (void)g; \
        cvt_item((SRCW), (LDW), (SRCCOL), (NVALID), (GAIN), (bf16_t*)(ws + (DST)), (KK), g * 32, kb * 64, scr, lane); } asm volatile("" ::: "memory");
    for (int it = gw; it < 200 * 16; it += NGW) {
        const int g = it >> 4, kb = it & 15, pn = g >> 3, gi = g & 7;
        int src, nv = 32;
        if (pn < 8) { const int bj = gi >> 2, wc = gi & 3; src = (pn >> 2) * 1024 + (pn & 3) * 256 + 64 * wc + 32 * bj; }
        else if (pn < 24) { src = 3072 + (pn - 8) * 256 + 32 * gi; }
        else { src = 7168; nv = (gi == 0) ? 16 : 0; }
        cvt_item(w_in, DIN, src, nv, g_attn, (bf16_t*)(ws + W_IN), 1024, g * 32, kb * 64, scr, lane);
    }
    asm volatile("" ::: "memory");
    CVT_JOB(32 * 16, 16, w_in, DIN, g_attn, W_V, 1024, 2048 + g * 32, 32)
    CVT_JOB(64 * 16, 16, w_in, DIN, g_attn, W_GL, 1024, 7184 + g * 32, 32)
    CVT_JOB(32 * 16, 16, PQ->in[I_WBRA] + (size_t)layer * 1024 * 1024, 1024, (const float*)nullptr, W_BRA, 1024, g * 32, 32)
    CVT_JOB(32 * 16, 16, PQ->in[I_WBRB] + (size_t)layer * 1024 * 1024, 1024, (const float*)nullptr, W_BRB, 1024, g * 32, 32)
    CVT_JOB(32 * 16, 16, PQ->in[I_WOUT] + (size_t)layer * 1024 * 1024, 1024, (const float*)nullptr, W_OUT, 1024, g * 32, 32)
    CVT_JOB(176 * 16, 16, PQ->in[I_WUP] + (size_t)layer * 1024 * 5632, 5632, g_ffn, W_UP, 1024, g * 32, 32)
    CVT_JOB(32 * 44, 44, PQ->in[I_WDOWN] + (size_t)layer * 2816 * 1024, 1024, (const float*)nullptr, W_DOWN, 2816, g * 32, 32)
    CVT_JOB(32 * 16, 16, PQ->in[I_WPG] + (size_t)layer * 1024 * 1024, 1024, g_ple, W_PG, 1024, g * 32, 32)
    CVT_JOB(32 * 4, 4, PQ->in[I_WPP] + (size_t)layer * 256 * 1024, 1024, (const float*)nullptr, W_PP, 256, g * 32, 32)
#undef CVT_JOB
}

constexpr int AT_KROW = 272, AT_VROW = 136  , AT_KBYTES = 64 * AT_KROW, AT_VBYTES = 128 * AT_VROW, AT_STAGE = AT_KBYTES + AT_VBYTES, AT_TB = 2 * AT_STAGE;
static_assert(AT_TB >= 65536 && AT_TB + 1024 <= LDS_BYTES, "attention LDS");
__device__ __forceinline__ void attn_unit(LAS unsigned char* lds, const bf16_t* QA, const bf16_t* KA, const bf16_t* VT, bf16_t* OA, int b, int h, int qb,
                                          float lam, float out_scale, const float* subln, const float* relb, int tid, bool do_store = true) {
    const int lane = tid & 63, wid = __builtin_amdgcn_readfirstlane(tid >> 6), j = wid >> 2, wq = wid & 3, r32 = lane & 31, hi = lane >> 5;
    const int Q0 = qb * 128, qrow = Q0 + 32 * wq + r32;
    const size_t tok = (size_t)b * SEQ + qrow;
    LAS float* TB = (LAS float*)(lds + AT_TB);
    for (int i = tid; i <= 128; i += NTHR) {
        float v = 0.f;
        if (i < 128) {
            int bk = i;
            if (i >= 16) { int lg = 16 + (int)(__logf((float)i * (1.f / 16.f)) / __logf(8.0f) * 16.f); bk = lg < 31 ? lg : 31; }
            v = (relb[bk * 8 + h] - relb[31 * 8 + h]) * LOG2E;
        }
        TB[i] = v;
    }
    bf16x8 qf[4];
#pragma unroll
    for (int d0 = 0; d0 < 4; ++d0) qf[d0] = *(const bf16x8*)(QA + tok * 1024 + h * 128 + 64 * j + 16 * d0 + 8 * hi);
    const int NT = (Q0 + 128) / 64;
    const int kr0 = tid >> 4, kc = tid & 15;
    const int vr0 = tid >> 3, vc = tid & 7;
    const bf16_t* kg = KA + ((size_t)b * SEQ + kr0) * 1024 + h * 128 + kc * 8;
    const bf16_t* vg = VT + (size_t)(h * 128 + vr0) * MTOK + (size_t)b * SEQ + vc * 8;
    u32x4 kreg0, kreg1, vreg0, vreg1;
#define AT_LOAD(t) do { kreg0 = *(const u32x4*)(kg + (size_t)(t) * 64 * 1024); kreg1 = *(const u32x4*)(kg + (size_t)((t) * 64 + 32) * 1024); \
        vreg0 = *(const u32x4*)(vg + (t) * 64); vreg1 = *(const u32x4*)(vg + (size_t)64 * MTOK + (t) * 64); } while (0)
#define AT_STORE(s) do { LAS unsigned char* kb_ = lds + (s) * AT_STAGE; LAS unsigned char* vb_ = kb_ + AT_KBYTES; \
        *(LAS u32x4*)(kb_ + kr0 * AT_KROW + kc * 16) = kreg0; *(LAS u32x4*)(kb_ + (kr0 + 32) * AT_KROW + kc * 16) = kreg1; \
        *(LAS u32x2*)(vb_ + vr0 * AT_VROW + vc * 16) = (u32x2){vreg0.x, vreg0.y}; *(LAS u32x2*)(vb_ + vr0 * AT_VROW + vc * 16 + 8) = (u32x2){vreg0.z, vreg0.w}; \
        *(LAS u32x2*)(vb_ + (vr0 + 64) * AT_VROW + vc * 16) = (u32x2){vreg1.x, vreg1.y}; *(LAS u32x2*)(vb_ + (vr0 + 64) * AT_VROW + vc * 16 + 8) = (u32x2){vreg1.z, vreg1.w}; } while (0)
    AT_LOAD(0); AT_STORE(0);
    __syncthreads();
    f32x16 o[4];
#pragma unroll
    for (int i = 0; i < 4; ++i)
#pragma unroll
        for (int r = 0; r < 16; ++r) o[i][r] = 0.f;
    float mrun = -INFINITY, lrun = 0.f;
    const int qmax_w = Q0 + 32 * wq + 31, qmin_w = Q0 + 32 * wq;
    for (int t = 0; t < NT; ++t) {
        if (t + 1 < NT) AT_LOAD(t + 1);
        const int kv0 = 64 * t;
        if (kv0 <= qmax_w) {
            const LAS unsigned char* Kb = lds + (t & 1) * AT_STAGE; const LAS unsigned char* Vb = Kb + AT_KBYTES;
            f32x16 s0, s1;
#pragma unroll
            for (int r = 0; r < 16; ++r) { s0[r] = 0.f; s1[r] = 0.f; }
#pragma unroll
            for (int d0 = 0; d0 < 4; ++d0) {
                const bf16x8 a0 = *(const LAS bf16x8*)(Kb + r32 * AT_KROW + (64 * j + 16 * d0 + 8 * hi) * 2);
                const bf16x8 a1 = *(const LAS bf16x8*)(Kb + (32 + r32) * AT_KROW + (64 * j + 16 * d0 + 8 * hi) * 2);
                s0 = __builtin_amdgcn_mfma_f32_32x32x16_bf16(a0, qf[d0], s0, 0, 0, 0);
                s1 = __builtin_amdgcn_mfma_f32_32x32x16_bf16(a1, qf[d0], s1, 0, 0, 0);
            }
            if (kv0 + 63 + 128 > qmin_w) {
#pragma unroll
                for (int r = 0; r < 16; ++r) {
                    const int rel0 = qrow - (kv0 + crow(r, hi)), rel1 = rel0 - 32;
                    s0[r] = rel0 < 0 ? -INFINITY : s0[r] + TB[rel0 < 128 ? rel0 : 128];
                    s1[r] = rel1 < 0 ? -INFINITY : s1[r] + TB[rel1 < 128 ? rel1 : 128];
                }
            }
            float mx = fmaxf(s0[0], s1[0]);
#pragma unroll
            for (int r = 1; r < 16; ++r) mx = fmaxf(mx, fmaxf(s0[r], s1[r]));
            mx = fmaxf(mx, __shfl_xor(mx, 32));
            const float mnew = fmaxf(mrun, mx);
            const float alpha = __builtin_amdgcn_exp2f(mrun - mnew);
            mrun = mnew;
            float ls = 0.f;
#pragma unroll
            for (int r = 0; r < 16; ++r) { s0[r] = __builtin_amdgcn_exp2f(s0[r] - mnew); s1[r] = __builtin_amdgcn_exp2f(s1[r] - mnew); ls += s0[r] + s1[r]; }
            lrun = lrun * alpha + ls;
#pragma unroll
            for (int i = 0; i < 4; ++i)
#pragma unroll
                for (int r = 0; r < 16; ++r) o[i][r] *= alpha;
            bf16x8 pf[4];
            { u32x4 w;
              w.x = pk2(s0[0], s0[1]); w.y = pk2(s0[2], s0[3]); w.z = pk2(s0[4], s0[5]); w.w = pk2(s0[6], s0[7]); pf[0] = __builtin_bit_cast(bf16x8, w);
              w.x = pk2(s0[8], s0[9]); w.y = pk2(s0[10], s0[11]); w.z = pk2(s0[12], s0[13]); w.w = pk2(s0[14], s0[15]); pf[1] = __builtin_bit_cast(bf16x8, w);
              w.x = pk2(s1[0], s1[1]); w.y = pk2(s1[2], s1[3]); w.z = pk2(s1[4], s1[5]); w.w = pk2(s1[6], s1[7]); pf[2] = __builtin_bit_cast(bf16x8, w);
              w.x = pk2(s1[8], s1[9]); w.y = pk2(s1[10], s1[11]); w.z = pk2(s1[12], s1[13]); w.w = pk2(s1[14], s1[15]); pf[3] = __builtin_bit_cast(bf16x8, w); }
#pragma unroll
            for (int blk = 0; blk < 4; ++blk)
#pragma unroll
                for (int s = 0; s < 4; ++s) {
                    const LAS unsigned char* vp = Vb + (32 * blk + r32) * AT_VROW + (16 * s + 4 * hi) * 2;
                    const u32x2 lo = *(const LAS u32x2*)vp, hh = *(const LAS u32x2*)(vp + 16);
                    const u32x4 w = (u32x4){lo.x, lo.y, hh.x, hh.y};
                    o[blk] = __builtin_amdgcn_mfma_f32_32x32x16_bf16(__builtin_bit_cast(bf16x8, w), pf[s], o[blk], 0, 0, 0);
                }
        }
        if (t + 1 < NT) AT_STORE((t + 1) & 1);
        __syncthreads();
    }
#undef AT_LOAD
#undef AT_STORE
    lrun += __shfl_xor(lrun, 32);
    const float inv = 1.f / lrun;
    LAS float* EX = (LAS float*)lds;
    if (j == 1) {
        const float sc = inv * lam;
#pragma unroll
        for (int blk = 0; blk < 4; ++blk)
#pragma unroll
            for (int r = 0; r < 16; ++r) EX[(wq * 64 + blk * 16 + r) * 64 + lane] = o[blk][r] * sc;
    }
    __syncthreads();
    if (j == 0) {
        float sq = 0.f;
#pragma unroll
        for (int blk = 0; blk < 4; ++blk)
#pragma unroll
            for (int r = 0; r < 16; ++r) { const float d = o[blk][r] * inv - EX[(wq * 64 + blk * 16 + r) * 64 + lane]; o[blk][r] = d; sq += d * d; }
        sq += __shfl_xor(sq, 32);
        const float rr = rsqrtf(sq * (1.f / 128.f) + EPS) * out_scale;
#pragma unroll
        for (int blk = 0; blk < 4; ++blk)
#pragma unroll
            for (int rq = 0; rq < 4; ++rq) {
                const int dv0 = 32 * blk + 8 * rq + 4 * hi;
                const f32x4 g = *(const f32x4*)(subln + dv0);
                u32x2 w; w.x = pk2(o[blk][4 * rq + 0] * rr * g[0], o[blk][4 * rq + 1] * rr * g[1]); w.y = pk2(o[blk][4 * rq + 2] * rr * g[2], o[blk][4 * rq + 3] * rr * g[3]);
                if (do_store) *(u32x2*)(OA + tok * 1024 + h * 128 + dv0) = w;
            }
    }
    __syncthreads();
}

__device__ __forceinline__ void dn_naive(LAS unsigned char* lds, unsigned char* ws, const float* convw  , int b, int h, int tid) {
    const int lane = tid & 63, wid = tid >> 6, dv = tid & 127, g4 = tid >> 7;
    LAS float* Y = (LAS float*)lds;
    LAS float* NR = Y + 384;
    LAS float* PT = NR + 8;
    LAS float* OP = PT + 512;
    float S[32];
#pragma unroll
    for (int i = 0; i < 32; ++i) S[i] = 0.f;
    bf16_t* QB = (bf16_t*)(ws + WS_QB); const bf16_t* KB = (const bf16_t*)(ws + WS_KB); const bf16_t* VB = (const bf16_t*)(ws + WS_VB);
    const float* GBp = (const float*)(ws + WS_GB);
    const int arr = tid >> 7;
    const bf16_t* src = (arr == 0 ? (const bf16_t*)QB : arr == 1 ? KB : VB) + h * 128 + dv;
    float w0 = 0.f, w1 = 0.f, w2 = 0.f, w3 = 0.f, x1 = 0.f, x2 = 0.f, x3 = 0.f;
    if (tid < 384) { const int ch = arr * 1024 + h * 128 + dv; w0 = convw[ch]; w1 = convw[3072 + ch]; w2 = convw[2 * 3072 + ch]; w3 = convw[3 * 3072 + ch]; }
    for (int t = 0; t < SEQ; ++t) {
        const size_t tok = (size_t)b * SEQ + t;
        if (tid < 384) {
            const float x0 = bf2f(src[tok * 1024]);
            float y = w0 * x3 + w1 * x2 + w2 * x1 + w3 * x0;
            y = siluf_(y); x3 = x2; x2 = x1; x1 = x0;
            Y[arr * 128 + dv] = y;
            const float sq = wave_sum(y * y);
            if (lane == 0) NR[wid] = sq;
        }
        __syncthreads();
        const float qn = rsqrtf(NR[0] + NR[1] + EPS) * 0.08838834764831845f, kn = rsqrtf(NR[2] + NR[3] + EPS);
        const float bt = GBp[tok * 16 + h], gt = GBp[tok * 16 + 8 + h], eg = __expf(gt);
        const float vv = Y[256 + dv];
        float ks = 0.f;
#pragma unroll
        for (int i = 0; i < 32; ++i) ks += Y[128 + 32 * g4 + i] * S[i];
        PT[g4 * 128 + dv] = ks * kn;
        __syncthreads();
        const float kS = (PT[dv] + PT[128 + dv]) + (PT[256 + dv] + PT[384 + dv]);
        const float c = bt * (vv - eg * kS);
        float op = 0.f;
#pragma unroll
        for (int i = 0; i < 32; ++i) { const float kk = Y[128 + 32 * g4 + i] * kn; S[i] = eg * S[i] + kk * c; op += Y[32 * g4 + i] * S[i]; }
        OP[g4 * 128 + dv] = op * qn;
        __syncthreads();
        if (g4 == 0) { const float ov = (OP[dv] + OP[128 + dv]) + (OP[256 + dv] + OP[384 + dv]); QB[tok * 1024 + h * 128 + dv] = f2bf(ov); }
    }
    __syncthreads();
}

__device__ __forceinline__ float row16_sum(float v) {
    v += __builtin_bit_cast(float, __builtin_amdgcn_update_dpp(0, __builtin_bit_cast(int, v), 0x128, 0xf, 0xf, false));
    v += __builtin_bit_cast(float, __builtin_amdgcn_update_dpp(0, __builtin_bit_cast(int, v), 0x124, 0xf, 0xf, false));
    v += __builtin_bit_cast(float, __builtin_amdgcn_update_dpp(0, __builtin_bit_cast(int, v), 0x122, 0xf, 0xf, false));
    v += __builtin_bit_cast(float, __builtin_amdgcn_update_dpp(0, __builtin_bit_cast(int, v), 0x121, 0xf, 0xf, false));
    return v;
}
__device__ __forceinline__ void dn_fast(LAS unsigned char* lds, unsigned char* ws, const float* convw  , int b, int h, int dvq, int tid) {
    const int lane = tid & 63, wid = tid >> 6, dvl = lane >> 4, grp = lane & 15;
    const int dvloc = 4 * wid + dvl, dv = 32 * dvq + dvloc;
    LAS float* Y = (LAS float*)lds;
    LAS float* NR = Y + 16 * 288;
    LAS float* GBs = NR + 16 * 16;
    LAS float* SC = GBs + 32;
    float S[8];
#pragma unroll
    for (int i = 0; i < 8; ++i) S[i] = 0.f;
    bf16_t* VB = (bf16_t*)(ws + WS_VB);
    const float* GBp = (const float*)(ws + WS_GB);
    const int arr = tid < 128 ? 0 : (tid < 256 ? 1 : 2);
    const int dch = arr == 2 ? 32 * dvq + ((tid - 256) & 31) : (tid & 127);
    const bf16_t* src = (const bf16_t*)(ws + (arr == 0 ? WS_QB : arr == 1 ? WS_KB : WS_VB)) + h * 128 + dch;
    float w0 = 0.f, w1 = 0.f, w2 = 0.f, w3 = 0.f, x1 = 0.f, x2 = 0.f, x3 = 0.f;
    if (tid < 288) { const int ch = arr * 1024 + h * 128 + dch; w0 = convw[ch]; w1 = convw[3072 + ch]; w2 = convw[2 * 3072 + ch]; w3 = convw[3 * 3072 + ch]; }
    for (int t0 = 0; t0 < SEQ; t0 += 16) {
        const size_t tokb = (size_t)b * SEQ + t0;
        if (tid < 288) {
            bf16_t xr[16];
#pragma unroll
            for (int tt = 0; tt < 16; ++tt) xr[tt] = src[(tokb + tt) * 1024];
#pragma unroll
            for (int tt = 0; tt < 16; ++tt) {
                const float x0 = bf2f(xr[tt]);
                float y = w0 * x3 + w1 * x2 + w2 * x1 + w3 * x0;
                y = siluf_(y); x3 = x2; x2 = x1; x1 = x0;
                Y[tt * 288 + tid] = y;
                if (tid < 256) { const float sq = row16_sum(y * y); if ((lane & 15) == 0) NR[tt * 16 + wid * 4 + (lane >> 4)] = sq; }
            }
        }
        if (tid >= 480) { const int i = tid - 480, tt = i >> 1, which = i & 1; GBs[tt * 2 + which] = GBp[(tokb + tt) * 16 + which * 8 + h]; }
        __syncthreads();
        if (tid < 16) {
            const f32x4 a = *(const LAS f32x4*)(NR + tid * 16), b2 = *(const LAS f32x4*)(NR + tid * 16 + 4), c2 = *(const LAS f32x4*)(NR + tid * 16 + 8), d2 = *(const LAS f32x4*)(NR + tid * 16 + 12);
            const float sq_q = ((a[0] + a[1]) + (a[2] + a[3])) + ((b2[0] + b2[1]) + (b2[2] + b2[3])), sq_k = ((c2[0] + c2[1]) + (c2[2] + c2[3])) + ((d2[0] + d2[1]) + (d2[2] + d2[3]));
            *(LAS f32x4*)(SC + tid * 4) = (f32x4){rsqrtf(sq_q + EPS) * 0.08838834764831845f, rsqrtf(sq_k + EPS), __expf(GBs[tid * 2 + 1]), GBs[tid * 2]};
        }
        __syncthreads();
#pragma unroll 4
        for (int tt = 0; tt < 16; ++tt) {
            const f32x4 sc = *(const LAS f32x4*)(SC + tt * 4);
            const float qn = sc[0], kn = sc[1], eg = sc[2], bt = sc[3];
            const f32x4 ka = *(const LAS f32x4*)(Y + tt * 288 + 128 + 8 * grp), kb = *(const LAS f32x4*)(Y + tt * 288 + 128 + 8 * grp + 4);
            const f32x4 qa = *(const LAS f32x4*)(Y + tt * 288 + 8 * grp), qb = *(const LAS f32x4*)(Y + tt * 288 + 8 * grp + 4);
            const float vv = Y[tt * 288 + 256 + dvloc];
            float ks = (ka[0] * S[0] + ka[1] * S[1]) + (ka[2] * S[2] + ka[3] * S[3]) + (kb[0] * S[4] + kb[1] * S[5]) + (kb[2] * S[6] + kb[3] * S[7]);
            ks = row16_sum(ks);
            const float c = bt * (vv - eg * ks * kn) * kn;
            float op = 0.f;
#pragma unroll
            for (int i = 0; i < 4; ++i) { S[i] = eg * S[i] + ka[i] * c; op += qa[i] * S[i]; S[4 + i] = eg * S[4 + i] + kb[i] * c; op += qb[i] * S[4 + i]; }
            op = row16_sum(op);
            if (grp == 0) VB[(tokb + tt) * 1024 + h * 128 + dv] = f2bf(op * qn);
        }
        __syncthreads();
    }
}

__device__ __forceinline__ float row8_sum(float v) {
    v += __builtin_bit_cast(float, __builtin_amdgcn_update_dpp(0, __builtin_bit_cast(int, v), 0x141, 0xf, 0xf, false));
    v += __builtin_bit_cast(float, __builtin_amdgcn_update_dpp(0, __builtin_bit_cast(int, v), 0x1B, 0xf, 0xf, false));
    v += __builtin_bit_cast(float, __builtin_amdgcn_update_dpp(0, __builtin_bit_cast(int, v), 0xB1, 0xf, 0xf, false));
    return v;
}
constexpr int DN2_YB = 16 * 288 + 16 * 16 + 32 + 64;
__device__ __forceinline__ void dn_pc(LAS unsigned char* lds, unsigned char* ws, const float* convw  , int b, int h, int dvq, int tid) {
    const int lane = tid & 63, wid = tid >> 6;
    const bool producer = tid >= 256;
    const int pt = tid - 256;
    LAS float* L = (LAS float*)lds;
    bf16_t* VB = (bf16_t*)(ws + WS_VB);
    const float* GBp = (const float*)(ws + WS_GB);
    const int parr = pt < 128 ? 0 : 1, pd = pt & 127;
    const bf16_t* src = (const bf16_t*)(ws + (parr == 0 ? WS_QB : WS_KB)) + h * 128 + pd;
    const bf16_t* srcv = (const bf16_t*)(ws + WS_VB) + h * 128 + 32 * dvq + (pt & 31);
    float w0 = 0.f, w1 = 0.f, w2 = 0.f, w3 = 0.f, x1 = 0.f, x2 = 0.f, x3 = 0.f, u0 = 0.f, u1 = 0.f, u2 = 0.f, u3 = 0.f, z1 = 0.f, z2 = 0.f, z3 = 0.f;
    if (producer) { const int ch = parr * 1024 + h * 128 + pd; w0 = convw[ch]; w1 = convw[3072 + ch]; w2 = convw[2 * 3072 + ch]; w3 = convw[3 * 3072 + ch];
        if (pt < 32) { const int cv = 2048 + h * 128 + 32 * dvq + pt; u0 = convw[cv]; u1 = convw[3072 + cv]; u2 = convw[2 * 3072 + cv]; u3 = convw[3 * 3072 + cv]; } }
    const int col = tid >> 3, grp = tid & 7;
    float S[16];
#pragma unroll
    for (int i = 0; i < 16; ++i) S[i] = 0.f;
#define DN2_PRODUCE(BUF, T0) do { LAS float* Yp = L + (BUF) * DN2_YB; LAS float* NRp = Yp + 16 * 288; LAS float* GBsp = NRp + 256; const size_t tb_ = (size_t)b * SEQ + (T0); \
        bf16_t xr[16]; bf16_t vr[16]; \
        _Pragma("unroll") for (int tt = 0; tt < 16; ++tt) xr[tt] = src[(tb_ + tt) * 1024]; \
        if (pt < 32) { _Pragma("unroll") for (int tt = 0; tt < 16; ++tt) vr[tt] = srcv[(tb_ + tt) * 1024]; } \
        if (pt >= 224) { const int i_ = pt - 224, tt_ = i_ >> 1, wh_ = i_ & 1; GBsp[tt_ * 2 + wh_] = GBp[(tb_ + tt_) * 16 + wh_ * 8 + h]; } \
        _Pragma("unroll") for (int tt = 0; tt < 16; ++tt) { const float x0 = bf2f(xr[tt]); float y = w0 * x3 + w1 * x2 + w2 * x1 + w3 * x0; y = siluf_(y); x3 = x2; x2 = x1; x1 = x0; \
            Yp[tt * 288 + pt] = y; const float sq = row16_sum(y * y); if ((lane & 15) == 0) NRp[tt * 16 + (wid - 4) * 4 + (lane >> 4)] = sq; } \
        if (pt < 32) { _Pragma("unroll") for (int tt = 0; tt < 16; ++tt) { const float x0 = bf2f(vr[tt]); float y = u0 * z3 + u1 * z2 + u2 * z1 + u3 * x0; y = siluf_(y); z3 = z2; z2 = z1; z1 = x0; Yp[tt * 288 + 256 + pt] = y; } } \
    } while (0)
    if (producer) DN2_PRODUCE(0, 0);
    for (int n = 0; n < SEQ / 16; ++n) {
        const int buf = n & 1;
        LAS float* Y = L + buf * DN2_YB; LAS float* NR = Y + 16 * 288; LAS float* GBs = NR + 256; LAS float* SC = GBs + 32;
        __syncthreads();
        if (tid < 16) {
            const f32x4 a = *(const LAS f32x4*)(NR + tid * 16), b2 = *(const LAS f32x4*)(NR + tid * 16 + 4), c2 = *(const LAS f32x4*)(NR + tid * 16 + 8), d2 = *(const LAS f32x4*)(NR + tid * 16 + 12);
            const float sq_q = ((a[0] + a[1]) + (a[2] + a[3])) + ((b2[0] + b2[1]) + (b2[2] + b2[3])), sq_k = ((c2[0] + c2[1]) + (c2[2] + c2[3])) + ((d2[0] + d2[1]) + (d2[2] + d2[3]));
            *(LAS f32x4*)(SC + tid * 4) = (f32x4){rsqrtf(sq_q + EPS) * 0.08838834764831845f, rsqrtf(sq_k + EPS), __expf(GBs[tid * 2 + 1]), GBs[tid * 2]};
        }
        __syncthreads();
        if (producer) { if (n + 1 < SEQ / 16) DN2_PRODUCE(buf ^ 1, 16 * (n + 1)); }
        else {
            const size_t tokb = (size_t)b * SEQ + 16 * n;
#pragma unroll 4
            for (int tt = 0; tt < 16; ++tt) {
                const f32x4 sc = *(const LAS f32x4*)(SC + tt * 4);
                const float qn = sc[0], kn = sc[1], eg = sc[2], bt = sc[3];
                const LAS f32x4* kp = (const LAS f32x4*)(Y + tt * 288 + 128 + 16 * grp); const LAS f32x4* qp = (const LAS f32x4*)(Y + tt * 288 + 16 * grp);
                const f32x4 k0 = kp[0], k1 = kp[1], k2 = kp[2], k3 = kp[3], q0 = qp[0], q1 = qp[1], q2 = qp[2], q3 = qp[3];
                const float vv = Y[tt * 288 + 256 + col];
                float ks = ((k0[0] * S[0] + k0[1] * S[1]) + (k0[2] * S[2] + k0[3] * S[3])) + ((k1[0] * S[4] + k1[1] * S[5]) + (k1[2] * S[6] + k1[3] * S[7]))
                         + ((k2[0] * S[8] + k2[1] * S[9]) + (k2[2] * S[10] + k2[3] * S[11])) + ((k3[0] * S[12] + k3[1] * S[13]) + (k3[2] * S[14] + k3[3] * S[15]));
                ks = row8_sum(ks);
                const float c = bt * (vv - eg * ks * kn) * kn;
                float op0 = 0.f, op1 = 0.f;
#pragma unroll
                for (int i = 0; i < 4; ++i) { S[i] = eg * S[i] + k0[i] * c; op0 += q0[i] * S[i]; S[4 + i] = eg * S[4 + i] + k1[i] * c; op1 += q1[i] * S[4 + i];
                                              S[8 + i] = eg * S[8 + i] + k2[i] * c; op0 += q2[i] * S[8 + i]; S[12 + i] = eg * S[12 + i] + k3[i] * c; op1 += q3[i] * S[12 + i]; }
                const float op = row8_sum(op0 + op1);
                if (grp == 0) VB[(tokb + tt) * 1024 + h * 128 + 32 * dvq + col] = f2bf(op * qn);
            }
        }
    }
    __syncthreads();
#undef DN2_PRODUCE
}

#define GEMM_PHASE(EPI, Aptr, Bptr, Mv, Nv, Kv, Eobj, HM) do { int m_ = (Mv), n_ = (Nv), k_ = (Kv); asm volatile("" : "+s"(m_), "+s"(n_), "+s"(k_)); pg8::Gemm g_{(const pg8::bf16_t*)(Aptr), (const pg8::bf16_t*)(Bptr), m_, n_, k_, (HM)}; pg8::StaticOrder S_; S_.init(m_, n_, G, bid); \
        pg8::gemm_phase<EPI, pg8::StaticOrder, true, true>(lds, g_, S_, (Eobj)); } while (0)

__global__ void __launch_bounds__(NTHR, 2) fwd_mega(Params P) {
    extern __shared__ __attribute__((aligned(16))) unsigned char lds_raw[];
    LAS unsigned char* lds = (LAS unsigned char*)lds_raw;
    cg::grid_group grid = cg::this_grid();
    if (threadIdx.x == 0) {
        const unsigned xcc = (unsigned)__builtin_amdgcn_s_getreg((3 << 11) | 20) & 7u;
        const unsigned loc = __hip_atomic_fetch_add((unsigned*)(P.ws + WS_CTL) + xcc, 1u, __ATOMIC_RELAXED, __HIP_MEMORY_SCOPE_AGENT);
        *(LAS int*)(lds + LDS_VB) = (int)((loc & 31u) * 8u + xcc);
    }
    __syncthreads();
    int seg = 0; const int seg_lo = P.seg_lo, seg_hi = P.seg_hi;
#ifdef L2FLUSH
#define L2_FLUSH() do { const Params* PF = (const Params*)__builtin_amdgcn_kernarg_segment_ptr(); asm volatile("" : "+s"(PF)); int tf_ = threadIdx.x; asm volatile("" : "+v"(tf_)); \
        const u32x4* jp = (const u32x4*)(PF->in[I_P]) + (size_t)blockIdx.x * (L2FLUSH * 64) + tf_; unsigned acc_ = 0u; \
        for (int q_ = 0; q_ < L2FLUSH * 64 / 512; ++q_) { const u32x4 v_ = __builtin_nontemporal_load(jp + (size_t)q_ * 512); acc_ |= v_.x & v_.y & v_.z & v_.w; asm volatile("" ::: "memory"); } \
        if (acc_ == 0x12345678u) PF->out[0] = 0.f; } while (0)
#else
#define L2_FLUSH() do {} while (0)
#endif
#ifdef NOSEG
#define SYNCCOND true
#else
#define SYNCCOND (seg >= seg_lo && seg + 1 < seg_hi)
#endif
#define GRID_SYNC() do { if (SYNCCOND) { asm volatile("s_waitcnt vmcnt(0) lgkmcnt(0)" ::: "memory");   grid.sync(); L2_FLUSH(); \
        if (threadIdx.x < 64) { __builtin_amdgcn_fence(__ATOMIC_ACQUIRE, "agent"); asm volatile("s_waitcnt vmcnt(0)" ::: "memory"); } __syncthreads();     \
        } ++seg; } while (0)
#ifdef NOSEG
#define SEGCOND true
#else
#define SEGCOND (seg >= seg_lo && seg < seg_hi)
#endif
#define PH_BEGIN if (SEGCOND) { const Params* PQ = (const Params*)__builtin_amdgcn_kernarg_segment_ptr(); asm volatile("" : "+s"(PQ)); int tid = threadIdx.x; asm volatile("" : "+v"(tid)); \
    const int lane = tid & 63, wave = __builtin_amdgcn_readfirstlane(tid >> 6); int bid = __builtin_amdgcn_readfirstlane(*(LAS int*)(lds + LDS_VB)), G = gridDim.x; asm volatile("" : "+s"(bid), "+s"(G)); \
    const int xb_ = bid & 7, jb_ = bid >> 3, wj = jb_ * NW + wave;     \
    unsigned char* ws = PQ->ws; float* X = PQ->out; float* SS = (float*)(ws + WS_SS); bf16_t* XB = (bf16_t*)(ws + WS_XB); \
    float* ss_attn = (float*)(ws + WS_HALO); float* ss_ffn = ss_attn + (size_t)MTOK * 16; float* ss_ple = ss_ffn + (size_t)MTOK * 16; float* ss_next = ss_attn; \
    (void)lane; (void)xb_; (void)jb_; (void)wj; (void)X; (void)XB; (void)ss_attn; (void)ss_ffn; (void)ss_ple; (void)ss_next; (void)G;
#define PH_END }
#define U ((bf16_t*)(ws + WS_MIX))
#define ACT ((bf16_t*)(ws + WS_MIX + 176 * MiB))

    { const int layer = 0; PH_BEGIN
      if (bid == 0 && tid == 0) __hip_atomic_store((unsigned*)(ws + WS_CTL) + 16, 0u, __ATOMIC_RELAXED, __HIP_MEMORY_SCOPE_AGENT);
      const float* xin = PQ->in[I_X];
      for (int r = wj; r < SEQ; r += 256) {
          const int m = xb_ * SEQ + r;
          const f32x4* xr = (const f32x4*)(xin + (size_t)m * 1024) + lane;
          f32x4 v[4]; float s = 0.f;
#pragma unroll
          for (int jj = 0; jj < 4; ++jj) { v[jj] = xr[64 * jj]; s += (v[jj][0] * v[jj][0] + v[jj][1] * v[jj][1]) + (v[jj][2] * v[jj][2] + v[jj][3] * v[jj][3]); }
          s = wave_sum(s);
          if (lane < 16) ss_attn[(size_t)m * 16 + lane] = lane == 0 ? s : 0.f;
          f32x4* xo = (f32x4*)(X + (size_t)m * 1024) + lane;
          u32x2* bo = (u32x2*)(XB + (size_t)m * 1024) + lane;
#pragma unroll
          for (int jj = 0; jj < 4; ++jj) { xo[64 * jj] = v[jj]; u32x2 w; w.x = pk2(v[jj][0], v[jj][1]); w.y = pk2(v[jj][2], v[jj][3]); bo[64 * jj] = w; }
      }
    PH_END }

    for (int layer = 0; layer < NLAYER; ++layer) {
        asm volatile("" ::: "memory");
        const float lam_init = 0.8f - 0.6f * __expf(-0.3f * (float)layer);
        PH_BEGIN
        convert_weights(PQ, layer, lds, bid * NW + wave, G * NW, wave, lane);
        { const float* pl = PQ->in[I_P] + ((size_t)layer * MTOK + (size_t)xb_ * SEQ) * DPLE;
          bf16_t* pb = (bf16_t*)(ws + WS_PB) + (size_t)xb_ * SEQ * DPLE;
          for (int i = jb_ * NTHR + tid; i < SEQ * DPLE / 8; i += 32 * NTHR) {
              const f32x4 a = *(const f32x4*)(pl + (size_t)i * 8), b = *(const f32x4*)(pl + (size_t)i * 8 + 4);
              u32x4 w; w.x = pk2(a[0], a[1]); w.y = pk2(a[2], a[3]); w.z = pk2(b[0], b[1]); w.w = pk2(b[2], b[3]);
              *(u32x4*)(pb + (size_t)i * 8) = w;
          }
        }
        PH_END
        GRID_SYNC();
#ifdef DBLTEST
#ifdef DBL_SC
#define DBL_LD(p) ldc16(p)
#else
#define DBL_LD(p) (*(p))
#endif
        if (layer == 0) {
#ifdef DBL_OUTP
        PH_BEGIN
        { EpiResid E{X, XB, ss_ffn, nullptr, -1};
          GEMM_PHASE(EpiResid, ws + WS_VT, ws + W_OUT, MTOK, 1024, 1024, E, -1); }
        PH_END
        GRID_SYNC();
#endif
        for (int rep = 0; rep < 2; ++rep) {
        PH_BEGIN
#ifdef DBL_COPY
            { const u32x4* s4 = (const u32x4*)XB; u32x4* d4 = (u32x4*)(ws + WS_MIX + (size_t)rep * 176 * MiB);
              const size_t per = (size_t)DBL_M * DBL_N * 2 / 16 / 8;
              for (size_t i = (size_t)((jb_ + rep * 13) & 31) * NTHR + tid; i < per; i += (size_t)32 * NTHR) d4[(size_t)xb_ * per + i] = DBL_LD(s4 + (size_t)xb_ * per + i); }
#else
#ifndef DBL_W
#define DBL_W W_UP
#define DBL_ACT 0
#endif
            { EpiRowScale<DBL_ACT> E{(bf16_t*)(ws + WS_MIX + (size_t)rep * DBL_OFF * MiB), DBL_N, ss_attn, DBL_H};
              GEMM_PHASE(EpiRowScale<DBL_ACT>, XB, ws + DBL_W, DBL_M, DBL_N, 1024, E, DBL_H); }
#endif
        PH_END
        GRID_SYNC();
        }
        PH_BEGIN
        { const u32x4* a4 = (const u32x4*)(ws + WS_MIX); const u32x4* b4 = (const u32x4*)(ws + WS_MIX + (size_t)DBL_OFF * MiB); unsigned bad = 0u;
          const size_t per = (size_t)DBL_M * DBL_N * 2 / 16 / 8;
          for (size_t i0 = (size_t)((jb_ + 7) & 31) * NTHR + tid; i0 < per; i0 += (size_t)32 * NTHR) { const size_t i = (size_t)xb_ * per + i0; const u32x4 a = DBL_LD(a4 + i), b = DBL_LD(b4 + i); bad |= ((a.x ^ b.x) | (a.y ^ b.y) | (a.z ^ b.z) | (a.w ^ b.w)) ? 1u : 0u; }
          if (bad) __hip_atomic_fetch_or((unsigned*)(ws + WS_CTL) + 16, 1u, __ATOMIC_RELAXED, __HIP_MEMORY_SCOPE_AGENT); }
        PH_END
        GRID_SYNC();
        }
#endif
#if defined(DBLMIX) && !defined(DBLMIX_AT_GATES)
        for (int rep = 0; rep < 2; ++rep) {
#endif
#ifndef NO_INPROJ
        PH_BEGIN
        { EpiQK E{ws, ss_attn, PQ->in[I_QNORM] + layer * 64, PQ->in[I_KNORM] + layer * 64};
          GEMM_PHASE(EpiQK, XB, ws + W_IN, MTOK, 2048, 1024, E, -1); }
        PH_END
        PH_BEGIN
        { EpiSeg E{ws, ss_attn};
          GEMM_PHASE(EpiSeg, XB, ws + W_IN + (size_t)2048 * 2048, MTOK, 4096, 1024, E, -1); }
        PH_END
        PH_BEGIN
        { EpiGB E{ws, ss_attn, PQ->in[I_ALOG] + layer * 8, PQ->in[I_DTB] + layer * 8};
          GEMM_PHASE(EpiGB, XB, ws + W_IN + (size_t)6144 * 2048, MTOK, 256, 1024, E, -1); }
        PH_END
        PH_BEGIN
        { EpiVt E{(bf16_t*)(ws + WS_VT), ss_attn};
          GEMM_PHASE(EpiVt, ws + W_V, XB, 1024, MTOK, 1024, E, -1); }
        PH_END
#endif
        GRID_SYNC();
#ifndef NO_ATTN
        PH_BEGIN
        { const float* lq = PQ->in[I_LAM] + layer * 256;
          const float a1 = wave_sum(lq[lane] * lq[64 + lane]), a2 = wave_sum(lq[128 + lane] * lq[192 + lane]);
          const float lam = __expf(a1) - __expf(a2) + lam_init;
#ifdef ATTN_PROBE
          for (int k = 0; k < 4; ++k) {
              const int pi = jb_ + 32 * k, hh = pi >> 4, s = pi & 15;
              attn_unit(lds, (const bf16_t*)(ws + WS_QA), (const bf16_t*)(ws + WS_KA), (const bf16_t*)(ws + WS_VT), (bf16_t*)(ws + WS_QA), xb_, hh, 31 - s, lam, 1.f - lam_init, PQ->in[I_SUBLN] + layer * 128, PQ->in[I_RELB], tid, false);
              attn_unit(lds, (const bf16_t*)(ws + WS_QA), (const bf16_t*)(ws + WS_KA), (const bf16_t*)(ws + WS_VT), (bf16_t*)(ws + WS_QA), xb_, hh, s, lam, 1.f - lam_init, PQ->in[I_SUBLN] + layer * 128, PQ->in[I_RELB], tid, false);
          }
          __syncthreads();
#endif
          for (int k = 0; k < 4; ++k) {
              const int pi = jb_ + 32 * k, hh = pi >> 4, s = pi & 15;
              attn_unit(lds, (const bf16_t*)(ws + WS_QA), (const bf16_t*)(ws + WS_KA), (const bf16_t*)(ws + WS_VT), (bf16_t*)(ws + WS_QA), xb_, hh, 31 - s, lam, 1.f - lam_init, PQ->in[I_SUBLN] + layer * 128, PQ->in[I_RELB], tid);
              attn_unit(lds, (const bf16_t*)(ws + WS_QA), (const bf16_t*)(ws + WS_KA), (const bf16_t*)(ws + WS_VT), (bf16_t*)(ws + WS_QA), xb_, hh, s, lam, 1.f - lam_init, PQ->in[I_SUBLN] + layer * 128, PQ->in[I_RELB], tid);
          }
        }
        PH_END
#endif
#ifndef NO_DN
        PH_BEGIN
#ifdef DN_NAIVE
        if (jb_ < 8) dn_naive(lds, ws, PQ->in[I_CONVB] + (size_t)layer * 4 * 3072, xb_, jb_, tid);
#else
#ifdef DN_FAST1
        dn_fast(lds, ws, PQ->in[I_CONVB] + (size_t)layer * 4 * 3072, xb_, jb_ >> 2, jb_ & 3, tid);
#else
        dn_pc(lds, ws, PQ->in[I_CONVB] + (size_t)layer * 4 * 3072, xb_, jb_ >> 2, jb_ & 3, tid);
#endif
#endif
        PH_END
#endif
        GRID_SYNC();
#if defined(DBLMIX) && defined(DBLMIX_AT_GATES)
        for (int rep = 0; rep < 2; ++rep) {
#endif
#ifndef NO_GATES
        PH_BEGIN
        { EpiRowScale<1> E{(bf16_t*)(ws + WS_G), 2048, ss_attn, -1};
          GEMM_PHASE(EpiRowScale<1>, XB, ws + W_GL, MTOK, 2048, 1024, E, -1); }
        PH_END
#endif
#ifndef NO_OBNORM
        PH_BEGIN
        { const float* on = PQ->in[I_ONORM] + layer * 128;
          const float g0 = on[2 * lane], g1 = on[2 * lane + 1];
          unsigned* OB = (unsigned*)(ws + WS_QB) + (size_t)xb_ * SEQ * 512; const unsigned* OI = (const unsigned*)(ws + WS_OSRC) + (size_t)xb_ * SEQ * 512; const unsigned* ZB = (const unsigned*)(ws + WS_ZB) + (size_t)xb_ * SEQ * 512;
          for (int r = wj; r < SEQ * NH; r += 256) {
              const unsigned ov = OI[(size_t)r * 64 + lane], zv = ZB[(size_t)r * 64 + lane];
              const float o0 = bflo(ov), o1 = bfhi(ov);
              const float sq = wave_sum(o0 * o0 + o1 * o1);
              const float rr = rsqrtf(sq * (1.f / 128.f) + EPS);
              OB[(size_t)r * 64 + lane] = pk2(o0 * rr * g0 * siluf_(bflo(zv)), o1 * rr * g1 * siluf_(bfhi(zv)));
          }
        }
        PH_END
#endif
        GRID_SYNC();
#ifndef NO_TMPA
        PH_BEGIN
        { EpiGateMul E{(bf16_t*)(ws + WS_TMPA), (const bf16_t*)(ws + WS_G), 2048, 0, nullptr};
          GEMM_PHASE(EpiGateMul, ws + WS_QA, ws + W_BRA, MTOK, 1024, 1024, E, -1); }
        PH_END
#endif
        GRID_SYNC();
#ifndef NO_MIXED
        PH_BEGIN
        { EpiGateMul E{(bf16_t*)(ws + WS_MIXED), (const bf16_t*)(ws + WS_G), 2048, 1024, (const bf16_t*)(ws + WS_TMPA)};
          GEMM_PHASE(EpiGateMul, ws + WS_QB, ws + W_BRB, MTOK, 1024, 1024, E, -1); }
        PH_END
#endif
        GRID_SYNC();
#ifdef DBLMIX
        PH_BEGIN
        { const u32x4* t4 = (const u32x4*)(ws + (size_t)DBL_TGT + (size_t)xb_ * ((size_t)DBL_TGT_BYTES / 8)); u32x4* s4 = (u32x4*)(ws + WS_PB + (size_t)xb_ * 2 * MiB); unsigned bad = 0u;
          for (size_t i = (size_t)((jb_ + 5 * rep) & 31) * NTHR + tid; i < (size_t)2 * MiB / 16; i += (size_t)32 * NTHR) {
              const u32x4 a = t4[i];
              if (rep == 0) s4[i] = a; else { const u32x4 b = s4[i]; bad |= ((a.x ^ b.x) | (a.y ^ b.y) | (a.z ^ b.z) | (a.w ^ b.w)) ? 1u : 0u; } }
          if (bad) __hip_atomic_fetch_or((unsigned*)(ws + WS_CTL) + 16, 1u, __ATOMIC_RELAXED, __HIP_MEMORY_SCOPE_AGENT); }
        PH_END
        GRID_SYNC();
        }
#endif
#ifndef NO_OUTP
        PH_BEGIN
        { EpiResid E{X, XB, ss_ffn, nullptr, -1};
          GEMM_PHASE(EpiResid, ws + WS_MIXED, ws + W_OUT, MTOK, 1024, 1024, E, -1); }
        PH_END
#endif
        GRID_SYNC();
        for (int half = 0; half < 2; ++half) {
#ifndef NO_UP
        PH_BEGIN
            { EpiRowScale<0> E{U, 5632, ss_ffn, half};
              GEMM_PHASE(EpiRowScale<0>, XB, ws + W_UP, 16384, 5632, 1024, E, half); }
        PH_END
#endif
            GRID_SYNC();
#ifndef NO_ACT
        PH_BEGIN
            { const float* cw = PQ->in[I_CONVFF] + (size_t)layer * 3 * 5632; const float* cb = PQ->in[I_CONVFFB] + (size_t)layer * 5632;
              bf16_t* UH = (bf16_t*)(ws + WS_UHALO) + (size_t)xb_ * 2 * 5632;
              for (int it = jb_ * NTHR + tid; it < 128 * 352; it += 32 * NTHR) {
                  const int cc = it % 352, rg = it / 352, c0 = cc * 8;
                  const int lrow0 = xb_ * 2048 + rg * 16;
                  float wg[3][8], wv[3][8], bg[8], bv[8];
#pragma unroll
                  for (int jj = 0; jj < 3; ++jj)
#pragma unroll
                      for (int e = 0; e < 8; ++e) { wg[jj][e] = cw[jj * 5632 + c0 + e]; wv[jj][e] = cw[jj * 5632 + 2816 + c0 + e]; }
#pragma unroll
                  for (int e = 0; e < 8; ++e) { bg[e] = cb[c0 + e]; bv[e] = cb[2816 + c0 + e]; }
                  float g2[8], g1[8], v2[8], v1[8];
#pragma unroll
                  for (int e = 0; e < 8; ++e) { g2[e] = 0.f; g1[e] = 0.f; v2[e] = 0.f; v1[e] = 0.f; }
                  if (rg > 0 || half == 1) {
                      const bf16_t* r2p = rg > 0 ? U + (size_t)(lrow0 - 2) * 5632 : UH;
                      const bf16_t* r1p = rg > 0 ? U + (size_t)(lrow0 - 1) * 5632 : UH + 5632;
                      const u32x4 a = *(const u32x4*)(r2p + c0), bq = *(const u32x4*)(r1p + c0);
                      const u32x4 c = *(const u32x4*)(r2p + 2816 + c0), d = *(const u32x4*)(r1p + 2816 + c0);
                      g2[0] = bflo(a.x); g2[1] = bfhi(a.x); g2[2] = bflo(a.y); g2[3] = bfhi(a.y); g2[4] = bflo(a.z); g2[5] = bfhi(a.z); g2[6] = bflo(a.w); g2[7] = bfhi(a.w);
                      g1[0] = bflo(bq.x); g1[1] = bfhi(bq.x); g1[2] = bflo(bq.y); g1[3] = bfhi(bq.y); g1[4] = bflo(bq.z); g1[5] = bfhi(bq.z); g1[6] = bflo(bq.w); g1[7] = bfhi(bq.w);
                      v2[0] = bflo(c.x); v2[1] = bfhi(c.x); v2[2] = bflo(c.y); v2[3] = bfhi(c.y); v2[4] = bflo(c.z); v2[5] = bfhi(c.z); v2[6] = bflo(c.w); v2[7] = bfhi(c.w);
                      v1[0] = bflo(d.x); v1[1] = bfhi(d.x); v1[2] = bflo(d.y); v1[3] = bfhi(d.y); v1[4] = bflo(d.z); v1[5] = bfhi(d.z); v1[6] = bflo(d.w); v1[7] = bfhi(d.w);
                  }
                  for (int rr = 0; rr < 16; ++rr) {
                      const size_t row = (size_t)lrow0 + rr;
                      const u32x4 a = *(const u32x4*)(U + row * 5632 + c0), c = *(const u32x4*)(U + row * 5632 + 2816 + c0);
                      if (half == 0 && rg == 127 && rr >= 14) { *(u32x4*)(UH + (size_t)(rr - 14) * 5632 + c0) = a; *(u32x4*)(UH + (size_t)(rr - 14) * 5632 + 2816 + c0) = c; }
                      float g0[8], v0[8], ov[8];
                      g0[0] = bflo(a.x); g0[1] = bfhi(a.x); g0[2] = bflo(a.y); g0[3] = bfhi(a.y); g0[4] = bflo(a.z); g0[5] = bfhi(a.z); g0[6] = bflo(a.w); g0[7] = bfhi(a.w);
                      v0[0] = bflo(c.x); v0[1] = bfhi(c.x); v0[2] = bflo(c.y); v0[3] = bfhi(c.y); v0[4] = bflo(c.z); v0[5] = bfhi(c.z); v0[6] = bflo(c.w); v0[7] = bfhi(c.w);
#pragma unroll
                      for (int e = 0; e < 8; ++e) {
                          const float ug = wg[0][e] * g2[e] + wg[1][e] * g1[e] + wg[2][e] * g0[e] + bg[e];
                          const float uv = wv[0][e] * v2[e] + wv[1][e] * v1[e] + wv[2][e] * v0[e] + bv[e];
                          ov[e] = siluf_(ug) * uv; g2[e] = g1[e]; g1[e] = g0[e]; v2[e] = v1[e]; v1[e] = v0[e];
                      }
                      u32x4 w; w.x = pk2(ov[0], ov[1]); w.y = pk2(ov[2], ov[3]); w.z = pk2(ov[4], ov[5]); w.w = pk2(ov[6], ov[7]);
                      *(u32x4*)(ACT + row * 2816 + c0) = w;
                  }
              }
            }
        PH_END
#endif
            GRID_SYNC();
#ifndef NO_DOWN
        PH_BEGIN
            { EpiResid E{X, XB, ss_ple, nullptr, half};
              GEMM_PHASE(EpiResid, ACT, ws + W_DOWN, 16384, 1024, 2816, E, -1); }
        PH_END
#endif
            GRID_SYNC();
        }
#ifndef NO_PLEG
        PH_BEGIN
        { EpiRowScale<1> E{(bf16_t*)(ws + WS_MIX), 1024, ss_ple, -1};
          GEMM_PHASE(EpiRowScale<1>, XB, ws + W_PG, MTOK, 1024, 1024, E, -1); }
        PH_END
#endif
        GRID_SYNC();
#ifndef NO_PLE
        PH_BEGIN
        { EpiResid E{X, XB, ss_next, (const bf16_t*)(ws + WS_MIX), -1};
          GEMM_PHASE(EpiResid, ws + WS_PB, ws + W_PP, MTOK, 1024, 256, E, -1); }
        PH_END
#endif
        GRID_SYNC();
    }
#ifdef NANCHK
    { const int layer = 0; PH_BEGIN
      unsigned bad = 0u;
      for (size_t i = (size_t)bid * NTHR + tid; i < (size_t)MTOK * 256; i += (size_t)G * NTHR) { const f32x4 v = *(const f32x4*)(X + i * 4);
          for (int e = 0; e < 4; ++e) bad |= ((__float_as_uint(v[e]) & 0x7f800000u) == 0x7f800000u) ? 1u : 0u; }
#ifdef NANCHK_BF_LO
      { const unsigned* bp = (const unsigned*)(ws + (size_t)NANCHK_BF_LO); const size_t nw = ((size_t)NANCHK_BF_HI - (size_t)NANCHK_BF_LO) / 4;
        for (size_t i = (size_t)bid * NTHR + tid; i < nw; i += (size_t)G * NTHR) { const unsigned w = bp[i]; bad |= (((w & 0x7f80u) == 0x7f80u) || ((w & 0x7f800000u) == 0x7f800000u)) ? 1u : 0u; } }
#endif
      if (bad) __hip_atomic_fetch_or((unsigned*)(ws + WS_CTL) + 16, 1u, __ATOMIC_RELAXED, __HIP_MEMORY_SCOPE_AGENT);
      PH_END }
    GRID_SYNC();
    { const int layer = 0; PH_BEGIN
      const unsigned fl = __hip_atomic_fetch_or((unsigned*)(ws + WS_CTL) + 16, 0u, __ATOMIC_RELAXED, __HIP_MEMORY_SCOPE_AGENT);
      if (fl) for (size_t i = (size_t)bid * NTHR + tid; i < (size_t)MTOK * 256; i += (size_t)G * NTHR) *(f32x4*)(X + i * 4) = (f32x4){0.f, 0.f, 0.f, 0.f};
      PH_END }
#endif
#undef U
#undef ACT
}

extern "C" void kernel_launch(void* const* d_in, const int* in_sizes, int n_in, void* d_out, int out_size, void* d_ws, size_t ws_size, hipStream_t stream) {
    static int grid = 0;
    if (grid == 0) {
        if (n_in != 24 || out_size != MTOK * DM || ws_size < WS_TOTAL) { fprintf(stderr, "kernel_launch: unexpected shapes / workspace (n_in %d out %d ws %zu need %zu)\n", n_in, out_size, ws_size, (size_t)WS_TOTAL); grid = -1; return; }
        int dev = 0, cus = 0, per_cu = 0;
        hipGetDevice(&dev);
        hipDeviceGetAttribute(&cus, hipDeviceAttributeMultiprocessorCount, dev);
        hipFuncSetAttribute((const void*)fwd_mega, hipFuncAttributeMaxDynamicSharedMemorySize, LDS_BYTES);
        hipOccupancyMaxActiveBlocksPerMultiprocessor(&per_cu, (const void*)fwd_mega, NTHR, LDS_BYTES);
        if (per_cu < 1) { fprintf(stderr, "kernel_launch: occupancy query says %d blocks per CU\n", per_cu); per_cu = 1; }
        (void)hipGetLastError();
        grid = cus;
    }
    if (grid < 0) return;
    Params p{};
    for (int i = 0; i < 24; ++i) p.in[i] = (const float*)d_in[i];
    p.out = (float*)d_out; p.ws = (unsigned char*)d_ws;
    hipError_t e = hipSuccess;
#ifdef N_SEG_LAUNCH
    for (int sgi = 0; sgi < 60 && e == hipSuccess; sgi += N_SEG_LAUNCH) {
        p.seg_lo = sgi; p.seg_hi = sgi + N_SEG_LAUNCH;
        void* args[] = {&p};
        e = hipLaunchCooperativeKernel((const void*)fwd_mega, dim3(grid), dim3(NTHR), args, LDS_BYTES, stream);
    }
#else
    p.seg_lo = 0; p.seg_hi = 1000;
    void* args[] = {&p};
    e = hipLaunchCooperativeKernel((const void*)fwd_mega, dim3(grid), dim3(NTHR), args, LDS_BYTES, stream);
#endif
    if (e != hipSuccess) fprintf(stderr, "cooperative launch failed: %s (grid %d)\n", hipGetErrorString(e), grid);
}
```

```cpp
#include <hip/hip_runtime.h>
#include <hip/hip_cooperative_groups.h>
#include <cstdio>
#include <cstdint>
namespace cg = cooperative_groups;
namespace pg8 {
#define PG8_LAS __attribute__((address_space(3)))
typedef unsigned short bf16_t;
typedef short bf16x8 __attribute__((ext_vector_type(8)));
typedef float f32x4 __attribute__((ext_vector_type(4)));
typedef unsigned u32x4 __attribute__((ext_vector_type(4)));
constexpr int BM = 256, BK = 64, HALF = 128, HTB = HALF * BK * 2  , STAGE_BYTES = 8 * HTB, NXCD = 8, WGM = 8;

__host__ __device__ __forceinline__ int lds_byte(int r, int c) { const int st = (r >> 4) * 2 + (c >> 5), rr = r & 15, cc = c & 31, ob = rr * 64 + cc * 2; return st * 1024 + (ob ^ (((ob >> 9) & 1) << 5)); }
__host__ __device__ __forceinline__ void stage_rc(int b, int& R, int& C) { const int st = b / 1024, sb = b % 1024, swz = sb ^ (((sb >> 9) & 1) << 5); R = (st >> 1) * 16 + swz / 64; C = (st & 1) * 32 + (swz % 64) / 2; }
__host__ __device__ __forceinline__ int perm32(int rho) { const int n = rho >> 4, i = rho & 15; return 8 * (i >> 2) + 4 * n + (i & 3); }

struct Unit { int pm, pn; };
struct Gemm { const bf16_t* A; const bf16_t* Bt; int M, N, K; int hmap; };
__device__ __forceinline__ int amap(int pm, int hmap) { return hmap < 0 ? pm : ((pm >> 3) * 16 + 8 * hmap + (pm & 7)); }

struct StaticOrder {
    int nM, nN, nwg, G, c;
    __host__ __device__ void init(int M, int N, int G_, int c_) { nM = M / BM; nN = N / BM; nwg = nM * nN; G = G_; c = c_; }
    __host__ __device__ bool next(int i, Unit& u) const {
        const long L = (long)i * G + c; if (L >= nwg) return false;
        int wgid = (int)L; { const int q = nwg / NXCD, r = nwg % NXCD, xcd = wgid % NXCD, off = wgid / NXCD; wgid = (xcd < r ? xcd * (q + 1) : r * (q + 1) + (xcd - r) * q) + off; }
        const int nig = WGM * nN, gid = wgid / nig, fm = gid * WGM, gsz = (nM - fm) < WGM ? (nM - fm) : WGM;
        u.pm = fm + ((wgid % nig) % gsz); u.pn = (wgid % nig) / gsz; return true;
    }
    __device__ __forceinline__ void a_ready(const Unit&) const {}
    __device__ __forceinline__ void done(const Unit&) const {}
};
__device__ __forceinline__ unsigned cvt_pk_bf16(float lo, float hi) { unsigned r; asm volatile("v_cvt_pk_bf16_f32 %0, %1, %2" : "=v"(r) : "v"(lo), "v"(hi)); return r; }
#ifdef NO_UNI
__device__ __forceinline__ const char* uni(const char* p) { return p; }
#else
__device__ __forceinline__ const char* uni(const char* p) { const unsigned long long v = (unsigned long long)p; const unsigned lo = __builtin_amdgcn_readfirstlane((unsigned)v), hi = __builtin_amdgcn_readfirstlane((unsigned)(v >> 32)); return (const char*)(((unsigned long long)hi << 32) | lo); }
#endif
template <class Epi, class Sched, bool ALIGN_EPI = false, bool SP2 = false>
__device__ __forceinline__ void gemm_phase(PG8_LAS unsigned char* lds, const Gemm g, const Sched& S, const Epi& E) {
    int tid = threadIdx.x;
#ifndef NO_LAUNDER
    asm volatile("" : "+v"(tid));
#endif

    const int wid = __builtin_amdgcn_readfirstlane(tid >> 6), lane = tid & 63, wr = wid >> 2, wc = wid & 3, fr = lane & 15, fq = lane >> 4;
    const int K = g.K, nt = K / BK;
    unsigned voffA[2], voffB[2];
#pragma unroll
    for (int i = 0; i < 2; ++i) { int R, C; stage_rc(tid * 16 + i * 8192, R, C); const int Rb = Epi::PERM ? ((R & ~31) + perm32(R & 31)) : R;
        voffA[i] = (unsigned)(R * K + C) * 2u; voffB[i] = (unsigned)(Rb * K + C) * 2u; }
    const size_t kstep = (size_t)(BK * 2);
    const size_t hstep = (size_t)HALF * K * 2;
    const size_t tstep = 2 * hstep;
    const unsigned ldsw = (unsigned)wid * 1024u;
    const int aoff = lds_byte(wr * 64 + fr, fq * 8), boff = lds_byte(wc * 32 + fr, fq * 8);
#define PG8_SA(b, h) (((b) * 2 + (h)) * HTB)
#define PG8_SB(b, h) ((4 + (b) * 2 + (h)) * HTB)
#define PG8_STAGE(bufoff, gbase, voff) do { _Pragma("unroll") for (int _i = 0; _i < 2; ++_i) \
        __builtin_amdgcn_global_load_lds((const unsigned*)((const char*)(gbase) + (voff)[_i]), (PG8_LAS unsigned*)(lds + (bufoff) + ldsw + _i * 8192), 16, 0, 0); } while (0)
#define PG8_LDA(dst, b, h) do { _Pragma("unroll") for (int m = 0; m < 4; ++m) _Pragma("unroll") for (int k = 0; k < 2; ++k) dst[m][k] = *(const PG8_LAS bf16x8*)(lds + PG8_SA(b, h) + aoff + m * 2048 + k * 1024); } while (0)
#define PG8_LDB(dst, b, h) do { _Pragma("unroll") for (int n = 0; n < 2; ++n) _Pragma("unroll") for (int k = 0; k < 2; ++k) dst[n][k] = *(const PG8_LAS bf16x8*)(lds + PG8_SB(b, h) + boff + n * 2048 + k * 1024); } while (0)
#define PG8_MMA(ai, bj, At, Bt) do { __builtin_amdgcn_s_setprio(1); _Pragma("unroll") for (int m = 0; m < 4; ++m) _Pragma("unroll") for (int n = 0; n < 2; ++n) _Pragma("unroll") for (int k = 0; k < 2; ++k) \
        acc[ai][bj][m][n] = __builtin_amdgcn_mfma_f32_16x16x32_bf16(Bt[n][k], At[m][k], acc[ai][bj][m][n], 0, 0, 0); __builtin_amdgcn_s_setprio(0); } while (0)
#define PG8_WAIT_V(n) asm volatile("s_waitcnt vmcnt(" #n ")" ::: "memory")
#define PG8_WAIT_L(n) asm volatile("s_waitcnt lgkmcnt(" #n ")" ::: "memory")
#define PG8_BAR __builtin_amdgcn_s_barrier()
#define PG8_SCHED __builtin_amdgcn_sched_barrier(0)
    Unit cur, nxt; int ui = 0;
    if (!S.next(0, cur)) return;
    f32x4 acc[2][2][4][2];
#pragma unroll
    for (int a = 0; a < 2; ++a)
#pragma unroll
        for (int b = 0; b < 2; ++b)
#pragma unroll
            for (int m = 0; m < 4; ++m)
#pragma unroll
                for (int n = 0; n < 2; ++n) acc[a][b][m][n] = (f32x4){0.f, 0.f, 0.f, 0.f};
    bf16x8 At[4][2], B0[2][2], B1[2][2];
    const char* cA = uni((const char*)g.A + (size_t)amap(cur.pm, g.hmap) * tstep); const char* cB = uni((const char*)g.Bt + (size_t)cur.pn * tstep);
    S.a_ready(cur);
    if constexpr (SP2) {
        PG8_STAGE(PG8_SB(0, 0), cB, voffB); PG8_STAGE(PG8_SB(0, 1), cB + hstep, voffB); PG8_STAGE(PG8_SA(0, 0), cA, voffA); PG8_STAGE(PG8_SA(0, 1), cA + hstep, voffA);
        if (wr == 1) PG8_BAR;
        PG8_WAIT_V(2); PG8_BAR;
        PG8_STAGE(PG8_SB(1, 0), cB + kstep, voffB); PG8_STAGE(PG8_SA(1, 0), cA + kstep, voffA); PG8_STAGE(PG8_SB(1, 1), cB + hstep + kstep, voffB);
        PG8_WAIT_V(6); PG8_BAR;
    } else {
        PG8_STAGE(PG8_SB(0, 0), cB, voffB); PG8_STAGE(PG8_SA(0, 0), cA, voffA); PG8_STAGE(PG8_SB(0, 1), cB + hstep, voffB); PG8_STAGE(PG8_SA(0, 1), cA + hstep, voffA);
        if (wr == 1) PG8_BAR;
        PG8_WAIT_V(4); PG8_BAR;
        PG8_STAGE(PG8_SB(1, 0), cB + kstep, voffB); PG8_STAGE(PG8_SA(1, 0), cA + kstep, voffA); PG8_STAGE(PG8_SB(1, 1), cB + hstep + kstep, voffB);
        PG8_WAIT_V(6); PG8_BAR;
    }
    for (;;) {
        const bool has_next = S.next(ui + 1, nxt);
        const char* nA = uni(has_next ? (const char*)g.A + (size_t)amap(nxt.pm, g.hmap) * tstep : cA); const char* nB = uni(has_next ? (const char*)g.Bt + (size_t)nxt.pn * tstep : cB);
        for (int t = 0; t < nt; t += 2) {
            const bool last = (t == nt - 2);
            const char* a1 = cA + (size_t)(t + 1) * kstep;
            const char* a2 = last ? nA : cA + (size_t)(t + 2) * kstep; const char* b2 = last ? nB : cB + (size_t)(t + 2) * kstep;
            const char* a3 = a2 + kstep; const char* b3 = b2 + kstep;
            if (last && has_next) S.a_ready(nxt);
            if constexpr (SP2) {
            PG8_LDB(B0, 0, 0); PG8_LDB(B1, 0, 1); PG8_SCHED; PG8_LDA(At, 0, 0); PG8_STAGE(PG8_SA(1, 1), a1 + hstep, voffA);
            PG8_WAIT_V(8); PG8_WAIT_L(0); PG8_BAR; PG8_MMA(0, 0, At, B0); PG8_MMA(0, 1, At, B1); PG8_BAR; PG8_SCHED;
            PG8_LDA(At, 0, 1); PG8_STAGE(PG8_SB(0, 0), b2, voffB); PG8_STAGE(PG8_SB(0, 1), b2 + hstep, voffB); PG8_STAGE(PG8_SA(0, 0), a2, voffA);
            PG8_WAIT_V(8); PG8_WAIT_L(0); PG8_BAR; PG8_MMA(1, 0, At, B0); PG8_MMA(1, 1, At, B1); PG8_BAR; PG8_SCHED;
            PG8_LDB(B0, 1, 0); PG8_LDB(B1, 1, 1); PG8_SCHED; PG8_LDA(At, 1, 0); PG8_STAGE(PG8_SA(0, 1), a2 + hstep, voffA);
            PG8_WAIT_V(8); PG8_WAIT_L(0); PG8_BAR; PG8_MMA(0, 0, At, B0); PG8_MMA(0, 1, At, B1); PG8_BAR; PG8_SCHED;
            PG8_LDA(At, 1, 1); PG8_STAGE(PG8_SB(1, 0), b3, voffB); PG8_STAGE(PG8_SB(1, 1), b3 + hstep, voffB); PG8_STAGE(PG8_SA(1, 0), a3, voffA);
            PG8_WAIT_V(8); PG8_WAIT_L(0); PG8_BAR; PG8_MMA(1, 0, At, B0); PG8_MMA(1, 1, At, B1); PG8_BAR; PG8_SCHED;
            } else {
            PG8_LDB(B0, 0, 0); PG8_SCHED; PG8_LDA(At, 0, 0); PG8_STAGE(PG8_SA(1, 1), a1 + hstep, voffA);
            PG8_WAIT_L(8); PG8_BAR; PG8_WAIT_L(0); PG8_MMA(0, 0, At, B0); PG8_BAR; PG8_SCHED;
            PG8_LDB(B1, 0, 1); PG8_STAGE(PG8_SB(0, 0), b2, voffB);
            PG8_BAR; PG8_WAIT_L(0); PG8_MMA(0, 1, At, B1); PG8_BAR;
            PG8_LDA(At, 0, 1); PG8_STAGE(PG8_SA(0, 0), a2, voffA);
            PG8_BAR; PG8_WAIT_L(0); PG8_MMA(1, 0, At, B0); PG8_BAR; PG8_SCHED;
            PG8_STAGE(PG8_SB(0, 1), b2 + hstep, voffB);
            PG8_WAIT_V(6); PG8_BAR; PG8_MMA(1, 1, At, B1); PG8_BAR;
            PG8_LDB(B0, 1, 0); PG8_SCHED; PG8_LDA(At, 1, 0); PG8_STAGE(PG8_SA(0, 1), a2 + hstep, voffA);
            PG8_WAIT_L(8); PG8_BAR; PG8_WAIT_L(0); PG8_MMA(0, 0, At, B0); PG8_BAR; PG8_SCHED;
            PG8_LDB(B1, 1, 1); PG8_STAGE(PG8_SB(1, 0), b3, voffB);
            PG8_BAR; PG8_WAIT_L(0); PG8_MMA(0, 1, At, B1); PG8_BAR;
            PG8_LDA(At, 1, 1); PG8_STAGE(PG8_SA(1, 0), a3, voffA);
            PG8_BAR; PG8_WAIT_L(0); PG8_MMA(1, 0, At, B0); PG8_BAR; PG8_SCHED;
            PG8_STAGE(PG8_SB(1, 1), b3 + hstep, voffB);
            PG8_WAIT_V(6); PG8_BAR; PG8_MMA(1, 1, At, B1); PG8_BAR;
            }
        }
        if constexpr (ALIGN_EPI) { if (wr == 0) PG8_BAR; }
        if constexpr (!Epi::AFTER_DRAIN) { E(acc, cur, wr, wc, fr, fq); S.done(cur); }
        if (!has_next) break;
#pragma unroll
        for (int a = 0; a < 2; ++a)
#pragma unroll
            for (int b = 0; b < 2; ++b)
#pragma unroll
                for (int m = 0; m < 4; ++m)
#pragma unroll
                    for (int n = 0; n < 2; ++n) acc[a][b][m][n] = (f32x4){0.f, 0.f, 0.f, 0.f};
        cur = nxt; cA = nA; cB = nB; ++ui;
        if constexpr (ALIGN_EPI) { if (wr == 1) PG8_BAR; }
    }
    PG8_WAIT_V(0);
    if constexpr (!ALIGN_EPI) { if (wr == 0) PG8_BAR; }
    PG8_BAR;
    if constexpr (Epi::AFTER_DRAIN) { E.fused(acc, cur, wr, wc, fr, fq, lds, wid, lane); S.done(cur); }
#undef PG8_SA
#undef PG8_SB
#undef PG8_STAGE
#undef PG8_LDA
#undef PG8_LDB
#undef PG8_MMA
#undef PG8_WAIT_V
#undef PG8_WAIT_L
#undef PG8_BAR
#undef PG8_SCHED
}
}

#define GAS __attribute__((address_space(1)))
#define LAS __attribute__((address_space(3)))
typedef unsigned short bf16_t;
typedef float f32x4 __attribute__((ext_vector_type(4)));
typedef float f32x16 __attribute__((ext_vector_type(16)));
typedef short bf16x8 __attribute__((ext_vector_type(8)));
typedef unsigned u32x4 __attribute__((ext_vector_type(4)));
typedef unsigned u32x2 __attribute__((ext_vector_type(2)));

#ifndef NLAYER_V
#define NLAYER_V 4
#endif
constexpr int NW = 8, NTHR = 512;
constexpr int MTOK = 32768, DM = 1024, SEQ = 4096, NB = 8, NLAYER = NLAYER_V, NH = 8;
constexpr int DIN = 9232, DFF = 2816, DPLE = 256;
constexpr float EPS = 1e-6f;
constexpr float LOG2E = 1.4426950408889634f;
constexpr size_t MiB = 1u << 20;
constexpr size_t WS_SS = 0;
constexpr size_t WS_CTL = 1792 * 1024;
constexpr size_t WS_UHALO = 1856 * 1024;
constexpr size_t WS_GB = 2 * MiB;
constexpr size_t WS_HALO = 4 * MiB;
constexpr size_t WS_PB = 14 * MiB;
constexpr size_t WS_W = 30 * MiB;
constexpr size_t W_IN = WS_W, W_V = W_IN + (size_t)6400 * 1024 * 2, W_GL = W_V + 2 * MiB, W_BRA = W_GL + 4 * MiB, W_BRB = W_BRA + 2 * MiB,
                 W_OUT = W_BRB + 2 * MiB, W_UP = W_OUT + 2 * MiB, W_DOWN = W_UP + 11 * MiB, W_PG = W_DOWN + (size_t)1024 * 2816 * 2, W_PP = W_PG + 2 * MiB, W_END = W_PP + (size_t)1024 * 256 * 2;
static_assert(W_END <= 74 * MiB, "weights region");
constexpr size_t WS_XB = 74 * MiB;
constexpr size_t WS_MIX = 138 * MiB;
constexpr size_t S64 = 64 * MiB;
constexpr size_t WS_QA = WS_MIX, WS_KA = WS_MIX + S64, WS_VT = WS_MIX + 2 * S64, WS_QB = WS_MIX + 3 * S64, WS_KB = WS_MIX + 4 * S64, WS_VB = WS_MIX + 5 * S64, WS_ZB = WS_MIX + 6 * S64;
constexpr size_t WS_TOTAL = WS_MIX + 7 * S64;
#ifdef DN_NAIVE
constexpr size_t WS_G = WS_KB, WS_TMPA = WS_KA, WS_MIXED = WS_VT, WS_OSRC = WS_QB;
#else
constexpr size_t WS_G = WS_KA, WS_TMPA = WS_KB, WS_MIXED = WS_VB, WS_OSRC = WS_VB;
#endif
constexpr int LDS_BYTES = 147456, LDS_VB = 140032;

__device__ __forceinline__ float bflo(unsigned w) { return __uint_as_float(w << 16); }
__device__ __forceinline__ float bfhi(unsigned w) { return __uint_as_float(w & 0xffff0000u); }
__device__ __forceinline__ float bf2f(bf16_t v) { return __uint_as_float((unsigned)v << 16); }
typedef float f32x2_t __attribute__((ext_vector_type(2))); typedef __bf16 bf16x2_t __attribute__((ext_vector_type(2)));
__device__ __forceinline__ unsigned pk2(float lo, float hi) { const f32x2_t v = {lo, hi}; const bf16x2_t b = __builtin_convertvector(v, bf16x2_t); return __builtin_bit_cast(unsigned, b); }
__device__ __forceinline__ bf16_t f2bf(float f) { return (bf16_t)(pk2(f, 0.f) & 0xffffu); }
__device__ __forceinline__ float sigmoidf_(float x) { x = fminf(fmaxf(x, -60.f), 60.f); return __builtin_amdgcn_rcpf(1.f + __expf(-x)); }
__device__ __forceinline__ float siluf_(float x) { return x * sigmoidf_(x); }
__device__ __forceinline__ float wave_sum(float v) {
#pragma unroll
    for (int o = 1; o < 64; o <<= 1) v += __shfl_xor(v, o);
    return v;
}
__device__ __forceinline__ float ss_load(const float* p) { const f32x4 a = *(const f32x4*)p, b = *(const f32x4*)(p + 4), c = *(const f32x4*)(p + 8), d = *(const f32x4*)(p + 12);
    float s = (((a[0] + a[1]) + (a[2] + a[3])) + ((b[0] + b[1]) + (b[2] + b[3]))) + (((c[0] + c[1]) + (c[2] + c[3])) + ((d[0] + d[1]) + (d[2] + d[3])));
    asm volatile("" : "+v"(s) :: "memory");
    return s; }
__device__ __forceinline__ u32x4 ldc16(const void* p) { u32x4 v; asm volatile("global_load_dwordx4 %0, %1, off sc0 sc1\n\ts_waitcnt vmcnt(0)" : "=v"(v) : "v"(p) : "memory"); return v; }
__device__ __forceinline__ int crow(int r, int hi) { return (r & 3) + 8 * (r >> 2) + 4 * hi; }

__device__ __forceinline__ float ss_sum16(const f32x4 a, const f32x4 b, const f32x4 c, const f32x4 d) {
    return (((a[0] + a[1]) + (a[2] + a[3])) + ((b[0] + b[1]) + (b[2] + b[3]))) + (((c[0] + c[1]) + (c[2] + c[3])) + ((d[0] + d[1]) + (d[2] + d[3]))); }
__device__ __forceinline__ int gmap(int row, int h) { return h < 0 ? row : ((row >> 11) * 4096 + 2048 * h + (row & 2047)); }

__device__ __forceinline__ void load_rs8(const float* ss, int rowbase, int hmap, int lane, int fr, float (&rs)[2][4]) {
    const float* p0 = ss + (size_t)gmap(rowbase + lane, hmap) * 16; const float* p1 = ss + (size_t)gmap(rowbase + 128 + lane, hmap) * 16;
    const f32x4 a0 = *(const f32x4*)p0, b0 = *(const f32x4*)(p0 + 4), c0 = *(const f32x4*)(p0 + 8), d0 = *(const f32x4*)(p0 + 12);
    const f32x4 a1 = *(const f32x4*)p1, b1 = *(const f32x4*)(p1 + 4), c1 = *(const f32x4*)(p1 + 8), d1 = *(const f32x4*)(p1 + 12);
    const float r0 = rsqrtf(ss_sum16(a0, b0, c0, d0) * (1.f / 1024.f) + EPS), r1 = rsqrtf(ss_sum16(a1, b1, c1, d1) * (1.f / 1024.f) + EPS);
#pragma unroll
    for (int m = 0; m < 4; ++m) { rs[0][m] = __shfl(r0, m * 16 + fr); rs[1][m] = __shfl(r1, m * 16 + fr); }
    asm volatile("" ::: "memory");
}

using pg8::Unit;
typedef f32x4 AccT[2][2][4][2];

template <int ACT> struct EpiRowScale {
    static constexpr bool PERM = true, AFTER_DRAIN = false;
    bf16_t* O; int ldc; const float* ss; int hmap;
    __device__ __forceinline__ void operator()(const AccT& acc, const Unit& u, int wr, int wc, int fr, int fq) const {
        const int row0 = u.pm * 256 + wr * 64 + fr, col0 = u.pn * 256 + wc * 32 + 8 * fq;
        float rsv[2][4]; load_rs8(ss, u.pm * 256 + wr * 64, hmap, (int)(threadIdx.x & 63), fr, rsv);
#pragma unroll
        for (int ai = 0; ai < 2; ++ai)
#pragma unroll
            for (int m = 0; m < 4; ++m) {
                const int row = row0 + ai * 128 + m * 16;
                const float rs = rsv[ai][m];
                bf16_t* rowp = O + (size_t)row * ldc + col0;
#pragma unroll
                for (int bj = 0; bj < 2; ++bj) {
                    f32x4 v0 = acc[ai][bj][m][0] * rs, v1 = acc[ai][bj][m][1] * rs;
                    if (ACT == 1) {
#pragma unroll
                        for (int e = 0; e < 4; ++e) { v0[e] = sigmoidf_(v0[e]); v1[e] = sigmoidf_(v1[e]); }
                    }
                    u32x4 w; w.x = pk2(v0[0], v0[1]); w.y = pk2(v0[2], v0[3]); w.z = pk2(v1[0], v1[1]); w.w = pk2(v1[2], v1[3]);
                    *(u32x4*)(rowp + bj * 128) = w;
                    asm volatile("" ::: "memory");
                }
            }
    }
};

struct EpiVt {
    static constexpr bool PERM = true, AFTER_DRAIN = false;
    bf16_t* O; const float* ss;
    __device__ __forceinline__ void operator()(const AccT& acc, const Unit& u, int wr, int wc, int fr, int fq) const {
        const int row0 = u.pm * 256 + wr * 64 + fr, col0 = u.pn * 256 + wc * 32 + 8 * fq;
        float rs[2][8];
        { const int L = (int)(threadIdx.x & 63); const float* pc = ss + (size_t)(u.pn * 256 + (L >> 5) * 128 + wc * 32 + (L & 31)) * 16;
          const f32x4 a = *(const f32x4*)pc, b = *(const f32x4*)(pc + 4), c = *(const f32x4*)(pc + 8), d = *(const f32x4*)(pc + 12);
          const float r = rsqrtf(ss_sum16(a, b, c, d) * (1.f / 1024.f) + EPS);
#pragma unroll
          for (int bj = 0; bj < 2; ++bj)
#pragma unroll
              for (int e = 0; e < 8; ++e) rs[bj][e] = __shfl(r, bj * 32 + 8 * fq + e); }
#pragma unroll
        for (int ai = 0; ai < 2; ++ai)
#pragma unroll
            for (int m = 0; m < 4; ++m) {
                const int row = row0 + ai * 128 + m * 16;
                bf16_t* rowp = O + (size_t)row * MTOK + col0;
#pragma unroll
                for (int bj = 0; bj < 2; ++bj) {
                    const f32x4 v0 = acc[ai][bj][m][0], v1 = acc[ai][bj][m][1];
                    u32x4 w; w.x = pk2(v0[0] * rs[bj][0], v0[1] * rs[bj][1]); w.y = pk2(v0[2] * rs[bj][2], v0[3] * rs[bj][3]);
                    w.z = pk2(v1[0] * rs[bj][4], v1[1] * rs[bj][5]); w.w = pk2(v1[2] * rs[bj][6], v1[3] * rs[bj][7]);
                    *(u32x4*)(rowp + bj * 128) = w;
                }
                asm volatile("" ::: "memory");
            }
    }
};

struct EpiGateMul {
    static constexpr bool PERM = true, AFTER_DRAIN = false;
    bf16_t* O; const bf16_t* G; int ldg, goff; const bf16_t* Add;
    __device__ __forceinline__ void operator()(const AccT& acc, const Unit& u, int wr, int wc, int fr, int fq) const {
        const int row0 = u.pm * 256 + wr * 64 + fr, col0 = u.pn * 256 + wc * 32 + 8 * fq;
#pragma unroll
        for (int ai = 0; ai < 2; ++ai)
#pragma unroll
            for (int m = 0; m < 4; ++m) {
                const int row = row0 + ai * 128 + m * 16;
#pragma unroll
                for (int bj = 0; bj < 2; ++bj) {
                    const int c = col0 + bj * 128;
                    const u32x4 g = *(const u32x4*)(G + (size_t)row * ldg + goff + c);
                    u32x4 a = (u32x4){0u, 0u, 0u, 0u};
                    if (Add) a = *(const u32x4*)(Add + (size_t)row * 1024 + c);
                    const f32x4 v0 = acc[ai][bj][m][0], v1 = acc[ai][bj][m][1];
                    u32x4 w;
                    w.x = pk2(bflo(a.x) + bflo(g.x) * v0[0], bfhi(a.x) + bfhi(g.x) * v0[1]);
                    w.y = pk2(bflo(a.y) + bflo(g.y) * v0[2], bfhi(a.y) + bfhi(g.y) * v0[3]);
                    w.z = pk2(bflo(a.z) + bflo(g.z) * v1[0], bfhi(a.z) + bfhi(g.z) * v1[1]);
                    w.w = pk2(bflo(a.w) + bflo(g.w) * v1[2], bfhi(a.w) + bfhi(g.w) * v1[3]);
                    *(u32x4*)(O + (size_t)row * 1024 + c) = w;
                }
                asm volatile("" ::: "memory");
            }
    }
};

struct EpiResid {
    static constexpr bool PERM = true, AFTER_DRAIN = false;
    float* X; bf16_t* XB; float* ssn; const bf16_t* Mul; int hmap;
    __device__ __forceinline__ void operator()(const AccT& acc, const Unit& u, int wr, int wc, int fr, int fq) const {
        const int row0 = u.pm * 256 + wr * 64 + fr, col0 = u.pn * 256 + wc * 32 + 8 * fq;
#pragma unroll
        for (int ai = 0; ai < 2; ++ai)
#pragma unroll
            for (int m = 0; m < 4; ++m) {
                const int row = gmap(row0 + ai * 128 + m * 16, hmap);
                const size_t off0 = (size_t)row * 1024 + col0;
                f32x4 xa = *(const f32x4*)(X + off0), xb2 = *(const f32x4*)(X + off0 + 4), xc = *(const f32x4*)(X + off0 + 128), xd = *(const f32x4*)(X + off0 + 132);
                f32x4 va = acc[ai][0][m][0], vb2 = acc[ai][0][m][1], vc = acc[ai][1][m][0], vd = acc[ai][1][m][1];
                if (Mul) {
                    const u32x4 g0 = *(const u32x4*)(Mul + off0), g1 = *(const u32x4*)(Mul + off0 + 128);
                    va[0] *= bflo(g0.x); va[1] *= bfhi(g0.x); va[2] *= bflo(g0.y); va[3] *= bfhi(g0.y); vb2[0] *= bflo(g0.z); vb2[1] *= bfhi(g0.z); vb2[2] *= bflo(g0.w); vb2[3] *= bfhi(g0.w);
                    vc[0] *= bflo(g1.x); vc[1] *= bfhi(g1.x); vc[2] *= bflo(g1.y); vc[3] *= bfhi(g1.y); vd[0] *= bflo(g1.z); vd[1] *= bfhi(g1.z); vd[2] *= bflo(g1.w); vd[3] *= bfhi(g1.w);
                }
                xa += va; xb2 += vb2; xc += vc; xd += vd;
                *(f32x4*)(X + off0) = xa; *(f32x4*)(X + off0 + 4) = xb2; *(f32x4*)(X + off0 + 128) = xc; *(f32x4*)(X + off0 + 132) = xd;
                u32x4 w0; w0.x = pk2(xa[0], xa[1]); w0.y = pk2(xa[2], xa[3]); w0.z = pk2(xb2[0], xb2[1]); w0.w = pk2(xb2[2], xb2[3]);
                u32x4 w1; w1.x = pk2(xc[0], xc[1]); w1.y = pk2(xc[2], xc[3]); w1.z = pk2(xd[0], xd[1]); w1.w = pk2(xd[2], xd[3]);
                *(u32x4*)(XB + off0) = w0; *(u32x4*)(XB + off0 + 128) = w1;
                float sq = ((xa[0] * xa[0] + xa[1] * xa[1]) + (xa[2] * xa[2] + xa[3] * xa[3])) + ((xb2[0] * xb2[0] + xb2[1] * xb2[1]) + (xb2[2] * xb2[2] + xb2[3] * xb2[3]))
                         + ((xc[0] * xc[0] + xc[1] * xc[1]) + (xc[2] * xc[2] + xc[3] * xc[3])) + ((xd[0] * xd[0] + xd[1] * xd[1]) + (xd[2] * xd[2] + xd[3] * xd[3]));
                sq += __shfl_xor(sq, 16); sq += __shfl_xor(sq, 32);
                if (fq == 0) ssn[(size_t)row * 16 + u.pn * 4 + wc] = sq;
                asm volatile("" ::: "memory");
            }
    }
};

struct EpiQK {
    static constexpr bool PERM = true, AFTER_DRAIN = false;
    unsigned char* ws; const float* ss; const float* qg; const float* kg;
    __device__ __forceinline__ void operator()(const AccT& acc, const Unit& u, int wr, int wc, int fr, int fq) const {
        const int row0 = u.pm * 256 + wr * 64 + fr;
        const int seg = u.pn >> 2, tl = u.pn & 3;
        bf16_t* base = (bf16_t*)(ws + (seg == 0 ? WS_QA : WS_KA));
        const float* gp = seg == 0 ? qg : kg; const float osc = seg == 0 ? 0.125f * LOG2E : 1.0f;
        const int col0 = tl * 256 + 64 * wc + 8 * fq;
        float rsv[2][4]; load_rs8(ss, u.pm * 256 + wr * 64, -1, (int)(threadIdx.x & 63), fr, rsv);
#pragma unroll
        for (int ai = 0; ai < 2; ++ai)
#pragma unroll
            for (int m = 0; m < 4; ++m) {
                const int row = row0 + ai * 128 + m * 16;
                const float rs = rsv[ai][m];
                f32x4 v[2][2]; float sq = 0.f;
#pragma unroll
                for (int bj = 0; bj < 2; ++bj)
#pragma unroll
                    for (int n = 0; n < 2; ++n) { v[bj][n] = acc[ai][bj][m][n] * rs; const f32x4 t = v[bj][n]; sq += (t[0] * t[0] + t[1] * t[1]) + (t[2] * t[2] + t[3] * t[3]); }
                sq += __shfl_xor(sq, 16); sq += __shfl_xor(sq, 32);
                const float r2o = rsqrtf(sq * (1.f / 64.f) + EPS) * osc;
#pragma unroll
                for (int bj = 0; bj < 2; ++bj) {
                    const f32x4 ga = *(const f32x4*)(gp + 32 * bj + 8 * fq), gb = *(const f32x4*)(gp + 32 * bj + 8 * fq + 4);
                    u32x4 w;
                    w.x = pk2(v[bj][0][0] * r2o * ga[0], v[bj][0][1] * r2o * ga[1]); w.y = pk2(v[bj][0][2] * r2o * ga[2], v[bj][0][3] * r2o * ga[3]);
                    w.z = pk2(v[bj][1][0] * r2o * gb[0], v[bj][1][1] * r2o * gb[1]); w.w = pk2(v[bj][1][2] * r2o * gb[2], v[bj][1][3] * r2o * gb[3]);
                    *(u32x4*)(base + (size_t)row * 1024 + col0 + 32 * bj) = w;
                }
                asm volatile("" ::: "memory");
            }
    }
};
struct EpiSeg {
    static constexpr bool PERM = true, AFTER_DRAIN = false;
    unsigned char* ws; const float* ss;
    __device__ __forceinline__ void operator()(const AccT& acc, const Unit& u, int wr, int wc, int fr, int fq) const {
        const int row0 = u.pm * 256 + wr * 64 + fr;
        bf16_t* base = (bf16_t*)(ws + WS_QB + (size_t)(u.pn >> 2) * S64);
        const int col0 = (u.pn & 3) * 256 + wc * 32 + 8 * fq;
        float rsv[2][4]; load_rs8(ss, u.pm * 256 + wr * 64, -1, (int)(threadIdx.x & 63), fr, rsv);
#pragma unroll
        for (int ai = 0; ai < 2; ++ai)
#pragma unroll
            for (int m = 0; m < 4; ++m) {
                const int row = row0 + ai * 128 + m * 16;
                const float rs = rsv[ai][m];
#pragma unroll
                for (int bj = 0; bj < 2; ++bj) {
                    const f32x4 v0 = acc[ai][bj][m][0] * rs, v1 = acc[ai][bj][m][1] * rs;
                    u32x4 w; w.x = pk2(v0[0], v0[1]); w.y = pk2(v0[2], v0[3]); w.z = pk2(v1[0], v1[1]); w.w = pk2(v1[2], v1[3]);
                    *(u32x4*)(base + (size_t)row * 1024 + col0 + bj * 128) = w;
                }
                asm volatile("" ::: "memory");
            }
    }
};
struct EpiGB {
    static constexpr bool PERM = true, AFTER_DRAIN = false;
    unsigned char* ws; const float* ss; const float* a_log; const float* dt_bias;
    __device__ __forceinline__ void operator()(const AccT& acc, const Unit& u, int wr, int wc, int fr, int fq) const {
        const int row0 = u.pm * 256 + wr * 64 + fr;
        float rsv[2][4]; load_rs8(ss, u.pm * 256 + wr * 64, -1, (int)(threadIdx.x & 63), fr, rsv);
        if (wc == 0 && fq < 2) {
            float* GBp = (float*)(ws + WS_GB);
#pragma unroll
            for (int ai = 0; ai < 2; ++ai)
#pragma unroll
                for (int m = 0; m < 4; ++m) {
                    const int row = row0 + ai * 128 + m * 16;
                    const float rs = rsv[ai][m];
                    float v[8];
#pragma unroll
                    for (int e = 0; e < 4; ++e) { v[e] = acc[ai][0][m][0][e] * rs; v[4 + e] = acc[ai][0][m][1][e] * rs; }
                    if (fq == 0) {
#pragma unroll
                        for (int e = 0; e < 8; ++e) v[e] = sigmoidf_(v[e]);
                    } else {
#pragma unroll
                        for (int e = 0; e < 8; ++e) { const float z = v[e] + dt_bias[e]; const float sp = fmaxf(z, 0.f) + __logf(1.f + __expf(-fabsf(z))); v[e] = -__expf(a_log[e]) * sp; }
                    }
                    float* dst = GBp + (size_t)row * 16 + 8 * fq;
                    *(f32x4*)dst = (f32x4){v[0], v[1], v[2], v[3]}; *(f32x4*)(dst + 4) = (f32x4){v[4], v[5], v[6], v[7]};
                    asm volatile("" ::: "memory");
                }
        }
    }
};

__device__ __forceinline__ void cvt_item(const float* W, int ldw, int src_col0, int nvalid, const float* gain, bf16_t* WT, int K, int dst_row0, int k0, LAS float* scr, int lane) {
    const int nn = lane & 31;
#pragma unroll 8
    for (int i = 0; i < 32; ++i) {
        const int kk = 2 * i + (lane >> 5);
        float v = 0.f;
        if (nn < nvalid) { v = W[(size_t)(k0 + kk) * ldw + src_col0 + nn]; if (gain) v *= gain[k0 + kk]; }
        scr[kk * 33 + nn] = v;
    }
    asm volatile("s_waitcnt lgkmcnt(0)" ::: "memory");
    const int c = lane & 7;
#pragma unroll
    for (int j = 0; j < 4; ++j) {
        const int n = (lane >> 3) + 8 * j; const LAS float* s = scr + (8 * c) * 33 + n;
        u32x4 o; o.x = pk2(s[0 * 33], s[1 * 33]); o.y = pk2(s[2 * 33], s[3 * 33]); o.z = pk2(s[4 * 33], s[5 * 33]); o.w = pk2(s[6 * 33], s[7 * 33]);
        *(u32x4*)(WT + (size_t)(dst_row0 + n) * K + k0 + 8 * c) = o;
    }
    asm volatile("s_waitcnt lgkmcnt(0)" ::: "memory");
}

struct Params {
    const float* in[24];
    float* out;
    unsigned char* ws;
    int seg_lo, seg_hi;
};
enum { I_X = 0, I_P, I_WIN, I_ATTN_NORM, I_QNORM, I_KNORM, I_LAM, I_SUBLN, I_RELB, I_CONVB, I_ALOG, I_DTB, I_ONORM, I_WBRA, I_WBRB, I_WOUT, I_FFN_NORM, I_WUP, I_CONVFF, I_CONVFFB, I_WDOWN, I_PLE_NORM, I_WPG, I_WPP };

__device__ __forceinline__ void convert_weights(const Params* PQ, int layer, LAS unsigned char* lds, int gw, int NGW, int wave, int lane) {
    LAS float* scr = (LAS float*)(lds + wave * 16384);
    unsigned char* ws = PQ->ws;
    const float* w_in = PQ->in[I_WIN] + (size_t)layer * 1024 * DIN;
    const float* g_attn = PQ->in[I_ATTN_NORM] + layer * 1024;
    const float* g_ffn = PQ->in[I_FFN_NORM] + layer * 1024;
    const float* g_ple = PQ->in[I_PLE_NORM] + layer * 1024;
#define CVT_JOB(NITEMS, KB, SRCW, LDW, GAIN, DST, KK, SRCCOL, NVALID) \
    for (int it = gw; it < (NITEMS); it += NGW) { const int g = it / (KB), kb = it % (KB); (void)g; \
        cvt_item((SRCW), (LDW), (SRCCOL), (NVALID), (GAIN), (bf16_t*)(ws + (DST)), (KK), g * 32, kb * 64, scr, lane); } asm volatile("" ::: "memory");
    for (int it = gw; it < 200 * 16; it += NGW) {
        const int g = it >> 4, kb = it & 15, pn = g >> 3, gi = g & 7;
        int src, nv = 32;
        if (pn < 8) { const int bj = gi >> 2, wc = gi & 3; src = (pn >> 2) * 1024 + (pn & 3) * 256 + 64 * wc + 32 * bj; }
        else if (pn < 24) { src = 3072 + (pn - 8) * 256 + 32 * gi; }
        else { src = 7168; nv = (gi == 0) ? 16 : 0; }
        cvt_item(w_in, DIN, src, nv, g_attn, (bf16_t*)(ws + W_IN), 1024, g * 32, kb * 64, scr, lane);
    }
    asm volatile("" ::: "memory");
    CVT_JOB(32 * 16, 16, w_in, DIN, g_attn, W_V, 1024, 2048 + g * 32, 32)
    CVT_JOB(64 * 16, 16, w_in, DIN, g_attn, W_GL, 1024, 7184 + g * 32, 32)
    CVT_JOB(32 * 16, 16, PQ->in[I_WBRA] + (size_t)layer * 1024 * 1024, 1024, (const float*)nullptr, W_BRA, 1024, g * 32, 32)
    CVT_JOB(32 * 16, 16, PQ->in[I_WBRB] + (size_t)layer * 1024 * 1024, 1024, (const float*)nullptr, W_BRB, 1024, g * 32, 32)
    CVT_JOB(32 * 16, 16, PQ->in[I_WOUT] + (size_t)layer * 1024 * 1024, 1024, (const float*)nullptr, W_OUT, 1024, g * 32, 32)
    CVT_JOB(176 * 16, 16, PQ->in[I_WUP] + (size_t)layer * 1024 * 5632, 5632, g_ffn, W_UP, 1024, g * 32, 32)
    CVT_JOB(32 * 44, 44, PQ->in[I_WDOWN] + (size_t)layer * 2816 * 1024, 1024, (const float*)nullptr, W_DOWN, 2816, g * 32, 32)
    CVT_JOB(32 * 16, 16, PQ->in[I_WPG] + (size_t)layer * 1024 * 1024, 1024, g_ple, W_PG, 1024, g * 32, 32)
    CVT_JOB(32 * 4, 4, PQ->in[I_WPP] + (size_t)layer * 256 * 1024, 1024, (const float*)nullptr, W_PP, 256, g * 32, 32)
#undef CVT_JOB
}

constexpr int AT_KROW = 272, AT_VROW = 136  , AT_KBYTES = 64 * AT_KROW, AT_VBYTES = 128 * AT_VROW, AT_STAGE = AT_KBYTES + AT_VBYTES, AT_TB = 2 * AT_STAGE;
static_assert(AT_TB >= 65536 && AT_TB + 1024 <= LDS_BYTES, "attention LDS");
__device__ __forceinline__ void attn_unit(LAS unsigned char* lds, const bf16_t* QA, const bf16_t* KA, const bf16_t* VT, bf16_t* OA, int b, int h, int qb,
                                          float lam, float out_scale, const float* subln, const float* relb, int tid, bool do_store = true) {
    const int lane = tid & 63, wid = __builtin_amdgcn_readfirstlane(tid >> 6), j = wid >> 2, wq = wid & 3, r32 = lane & 31, hi = lane >> 5;
    const int Q0 = qb * 128, qrow = Q0 + 32 * wq + r32;
    const size_t tok = (size_t)b * SEQ + qrow;
    LAS float* TB = (LAS float*)(lds + AT_TB);
    for (int i = tid; i <= 128; i += NTHR) {
        float v = 0.f;
        if (i < 128) {
            int bk = i;
            if (i >= 16) { int lg = 16 + (int)(__logf((float)i * (1.f / 16.f)) / __logf(8.0f) * 16.f); bk = lg < 31 ? lg : 31; }
            v = (relb[bk * 8 + h] - relb[31 * 8 + h]) * LOG2E;
        }
        TB[i] = v;
    }
    bf16x8 qf[4];
#pragma unroll
    for (int d0 = 0; d0 < 4; ++d0) qf[d0] = *(const bf16x8*)(QA + tok * 1024 + h * 128 + 64 * j + 16 * d0 + 8 * hi);
    const int NT = (Q0 + 128) / 64;
    const int kr0 = tid >> 4, kc = tid & 15;
    const int vr0 = tid >> 3, vc = tid & 7;
    const bf16_t* kg = KA + ((size_t)b * SEQ + kr0) * 1024 + h * 128 + kc * 8;
    const bf16_t* vg = VT + (size_t)(h * 128 + vr0) * MTOK + (size_t)b * SEQ + vc * 8;
    u32x4 kreg0, kreg1, vreg0, vreg1;
#define AT_LOAD(t) do { kreg0 = *(const u32x4*)(kg + (size_t)(t) * 64 * 1024); kreg1 = *(const u32x4*)(kg + (size_t)((t) * 64 + 32) * 1024); \
        vreg0 = *(const u32x4*)(vg + (t) * 64); vreg1 = *(const u32x4*)(vg + (size_t)64 * MTOK + (t) * 64); } while (0)
#define AT_STORE(s) do { LAS unsigned char* kb_ = lds + (s) * AT_STAGE; LAS unsigned char* vb_ = kb_ + AT_KBYTES; \
        *(LAS u32x4*)(kb_ + kr0 * AT_KROW + kc * 16) = kreg0; *(LAS u32x4*)(kb_ + (kr0 + 32) * AT_KROW + kc * 16) = kreg1; \
        *(LAS u32x2*)(vb_ + vr0 * AT_VROW + vc * 16) = (u32x2){vreg0.x, vreg0.y}; *(LAS u32x2*)(vb_ + vr0 * AT_VROW + vc * 16 + 8) = (u32x2){vreg0.z, vreg0.w}; \
        *(LAS u32x2*)(vb_ + (vr0 + 64) * AT_VROW + vc * 16) = (u32x2){vreg1.x, vreg1.y}; *(LAS u32x2*)(vb_ + (vr0 + 64) * AT_VROW + vc * 16 + 8) = (u32x2){vreg1.z, vreg1.w}; } while (0)
    AT_LOAD(0); AT_STORE(0);
    __syncthreads();
    f32x16 o[4];
#pragma unroll
    for (int i = 0; i < 4; ++i)
#pragma unroll
        for (int r = 0; r < 16; ++r) o[i][r] = 0.f;
    float mrun = -INFINITY, lrun = 0.f;
    const int qmax_w = Q0 + 32 * wq + 31, qmin_w = Q0 + 32 * wq;
    for (int t = 0; t < NT; ++t) {
        if (t + 1 < NT) AT_LOAD(t + 1);
        const int kv0 = 64 * t;
        if (kv0 <= qmax_w) {
            const LAS unsigned char* Kb = lds + (t & 1) * AT_STAGE; const LAS unsigned char* Vb = Kb + AT_KBYTES;
            f32x16 s0, s1;
#pragma unroll
            for (int r = 0; r < 16; ++r) { s0[r] = 0.f; s1[r] = 0.f; }
#pragma unroll
            for (int d0 = 0; d0 < 4; ++d0) {
                const bf16x8 a0 = *(const LAS bf16x8*)(Kb + r32 * AT_KROW + (64 * j + 16 * d0 + 8 * hi) * 2);
                const bf16x8 a1 = *(const LAS bf16x8*)(Kb + (32 + r32) * AT_KROW + (64 * j + 16 * d0 + 8 * hi) * 2);
                s0 = __builtin_amdgcn_mfma_f32_32x32x16_bf16(a0, qf[d0], s0, 0, 0, 0);
                s1 = __builtin_amdgcn_mfma_f32_32x32x16_bf16(a1, qf[d0], s1, 0, 0, 0);
            }
            if (kv0 + 63 + 128 > qmin_w) {
#pragma unroll
                for (int r = 0; r < 16; ++r) {
                    const int rel0 = qrow - (kv0 + crow(r, hi)), rel1 = rel0 - 32;
                    s0[r] = rel0 < 0 ? -INFINITY : s0[r] + TB[rel0 < 128 ? rel0 : 128];
                    s1[r] = rel1 < 0 ? -INFINITY : s1[r] + TB[rel1 < 128 ? rel1 : 128];
                }
            }
            float mx = fmaxf(s0[0], s1[0]);
#pragma unroll
            for (int r = 1; r < 16; ++r) mx = fmaxf(mx, fmaxf(s0[r], s1[r]));
            mx = fmaxf(mx, __shfl_xor(mx, 32));
            const float mnew = fmaxf(mrun, mx);
            const float alpha = __builtin_amdgcn_exp2f(mrun - mnew);
            mrun = mnew;
            float ls = 0.f;
#pragma unroll
            for (int r = 0; r < 16; ++r) { s0[r] = __builtin_amdgcn_exp2f(s0[r] - mnew); s1[r] = __builtin_amdgcn_exp2f(s1[r] - mnew); ls += s0[r] + s1[r]; }
            lrun = lrun * alpha + ls;
#pragma unroll
            for (int i = 0; i < 4; ++i)
#pragma unroll
                for (int r = 0; r < 16; ++r) o[i][r] *= alpha;
            bf16x8 pf[4];
            { u32x4 w;
              w.x = pk2(s0[0], s0[1]); w.y = pk2(s0[2], s0[3]); w.z = pk2(s0[4], s0[5]); w.w = pk2(s0[6], s0[7]); pf[0] = __builtin_bit_cast(bf16x8, w);
              w.x = pk2(s0[8], s0[9]); w.y = pk2(s0[10], s0[11]); w.z = pk2(s0[12], s0[13]); w.w = pk2(s0[14], s0[15]); pf[1] = __builtin_bit_cast(bf16x8, w);
              w.x = pk2(s1[0], s1[1]); w.y = pk2(s1[2], s1[3]); w.z = pk2(s1[4], s1[5]); w.w = pk2(s1[6], s1[7]); pf[2] = __builtin_bit_cast(bf16x8, w);
              w.x = pk2(s1[8], s1[9]); w.y = pk2(s1[10], s1[11]); w.z = pk2(s1[12], s1[13]); w.w = pk2(s1[14], s1[15]); pf[3] = __builtin_bit_cast(bf16x8, w); }
#pragma unroll
            for (int blk = 0; blk < 4; ++blk)
#pragma unroll
                for (int s = 0; s < 4; ++s) {
                    const LAS unsigned char* vp = Vb + (32 * blk + r32) * AT_VROW + (16 * s + 4 * hi) * 2;
                    const u32x2 lo = *(const LAS u32x2*)vp, hh = *(const LAS u32x2*)(vp + 16);
                    const u32x4 w = (u32x4){lo.x, lo.y, hh.x, hh.y};
                    o[blk] = __builtin_amdgcn_mfma_f32_32x32x16_bf16(__builtin_bit_cast(bf16x8, w), pf[s], o[blk], 0, 0, 0);
                }
        }
        if (t + 1 < NT) AT_STORE((t + 1) & 1);
        __syncthreads();
    }
#undef AT_LOAD
#undef AT_STORE
    lrun += __shfl_xor(lrun, 32);
    const float inv = 1.f / lrun;
    LAS float* EX = (LAS float*)lds;
    if (j == 1) {
        const float sc = inv * lam;
#pragma unroll
        for (int blk = 0; blk < 4; ++blk)
#pragma unroll
            for (int r = 0; r < 16; ++r) EX[(wq * 64 + blk * 16 + r) * 64 + lane] = o[blk][r] * sc;
    }
    __syncthreads();
    if (j == 0) {
        float sq = 0.f;
#pragma unroll
        for (int blk = 0; blk < 4; ++blk)
#pragma unroll
            for (int r = 0; r < 16; ++r) { const float d = o[blk][r] * inv - EX[(wq * 64 + blk * 16 + r) * 64 + lane]; o[blk][r] = d; sq += d * d; }
        sq += __shfl_xor(sq, 32);
        const float rr = rsqrtf(sq * (1.f / 128.f) + EPS) * out_scale;
#pragma unroll
        for (int blk = 0; blk < 4; ++blk)
#pragma unroll
            for (int rq = 0; rq < 4; ++rq) {
                const int dv0 = 32 * blk + 8 * rq + 4 * hi;
                const f32x4 g = *(const f32x4*)(subln + dv0);
                u32x2 w; w.x = pk2(o[blk][4 * rq + 0] * rr * g[0], o[blk][4 * rq + 1] * rr * g[1]); w.y = pk2(o[blk][4 * rq + 2] * rr * g[2], o[blk][4 * rq + 3] * rr * g[3]);
                if (do_store) *(u32x2*)(OA + tok * 1024 + h * 128 + dv0) = w;
            }
    }
    __syncthreads();
}

__device__ __forceinline__ void dn_naive(LAS unsigned char* lds, unsigned char* ws, const float* convw  , int b, int h, int tid) {
    const int lane = tid & 63, wid = tid >> 6, dv = tid & 127, g4 = tid >> 7;
    LAS float* Y = (LAS float*)lds;
    LAS float* NR = Y + 384;
    LAS float* PT = NR + 8;
    LAS float* OP = PT + 512;
    float S[32];
#pragma unroll
    for (int i = 0; i < 32; ++i) S[i] = 0.f;
    bf16_t* QB = (bf16_t*)(ws + WS_QB); const bf16_t* KB = (const bf16_t*)(ws + WS_KB); const bf16_t* VB = (const bf16_t*)(ws + WS_VB);
    const float* GBp = (const float*)(ws + WS_GB);
    const int arr = tid >> 7;
    const bf16_t* src = (arr == 0 ? (const bf16_t*)QB : arr == 1 ? KB : VB) + h * 128 + dv;
    float w0 = 0.f, w1 = 0.f, w2 = 0.f, w3 = 0.f, x1 = 0.f, x2 = 0.f, x3 = 0.f;
    if (tid < 384) { const int ch = arr * 1024 + h * 128 + dv; w0 = convw[ch]; w1 = convw[3072 + ch]; w2 = convw[2 * 3072 + ch]; w3 = convw[3 * 3072 + ch]; }
    for (int t = 0; t < SEQ; ++t) {
        const size_t tok = (size_t)b * SEQ + t;
        if (tid < 384) {
            const float x0 = bf2f(src[tok * 1024]);
            float y = w0 * x3 + w1 * x2 + w2 * x1 + w3 * x0;
            y = siluf_(y); x3 = x2; x2 = x1; x1 = x0;
            Y[arr * 128 + dv] = y;
            const float sq = wave_sum(y * y);
            if (lane == 0) NR[wid] = sq;
        }
        __syncthreads();
        const float qn = rsqrtf(NR[0] + NR[1] + EPS) * 0.08838834764831845f, kn = rsqrtf(NR[2] + NR[3] + EPS);
        const float bt = GBp[tok * 16 + h], gt = GBp[tok * 16 + 8 + h], eg = __expf(gt);
        const float vv = Y[256 + dv];
        float ks = 0.f;
#pragma unroll
        for (int i = 0; i < 32; ++i) ks += Y[128 + 32 * g4 + i] * S[i];
        PT[g4 * 128 + dv] = ks * kn;
        __syncthreads();
        const float kS = (PT[dv] + PT[128 + dv]) + (PT[256 + dv] + PT[384 + dv]);
        const float c = bt * (vv - eg * kS);
        float op = 0.f;
#pragma unroll
        for (int i = 0; i < 32; ++i) { const float kk = Y[128 + 32 * g4 + i] * kn; S[i] = eg * S[i] + kk * c; op += Y[32 * g4 + i] * S[i]; }
        OP[g4 * 128 + dv] = op * qn;
        __syncthreads();
        if (g4 == 0) { const float ov = (OP[dv] + OP[128 + dv]) + (OP[256 + dv] + OP[384 + dv]); QB[tok * 1024 + h * 128 + dv] = f2bf(ov); }
    }
    __syncthreads();
}

__device__ __forceinline__ float row16_sum(float v) {
    v += __builtin_bit_cast(float, __builtin_amdgcn_update_dpp(0, __builtin_bit_cast(int, v), 0x128, 0xf, 0xf, false));
    v += __builtin_bit_cast(float, __builtin_amdgcn_update_dpp(0, __builtin_bit_cast(int, v), 0x124, 0xf, 0xf, false));
    v += __builtin_bit_cast(float, __builtin_amdgcn_update_dpp(0, __builtin_bit_cast(int, v), 0x122, 0xf, 0xf, false));
    v += __builtin_bit_cast(float, __builtin_amdgcn_update_dpp(0, __builtin_bit_cast(int, v), 0x121, 0xf, 0xf, false));
    return v;
}
__device__ __forceinline__ void dn_fast(LAS unsigned char* lds, unsigned char* ws, const float* convw  , int b, int h, int dvq, int tid) {
    const int lane = tid & 63, wid = tid >> 6, dvl = lane >> 4, grp = lane & 15;
    const int dvloc = 4 * wid + dvl, dv = 32 * dvq + dvloc;
    LAS float* Y = (LAS float*)lds;
    LAS float* NR = Y + 16 * 288;
    LAS float* GBs = NR + 16 * 16;
    LAS float* SC = GBs + 32;
    float S[8];
#pragma unroll
    for (int i = 0; i < 8; ++i) S[i] = 0.f;
    bf16_t* VB = (bf16_t*)(ws + WS_VB);
    const float* GBp = (const float*)(ws + WS_GB);
    const int arr = tid < 128 ? 0 : (tid < 256 ? 1 : 2);
    const int dch = arr == 2 ? 32 * dvq + ((tid - 256) & 31) : (tid & 127);
    const bf16_t* src = (const bf16_t*)(ws + (arr == 0 ? WS_QB : arr == 1 ? WS_KB : WS_VB)) + h * 128 + dch;
    float w0 = 0.f, w1 = 0.f, w2 = 0.f, w3 = 0.f, x1 = 0.f, x2 = 0.f, x3 = 0.f;
    if (tid < 288) { const int ch = arr * 1024 + h * 128 + dch; w0 = convw[ch]; w1 = convw[3072 + ch]; w2 = convw[2 * 3072 + ch]; w3 = convw[3 * 3072 + ch]; }
    for (int t0 = 0; t0 < SEQ; t0 += 16) {
        const size_t tokb = (size_t)b * SEQ + t0;
        if (tid < 288) {
            bf16_t xr[16];
#pragma unroll
            for (int tt = 0; tt < 16; ++tt) xr[tt] = src[(tokb + tt) * 1024];
#pragma unroll
            for (int tt = 0; tt < 16; ++tt) {
                const float x0 = bf2f(xr[tt]);
                float y = w0 * x3 + w1 * x2 + w2 * x1 + w3 * x0;
                y = siluf_(y); x3 = x2; x2 = x1; x1 = x0;
                Y[tt * 288 + tid] = y;
                if (tid < 256) { const float sq = row16_sum(y * y); if ((lane & 15) == 0) NR[tt * 16 + wid * 4 + (lane >> 4)] = sq; }
            }
        }
        if (tid >= 480) { const int i = tid - 480, tt = i >> 1, which = i & 1; GBs[tt * 2 + which] = GBp[(tokb + tt) * 16 + which * 8 + h]; }
        __syncthreads();
        if (tid < 16) {
            const f32x4 a = *(const LAS f32x4*)(NR + tid * 16), b2 = *(const LAS f32x4*)(NR + tid * 16 + 4), c2 = *(const LAS f32x4*)(NR + tid * 16 + 8), d2 = *(const LAS f32x4*)(NR + tid * 16 + 12);
            const float sq_q = ((a[0] + a[1]) + (a[2] + a[3])) + ((b2[0] + b2[1]) + (b2[2] + b2[3])), sq_k = ((c2[0] + c2[1]) + (c2[2] + c2[3])) + ((d2[0] + d2[1]) + (d2[2] + d2[3]));
            *(LAS f32x4*)(SC + tid * 4) = (f32x4){rsqrtf(sq_q + EPS) * 0.08838834764831845f, rsqrtf(sq_k + EPS), __expf(GBs[tid * 2 + 1]), GBs[tid * 2]};
        }
        __syncthreads();
#pragma unroll 4
        for (int tt = 0; tt < 16; ++tt) {
            const f32x4 sc = *(const LAS f32x4*)(SC + tt * 4);
            const float qn = sc[0], kn = sc[1], eg = sc[2], bt = sc[3];
            const f32x4 ka = *(const LAS f32x4*)(Y + tt * 288 + 128 + 8 * grp), kb = *(const LAS f32x4*)(Y + tt * 288 + 128 + 8 * grp + 4);
            const f32x4 qa = *(const LAS f32x4*)(Y + tt * 288 + 8 * grp), qb = *(const LAS f32x4*)(Y + tt * 288 + 8 * grp + 4);
            const float vv = Y[tt * 288 + 256 + dvloc];
            float ks = (ka[0] * S[0] + ka[1] * S[1]) + (ka[2] * S[2] + ka[3] * S[3]) + (kb[0] * S[4] + kb[1] * S[5]) + (kb[2] * S[6] + kb[3] * S[7]);
            ks = row16_sum(ks);
            const float c = bt * (vv - eg * ks * kn) * kn;
            float op = 0.f;
#pragma unroll
            for (int i = 0; i < 4; ++i) { S[i] = eg * S[i] + ka[i] * c; op += qa[i] * S[i]; S[4 + i] = eg * S[4 + i] + kb[i] * c; op += qb[i] * S[4 + i]; }
            op = row16_sum(op);
            if (grp == 0) VB[(tokb + tt) * 1024 + h * 128 + dv] = f2bf(op * qn);
        }
        __syncthreads();
    }
}

__device__ __forceinline__ float row8_sum(float v) {
    v += __builtin_bit_cast(float, __builtin_amdgcn_update_dpp(0, __builtin_bit_cast(int, v), 0x141, 0xf, 0xf, false));
    v += __builtin_bit_cast(float, __builtin_amdgcn_update_dpp(0, __builtin_bit_cast(int, v), 0x1B, 0xf, 0xf, false));
    v += __builtin_bit_cast(float, __builtin_amdgcn_update_dpp(0, __builtin_bit_cast(int, v), 0xB1, 0xf, 0xf, false));
    return v;
}
constexpr int DN2_YB = 16 * 288 + 16 * 16 + 32 + 64;
__device__ __forceinline__ void dn_pc(LAS unsigned char* lds, unsigned char* ws, const float* convw  , int b, int h, int dvq, int tid, bool do_store = true) {
    const int lane = tid & 63, wid = tid >> 6;
    const bool producer = tid >= 256;
    const int pt = tid - 256;
    LAS float* L = (LAS float*)lds;
    bf16_t* VB = (bf16_t*)(ws + WS_VB);
    const float* GBp = (const float*)(ws + WS_GB);
    const int parr = pt < 128 ? 0 : 1, pd = pt & 127;
    const bf16_t* src = (const bf16_t*)(ws + (parr == 0 ? WS_QB : WS_KB)) + h * 128 + pd;
    const bf16_t* srcv = (const bf16_t*)(ws + WS_VB) + h * 128 + 32 * dvq + (pt & 31);
    float w0 = 0.f, w1 = 0.f, w2 = 0.f, w3 = 0.f, x1 = 0.f, x2 = 0.f, x3 = 0.f, u0 = 0.f, u1 = 0.f, u2 = 0.f, u3 = 0.f, z1 = 0.f, z2 = 0.f, z3 = 0.f;
    if (producer) { const int ch = parr * 1024 + h * 128 + pd; w0 = convw[ch]; w1 = convw[3072 + ch]; w2 = convw[2 * 3072 + ch]; w3 = convw[3 * 3072 + ch];
        if (pt < 32) { const int cv = 2048 + h * 128 + 32 * dvq + pt; u0 = convw[cv]; u1 = convw[3072 + cv]; u2 = convw[2 * 3072 + cv]; u3 = convw[3 * 3072 + cv]; } }
    const int col = tid >> 3, grp = tid & 7;
    float S[16];
#pragma unroll
    for (int i = 0; i < 16; ++i) S[i] = 0.f;
#define DN2_PRODUCE(BUF, T0) do { LAS float* Yp = L + (BUF) * DN2_YB; LAS float* NRp = Yp + 16 * 288; LAS float* GBsp = NRp + 256; const size_t tb_ = (size_t)b * SEQ + (T0); \
        bf16_t xr[16]; bf16_t vr[16]; \
        _Pragma("unroll") for (int tt = 0; tt < 16; ++tt) xr[tt] = src[(tb_ + tt) * 1024]; \
        if (pt < 32) { _Pragma("unroll") for (int tt = 0; tt < 16; ++tt) vr[tt] = srcv[(tb_ + tt) * 1024]; } \
        if (pt >= 224) { const int i_ = pt - 224, tt_ = i_ >> 1, wh_ = i_ & 1; GBsp[tt_ * 2 + wh_] = GBp[(tb_ + tt_) * 16 + wh_ * 8 + h]; } \
        _Pragma("unroll") for (int tt = 0; tt < 16; ++tt) { const float x0 = bf2f(xr[tt]); float y = w0 * x3 + w1 * x2 + w2 * x1 + w3 * x0; y = siluf_(y); x3 = x2; x2 = x1; x1 = x0; \
            Yp[tt * 288 + pt] = y; const float sq = row16_sum(y * y); if ((lane & 15) == 0) NRp[tt * 16 + (wid - 4) * 4 + (lane >> 4)] = sq; } \
        if (pt < 32) { _Pragma("unroll") for (int tt = 0; tt < 16; ++tt) { const float x0 = bf2f(vr[tt]); float y = u0 * z3 + u1 * z2 + u2 * z1 + u3 * x0; y = siluf_(y); z3 = z2; z2 = z1; z1 = x0; Yp[tt * 288 + 256 + pt] = y; } } \
    } while (0)
    if (producer) DN2_PRODUCE(0, 0);
    for (int n = 0; n < SEQ / 16; ++n) {
        const int buf = n & 1;
        LAS float* Y = L + buf * DN2_YB; LAS float* NR = Y + 16 * 288; LAS float* GBs = NR + 256; LAS float* SC = GBs + 32;
        __syncthreads();
        if (tid < 16) {
            const f32x4 a = *(const LAS f32x4*)(NR + tid * 16), b2 = *(const LAS f32x4*)(NR + tid * 16 + 4), c2 = *(const LAS f32x4*)(NR + tid * 16 + 8), d2 = *(const LAS f32x4*)(NR + tid * 16 + 12);
            const float sq_q = ((a[0] + a[1]) + (a[2] + a[3])) + ((b2[0] + b2[1]) + (b2[2] + b2[3])), sq_k = ((c2[0] + c2[1]) + (c2[2] + c2[3])) + ((d2[0] + d2[1]) + (d2[2] + d2[3]));
            *(LAS f32x4*)(SC + tid * 4) = (f32x4){rsqrtf(sq_q + EPS) * 0.08838834764831845f, rsqrtf(sq_k + EPS), __expf(GBs[tid * 2 + 1]), GBs[tid * 2]};
        }
        __syncthreads();
        if (producer) { if (n + 1 < SEQ / 16) DN2_PRODUCE(buf ^ 1, 16 * (n + 1)); }
        else {
            const size_t tokb = (size_t)b * SEQ + 16 * n;
#pragma unroll 8
            for (int tt = 0; tt < 16; ++tt) {
                const f32x4 sc = *(const LAS f32x4*)(SC + tt * 4);
                const float qn = sc[0], kn = sc[1], eg = sc[2], bt = sc[3];
                const LAS f32x4* kp = (const LAS f32x4*)(Y + tt * 288 + 128 + 16 * grp); const LAS f32x4* qp = (const LAS f32x4*)(Y + tt * 288 + 16 * grp);
                const f32x4 k0 = kp[0], k1 = kp[1], k2 = kp[2], k3 = kp[3], q0 = qp[0], q1 = qp[1], q2 = qp[2], q3 = qp[3];
                const float vv = Y[tt * 288 + 256 + col];
                float ks = ((k0[0] * S[0] + k0[1] * S[1]) + (k0[2] * S[2] + k0[3] * S[3])) + ((k1[0] * S[4] + k1[1] * S[5]) + (k1[2] * S[6] + k1[3] * S[7]))
                         + ((k2[0] * S[8] + k2[1] * S[9]) + (k2[2] * S[10] + k2[3] * S[11])) + ((k3[0] * S[12] + k3[1] * S[13]) + (k3[2] * S[14] + k3[3] * S[15]));
                ks = row8_sum(ks);
                const float c = bt * (vv - eg * ks * kn) * kn;
                float op0 = 0.f, op1 = 0.f;
#pragma unroll
                for (int i = 0; i < 4; ++i) { S[i] = eg * S[i] + k0[i] * c; op0 += q0[i] * S[i]; S[4 + i] = eg * S[4 + i] + k1[i] * c; op1 += q1[i] * S[4 + i];
                                              S[8 + i] = eg * S[8 + i] + k2[i] * c; op0 += q2[i] * S[8 + i]; S[12 + i] = eg * S[12 + i] + k3[i] * c; op1 += q3[i] * S[12 + i]; }
                const float op = row8_sum(op0 + op1);
                if (grp == 0 && do_store) VB[(tokb + tt) * 1024 + h * 128 + 32 * dvq + col] = f2bf(op * qn);
                if (!do_store) asm volatile("" :: "v"(op));
            }
        }
    }
    __syncthreads();
#undef DN2_PRODUCE
}

#define GEMM_PHASE(EPI, Aptr, Bptr, Mv, Nv, Kv, Eobj, HM) do { int m_ = (Mv), n_ = (Nv), k_ = (Kv); asm volatile("" : "+s"(m_), "+s"(n_), "+s"(k_)); pg8::Gemm g_{(const pg8::bf16_t*)(Aptr), (const pg8::bf16_t*)(Bptr), m_, n_, k_, (HM)}; pg8::StaticOrder S_; S_.init(m_, n_, G, bid); \
        pg8::gemm_phase<EPI, pg8::StaticOrder, true, true>(lds, g_, S_, (Eobj)); } while (0)

__global__ void __launch_bounds__(NTHR, 2) fwd_mega(Params P) {
    extern __shared__ __attribute__((aligned(16))) unsigned char lds_raw[];
    LAS unsigned char* lds = (LAS unsigned char*)lds_raw;
    cg::grid_group grid = cg::this_grid();
    if (threadIdx.x == 0) {
        const unsigned xcc = (unsigned)__builtin_amdgcn_s_getreg((3 << 11) | 20) & 7u;
        const unsigned loc = __hip_atomic_fetch_add((unsigned*)(P.ws + WS_CTL) + xcc, 1u, __ATOMIC_RELAXED, __HIP_MEMORY_SCOPE_AGENT);
        *(LAS int*)(lds + LDS_VB) = (int)((loc & 31u) * 8u + xcc);
    }
    __syncthreads();
    int seg = 0; const int seg_lo = P.seg_lo, seg_hi = P.seg_hi;
#ifdef L2FLUSH
#define L2_FLUSH() do { const Params* PF = (const Params*)__builtin_amdgcn_kernarg_segment_ptr(); asm volatile("" : "+s"(PF)); int tf_ = threadIdx.x; asm volatile("" : "+v"(tf_)); \
        const u32x4* jp = (const u32x4*)(PF->in[I_P]) + (size_t)blockIdx.x * (L2FLUSH * 64) + tf_; unsigned acc_ = 0u; \
        for (int q_ = 0; q_ < L2FLUSH * 64 / 512; ++q_) { const u32x4 v_ = __builtin_nontemporal_load(jp + (size_t)q_ * 512); acc_ |= v_.x & v_.y & v_.z & v_.w; asm volatile("" ::: "memory"); } \
        if (acc_ == 0x12345678u) PF->out[0] = 0.f; } while (0)
#else
#define L2_FLUSH() do {} while (0)
#endif
#ifdef NOSEG
#define SYNCCOND true
#else
#define SYNCCOND (seg >= seg_lo && seg + 1 < seg_hi)
#endif
#define GRID_SYNC() do { if (SYNCCOND) { asm volatile("s_waitcnt vmcnt(0) lgkmcnt(0)" ::: "memory");   grid.sync(); L2_FLUSH(); \
        if (threadIdx.x < 64) { __builtin_amdgcn_fence(__ATOMIC_ACQUIRE, "agent"); asm volatile("s_waitcnt vmcnt(0)" ::: "memory"); } __syncthreads();     \
        } ++seg; } while (0)
#ifdef NOSEG
#define SEGCOND true
#else
#define SEGCOND (seg >= seg_lo && seg < seg_hi)
#endif
#define PH_BEGIN if (SEGCOND) { const Params* PQ = (const Params*)__builtin_amdgcn_kernarg_segment_ptr(); asm volatile("" : "+s"(PQ)); int tid = threadIdx.x; asm volatile("" : "+v"(tid)); \
    const int lane = tid & 63, wave = __builtin_amdgcn_readfirstlane(tid >> 6); int bid = __builtin_amdgcn_readfirstlane(*(LAS int*)(lds + LDS_VB)), G = gridDim.x; asm volatile("" : "+s"(bid), "+s"(G)); \
    const int xb_ = bid & 7, jb_ = bid >> 3, wj = jb_ * NW + wave;     \
    unsigned char* ws = PQ->ws; float* X = PQ->out; float* SS = (float*)(ws + WS_SS); bf16_t* XB = (bf16_t*)(ws + WS_XB); \
    float* ss_attn = (float*)(ws + WS_HALO); float* ss_ffn = ss_attn + (size_t)MTOK * 16; float* ss_ple = ss_ffn + (size_t)MTOK * 16; float* ss_next = ss_attn; \
    (void)lane; (void)xb_; (void)jb_; (void)wj; (void)X; (void)XB; (void)ss_attn; (void)ss_ffn; (void)ss_ple; (void)ss_next; (void)G;
#define PH_END }
#define U ((bf16_t*)(ws + WS_MIX))
#define ACT ((bf16_t*)(ws + WS_MIX + 176 * MiB))

    { const int layer = 0; PH_BEGIN
      if (bid == 0 && tid == 0) __hip_atomic_store((unsigned*)(ws + WS_CTL) + 16, 0u, __ATOMIC_RELAXED, __HIP_MEMORY_SCOPE_AGENT);
      const float* xin = PQ->in[I_X];
      for (int r = wj; r < SEQ; r += 256) {
          const int m = xb_ * SEQ + r;
          const f32x4* xr = (const f32x4*)(xin + (size_t)m * 1024) + lane;
          f32x4 v[4]; float s = 0.f;
#pragma unroll
          for (int jj = 0; jj < 4; ++jj) { v[jj] = xr[64 * jj]; s += (v[jj][0] * v[jj][0] + v[jj][1] * v[jj][1]) + (v[jj][2] * v[jj][2] + v[jj][3] * v[jj][3]); }
          s = wave_sum(s);
          if (lane < 16) ss_attn[(size_t)m * 16 + lane] = lane == 0 ? s : 0.f;
          f32x4* xo = (f32x4*)(X + (size_t)m * 1024) + lane;
          u32x2* bo = (u32x2*)(XB + (size_t)m * 1024) + lane;
#pragma unroll
          for (int jj = 0; jj < 4; ++jj) { xo[64 * jj] = v[jj]; u32x2 w; w.x = pk2(v[jj][0], v[jj][1]); w.y = pk2(v[jj][2], v[jj][3]); bo[64 * jj] = w; }
      }
    PH_END }

    for (int layer = 0; layer < NLAYER; ++layer) {
        asm volatile("" ::: "memory");
        const float lam_init = 0.8f - 0.6f * __expf(-0.3f * (float)layer);
        PH_BEGIN
        convert_weights(PQ, layer, lds, bid * NW + wave, G * NW, wave, lane);
        { const float* pl = PQ->in[I_P] + ((size_t)layer * MTOK + (size_t)xb_ * SEQ) * DPLE;
          bf16_t* pb = (bf16_t*)(ws + WS_PB) + (size_t)xb_ * SEQ * DPLE;
          for (int i = jb_ * NTHR + tid; i < SEQ * DPLE / 8; i += 32 * NTHR) {
              const f32x4 a = *(const f32x4*)(pl + (size_t)i * 8), b = *(const f32x4*)(pl + (size_t)i * 8 + 4);
              u32x4 w; w.x = pk2(a[0], a[1]); w.y = pk2(a[2], a[3]); w.z = pk2(b[0], b[1]); w.w = pk2(b[2], b[3]);
              *(u32x4*)(pb + (size_t)i * 8) = w;
          }
        }
        PH_END
        GRID_SYNC();
#ifdef DBLTEST
#ifdef DBL_SC
#define DBL_LD(p) ldc16(p)
#else
#define DBL_LD(p) (*(p))
#endif
        if (layer == 0) {
#ifdef DBL_OUTP
        PH_BEGIN
        { EpiResid E{X, XB, ss_ffn, nullptr, -1};
          GEMM_PHASE(EpiResid, ws + WS_VT, ws + W_OUT, MTOK, 1024, 1024, E, -1); }
        PH_END
        GRID_SYNC();
#endif
        for (int rep = 0; rep < 2; ++rep) {
        PH_BEGIN
#ifdef DBL_COPY
            { const u32x4* s4 = (const u32x4*)XB; u32x4* d4 = (u32x4*)(ws + WS_MIX + (size_t)rep * 176 * MiB);
              const size_t per = (size_t)DBL_M * DBL_N * 2 / 16 / 8;
              for (size_t i = (size_t)((jb_ + rep * 13) & 31) * NTHR + tid; i < per; i += (size_t)32 * NTHR) d4[(size_t)xb_ * per + i] = DBL_LD(s4 + (size_t)xb_ * per + i); }
#else
#ifndef DBL_W
#define DBL_W W_UP
#define DBL_ACT 0
#endif
            { EpiRowScale<DBL_ACT> E{(bf16_t*)(ws + WS_MIX + (size_t)rep * DBL_OFF * MiB), DBL_N, ss_attn, DBL_H};
              GEMM_PHASE(EpiRowScale<DBL_ACT>, XB, ws + DBL_W, DBL_M, DBL_N, 1024, E, DBL_H); }
#endif
        PH_END
        GRID_SYNC();
        }
        PH_BEGIN
        { const u32x4* a4 = (const u32x4*)(ws + WS_MIX); const u32x4* b4 = (const u32x4*)(ws + WS_MIX + (size_t)DBL_OFF * MiB); unsigned bad = 0u;
          const size_t per = (size_t)DBL_M * DBL_N * 2 / 16 / 8;
          for (size_t i0 = (size_t)((jb_ + 7) & 31) * NTHR + tid; i0 < per; i0 += (size_t)32 * NTHR) { const size_t i = (size_t)xb_ * per + i0; const u32x4 a = DBL_LD(a4 + i), b = DBL_LD(b4 + i); bad |= ((a.x ^ b.x) | (a.y ^ b.y) | (a.z ^ b.z) | (a.w ^ b.w)) ? 1u : 0u; }
          if (bad) __hip_atomic_fetch_or((unsigned*)(ws + WS_CTL) + 16, 1u, __ATOMIC_RELAXED, __HIP_MEMORY_SCOPE_AGENT); }
        PH_END
        GRID_SYNC();
        }
#endif
#if defined(DBLMIX) && !defined(DBLMIX_AT_GATES)
        for (int rep = 0; rep < 2; ++rep) {
#endif
#ifndef NO_INPROJ
        PH_BEGIN
        { EpiQK E{ws, ss_attn, PQ->in[I_QNORM] + layer * 64, PQ->in[I_KNORM] + layer * 64};
          GEMM_PHASE(EpiQK, XB, ws + W_IN, MTOK, 2048, 1024, E, -1); }
        PH_END
        PH_BEGIN
        { EpiSeg E{ws, ss_attn};
          GEMM_PHASE(EpiSeg, XB, ws + W_IN + (size_t)2048 * 2048, MTOK, 4096, 1024, E, -1); }
        PH_END
#ifdef SEG_PROBE
        PH_BEGIN
        { EpiSeg E{ws, ss_attn};
          GEMM_PHASE(EpiSeg, XB, ws + W_IN + (size_t)2048 * 2048, MTOK, 4096, 1024, E, -1); }
        PH_END
#endif
        PH_BEGIN
        { EpiGB E{ws, ss_attn, PQ->in[I_ALOG] + layer * 8, PQ->in[I_DTB] + layer * 8};
          GEMM_PHASE(EpiGB, XB, ws + W_IN + (size_t)6144 * 2048, MTOK, 256, 1024, E, -1); }
        PH_END
        PH_BEGIN
        { EpiVt E{(bf16_t*)(ws + WS_VT), ss_attn};
          GEMM_PHASE(EpiVt, ws + W_V, XB, 1024, MTOK, 1024, E, -1); }
        PH_END
#endif
        GRID_SYNC();
#ifndef NO_ATTN
        PH_BEGIN
        { const float* lq = PQ->in[I_LAM] + layer * 256;
          const float a1 = wave_sum(lq[lane] * lq[64 + lane]), a2 = wave_sum(lq[128 + lane] * lq[192 + lane]);
          const float lam = __expf(a1) - __expf(a2) + lam_init;
#ifdef ATTN_PROBE
          for (int k = 0; k < 4; ++k) {
              const int pi = jb_ + 32 * k, hh = pi >> 4, s = pi & 15;
              attn_unit(lds, (const bf16_t*)(ws + WS_QA), (const bf16_t*)(ws + WS_KA), (const bf16_t*)(ws + WS_VT), (bf16_t*)(ws + WS_QA), xb_, hh, 31 - s, lam, 1.f - lam_init, PQ->in[I_SUBLN] + layer * 128, PQ->in[I_RELB], tid, false);
              attn_unit(lds, (const bf16_t*)(ws + WS_QA), (const bf16_t*)(ws + WS_KA), (const bf16_t*)(ws + WS_VT), (bf16_t*)(ws + WS_QA), xb_, hh, s, lam, 1.f - lam_init, PQ->in[I_SUBLN] + layer * 128, PQ->in[I_RELB], tid, false);
          }
          __syncthreads();
#endif
          for (int k = 0; k < 4; ++k) {
              const int pi = jb_ + 32 * k, hh = pi >> 4, s = pi & 15;
              attn_unit(lds, (const bf16_t*)(ws + WS_QA), (const bf16_t*)(ws + WS_KA), (const bf16_t*)(ws + WS_VT), (bf16_t*)(ws + WS_QA), xb_, hh, 31 - s, lam, 1.f - lam_init, PQ->in[I_SUBLN] + layer * 128, PQ->in[I_RELB], tid);
              attn_unit(lds, (const bf16_t*)(ws + WS_QA), (const bf16_t*)(ws + WS_KA), (const bf16_t*)(ws + WS_VT), (bf16_t*)(ws + WS_QA), xb_, hh, s, lam, 1.f - lam_init, PQ->in[I_SUBLN] + layer * 128, PQ->in[I_RELB], tid);
          }
        }
        PH_END
#endif
#ifndef NO_DN
        PH_BEGIN
#ifdef DN_NAIVE
        if (jb_ < 8) dn_naive(lds, ws, PQ->in[I_CONVB] + (size_t)layer * 4 * 3072, xb_, jb_, tid);
#else
#ifdef DN_FAST1
        dn_fast(lds, ws, PQ->in[I_CONVB] + (size_t)layer * 4 * 3072, xb_, jb_ >> 2, jb_ & 3, tid);
#else
#ifdef DN_PROBE
        dn_pc(lds, ws, PQ->in[I_CONVB] + (size_t)layer * 4 * 3072, xb_, jb_ >> 2, jb_ & 3, tid, false);
#endif
        dn_pc(lds, ws, PQ->in[I_CONVB] + (size_t)layer * 4 * 3072, xb_, jb_ >> 2, jb_ & 3, tid);
#endif
#endif
        PH_END
#endif
        GRID_SYNC();
#if defined(DBLMIX) && defined(DBLMIX_AT_GATES)
        for (int rep = 0; rep < 2; ++rep) {
#endif
#ifndef NO_GATES
        PH_BEGIN
        { EpiRowScale<1> E{(bf16_t*)(ws + WS_G), 2048, ss_attn, -1};
          GEMM_PHASE(EpiRowScale<1>, XB, ws + W_GL, MTOK, 2048, 1024, E, -1); }
        PH_END
#endif
#ifndef NO_OBNORM
        PH_BEGIN
        { const float* on = PQ->in[I_ONORM] + layer * 128;
          const float g0 = on[2 * lane], g1 = on[2 * lane + 1];
          unsigned* OB = (unsigned*)(ws + WS_QB) + (size_t)xb_ * SEQ * 512; const unsigned* OI = (const unsigned*)(ws + WS_OSRC) + (size_t)xb_ * SEQ * 512; const unsigned* ZB = (const unsigned*)(ws + WS_ZB) + (size_t)xb_ * SEQ * 512;
          for (int r = wj; r < SEQ * NH; r += 256) {
              const unsigned ov = OI[(size_t)r * 64 + lane], zv = ZB[(size_t)r * 64 + lane];
              const float o0 = bflo(ov), o1 = bfhi(ov);
              const float sq = wave_sum(o0 * o0 + o1 * o1);
              const float rr = rsqrtf(sq * (1.f / 128.f) + EPS);
              OB[(size_t)r * 64 + lane] = pk2(o0 * rr * g0 * siluf_(bflo(zv)), o1 * rr * g1 * siluf_(bfhi(zv)));
          }
        }
        PH_END
#endif
        GRID_SYNC();
#ifndef NO_TMPA
        PH_BEGIN
        { EpiGateMul E{(bf16_t*)(ws + WS_TMPA), (const bf16_t*)(ws + WS_G), 2048, 0, nullptr};
          GEMM_PHASE(EpiGateMul, ws + WS_QA, ws + W_BRA, MTOK, 1024, 1024, E, -1); }
        PH_END
#endif
        GRID_SYNC();
#ifndef NO_MIXED
        PH_BEGIN
        { EpiGateMul E{(bf16_t*)(ws + WS_MIXED), (const bf16_t*)(ws + WS_G), 2048, 1024, (const bf16_t*)(ws + WS_TMPA)};
          GEMM_PHASE(EpiGateMul, ws + WS_QB, ws + W_BRB, MTOK, 1024, 1024, E, -1); }
        PH_END
#endif
        GRID_SYNC();
#ifdef DBLMIX
        PH_BEGIN
        { const u32x4* t4 = (const u32x4*)(ws + (size_t)DBL_TGT + (size_t)xb_ * ((size_t)DBL_TGT_BYTES / 8)); u32x4* s4 = (u32x4*)(ws + WS_PB + (size_t)xb_ * 2 * MiB); unsigned bad = 0u;
          for (size_t i = (size_t)((jb_ + 5 * rep) & 31) * NTHR + tid; i < (size_t)2 * MiB / 16; i += (size_t)32 * NTHR) {
              const u32x4 a = t4[i];
              if (rep == 0) s4[i] = a; else { const u32x4 b = s4[i]; bad |= ((a.x ^ b.x) | (a.y ^ b.y) | (a.z ^ b.z) | (a.w ^ b.w)) ? 1u : 0u; } }
          if (bad) __hip_atomic_fetch_or((unsigned*)(ws + WS_CTL) + 16, 1u, __ATOMIC_RELAXED, __HIP_MEMORY_SCOPE_AGENT); }
        PH_END
        GRID_SYNC();
        }
#endif
#ifndef NO_OUTP
        PH_BEGIN
        { EpiResid E{X, XB, ss_ffn, nullptr, -1};
          GEMM_PHASE(EpiResid, ws + WS_MIXED, ws + W_OUT, MTOK, 1024, 1024, E, -1); }
        PH_END
#endif
        GRID_SYNC();
        for (int half = 0; half < 2; ++half) {
#ifndef NO_UP
        PH_BEGIN
            { EpiRowScale<0> E{U, 5632, ss_ffn, half};
              GEMM_PHASE(EpiRowScale<0>, XB, ws + W_UP, 16384, 5632, 1024, E, half); }
        PH_END
#endif
            GRID_SYNC();
#ifndef NO_ACT
        PH_BEGIN
            { const float* cw = PQ->in[I_CONVFF] + (size_t)layer * 3 * 5632; const float* cb = PQ->in[I_CONVFFB] + (size_t)layer * 5632;
              bf16_t* UH = (bf16_t*)(ws + WS_UHALO) + (size_t)xb_ * 2 * 5632;
              for (int it = jb_ * NTHR + tid; it < 128 * 352; it += 32 * NTHR) {
                  const int cc = it % 352, rg = it / 352, c0 = cc * 8;
                  const int lrow0 = xb_ * 2048 + rg * 16;
                  float wg[3][8], wv[3][8], bg[8], bv[8];
#pragma unroll
                  for (int jj = 0; jj < 3; ++jj)
#pragma unroll
                      for (int e = 0; e < 8; ++e) { wg[jj][e] = cw[jj * 5632 + c0 + e]; wv[jj][e] = cw[jj * 5632 + 2816 + c0 + e]; }
#pragma unroll
                  for (int e = 0; e < 8; ++e) { bg[e] = cb[c0 + e]; bv[e] = cb[2816 + c0 + e]; }
                  float g2[8], g1[8], v2[8], v1[8];
#pragma unroll
                  for (int e = 0; e < 8; ++e) { g2[e] = 0.f; g1[e] = 0.f; v2[e] = 0.f; v1[e] = 0.f; }
                  if (rg > 0 || half == 1) {
                      const bf16_t* r2p = rg > 0 ? U + (size_t)(lrow0 - 2) * 5632 : UH;
                      const bf16_t* r1p = rg > 0 ? U + (size_t)(lrow0 - 1) * 5632 : UH + 5632;
                      const u32x4 a = *(const u32x4*)(r2p + c0), bq = *(const u32x4*)(r1p + c0);
                      const u32x4 c = *(const u32x4*)(r2p + 2816 + c0), d = *(const u32x4*)(r1p + 2816 + c0);
                      g2[0] = bflo(a.x); g2[1] = bfhi(a.x); g2[2] = bflo(a.y); g2[3] = bfhi(a.y); g2[4] = bflo(a.z); g2[5] = bfhi(a.z); g2[6] = bflo(a.w); g2[7] = bfhi(a.w);
                      g1[0] = bflo(bq.x); g1[1] = bfhi(bq.x); g1[2] = bflo(bq.y); g1[3] = bfhi(bq.y); g1[4] = bflo(bq.z); g1[5] = bfhi(bq.z); g1[6] = bflo(bq.w); g1[7] = bfhi(bq.w);
                      v2[0] = bflo(c.x); v2[1] = bfhi(c.x); v2[2] = bflo(c.y); v2[3] = bfhi(c.y); v2[4] = bflo(c.z); v2[5] = bfhi(c.z); v2[6] = bflo(c.w); v2[7] = bfhi(c.w);
                      v1[0] = bflo(d.x); v1[1] = bfhi(d.x); v1[2] = bflo(d.y); v1[3] = bfhi(d.y); v1[4] = bflo(d.z); v1[5] = bfhi(d.z); v1[6] = bflo(d.w); v1[7] = bfhi(d.w);
                  }
                  for (int rr = 0; rr < 16; ++rr) {
                      const size_t row = (size_t)lrow0 + rr;
                      const u32x4 a = *(const u32x4*)(U + row * 5632 + c0), c = *(const u32x4*)(U + row * 5632 + 2816 + c0);
                      if (half == 0 && rg == 127 && rr >= 14) { *(u32x4*)(UH + (size_t)(rr - 14) * 5632 + c0) = a; *(u32x4*)(UH + (size_t)(rr - 14) * 5632 + 2816 + c0) = c; }
                      float g0[8], v0[8], ov[8];
                      g0[0] = bflo(a.x); g0[1] = bfhi(a.x); g0[2] = bflo(a.y); g0[3] = bfhi(a.y); g0[4] = bflo(a.z); g0[5] = bfhi(a.z); g0[6] = bflo(a.w); g0[7] = bfhi(a.w);
                      v0[0] = bflo(c.x); v0[1] = bfhi(c.x); v0[2] = bflo(c.y); v0[3] = bfhi(c.y); v0[4] = bflo(c.z); v0[5] = bfhi(c.z); v0[6] = bflo(c.w); v0[7] = bfhi(c.w);
#pragma unroll
                      for (int e = 0; e < 8; ++e) {
                          const float ug = wg[0][e] * g2[e] + wg[1][e] * g1[e] + wg[2][e] * g0[e] + bg[e];
                          const float uv = wv[0][e] * v2[e] + wv[1][e] * v1[e] + wv[2][e] * v0[e] + bv[e];
                          ov[e] = siluf_(ug) * uv; g2[e] = g1[e]; g1[e] = g0[e]; v2[e] = v1[e]; v1[e] = v0[e];
                      }
                      u32x4 w; w.x = pk2(ov[0], ov[1]); w.y = pk2(ov[2], ov[3]); w.z = pk2(ov[4], ov[5]); w.w = pk2(ov[6], ov[7]);
                      *(u32x4*)(ACT + row * 2816 + c0) = w;
                  }
              }
            }
        PH_END
#endif
            GRID_SYNC();
#ifndef NO_DOWN
        PH_BEGIN
            { EpiResid E{X, XB, ss_ple, nullptr, half};
              GEMM_PHASE(EpiResid, ACT, ws + W_DOWN, 16384, 1024, 2816, E, -1); }
        PH_END
#endif
            GRID_SYNC();
        }
#ifndef NO_PLEG
        PH_BEGIN
        { EpiRowScale<1> E{(bf16_t*)(ws + WS_MIX), 1024, ss_ple, -1};
          GEMM_PHASE(EpiRowScale<1>, XB, ws + W_PG, MTOK, 1024, 1024, E, -1); }
        PH_END
#endif
        GRID_SYNC();
#ifndef NO_PLE
        PH_BEGIN
        { EpiResid E{X, XB, ss_next, (const bf16_t*)(ws + WS_MIX), -1};
          GEMM_PHASE(EpiResid, ws + WS_PB, ws + W_PP, MTOK, 1024, 256, E, -1); }
        PH_END
#endif
        GRID_SYNC();
    }
#ifdef NANCHK
    { const int layer = 0; PH_BEGIN
      unsigned bad = 0u;
      for (size_t i = (size_t)bid * NTHR + tid; i < (size_t)MTOK * 256; i += (size_t)G * NTHR) { const f32x4 v = *(const f32x4*)(X + i * 4);
          for (int e = 0; e < 4; ++e) bad |= ((__float_as_uint(v[e]) & 0x7f800000u) == 0x7f800000u) ? 1u : 0u; }
#ifdef NANCHK_BF_LO
      { const unsigned* bp = (const unsigned*)(ws + (size_t)NANCHK_BF_LO); const size_t nw = ((size_t)NANCHK_BF_HI - (size_t)NANCHK_BF_LO) / 4;
        for (size_t i = (size_t)bid * NTHR + tid; i < nw; i += (size_t)G * NTHR) { const unsigned w = bp[i]; bad |= (((w & 0x7f80u) == 0x7f80u) || ((w & 0x7f800000u) == 0x7f800000u)) ? 1u : 0u; } }
#endif
      if (bad) __hip_atomic_fetch_or((unsigned*)(ws + WS_CTL) + 16, 1u, __ATOMIC_RELAXED, __HIP_MEMORY_SCOPE_AGENT);
      PH_END }
    GRID_SYNC();
    { const int layer = 0; PH_BEGIN
      const unsigned fl = __hip_atomic_fetch_or((unsigned*)(ws + WS_CTL) + 16, 0u, __ATOMIC_RELAXED, __HIP_MEMORY_SCOPE_AGENT);
      if (fl) for (size_t i = (size_t)bid * NTHR + tid; i < (size_t)MTOK * 256; i += (size_t)G * NTHR) *(f32x4*)(X + i * 4) = (f32x4){0.f, 0.f, 0.f, 0.f};
      PH_END }
#endif
#undef U
#undef ACT
}

extern "C" void kernel_launch(void* const* d_in, const int* in_sizes, int n_in, void* d_out, int out_size, void* d_ws, size_t ws_size, hipStream_t stream) {
    static int grid = 0;
    if (grid == 0) {
        if (n_in != 24 || out_size != MTOK * DM || ws_size < WS_TOTAL) { fprintf(stderr, "kernel_launch: unexpected shapes / workspace (n_in %d out %d ws %zu need %zu)\n", n_in, out_size, ws_size, (size_t)WS_TOTAL); grid = -1; return; }
        int dev = 0, cus = 0, per_cu = 0;
        hipGetDevice(&dev);
        hipDeviceGetAttribute(&cus, hipDeviceAttributeMultiprocessorCount, dev);
        hipFuncSetAttribute((const void*)fwd_mega, hipFuncAttributeMaxDynamicSharedMemorySize, LDS_BYTES);
        hipOccupancyMaxActiveBlocksPerMultiprocessor(&per_cu, (const void*)fwd_mega, NTHR, LDS_BYTES);
        if (per_cu < 1) { fprintf(stderr, "kernel_launch: occupancy query says %d blocks per CU\n", per_cu); per_cu = 1; }
        (void)hipGetLastError();
        grid = cus;
    }
    if (grid < 0) return;
    Params p{};
    for (int i = 0; i < 24; ++i) p.in[i] = (const float*)d_in[i];
    p.out = (float*)d_out; p.ws = (unsigned char*)d_ws;
    hipError_t e = hipSuccess;
#ifdef N_SEG_LAUNCH
    for (int sgi = 0; sgi < 60 && e == hipSuccess; sgi += N_SEG_LAUNCH) {
        p.seg_lo = sgi; p.seg_hi = sgi + N_SEG_LAUNCH;
        void* args[] = {&p};
        e = hipLaunchCooperativeKernel((const void*)fwd_mega, dim3(grid), dim3(NTHR), args, LDS_BYTES, stream);
    }
#else
    p.seg_lo = 0; p.seg_hi = 1000;
    void* args[] = {&p};
    e = hipLaunchCooperativeKernel((const void*)fwd_mega, dim3(grid), dim3(NTHR), args, LDS_BYTES, stream);
#endif
    if (e != hipSuccess) fprintf(stderr, "cooperative launch failed: %s (grid %d)\n", hipGetErrorString(e), grid);
}
```

```cpp
#include <hip/hip_runtime.h>
#include <hip/hip_cooperative_groups.h>
#include <cstdio>
#include <cstdint>
namespace cg = cooperative_groups;
namespace pg8 {
#define PG8_LAS __attribute__((address_space(3)))
typedef unsigned short bf16_t;
typedef short bf16x8 __attribute__((ext_vector_type(8)));
typedef float f32x4 __attribute__((ext_vector_type(4)));
typedef unsigned u32x4 __attribute__((ext_vector_type(4)));
constexpr int BM = 256, BK = 64, HALF = 128, HTB = HALF * BK * 2  , STAGE_BYTES = 8 * HTB, NXCD = 8, WGM = 8;

__host__ __device__ __forceinline__ int lds_byte(int r, int c) { const int st = (r >> 4) * 2 + (c >> 5), rr = r & 15, cc = c & 31, ob = rr * 64 + cc * 2; return st * 1024 + (ob ^ (((ob >> 9) & 1) << 5)); }
__host__ __device__ __forceinline__ void stage_rc(int b, int& R, int& C) { const int st = b / 1024, sb = b % 1024, swz = sb ^ (((sb >> 9) & 1) << 5); R = (st >> 1) * 16 + swz / 64; C = (st & 1) * 32 + (swz % 64) / 2; }
__host__ __device__ __forceinline__ int perm32(int rho) { const int n = rho >> 4, i = rho & 15; return 8 * (i >> 2) + 4 * n + (i & 3); }

struct Unit { int pm, pn; };
struct Gemm { const bf16_t* A; const bf16_t* Bt; int M, N, K; int hmap; };
__device__ __forceinline__ int amap(int pm, int hmap) { return hmap < 0 ? pm : ((pm >> 3) * 16 + 8 * hmap + (pm & 7)); }

struct StaticOrder {
    int nM, nN, nwg, G, c;
    __host__ __device__ void init(int M, int N, int G_, int c_) { nM = M / BM; nN = N / BM; nwg = nM * nN; G = G_; c = c_; }
    __host__ __device__ bool next(int i, Unit& u) const {
        const long L = (long)i * G + c; if (L >= nwg) return false;
        int wgid = (int)L; { const int q = nwg / NXCD, r = nwg % NXCD, xcd = wgid % NXCD, off = wgid / NXCD; wgid = (xcd < r ? xcd * (q + 1) : r * (q + 1) + (xcd - r) * q) + off; }
        const int nig = WGM * nN, gid = wgid / nig, fm = gid * WGM, gsz = (nM - fm) < WGM ? (nM - fm) : WGM;
        u.pm = fm + ((wgid % nig) % gsz); u.pn = (wgid % nig) / gsz; return true;
    }
    __device__ __forceinline__ void a_ready(const Unit&) const {}
    __device__ __forceinline__ void done(const Unit&) const {}
};
__device__ __forceinline__ unsigned cvt_pk_bf16(float lo, float hi) { unsigned r; asm volatile("v_cvt_pk_bf16_f32 %0, %1, %2" : "=v"(r) : "v"(lo), "v"(hi)); return r; }
#ifdef NO_UNI
__device__ __forceinline__ const char* uni(const char* p) { return p; }
#else
__device__ __forceinline__ const char* uni(const char* p) { const unsigned long long v = (unsigned long long)p; const unsigned lo = __builtin_amdgcn_readfirstlane((unsigned)v), hi = __builtin_amdgcn_readfirstlane((unsigned)(v >> 32)); return (const char*)(((unsigned long long)hi << 32) | lo); }
#endif
template <class Epi, class Sched, bool ALIGN_EPI = false, bool SP2 = false>
__device__ __forceinline__ void gemm_phase(PG8_LAS unsigned char* lds, const Gemm g, const Sched& S, const Epi& E) {
    int tid = threadIdx.x;
#ifndef NO_LAUNDER
    asm volatile("" : "+v"(tid));
#endif

    const int wid = __builtin_amdgcn_readfirstlane(tid >> 6), lane = tid & 63, wr = wid >> 2, wc = wid & 3, fr = lane & 15, fq = lane >> 4;
    const int K = g.K, nt = K / BK;
    unsigned voffA[2], voffB[2];
#pragma unroll
    for (int i = 0; i < 2; ++i) { int R, C; stage_rc(tid * 16 + i * 8192, R, C); const int Rb = Epi::PERM ? ((R & ~31) + perm32(R & 31)) : R;
        voffA[i] = (unsigned)(R * K + C) * 2u; voffB[i] = (unsigned)(Rb * K + C) * 2u; }
    const size_t kstep = (size_t)(BK * 2);
    const size_t hstep = (size_t)HALF * K * 2;
    const size_t tstep = 2 * hstep;
    const unsigned ldsw = (unsigned)wid * 1024u;
    const int aoff = lds_byte(wr * 64 + fr, fq * 8), boff = lds_byte(wc * 32 + fr, fq * 8);
#define PG8_SA(b, h) (((b) * 2 + (h)) * HTB)
#define PG8_SB(b, h) ((4 + (b) * 2 + (h)) * HTB)
#define PG8_STAGE(bufoff, gbase, voff) do { _Pragma("unroll") for (int _i = 0; _i < 2; ++_i) \
        __builtin_amdgcn_global_load_lds((const unsigned*)((const char*)(gbase) + (voff)[_i]), (PG8_LAS unsigned*)(lds + (bufoff) + ldsw + _i * 8192), 16, 0, 0); } while (0)
#define PG8_LDA(dst, b, h) do { _Pragma("unroll") for (int m = 0; m < 4; ++m) _Pragma("unroll") for (int k = 0; k < 2; ++k) dst[m][k] = *(const PG8_LAS bf16x8*)(lds + PG8_SA(b, h) + aoff + m * 2048 + k * 1024); } while (0)
#define PG8_LDB(dst, b, h) do { _Pragma("unroll") for (int n = 0; n < 2; ++n) _Pragma("unroll") for (int k = 0; k < 2; ++k) dst[n][k] = *(const PG8_LAS bf16x8*)(lds + PG8_SB(b, h) + boff + n * 2048 + k * 1024); } while (0)
#define PG8_MMA(ai, bj, At, Bt) do { __builtin_amdgcn_s_setprio(1); _Pragma("unroll") for (int m = 0; m < 4; ++m) _Pragma("unroll") for (int n = 0; n < 2; ++n) _Pragma("unroll") for (int k = 0; k < 2; ++k) \
        acc[ai][bj][m][n] = __builtin_amdgcn_mfma_f32_16x16x32_bf16(Bt[n][k], At[m][k], acc[ai][bj][m][n], 0, 0, 0); __builtin_amdgcn_s_setprio(0); } while (0)
#define PG8_WAIT_V(n) asm volatile("s_waitcnt vmcnt(" #n ")" ::: "memory")
#define PG8_WAIT_L(n) asm volatile("s_waitcnt lgkmcnt(" #n ")" ::: "memory")
#define PG8_BAR __builtin_amdgcn_s_barrier()
#define PG8_SCHED __builtin_amdgcn_sched_barrier(0)
    Unit cur, nxt; int ui = 0;
    if (!S.next(0, cur)) return;
    f32x4 acc[2][2][4][2];
#pragma unroll
    for (int a = 0; a < 2; ++a)
#pragma unroll
        for (int b = 0; b < 2; ++b)
#pragma unroll
            for (int m = 0; m < 4; ++m)
#pragma unroll
                for (int n = 0; n < 2; ++n) acc[a][b][m][n] = (f32x4){0.f, 0.f, 0.f, 0.f};
    bf16x8 At[4][2], B0[2][2], B1[2][2];
    const char* cA = uni((const char*)g.A + (size_t)amap(cur.pm, g.hmap) * tstep); const char* cB = uni((const char*)g.Bt + (size_t)cur.pn * tstep);
    S.a_ready(cur);
    if constexpr (SP2) {
        PG8_STAGE(PG8_SB(0, 0), cB, voffB); PG8_STAGE(PG8_SB(0, 1), cB + hstep, voffB); PG8_STAGE(PG8_SA(0, 0), cA, voffA); PG8_STAGE(PG8_SA(0, 1), cA + hstep, voffA);
        if (wr == 1) PG8_BAR;
        PG8_WAIT_V(2); PG8_BAR;
        PG8_STAGE(PG8_SB(1, 0), cB + kstep, voffB); PG8_STAGE(PG8_SA(1, 0), cA + kstep, voffA); PG8_STAGE(PG8_SB(1, 1), cB + hstep + kstep, voffB);
        PG8_WAIT_V(6); PG8_BAR;
    } else {
        PG8_STAGE(PG8_SB(0, 0), cB, voffB); PG8_STAGE(PG8_SA(0, 0), cA, voffA); PG8_STAGE(PG8_SB(0, 1), cB + hstep, voffB); PG8_STAGE(PG8_SA(0, 1), cA + hstep, voffA);
        if (wr == 1) PG8_BAR;
        PG8_WAIT_V(4); PG8_BAR;
        PG8_STAGE(PG8_SB(1, 0), cB + kstep, voffB); PG8_STAGE(PG8_SA(1, 0), cA + kstep, voffA); PG8_STAGE(PG8_SB(1, 1), cB + hstep + kstep, voffB);
        PG8_WAIT_V(6); PG8_BAR;
    }
    for (;;) {
        const bool has_next = S.next(ui + 1, nxt);
        const char* nA = uni(has_next ? (const char*)g.A + (size_t)amap(nxt.pm, g.hmap) * tstep : cA); const char* nB = uni(has_next ? (const char*)g.Bt + (size_t)nxt.pn * tstep : cB);
        for (int t = 0; t < nt; t += 2) {
            const bool last = (t == nt - 2);
            const char* a1 = cA + (size_t)(t + 1) * kstep;
            const char* a2 = last ? nA : cA + (size_t)(t + 2) * kstep; const char* b2 = last ? nB : cB + (size_t)(t + 2) * kstep;
            const char* a3 = a2 + kstep; const char* b3 = b2 + kstep;
            if (last && has_next) S.a_ready(nxt);
            if constexpr (SP2) {
            PG8_LDB(B0, 0, 0); PG8_LDB(B1, 0, 1); PG8_SCHED; PG8_LDA(At, 0, 0); PG8_STAGE(PG8_SA(1, 1), a1 + hstep, voffA);
            PG8_WAIT_V(8); PG8_WAIT_L(0); PG8_BAR; PG8_MMA(0, 0, At, B0); PG8_MMA(0, 1, At, B1); PG8_BAR; PG8_SCHED;
            PG8_LDA(At, 0, 1); PG8_STAGE(PG8_SB(0, 0), b2, voffB); PG8_STAGE(PG8_SB(0, 1), b2 + hstep, voffB); PG8_STAGE(PG8_SA(0, 0), a2, voffA);
            PG8_WAIT_V(8); PG8_WAIT_L(0); PG8_BAR; PG8_MMA(1, 0, At, B0); PG8_MMA(1, 1, At, B1); PG8_BAR; PG8_SCHED;
            PG8_LDB(B0, 1, 0); PG8_LDB(B1, 1, 1); PG8_SCHED; PG8_LDA(At, 1, 0); PG8_STAGE(PG8_SA(0, 1), a2 + hstep, voffA);
            PG8_WAIT_V(8); PG8_WAIT_L(0); PG8_BAR; PG8_MMA(0, 0, At, B0); PG8_MMA(0, 1, At, B1); PG8_BAR; PG8_SCHED;
            PG8_LDA(At, 1, 1); PG8_STAGE(PG8_SB(1, 0), b3, voffB); PG8_STAGE(PG8_SB(1, 1), b3 + hstep, voffB); PG8_STAGE(PG8_SA(1, 0), a3, voffA);
            PG8_WAIT_V(8); PG8_WAIT_L(0); PG8_BAR; PG8_MMA(1, 0, At, B0); PG8_MMA(1, 1, At, B1); PG8_BAR; PG8_SCHED;
            } else {
            PG8_LDB(B0, 0, 0); PG8_SCHED; PG8_LDA(At, 0, 0); PG8_STAGE(PG8_SA(1, 1), a1 + hstep, voffA);
            PG8_WAIT_L(8); PG8_BAR; PG8_WAIT_L(0); PG8_MMA(0, 0, At, B0); PG8_BAR; PG8_SCHED;
            PG8_LDB(B1, 0, 1); PG8_STAGE(PG8_SB(0, 0), b2, voffB);
            PG8_BAR; PG8_WAIT_L(0); PG8_MMA(0, 1, At, B1); PG8_BAR;
            PG8_LDA(At, 0, 1); PG8_STAGE(PG8_SA(0, 0), a2, voffA);
            PG8_BAR; PG8_WAIT_L(0); PG8_MMA(1, 0, At, B0); PG8_BAR; PG8_SCHED;
            PG8_STAGE(PG8_SB(0, 1), b2 + hstep, voffB);
            PG8_WAIT_V(6); PG8_BAR; PG8_MMA(1, 1, At, B1); PG8_BAR;
            PG8_LDB(B0, 1, 0); PG8_SCHED; PG8_LDA(At, 1, 0); PG8_STAGE(PG8_SA(0, 1), a2 + hstep, voffA);
            PG8_WAIT_L(8); PG8_BAR; PG8_WAIT_L(0); PG8_MMA(0, 0, At, B0); PG8_BAR; PG8_SCHED;
            PG8_LDB(B1, 1, 1); PG8_STAGE(PG8_SB(1, 0), b3, voffB);
            PG8_BAR; PG8_WAIT_L(0); PG8_MMA(0, 1, At, B1); PG8_BAR;
            PG8_LDA(At, 1, 1); PG8_STAGE(PG8_SA(1, 0), a3, voffA);
            PG8_BAR; PG8_WAIT_L(0); PG8_MMA(1, 0, At, B0); PG8_BAR; PG8_SCHED;
            PG8_STAGE(PG8_SB(1, 1), b3 + hstep, voffB);
            PG8_WAIT_V(6); PG8_BAR; PG8_MMA(1, 1, At, B1); PG8_BAR;
            }
        }
        if constexpr (ALIGN_EPI) { if (wr == 0) PG8_BAR; }
        if constexpr (!Epi::AFTER_DRAIN) { E(acc, cur, wr, wc, fr, fq); S.done(cur); }
        if (!has_next) break;
#pragma unroll
        for (int a = 0; a < 2; ++a)
#pragma unroll
            for (int b = 0; b < 2; ++b)
#pragma unroll
                for (int m = 0; m < 4; ++m)
#pragma unroll
                    for (int n = 0; n < 2; ++n) acc[a][b][m][n] = (f32x4){0.f, 0.f, 0.f, 0.f};
        cur = nxt; cA = nA; cB = nB; ++ui;
        if constexpr (ALIGN_EPI) { if (wr == 1) PG8_BAR; }
    }
    PG8_WAIT_V(0);
    if constexpr (!ALIGN_EPI) { if (wr == 0) PG8_BAR; }
    PG8_BAR;
    if constexpr (Epi::AFTER_DRAIN) { E.fused(acc, cur, wr, wc, fr, fq, lds, wid, lane); S.done(cur); }
#undef PG8_SA
#undef PG8_SB
#undef PG8_STAGE
#undef PG8_LDA
#undef PG8_LDB
#undef PG8_MMA
#undef PG8_WAIT_V
#undef PG8_WAIT_L
#undef PG8_BAR
#undef PG8_SCHED
}
}

#define GAS __attribute__((address_space(1)))
#define LAS __attribute__((address_space(3)))
typedef unsigned short bf16_t;
typedef float f32x4 __attribute__((ext_vector_type(4)));
typedef float f32x16 __attribute__((ext_vector_type(16)));
typedef short bf16x8 __attribute__((ext_vector_type(8)));
typedef unsigned u32x4 __attribute__((ext_vector_type(4)));
typedef unsigned u32x2 __attribute__((ext_vector_type(2)));

#ifndef NLAYER_V
#define NLAYER_V 4
#endif
constexpr int NW = 8, NTHR = 512;
constexpr int MTOK = 32768, DM = 1024, SEQ = 4096, NB = 8, NLAYER = NLAYER_V, NH = 8;
constexpr int DIN = 9232, DFF = 2816, DPLE = 256;
constexpr float EPS = 1e-6f;
constexpr float LOG2E = 1.4426950408889634f;
constexpr size_t MiB = 1u << 20;
constexpr size_t WS_SS = 0;
constexpr size_t WS_CTL = 1792 * 1024;
constexpr size_t WS_UHALO = 1856 * 1024;
constexpr size_t WS_GB = 2 * MiB;
constexpr size_t WS_HALO = 4 * MiB;
constexpr size_t WS_PB = 14 * MiB;
constexpr size_t WS_W = 30 * MiB;
constexpr size_t W_IN = WS_W, W_V = W_IN + (size_t)6400 * 1024 * 2, W_GL = W_V + 2 * MiB, W_BRA = W_GL + 4 * MiB, W_BRB = W_BRA + 2 * MiB,
                 W_OUT = W_BRB + 2 * MiB, W_UP = W_OUT + 2 * MiB, W_DOWN = W_UP + 11 * MiB, W_PG = W_DOWN + (size_t)1024 * 2816 * 2, W_PP = W_PG + 2 * MiB, W_END = W_PP + (size_t)1024 * 256 * 2;
static_assert(W_END <= 74 * MiB, "weights region");
constexpr size_t WS_XB = 74 * MiB;
constexpr size_t WS_MIX = 138 * MiB;
constexpr size_t S64 = 64 * MiB;
constexpr size_t WS_QA = WS_MIX, WS_KA = WS_MIX + S64, WS_VT = WS_MIX + 2 * S64, WS_QB = WS_MIX + 3 * S64, WS_KB = WS_MIX + 4 * S64, WS_VB = WS_MIX + 5 * S64, WS_ZB = WS_MIX + 6 * S64;
constexpr size_t WS_TOTAL = WS_MIX + 7 * S64;
#ifdef DN_NAIVE
constexpr size_t WS_G = WS_KB, WS_TMPA = WS_KA, WS_MIXED = WS_VT, WS_OSRC = WS_QB;
#else
constexpr size_t WS_G = WS_KA, WS_TMPA = WS_KB, WS_MIXED = WS_VB, WS_OSRC = WS_VB;
#endif
constexpr int LDS_BYTES = 147456, LDS_VB = 140032;

__device__ __forceinline__ float bflo(unsigned w) { return __uint_as_float(w << 16); }
__device__ __forceinline__ float bfhi(unsigned w) { return __uint_as_float(w & 0xffff0000u); }
__device__ __forceinline__ float bf2f(bf16_t v) { return __uint_as_float((unsigned)v << 16); }
typedef float f32x2_t __attribute__((ext_vector_type(2))); typedef __bf16 bf16x2_t __attribute__((ext_vector_type(2)));
__device__ __forceinline__ unsigned pk2(float lo, float hi) { const f32x2_t v = {lo, hi}; const bf16x2_t b = __builtin_convertvector(v, bf16x2_t); return __builtin_bit_cast(unsigned, b); }
__device__ __forceinline__ bf16_t f2bf(float f) { return (bf16_t)(pk2(f, 0.f) & 0xffffu); }
__device__ __forceinline__ float sigmoidf_(float x) { x = fminf(fmaxf(x, -60.f), 60.f); return __builtin_amdgcn_rcpf(1.f + __expf(-x)); }
__device__ __forceinline__ float siluf_(float x) { return x * sigmoidf_(x); }
__device__ __forceinline__ float wave_sum(float v) {
#pragma unroll
    for (int o = 1; o < 64; o <<= 1) v += __shfl_xor(v, o);
    return v;
}
__device__ __forceinline__ float ss_load(const float* p) { const f32x4 a = *(const f32x4*)p, b = *(const f32x4*)(p + 4), c = *(const f32x4*)(p + 8), d = *(const f32x4*)(p + 12);
    float s = (((a[0] + a[1]) + (a[2] + a[3])) + ((b[0] + b[1]) + (b[2] + b[3]))) + (((c[0] + c[1]) + (c[2] + c[3])) + ((d[0] + d[1]) + (d[2] + d[3])));
    asm volatile("" : "+v"(s) :: "memory");
    return s; }
__device__ __forceinline__ u32x4 ldc16(const void* p) { u32x4 v; asm volatile("global_load_dwordx4 %0, %1, off sc0 sc1\n\ts_waitcnt vmcnt(0)" : "=v"(v) : "v"(p) : "memory"); return v; }
__device__ __forceinline__ int crow(int r, int hi) { return (r & 3) + 8 * (r >> 2) + 4 * hi; }

__device__ __forceinline__ float ss_sum16(const f32x4 a, const f32x4 b, const f32x4 c, const f32x4 d) {
    return (((a[0] + a[1]) + (a[2] + a[3])) + ((b[0] + b[1]) + (b[2] + b[3]))) + (((c[0] + c[1]) + (c[2] + c[3])) + ((d[0] + d[1]) + (d[2] + d[3]))); }
__device__ __forceinline__ int gmap(int row, int h) { return h < 0 ? row : ((row >> 11) * 4096 + 2048 * h + (row & 2047)); }

__device__ __forceinline__ void load_rs8(const float* ss, int rowbase, int hmap, int lane, int fr, float (&rs)[2][4]) {
    const float* p0 = ss + (size_t)gmap(rowbase + lane, hmap) * 16; const float* p1 = ss + (size_t)gmap(rowbase + 128 + lane, hmap) * 16;
    const f32x4 a0 = *(const f32x4*)p0, b0 = *(const f32x4*)(p0 + 4), c0 = *(const f32x4*)(p0 + 8), d0 = *(const f32x4*)(p0 + 12);
    const f32x4 a1 = *(const f32x4*)p1, b1 = *(const f32x4*)(p1 + 4), c1 = *(const f32x4*)(p1 + 8), d1 = *(const f32x4*)(p1 + 12);
    const float r0 = rsqrtf(ss_sum16(a0, b0, c0, d0) * (1.f / 1024.f) + EPS), r1 = rsqrtf(ss_sum16(a1, b1, c1, d1) * (1.f / 1024.f) + EPS);
#pragma unroll
    for (int m = 0; m < 4; ++m) { rs[0][m] = __shfl(r0, m * 16 + fr); rs[1][m] = __shfl(r1, m * 16 + fr); }
    asm volatile("" ::: "memory");
}

using pg8::Unit;
typedef f32x4 AccT[2][2][4][2];

template <int ACT> struct EpiRowScale {
    static constexpr bool PERM = true, AFTER_DRAIN = false;
    bf16_t* O; int ldc; const float* ss; int hmap;
    __device__ __forceinline__ void operator()(const AccT& acc, const Unit& u, int wr, int wc, int fr, int fq) const {
        const int row0 = u.pm * 256 + wr * 64 + fr, col0 = u.pn * 256 + wc * 32 + 8 * fq;
        float rsv[2][4]; load_rs8(ss, u.pm * 256 + wr * 64, hmap, (int)(threadIdx.x & 63), fr, rsv);
#pragma unroll
        for (int ai = 0; ai < 2; ++ai)
#pragma unroll
            for (int m = 0; m < 4; ++m) {
                const int row = row0 + ai * 128 + m * 16;
                const float rs = rsv[ai][m];
                bf16_t* rowp = O + (size_t)row * ldc + col0;
#pragma unroll
                for (int bj = 0; bj < 2; ++bj) {
                    f32x4 v0 = acc[ai][bj][m][0] * rs, v1 = acc[ai][bj][m][1] * rs;
                    if (ACT == 1) {
#pragma unroll
                        for (int e = 0; e < 4; ++e) { v0[e] = sigmoidf_(v0[e]); v1[e] = sigmoidf_(v1[e]); }
                    }
                    u32x4 w; w.x = pk2(v0[0], v0[1]); w.y = pk2(v0[2], v0[3]); w.z = pk2(v1[0], v1[1]); w.w = pk2(v1[2], v1[3]);
                    *(u32x4*)(rowp + bj * 128) = w;
                    asm volatile("" ::: "memory");
                }
            }
    }
};

struct EpiVt {
    static constexpr bool PERM = true, AFTER_DRAIN = false;
    bf16_t* O; const float* ss;
    __device__ __forceinline__ void operator()(const AccT& acc, const Unit& u, int wr, int wc, int fr, int fq) const {
        const int row0 = u.pm * 256 + wr * 64 + fr, col0 = u.pn * 256 + wc * 32 + 8 * fq;
        float rs[2][8];
        { const int L = (int)(threadIdx.x & 63); const float* pc = ss + (size_t)(u.pn * 256 + (L >> 5) * 128 + wc * 32 + (L & 31)) * 16;
          const f32x4 a = *(const f32x4*)pc, b = *(const f32x4*)(pc + 4), c = *(const f32x4*)(pc + 8), d = *(const f32x4*)(pc + 12);
          const float r = rsqrtf(ss_sum16(a, b, c, d) * (1.f / 1024.f) + EPS);
#pragma unroll
          for (int bj = 0; bj < 2; ++bj)
#pragma unroll
              for (int e = 0; e < 8; ++e) rs[bj][e] = __shfl(r, bj * 32 + 8 * fq + e); }
#pragma unroll
        for (int ai = 0; ai < 2; ++ai)
#pragma unroll
            for (int m = 0; m < 4; ++m) {
                const int row = row0 + ai * 128 + m * 16;
                bf16_t* rowp = O + (size_t)row * MTOK + col0;
#pragma unroll
                for (int bj = 0; bj < 2; ++bj) {
                    const f32x4 v0 = acc[ai][bj][m][0], v1 = acc[ai][bj][m][1];
                    u32x4 w; w.x = pk2(v0[0] * rs[bj][0], v0[1] * rs[bj][1]); w.y = pk2(v0[2] * rs[bj][2], v0[3] * rs[bj][3]);
                    w.z = pk2(v1[0] * rs[bj][4], v1[1] * rs[bj][5]); w.w = pk2(v1[2] * rs[bj][6], v1[3] * rs[bj][7]);
                    *(u32x4*)(rowp + bj * 128) = w;
                }
                asm volatile("" ::: "memory");
            }
    }
};

struct EpiGateMul {
    static constexpr bool PERM = true, AFTER_DRAIN = false;
    bf16_t* O; const bf16_t* G; int ldg, goff; const bf16_t* Add;
    __device__ __forceinline__ void operator()(const AccT& acc, const Unit& u, int wr, int wc, int fr, int fq) const {
        const int row0 = u.pm * 256 + wr * 64 + fr, col0 = u.pn * 256 + wc * 32 + 8 * fq;
#pragma unroll
        for (int ai = 0; ai < 2; ++ai)
#pragma unroll
            for (int m = 0; m < 4; ++m) {
                const int row = row0 + ai * 128 + m * 16;
#pragma unroll
                for (int bj = 0; bj < 2; ++bj) {
                    const int c = col0 + bj * 128;
                    const u32x4 g = *(const u32x4*)(G + (size_t)row * ldg + goff + c);
                    u32x4 a = (u32x4){0u, 0u, 0u, 0u};
                    if (Add) a = *(const u32x4*)(Add + (size_t)row * 1024 + c);
                    const f32x4 v0 = acc[ai][bj][m][0], v1 = acc[ai][bj][m][1];
                    u32x4 w;
                    w.x = pk2(bflo(a.x) + bflo(g.x) * v0[0], bfhi(a.x) + bfhi(g.x) * v0[1]);
                    w.y = pk2(bflo(a.y) + bflo(g.y) * v0[2], bfhi(a.y) + bfhi(g.y) * v0[3]);
                    w.z = pk2(bflo(a.z) + bflo(g.z) * v1[0], bfhi(a.z) + bfhi(g.z) * v1[1]);
                    w.w = pk2(bflo(a.w) + bflo(g.w) * v1[2], bfhi(a.w) + bfhi(g.w) * v1[3]);
                    *(u32x4*)(O + (size_t)row * 1024 + c) = w;
                }
                asm volatile("" ::: "memory");
            }
    }
};

struct EpiResid {
    static constexpr bool PERM = true, AFTER_DRAIN = false;
    float* X; bf16_t* XB; float* ssn; const bf16_t* Mul; int hmap;
    __device__ __forceinline__ void operator()(const AccT& acc, const Unit& u, int wr, int wc, int fr, int fq) const {
        const int row0 = u.pm * 256 + wr * 64 + fr, col0 = u.pn * 256 + wc * 32 + 8 * fq;
#pragma unroll
        for (int ai = 0; ai < 2; ++ai)
#pragma unroll
            for (int m = 0; m < 4; ++m) {
                const int row = gmap(row0 + ai * 128 + m * 16, hmap);
                const size_t off0 = (size_t)row * 1024 + col0;
                f32x4 xa = *(const f32x4*)(X + off0), xb2 = *(const f32x4*)(X + off0 + 4), xc = *(const f32x4*)(X + off0 + 128), xd = *(const f32x4*)(X + off0 + 132);
                f32x4 va = acc[ai][0][m][0], vb2 = acc[ai][0][m][1], vc = acc[ai][1][m][0], vd = acc[ai][1][m][1];
                if (Mul) {
                    const u32x4 g0 = *(const u32x4*)(Mul + off0), g1 = *(const u32x4*)(Mul + off0 + 128);
                    va[0] *= bflo(g0.x); va[1] *= bfhi(g0.x); va[2] *= bflo(g0.y); va[3] *= bfhi(g0.y); vb2[0] *= bflo(g0.z); vb2[1] *= bfhi(g0.z); vb2[2] *= bflo(g0.w); vb2[3] *= bfhi(g0.w);
                    vc[0] *= bflo(g1.x); vc[1] *= bfhi(g1.x); vc[2] *= bflo(g1.y); vc[3] *= bfhi(g1.y); vd[0] *= bflo(g1.z); vd[1] *= bfhi(g1.z); vd[2] *= bflo(g1.w); vd[3] *= bfhi(g1.w);
                }
                xa += va; xb2 += vb2; xc += vc; xd += vd;
                *(f32x4*)(X + off0) = xa; *(f32x4*)(X + off0 + 4) = xb2; *(f32x4*)(X + off0 + 128) = xc; *(f32x4*)(X + off0 + 132) = xd;
                u32x4 w0; w0.x = pk2(xa[0], xa[1]); w0.y = pk2(xa[2], xa[3]); w0.z = pk2(xb2[0], xb2[1]); w0.w = pk2(xb2[2], xb2[3]);
                u32x4 w1; w1.x = pk2(xc[0], xc[1]); w1.y = pk2(xc[2], xc[3]); w1.z = pk2(xd[0], xd[1]); w1.w = pk2(xd[2], xd[3]);
                *(u32x4*)(XB + off0) = w0; *(u32x4*)(XB + off0 + 128) = w1;
                float sq = ((xa[0] * xa[0] + xa[1] * xa[1]) + (xa[2] * xa[2] + xa[3] * xa[3])) + ((xb2[0] * xb2[0] + xb2[1] * xb2[1]) + (xb2[2] * xb2[2] + xb2[3] * xb2[3]))
                         + ((xc[0] * xc[0] + xc[1] * xc[1]) + (xc[2] * xc[2] + xc[3] * xc[3])) + ((xd[0] * xd[0] + xd[1] * xd[1]) + (xd[2] * xd[2] + xd[3] * xd[3]));
                sq += __shfl_xor(sq, 16); sq += __shfl_xor(sq, 32);
                if (fq == 0) ssn[(size_t)row * 16 + u.pn * 4 + wc] = sq;
                asm volatile("" ::: "memory");
            }
    }
};

struct EpiQK {
    static constexpr bool PERM = true, AFTER_DRAIN = false;
    unsigned char* ws; const float* ss; const float* qg; const float* kg;
    __device__ __forceinline__ void operator()(const AccT& acc, const Unit& u, int wr, int wc, int fr, int fq) const {
        const int row0 = u.pm * 256 + wr * 64 + fr;
        const int seg = u.pn >> 2, tl = u.pn & 3;
        bf16_t* base = (bf16_t*)(ws + (seg == 0 ? WS_QA : WS_KA));
        const float* gp = seg == 0 ? qg : kg; const float osc = seg == 0 ? 0.125f * LOG2E : 1.0f;
        const int col0 = tl * 256 + 64 * wc + 8 * fq;
        float rsv[2][4]; load_rs8(ss, u.pm * 256 + wr * 64, -1, (int)(threadIdx.x & 63), fr, rsv);
#pragma unroll
        for (int ai = 0; ai < 2; ++ai)
#pragma unroll
            for (int m = 0; m < 4; ++m) {
                const int row = row0 + ai * 128 + m * 16;
                const float rs = rsv[ai][m];
                f32x4 v[2][2]; float sq = 0.f;
#pragma unroll
                for (int bj = 0; bj < 2; ++bj)
#pragma unroll
                    for (int n = 0; n < 2; ++n) { v[bj][n] = acc[ai][bj][m][n] * rs; const f32x4 t = v[bj][n]; sq += (t[0] * t[0] + t[1] * t[1]) + (t[2] * t[2] + t[3] * t[3]); }
                sq += __shfl_xor(sq, 16); sq += __shfl_xor(sq, 32);
                const float r2o = rsqrtf(sq * (1.f / 64.f) + EPS) * osc;
#pragma unroll
                for (int bj = 0; bj < 2; ++bj) {
                    const f32x4 ga = *(const f32x4*)(gp + 32 * bj + 8 * fq), gb = *(const f32x4*)(gp + 32 * bj + 8 * fq + 4);
                    u32x4 w;
                    w.x = pk2(v[bj][0][0] * r2o * ga[0], v[bj][0][1] * r2o * ga[1]); w.y = pk2(v[bj][0][2] * r2o * ga[2], v[bj][0][3] * r2o * ga[3]);
                    w.z = pk2(v[bj][1][0] * r2o * gb[0], v[bj][1][1] * r2o * gb[1]); w.w = pk2(v[bj][1][2] * r2o * gb[2], v[bj][1][3] * r2o * gb[3]);
                    *(u32x4*)(base + (size_t)row * 1024 + col0 + 32 * bj) = w;
                }
                asm volatile("" ::: "memory");
            }
    }
};
struct EpiSeg {
    static constexpr bool PERM = true, AFTER_DRAIN = false;
    unsigned char* ws; const float* ss;
    __device__ __forceinline__ void operator()(const AccT& acc, const Unit& u, int wr, int wc, int fr, int fq) const {
        const int row0 = u.pm * 256 + wr * 64 + fr;
        bf16_t* base = (bf16_t*)(ws + WS_QB + (size_t)(u.pn >> 2) * S64);
        const int col0 = (u.pn & 3) * 256 + wc * 32 + 8 * fq;
        float rsv[2][4]; load_rs8(ss, u.pm * 256 + wr * 64, -1, (int)(threadIdx.x & 63), fr, rsv);
#pragma unroll
        for (int ai = 0; ai < 2; ++ai)
#pragma unroll
            for (int m = 0; m < 4; ++m) {
                const int row = row0 + ai * 128 + m * 16;
                const float rs = rsv[ai][m];
#pragma unroll
                for (int bj = 0; bj < 2; ++bj) {
                    const f32x4 v0 = acc[ai][bj][m][0] * rs, v1 = acc[ai][bj][m][1] * rs;
                    u32x4 w; w.x = pk2(v0[0], v0[1]); w.y = pk2(v0[2], v0[3]); w.z = pk2(v1[0], v1[1]); w.w = pk2(v1[2], v1[3]);
                    *(u32x4*)(base + (size_t)row * 1024 + col0 + bj * 128) = w;
                }
                asm volatile("" ::: "memory");
            }
    }
};
struct EpiGB {
    static constexpr bool PERM = true, AFTER_DRAIN = false;
    unsigned char* ws; const float* ss; const float* a_log; const float* dt_bias;
    __device__ __forceinline__ void operator()(const AccT& acc, const Unit& u, int wr, int wc, int fr, int fq) const {
        const int row0 = u.pm * 256 + wr * 64 + fr;
        float rsv[2][4]; load_rs8(ss, u.pm * 256 + wr * 64, -1, (int)(threadIdx.x & 63), fr, rsv);
        if (wc == 0 && fq < 2) {
            float* GBp = (float*)(ws + WS_GB);
#pragma unroll
            for (int ai = 0; ai < 2; ++ai)
#pragma unroll
                for (int m = 0; m < 4; ++m) {
                    const int row = row0 + ai * 128 + m * 16;
                    const float rs = rsv[ai][m];
                    float v[8];
#pragma unroll
                    for (int e = 0; e < 4; ++e) { v[e] = acc[ai][0][m][0][e] * rs; v[4 + e] = acc[ai][0][m][1][e] * rs; }
                    if (fq == 0) {
#pragma unroll
                        for (int e = 0; e < 8; ++e) v[e] = sigmoidf_(v[e]);
                    } else {
#pragma unroll
                        for (int e = 0; e < 8; ++e) { const float z = v[e] + dt_bias[e]; const float sp = fmaxf(z, 0.f) + __logf(1.f + __expf(-fabsf(z))); v[e] = -__expf(a_log[e]) * sp; }
                    }
                    float* dst = GBp + (size_t)row * 16 + 8 * fq;
                    *(f32x4*)dst = (f32x4){v[0], v[1], v[2], v[3]}; *(f32x4*)(dst + 4) = (f32x4){v[4], v[5], v[6], v[7]};
                    asm volatile("" ::: "memory");
                }
        }
    }
};

__device__ __forceinline__ void cvt_item(const float* W, int ldw, int src_col0, int nvalid, const float* gain, bf16_t* WT, int K, int dst_row0, int k0, LAS float* scr, int lane) {
    const int nn = lane & 31;
#pragma unroll 8
    for (int i = 0; i < 32; ++i) {
        const int kk = 2 * i + (lane >> 5);
        float v = 0.f;
        if (nn < nvalid) { v = W[(size_t)(k0 + kk) * ldw + src_col0 + nn]; if (gain) v *= gain[k0 + kk]; }
        scr[kk * 33 + nn] = v;
    }
    asm volatile("s_waitcnt lgkmcnt(0)" ::: "memory");
    const int c = lane & 7;
#pragma unroll
    for (int j = 0; j < 4; ++j) {
        const int n = (lane >> 3) + 8 * j; const LAS float* s = scr + (8 * c) * 33 + n;
        u32x4 o; o.x = pk2(s[0 * 33], s[1 * 33]); o.y = pk2(s[2 * 33], s[3 * 33]); o.z = pk2(s[4 * 33], s[5 * 33]); o.w = pk2(s[6 * 33], s[7 * 33]);
        *(u32x4*)(WT + (size_t)(dst_row0 + n) * K + k0 + 8 * c) = o;
    }
    asm volatile("s_waitcnt lgkmcnt(0)" ::: "memory");
}

struct Params {
    const float* in[24];
    float* out;
    unsigned char* ws;
    int seg_lo, seg_hi;
};
enum { I_X = 0, I_P, I_WIN, I_ATTN_NORM, I_QNORM, I_KNORM, I_LAM, I_SUBLN, I_RELB, I_CONVB, I_ALOG, I_DTB, I_ONORM, I_WBRA, I_WBRB, I_WOUT, I_FFN_NORM, I_WUP, I_CONVFF, I_CONVFFB, I_WDOWN, I_PLE_NORM, I_WPG, I_WPP };

__device__ __forceinline__ void convert_weights(const Params* PQ, int layer, LAS unsigned char* lds, int gw, int NGW, int wave, int lane) {
    LAS float* scr = (LAS float*)(lds + wave * 16384);
    unsigned char* ws = PQ->ws;
    const float* w_in = PQ->in[I_WIN] + (size_t)layer * 1024 * DIN;
    const float* g_attn = PQ->in[I_ATTN_NORM] + layer * 1024;
    const float* g_ffn = PQ->in[I_FFN_NORM] + layer * 1024;
    const float* g_ple = PQ->in[I_PLE_NORM] + layer * 1024;
#define CVT_JOB(NITEMS, KB, SRCW, LDW, GAIN, DST, KK, SRCCOL, NVALID) \
    for (int it = gw; it < (NITEMS); it += NGW) { const int g = it / (KB), kb = it % (KB); (void)g; \
        cvt_item((SRCW), (LDW), (SRCCOL), (NVALID), (GAIN), (bf16_t*)(ws + (DST)), (KK), g * 32, kb * 64, scr, lane); } asm volatile("" ::: "memory");
    for (int it = gw; it < 200 * 16; it += NGW) {
        const int g = it >> 4, kb = it & 15, pn = g >> 3, gi = g & 7;
        int src, nv = 32;
        if (pn < 8) { const int bj = gi >> 2, wc = gi & 3; src = (pn >> 2) * 1024 + (pn & 3) * 256 + 64 * wc + 32 * bj; }
        else if (pn < 24) { src = 3072 + (pn - 8) * 256 + 32 * gi; }
        else { src = 7168; nv = (gi == 0) ? 16 : 0; }
        cvt_item(w_in, DIN, src, nv, g_attn, (bf16_t*)(ws + W_IN), 1024, g * 32, kb * 64, scr, lane);
    }
    asm volatile("" ::: "memory");
    CVT_JOB(32 * 16, 16, w_in, DIN, g_attn, W_V, 1024, 2048 + g * 32, 32)
    CVT_JOB(64 * 16, 16, w_in, DIN, g_attn, W_GL, 1024, 7184 + g * 32, 32)
    CVT_JOB(32 * 16, 16, PQ->in[I_WBRA] + (size_t)layer * 1024 * 1024, 1024, (const float*)nullptr, W_BRA, 1024, g * 32, 32)
    CVT_JOB(32 * 16, 16, PQ->in[I_WBRB] + (size_t)layer * 1024 * 1024, 1024, (const float*)nullptr, W_BRB, 1024, g * 32, 32)
    CVT_JOB(32 * 16, 16, PQ->in[I_WOUT] + (size_t)layer * 1024 * 1024, 1024, (const float*)nullptr, W_OUT, 1024, g * 32, 32)
    CVT_JOB(176 * 16, 16, PQ->in[I_WUP] + (size_t)layer * 1024 * 5632, 5632, g_ffn, W_UP, 1024, g * 32, 32)
    CVT_JOB(32 * 44, 44, PQ->in[I_WDOWN] + (size_t)layer * 2816 * 1024, 1024, (const float*)nullptr, W_DOWN, 2816, g * 32, 32)
    CVT_JOB(32 * 16, 16, PQ->in[I_WPG] + (size_t)layer * 1024 * 1024, 1024, g_ple, W_PG, 1024, g * 32, 32)
    CVT_JOB(32 * 4, 4, PQ->in[I_WPP] + (size_t)layer * 256 * 1024, 1024, (const float*)nullptr, W_PP, 256, g * 32, 32)
#undef CVT_JOB
}

constexpr int AT_KROW = 272, AT_VROW = 136  , AT_KBYTES = 64 * AT_KROW, AT_VBYTES = 128 * AT_VROW, AT_STAGE = AT_KBYTES + AT_VBYTES, AT_TB = 2 * AT_STAGE;
static_assert(AT_TB >= 65536 && AT_TB + 1024 <= LDS_BYTES, "attention LDS");
__device__ __forceinline__ void attn_unit(LAS unsigned char* lds, const bf16_t* QA, const bf16_t* KA, const bf16_t* VT, bf16_t* OA, int b, int h, int qb,
                                          float lam, float out_scale, const float* subln, const float* relb, int tid, bool do_store = true) {
    const int lane = tid & 63, wid = __builtin_amdgcn_readfirstlane(tid >> 6), j = wid >> 2, wq = wid & 3, r32 = lane & 31, hi = lane >> 5;
    const int Q0 = qb * 128, qrow = Q0 + 32 * wq + r32;
    const size_t tok = (size_t)b * SEQ + qrow;
    LAS float* TB = (LAS float*)(lds + AT_TB);
    for (int i = tid; i <= 128; i += NTHR) {
        float v = 0.f;
        if (i < 128) {
            int bk = i;
            if (i >= 16) { int lg = 16 + (int)(__logf((float)i * (1.f / 16.f)) / __logf(8.0f) * 16.f); bk = lg < 31 ? lg : 31; }
            v = (relb[bk * 8 + h] - relb[31 * 8 + h]) * LOG2E;
        }
        TB[i] = v;
    }
    bf16x8 qf[4];
#pragma unroll
    for (int d0 = 0; d0 < 4; ++d0) qf[d0] = *(const bf16x8*)(QA + tok * 1024 + h * 128 + 64 * j + 16 * d0 + 8 * hi);
    const int NT = (Q0 + 128) / 64;
    const int kr0 = tid >> 4, kc = tid & 15;
    const int vr0 = tid >> 3, vc = tid & 7;
    const bf16_t* kg = KA + ((size_t)b * SEQ + kr0) * 1024 + h * 128 + kc * 8;
    const bf16_t* vg = VT + (size_t)(h * 128 + vr0) * MTOK + (size_t)b * SEQ + vc * 8;
    u32x4 kreg0, kreg1, vreg0, vreg1;
#define AT_LOAD(t) do { kreg0 = *(const u32x4*)(kg + (size_t)(t) * 64 * 1024); kreg1 = *(const u32x4*)(kg + (size_t)((t) * 64 + 32) * 1024); \
        vreg0 = *(const u32x4*)(vg + (t) * 64); vreg1 = *(const u32x4*)(vg + (size_t)64 * MTOK + (t) * 64); } while (0)
#define AT_STORE(s) do { LAS unsigned char* kb_ = lds + (s) * AT_STAGE; LAS unsigned char* vb_ = kb_ + AT_KBYTES; \
        *(LAS u32x4*)(kb_ + kr0 * AT_KROW + kc * 16) = kreg0; *(LAS u32x4*)(kb_ + (kr0 + 32) * AT_KROW + kc * 16) = kreg1; \
        *(LAS u32x2*)(vb_ + vr0 * AT_VROW + vc * 16) = (u32x2){vreg0.x, vreg0.y}; *(LAS u32x2*)(vb_ + vr0 * AT_VROW + vc * 16 + 8) = (u32x2){vreg0.z, vreg0.w}; \
        *(LAS u32x2*)(vb_ + (vr0 + 64) * AT_VROW + vc * 16) = (u32x2){vreg1.x, vreg1.y}; *(LAS u32x2*)(vb_ + (vr0 + 64) * AT_VROW + vc * 16 + 8) = (u32x2){vreg1.z, vreg1.w}; } while (0)
    AT_LOAD(0); AT_STORE(0);
    __syncthreads();
    f32x16 o[4];
#pragma unroll
    for (int i = 0; i < 4; ++i)
#pragma unroll
        for (int r = 0; r < 16; ++r) o[i][r] = 0.f;
    float mrun = -INFINITY, lrun = 0.f;
    const int qmax_w = Q0 + 32 * wq + 31, qmin_w = Q0 + 32 * wq;
    for (int t = 0; t < NT; ++t) {
        if (t + 1 < NT) AT_LOAD(t + 1);
        const int kv0 = 64 * t;
        if (kv0 <= qmax_w) {
            const LAS unsigned char* Kb = lds + (t & 1) * AT_STAGE; const LAS unsigned char* Vb = Kb + AT_KBYTES;
            f32x16 s0, s1;
#pragma unroll
            for (int r = 0; r < 16; ++r) { s0[r] = 0.f; s1[r] = 0.f; }
#pragma unroll
            for (int d0 = 0; d0 < 4; ++d0) {
                const bf16x8 a0 = *(const LAS bf16x8*)(Kb + r32 * AT_KROW + (64 * j + 16 * d0 + 8 * hi) * 2);
                const bf16x8 a1 = *(const LAS bf16x8*)(Kb + (32 + r32) * AT_KROW + (64 * j + 16 * d0 + 8 * hi) * 2);
                s0 = __builtin_amdgcn_mfma_f32_32x32x16_bf16(a0, qf[d0], s0, 0, 0, 0);
                s1 = __builtin_amdgcn_mfma_f32_32x32x16_bf16(a1, qf[d0], s1, 0, 0, 0);
            }
            if (kv0 + 63 + 128 > qmin_w) {
#pragma unroll
                for (int r = 0; r < 16; ++r) {
                    const int rel0 = qrow - (kv0 + crow(r, hi)), rel1 = rel0 - 32;
                    s0[r] = rel0 < 0 ? -INFINITY : s0[r] + TB[rel0 < 128 ? rel0 : 128];
                    s1[r] = rel1 < 0 ? -INFINITY : s1[r] + TB[rel1 < 128 ? rel1 : 128];
                }
            }
            float mx = fmaxf(s0[0], s1[0]);
#pragma unroll
            for (int r = 1; r < 16; ++r) mx = fmaxf(mx, fmaxf(s0[r], s1[r]));
            mx = fmaxf(mx, __shfl_xor(mx, 32));
            const float mnew = fmaxf(mrun, mx);
            const float alpha = __builtin_amdgcn_exp2f(mrun - mnew);
            mrun = mnew;
            float ls = 0.f;
#pragma unroll
            for (int r = 0; r < 16; ++r) { s0[r] = __builtin_amdgcn_exp2f(s0[r] - mnew); s1[r] = __builtin_amdgcn_exp2f(s1[r] - mnew); ls += s0[r] + s1[r]; }
            lrun = lrun * alpha + ls;
#pragma unroll
            for (int i = 0; i < 4; ++i)
#pragma unroll
                for (int r = 0; r < 16; ++r) o[i][r] *= alpha;
            bf16x8 pf[4];
            { u32x4 w;
              w.x = pk2(s0[0], s0[1]); w.y = pk2(s0[2], s0[3]); w.z = pk2(s0[4], s0[5]); w.w = pk2(s0[6], s0[7]); pf[0] = __builtin_bit_cast(bf16x8, w);
              w.x = pk2(s0[8], s0[9]); w.y = pk2(s0[10], s0[11]); w.z = pk2(s0[12], s0[13]); w.w = pk2(s0[14], s0[15]); pf[1] = __builtin_bit_cast(bf16x8, w);
              w.x = pk2(s1[0], s1[1]); w.y = pk2(s1[2], s1[3]); w.z = pk2(s1[4], s1[5]); w.w = pk2(s1[6], s1[7]); pf[2] = __builtin_bit_cast(bf16x8, w);
              w.x = pk2(s1[8], s1[9]); w.y = pk2(s1[10], s1[11]); w.z = pk2(s1[12], s1[13]); w.w = pk2(s1[14], s1[15]); pf[3] = __builtin_bit_cast(bf16x8, w); }
#pragma unroll
            for (int blk = 0; blk < 4; ++blk)
#pragma unroll
                for (int s = 0; s < 4; ++s) {
                    const LAS unsigned char* vp = Vb + (32 * blk + r32) * AT_VROW + (16 * s + 4 * hi) * 2;
                    const u32x2 lo = *(const LAS u32x2*)vp, hh = *(const LAS u32x2*)(vp + 16);
                    const u32x4 w = (u32x4){lo.x, lo.y, hh.x, hh.y};
                    o[blk] = __builtin_amdgcn_mfma_f32_32x32x16_bf16(__builtin_bit_cast(bf16x8, w), pf[s], o[blk], 0, 0, 0);
                }
        }
        if (t + 1 < NT) AT_STORE((t + 1) & 1);
        __syncthreads();
    }
#undef AT_LOAD
#undef AT_STORE
    lrun += __shfl_xor(lrun, 32);
    const float inv = 1.f / lrun;
    LAS float* EX = (LAS float*)lds;
    if (j == 1) {
        const float sc = inv * lam;
#pragma unroll
        for (int blk = 0; blk < 4; ++blk)
#pragma unroll
            for (int r = 0; r < 16; ++r) EX[(wq * 64 + blk * 16 + r) * 64 + lane] = o[blk][r] * sc;
    }
    __syncthreads();
    if (j == 0) {
        float sq = 0.f;
#pragma unroll
        for (int blk = 0; blk < 4; ++blk)
#pragma unroll
            for (int r = 0; r < 16; ++r) { const float d = o[blk][r] * inv - EX[(wq * 64 + blk * 16 + r) * 64 + lane]; o[blk][r] = d; sq += d * d; }
        sq += __shfl_xor(sq, 32);
        const float rr = rsqrtf(sq * (1.f / 128.f) + EPS) * out_scale;
#pragma unroll
        for (int blk = 0; blk < 4; ++blk)
#pragma unroll
            for (int rq = 0; rq < 4; ++rq) {
                const int dv0 = 32 * blk + 8 * rq + 4 * hi;
                const f32x4 g = *(const f32x4*)(subln + dv0);
                u32x2 w; w.x = pk2(o[blk][4 * rq + 0] * rr * g[0], o[blk][4 * rq + 1] * rr * g[1]); w.y = pk2(o[blk][4 * rq + 2] * rr * g[2], o[blk][4 * rq + 3] * rr * g[3]);
                if (do_store) *(u32x2*)(OA + tok * 1024 + h * 128 + dv0) = w;
            }
    }
    __syncthreads();
}

__device__ __forceinline__ void dn_naive(LAS unsigned char* lds, unsigned char* ws, const float* convw  , int b, int h, int tid) {
    const int lane = tid & 63, wid = tid >> 6, dv = tid & 127, g4 = tid >> 7;
    LAS float* Y = (LAS float*)lds;
    LAS float* NR = Y + 384;
    LAS float* PT = NR + 8;
    LAS float* OP = PT + 512;
    float S[32];
#pragma unroll
    for (int i = 0; i < 32; ++i) S[i] = 0.f;
    bf16_t* QB = (bf16_t*)(ws + WS_QB); const bf16_t* KB = (const bf16_t*)(ws + WS_KB); const bf16_t* VB = (const bf16_t*)(ws + WS_VB);
    const float* GBp = (const float*)(ws + WS_GB);
    const int arr = tid >> 7;
    const bf16_t* src = (arr == 0 ? (const bf16_t*)QB : arr == 1 ? KB : VB) + h * 128 + dv;
    float w0 = 0.f, w1 = 0.f, w2 = 0.f, w3 = 0.f, x1 = 0.f, x2 = 0.f, x3 = 0.f;
    if (tid < 384) { const int ch = arr * 1024 + h * 128 + dv; w0 = convw[ch]; w1 = convw[3072 + ch]; w2 = convw[2 * 3072 + ch]; w3 = convw[3 * 3072 + ch]; }
    for (int t = 0; t < SEQ; ++t) {
        const size_t tok = (size_t)b * SEQ + t;
        if (tid < 384) {
            const float x0 = bf2f(src[tok * 1024]);
            float y = w0 * x3 + w1 * x2 + w2 * x1 + w3 * x0;
            y = siluf_(y); x3 = x2; x2 = x1; x1 = x0;
            Y[arr * 128 + dv] = y;
            const float sq = wave_sum(y * y);
            if (lane == 0) NR[wid] = sq;
        }
        __syncthreads();
        const float qn = rsqrtf(NR[0] + NR[1] + EPS) * 0.08838834764831845f, kn = rsqrtf(NR[2] + NR[3] + EPS);
        const float bt = GBp[tok * 16 + h], gt = GBp[tok * 16 + 8 + h], eg = __expf(gt);
        const float vv = Y[256 + dv];
        float ks = 0.f;
#pragma unroll
        for (int i = 0; i < 32; ++i) ks += Y[128 + 32 * g4 + i] * S[i];
        PT[g4 * 128 + dv] = ks * kn;
        __syncthreads();
        const float kS = (PT[dv] + PT[128 + dv]) + (PT[256 + dv] + PT[384 + dv]);
        const float c = bt * (vv - eg * kS);
        float op = 0.f;
#pragma unroll
        for (int i = 0; i < 32; ++i) { const float kk = Y[128 + 32 * g4 + i] * kn; S[i] = eg * S[i] + kk * c; op += Y[32 * g4 + i] * S[i]; }
        OP[g4 * 128 + dv] = op * qn;
        __syncthreads();
        if (g4 == 0) { const float ov = (OP[dv] + OP[128 + dv]) + (OP[256 + dv] + OP[384 + dv]); QB[tok * 1024 + h * 128 + dv] = f2bf(ov); }
    }
    __syncthreads();
}

__device__ __forceinline__ float row16_sum(float v) {
    v += __builtin_bit_cast(float, __builtin_amdgcn_update_dpp(0, __builtin_bit_cast(int, v), 0x128, 0xf, 0xf, false));
    v += __builtin_bit_cast(float, __builtin_amdgcn_update_dpp(0, __builtin_bit_cast(int, v), 0x124, 0xf, 0xf, false));
    v += __builtin_bit_cast(float, __builtin_amdgcn_update_dpp(0, __builtin_bit_cast(int, v), 0x122, 0xf, 0xf, false));
    v += __builtin_bit_cast(float, __builtin_amdgcn_update_dpp(0, __builtin_bit_cast(int, v), 0x121, 0xf, 0xf, false));
    return v;
}
__device__ __forceinline__ void dn_fast(LAS unsigned char* lds, unsigned char* ws, const float* convw  , int b, int h, int dvq, int tid) {
    const int lane = tid & 63, wid = tid >> 6, dvl = lane >> 4, grp = lane & 15;
    const int dvloc = 4 * wid + dvl, dv = 32 * dvq + dvloc;
    LAS float* Y = (LAS float*)lds;
    LAS float* NR = Y + 16 * 288;
    LAS float* GBs = NR + 16 * 16;
    LAS float* SC = GBs + 32;
    float S[8];
#pragma unroll
    for (int i = 0; i < 8; ++i) S[i] = 0.f;
    bf16_t* VB = (bf16_t*)(ws + WS_VB);
    const float* GBp = (const float*)(ws + WS_GB);
    const int arr = tid < 128 ? 0 : (tid < 256 ? 1 : 2);
    const int dch = arr == 2 ? 32 * dvq + ((tid - 256) & 31) : (tid & 127);
    const bf16_t* src = (const bf16_t*)(ws + (arr == 0 ? WS_QB : arr == 1 ? WS_KB : WS_VB)) + h * 128 + dch;
    float w0 = 0.f, w1 = 0.f, w2 = 0.f, w3 = 0.f, x1 = 0.f, x2 = 0.f, x3 = 0.f;
    if (tid < 288) { const int ch = arr * 1024 + h * 128 + dch; w0 = convw[ch]; w1 = convw[3072 + ch]; w2 = convw[2 * 3072 + ch]; w3 = convw[3 * 3072 + ch]; }
    for (int t0 = 0; t0 < SEQ; t0 += 16) {
        const size_t tokb = (size_t)b * SEQ + t0;
        if (tid < 288) {
            bf16_t xr[16];
#pragma unroll
            for (int tt = 0; tt < 16; ++tt) xr[tt] = src[(tokb + tt) * 1024];
#pragma unroll
            for (int tt = 0; tt < 16; ++tt) {
                const float x0 = bf2f(xr[tt]);
                float y = w0 * x3 + w1 * x2 + w2 * x1 + w3 * x0;
                y = siluf_(y); x3 = x2; x2 = x1; x1 = x0;
                Y[tt * 288 + tid] = y;
                if (tid < 256) { const float sq = row16_sum(y * y); if ((lane & 15) == 0) NR[tt * 16 + wid * 4 + (lane >> 4)] = sq; }
            }
        }
        if (tid >= 480) { const int i = tid - 480, tt = i >> 1, which = i & 1; GBs[tt * 2 + which] = GBp[(tokb + tt) * 16 + which * 8 + h]; }
        __syncthreads();
        if (tid < 16) {
            const f32x4 a = *(const LAS f32x4*)(NR + tid * 16), b2 = *(const LAS f32x4*)(NR + tid * 16 + 4), c2 = *(const LAS f32x4*)(NR + tid * 16 + 8), d2 = *(const LAS f32x4*)(NR + tid * 16 + 12);
            const float sq_q = ((a[0] + a[1]) + (a[2] + a[3])) + ((b2[0] + b2[1]) + (b2[2] + b2[3])), sq_k = ((c2[0] + c2[1]) + (c2[2] + c2[3])) + ((d2[0] + d2[1]) + (d2[2] + d2[3]));
            *(LAS f32x4*)(SC + tid * 4) = (f32x4){rsqrtf(sq_q + EPS) * 0.08838834764831845f, rsqrtf(sq_k + EPS), __expf(GBs[tid * 2 + 1]), GBs[tid * 2]};
        }
        __syncthreads();
#pragma unroll 4
        for (int tt = 0; tt < 16; ++tt) {
            const f32x4 sc = *(const LAS f32x4*)(SC + tt * 4);
            const float qn = sc[0], kn = sc[1], eg = sc[2], bt = sc[3];
            const f32x4 ka = *(const LAS f32x4*)(Y + tt * 288 + 128 + 8 * grp), kb = *(const LAS f32x4*)(Y + tt * 288 + 128 + 8 * grp + 4);
            const f32x4 qa = *(const LAS f32x4*)(Y + tt * 288 + 8 * grp), qb = *(const LAS f32x4*)(Y + tt * 288 + 8 * grp + 4);
            const float vv = Y[tt * 288 + 256 + dvloc];
            float ks = (ka[0] * S[0] + ka[1] * S[1]) + (ka[2] * S[2] + ka[3] * S[3]) + (kb[0] * S[4] + kb[1] * S[5]) + (kb[2] * S[6] + kb[3] * S[7]);
            ks = row16_sum(ks);
            const float c = bt * (vv - eg * ks * kn) * kn;
            float op = 0.f;
#pragma unroll
            for (int i = 0; i < 4; ++i) { S[i] = eg * S[i] + ka[i] * c; op += qa[i] * S[i]; S[4 + i] = eg * S[4 + i] + kb[i] * c; op += qb[i] * S[4 + i]; }
            op = row16_sum(op);
            if (grp == 0) VB[(tokb + tt) * 1024 + h * 128 + dv] = f2bf(op * qn);
        }
        __syncthreads();
    }
}

__device__ __forceinline__ float row8_sum(float v) {
    v += __builtin_bit_cast(float, __builtin_amdgcn_update_dpp(0, __builtin_bit_cast(int, v), 0x141, 0xf, 0xf, false));
    v += __builtin_bit_cast(float, __builtin_amdgcn_update_dpp(0, __builtin_bit_cast(int, v), 0x1B, 0xf, 0xf, false));
    v += __builtin_bit_cast(float, __builtin_amdgcn_update_dpp(0, __builtin_bit_cast(int, v), 0xB1, 0xf, 0xf, false));
    return v;
}
constexpr int DN_T = 32;
constexpr int DN2_YB = DN_T * 288 + DN_T * 16 + DN_T * 2 + DN_T * 4;
__device__ __forceinline__ void dn_pc(LAS unsigned char* lds, unsigned char* ws, const float* convw  , int b, int h, int dvq, int tid, bool do_store = true) {
    const int lane = tid & 63, wid = tid >> 6;
    const bool producer = tid >= 256;
    const int pt = tid - 256;
    LAS float* L = (LAS float*)lds;
    bf16_t* VB = (bf16_t*)(ws + WS_VB);
    const float* GBp = (const float*)(ws + WS_GB);
    const int parr = pt < 128 ? 0 : 1, pd = pt & 127;
    const bf16_t* src = (const bf16_t*)(ws + (parr == 0 ? WS_QB : WS_KB)) + h * 128 + pd;
    const bf16_t* srcv = (const bf16_t*)(ws + WS_VB) + h * 128 + 32 * dvq + (pt & 31);
    float w0 = 0.f, w1 = 0.f, w2 = 0.f, w3 = 0.f, x1 = 0.f, x2 = 0.f, x3 = 0.f, u0 = 0.f, u1 = 0.f, u2 = 0.f, u3 = 0.f, z1 = 0.f, z2 = 0.f, z3 = 0.f;
    if (producer) { const int ch = parr * 1024 + h * 128 + pd; w0 = convw[ch]; w1 = convw[3072 + ch]; w2 = convw[2 * 3072 + ch]; w3 = convw[3 * 3072 + ch];
        if (pt < 32) { const int cv = 2048 + h * 128 + 32 * dvq + pt; u0 = convw[cv]; u1 = convw[3072 + cv]; u2 = convw[2 * 3072 + cv]; u3 = convw[3 * 3072 + cv]; } }
    const int col = tid >> 3, grp = tid & 7;
    float S[16];
#pragma unroll
    for (int i = 0; i < 16; ++i) S[i] = 0.f;
#define DN2_PRODUCE(BUF, T0) do { LAS float* Yp = L + (BUF) * DN2_YB; LAS float* NRp = Yp + DN_T * 288; LAS float* GBsp = NRp + DN_T * 16; const size_t tb_ = (size_t)b * SEQ + (T0); \
        bf16_t xr[DN_T]; bf16_t vr[DN_T]; \
        _Pragma("unroll") for (int tt = 0; tt < DN_T; ++tt) xr[tt] = src[(tb_ + tt) * 1024]; \
        if (pt < 32) { _Pragma("unroll") for (int tt = 0; tt < DN_T; ++tt) vr[tt] = srcv[(tb_ + tt) * 1024]; } \
        if (pt >= 256 - 2 * DN_T) { const int i_ = pt - (256 - 2 * DN_T), tt_ = i_ >> 1, wh_ = i_ & 1; GBsp[tt_ * 2 + wh_] = GBp[(tb_ + tt_) * 16 + wh_ * 8 + h]; } \
        _Pragma("unroll") for (int tt = 0; tt < DN_T; ++tt) { const float x0 = bf2f(xr[tt]); float y = w0 * x3 + w1 * x2 + w2 * x1 + w3 * x0; y = siluf_(y); x3 = x2; x2 = x1; x1 = x0; \
            Yp[tt * 288 + pt] = y; const float sq = row16_sum(y * y); if ((lane & 15) == 0) NRp[tt * 16 + (wid - 4) * 4 + (lane >> 4)] = sq; } \
        if (pt < 32) { _Pragma("unroll") for (int tt = 0; tt < DN_T; ++tt) { const float x0 = bf2f(vr[tt]); float y = u0 * z3 + u1 * z2 + u2 * z1 + u3 * x0; y = siluf_(y); z3 = z2; z2 = z1; z1 = x0; Yp[tt * 288 + 256 + pt] = y; } } \
    } while (0)
    if (producer) DN2_PRODUCE(0, 0);
    for (int n = 0; n < SEQ / DN_T; ++n) {
        const int buf = n & 1;
        LAS float* Y = L + buf * DN2_YB; LAS float* NR = Y + DN_T * 288; LAS float* GBs = NR + DN_T * 16; LAS float* SC = GBs + DN_T * 2;
        __syncthreads();
        if (tid < DN_T) {
            const f32x4 a = *(const LAS f32x4*)(NR + tid * 16), b2 = *(const LAS f32x4*)(NR + tid * 16 + 4), c2 = *(const LAS f32x4*)(NR + tid * 16 + 8), d2 = *(const LAS f32x4*)(NR + tid * 16 + 12);
            const float sq_q = ((a[0] + a[1]) + (a[2] + a[3])) + ((b2[0] + b2[1]) + (b2[2] + b2[3])), sq_k = ((c2[0] + c2[1]) + (c2[2] + c2[3])) + ((d2[0] + d2[1]) + (d2[2] + d2[3]));
            *(LAS f32x4*)(SC + tid * 4) = (f32x4){rsqrtf(sq_q + EPS) * 0.08838834764831845f, rsqrtf(sq_k + EPS), __expf(GBs[tid * 2 + 1]), GBs[tid * 2]};
        }
        __syncthreads();
        if (producer) { if (n + 1 < SEQ / DN_T) DN2_PRODUCE(buf ^ 1, DN_T * (n + 1)); }
        else {
            const size_t tokb = (size_t)b * SEQ + DN_T * n;
#pragma unroll 8
            for (int tt = 0; tt < DN_T; ++tt) {
                const f32x4 sc = *(const LAS f32x4*)(SC + tt * 4);
                const float qn = sc[0], kn = sc[1], eg = sc[2], bt = sc[3];
                const LAS f32x4* kp = (const LAS f32x4*)(Y + tt * 288 + 128 + 16 * grp); const LAS f32x4* qp = (const LAS f32x4*)(Y + tt * 288 + 16 * grp);
                const f32x4 k0 = kp[0], k1 = kp[1], k2 = kp[2], k3 = kp[3], q0 = qp[0], q1 = qp[1], q2 = qp[2], q3 = qp[3];
                const float vv = Y[tt * 288 + 256 + col];
                float ks = ((k0[0] * S[0] + k0[1] * S[1]) + (k0[2] * S[2] + k0[3] * S[3])) + ((k1[0] * S[4] + k1[1] * S[5]) + (k1[2] * S[6] + k1[3] * S[7]))
                         + ((k2[0] * S[8] + k2[1] * S[9]) + (k2[2] * S[10] + k2[3] * S[11])) + ((k3[0] * S[12] + k3[1] * S[13]) + (k3[2] * S[14] + k3[3] * S[15]));
                ks = row8_sum(ks);
                const float c = bt * (vv - eg * ks * kn) * kn;
                float op0 = 0.f, op1 = 0.f;
#pragma unroll
                for (int i = 0; i < 4; ++i) { S[i] = eg * S[i] + k0[i] * c; op0 += q0[i] * S[i]; S[4 + i] = eg * S[4 + i] + k1[i] * c; op1 += q1[i] * S[4 + i];
                                              S[8 + i] = eg * S[8 + i] + k2[i] * c; op0 += q2[i] * S[8 + i]; S[12 + i] = eg * S[12 + i] + k3[i] * c; op1 += q3[i] * S[12 + i]; }
                const float op = row8_sum(op0 + op1);
                if (grp == 0 && do_store) VB[(tokb + tt) * 1024 + h * 128 + 32 * dvq + col] = f2bf(op * qn);
                if (!do_store) asm volatile("" :: "v"(op));
            }
        }
    }
    __syncthreads();
#undef DN2_PRODUCE
}

#define GEMM_PHASE(EPI, Aptr, Bptr, Mv, Nv, Kv, Eobj, HM) do { int m_ = (Mv), n_ = (Nv), k_ = (Kv); asm volatile("" : "+s"(m_), "+s"(n_), "+s"(k_)); pg8::Gemm g_{(const pg8::bf16_t*)(Aptr), (const pg8::bf16_t*)(Bptr), m_, n_, k_, (HM)}; pg8::StaticOrder S_; S_.init(m_, n_, G, bid); \
        pg8::gemm_phase<EPI, pg8::StaticOrder, true, true>(lds, g_, S_, (Eobj)); } while (0)

__global__ void __launch_bounds__(NTHR, 2) fwd_mega(Params P) {
    extern __shared__ __attribute__((aligned(16))) unsigned char lds_raw[];
    LAS unsigned char* lds = (LAS unsigned char*)lds_raw;
    cg::grid_group grid = cg::this_grid();
    if (threadIdx.x == 0) {
        const unsigned xcc = (unsigned)__builtin_amdgcn_s_getreg((3 << 11) | 20) & 7u;
        const unsigned loc = __hip_atomic_fetch_add((unsigned*)(P.ws + WS_CTL) + xcc, 1u, __ATOMIC_RELAXED, __HIP_MEMORY_SCOPE_AGENT);
        *(LAS int*)(lds + LDS_VB) = (int)((loc & 31u) * 8u + xcc);
    }
    __syncthreads();
    int seg = 0; const int seg_lo = P.seg_lo, seg_hi = P.seg_hi;
#ifdef L2FLUSH
#define L2_FLUSH() do { const Params* PF = (const Params*)__builtin_amdgcn_kernarg_segment_ptr(); asm volatile("" : "+s"(PF)); int tf_ = threadIdx.x; asm volatile("" : "+v"(tf_)); \
        const u32x4* jp = (const u32x4*)(PF->in[I_P]) + (size_t)blockIdx.x * (L2FLUSH * 64) + tf_; unsigned acc_ = 0u; \
        for (int q_ = 0; q_ < L2FLUSH * 64 / 512; ++q_) { const u32x4 v_ = __builtin_nontemporal_load(jp + (size_t)q_ * 512); acc_ |= v_.x & v_.y & v_.z & v_.w; asm volatile("" ::: "memory"); } \
        if (acc_ == 0x12345678u) PF->out[0] = 0.f; } while (0)
#else
#define L2_FLUSH() do {} while (0)
#endif
#ifdef NOSEG
#define SYNCCOND true
#else
#define SYNCCOND (seg >= seg_lo && seg + 1 < seg_hi)
#endif
#define GRID_SYNC() do { if (SYNCCOND) { asm volatile("s_waitcnt vmcnt(0) lgkmcnt(0)" ::: "memory");   grid.sync(); L2_FLUSH(); \
        if (threadIdx.x < 64) { __builtin_amdgcn_fence(__ATOMIC_ACQUIRE, "agent"); asm volatile("s_waitcnt vmcnt(0)" ::: "memory"); } __syncthreads();     \
        } ++seg; } while (0)
#ifdef NOSEG
#define SEGCOND true
#else
#define SEGCOND (seg >= seg_lo && seg < seg_hi)
#endif
#define PH_BEGIN if (SEGCOND) { const Params* PQ = (const Params*)__builtin_amdgcn_kernarg_segment_ptr(); asm volatile("" : "+s"(PQ)); int tid = threadIdx.x; asm volatile("" : "+v"(tid)); \
    const int lane = tid & 63, wave = __builtin_amdgcn_readfirstlane(tid >> 6); int bid = __builtin_amdgcn_readfirstlane(*(LAS int*)(lds + LDS_VB)), G = gridDim.x; asm volatile("" : "+s"(bid), "+s"(G)); \
    const int xb_ = bid & 7, jb_ = bid >> 3, wj = jb_ * NW + wave;     \
    unsigned char* ws = PQ->ws; float* X = PQ->out; float* SS = (float*)(ws + WS_SS); bf16_t* XB = (bf16_t*)(ws + WS_XB); \
    float* ss_attn = (float*)(ws + WS_HALO); float* ss_ffn = ss_attn + (size_t)MTOK * 16; float* ss_ple = ss_ffn + (size_t)MTOK * 16; float* ss_next = ss_attn; \
    (void)lane; (void)xb_; (void)jb_; (void)wj; (void)X; (void)XB; (void)ss_attn; (void)ss_ffn; (void)ss_ple; (void)ss_next; (void)G;
#define PH_END }
#define U ((bf16_t*)(ws + WS_MIX))
#define ACT ((bf16_t*)(ws + WS_MIX + 176 * MiB))

    { const int layer = 0; PH_BEGIN
      if (bid == 0 && tid == 0) __hip_atomic_store((unsigned*)(ws + WS_CTL) + 16, 0u, __ATOMIC_RELAXED, __HIP_MEMORY_SCOPE_AGENT);
      const float* xin = PQ->in[I_X];
      for (int r = wj; r < SEQ; r += 256) {
          const int m = xb_ * SEQ + r;
          const f32x4* xr = (const f32x4*)(xin + (size_t)m * 1024) + lane;
          f32x4 v[4]; float s = 0.f;
#pragma unroll
          for (int jj = 0; jj < 4; ++jj) { v[jj] = xr[64 * jj]; s += (v[jj][0] * v[jj][0] + v[jj][1] * v[jj][1]) + (v[jj][2] * v[jj][2] + v[jj][3] * v[jj][3]); }
          s = wave_sum(s);
          if (lane < 16) ss_attn[(size_t)m * 16 + lane] = lane == 0 ? s : 0.f;
          f32x4* xo = (f32x4*)(X + (size_t)m * 1024) + lane;
          u32x2* bo = (u32x2*)(XB + (size_t)m * 1024) + lane;
#pragma unroll
          for (int jj = 0; jj < 4; ++jj) { xo[64 * jj] = v[jj]; u32x2 w; w.x = pk2(v[jj][0], v[jj][1]); w.y = pk2(v[jj][2], v[jj][3]); bo[64 * jj] = w; }
      }
    PH_END }

    for (int layer = 0; layer < NLAYER; ++layer) {
        asm volatile("" ::: "memory");
        const float lam_init = 0.8f - 0.6f * __expf(-0.3f * (float)layer);
        PH_BEGIN
        convert_weights(PQ, layer, lds, bid * NW + wave, G * NW, wave, lane);
        { const float* pl = PQ->in[I_P] + ((size_t)layer * MTOK + (size_t)xb_ * SEQ) * DPLE;
          bf16_t* pb = (bf16_t*)(ws + WS_PB) + (size_t)xb_ * SEQ * DPLE;
          for (int i = jb_ * NTHR + tid; i < SEQ * DPLE / 8; i += 32 * NTHR) {
              const f32x4 a = *(const f32x4*)(pl + (size_t)i * 8), b = *(const f32x4*)(pl + (size_t)i * 8 + 4);
              u32x4 w; w.x = pk2(a[0], a[1]); w.y = pk2(a[2], a[3]); w.z = pk2(b[0], b[1]); w.w = pk2(b[2], b[3]);
              *(u32x4*)(pb + (size_t)i * 8) = w;
          }
        }
        PH_END
        GRID_SYNC();
#ifdef DBLTEST
#ifdef DBL_SC
#define DBL_LD(p) ldc16(p)
#else
#define DBL_LD(p) (*(p))
#endif
        if (layer == 0) {
#ifdef DBL_OUTP
        PH_BEGIN
        { EpiResid E{X, XB, ss_ffn, nullptr, -1};
          GEMM_PHASE(EpiResid, ws + WS_VT, ws + W_OUT, MTOK, 1024, 1024, E, -1); }
        PH_END
        GRID_SYNC();
#endif
        for (int rep = 0; rep < 2; ++rep) {
        PH_BEGIN
#ifdef DBL_COPY
            { const u32x4* s4 = (const u32x4*)XB; u32x4* d4 = (u32x4*)(ws + WS_MIX + (size_t)rep * 176 * MiB);
              const size_t per = (size_t)DBL_M * DBL_N * 2 / 16 / 8;
              for (size_t i = (size_t)((jb_ + rep * 13) & 31) * NTHR + tid; i < per; i += (size_t)32 * NTHR) d4[(size_t)xb_ * per + i] = DBL_LD(s4 + (size_t)xb_ * per + i); }
#else
#ifndef DBL_W
#define DBL_W W_UP
#define DBL_ACT 0
#endif
            { EpiRowScale<DBL_ACT> E{(bf16_t*)(ws + WS_MIX + (size_t)rep * DBL_OFF * MiB), DBL_N, ss_attn, DBL_H};
              GEMM_PHASE(EpiRowScale<DBL_ACT>, XB, ws + DBL_W, DBL_M, DBL_N, 1024, E, DBL_H); }
#endif
        PH_END
        GRID_SYNC();
        }
        PH_BEGIN
        { const u32x4* a4 = (const u32x4*)(ws + WS_MIX); const u32x4* b4 = (const u32x4*)(ws + WS_MIX + (size_t)DBL_OFF * MiB); unsigned bad = 0u;
          const size_t per = (size_t)DBL_M * DBL_N * 2 / 16 / 8;
          for (size_t i0 = (size_t)((jb_ + 7) & 31) * NTHR + tid; i0 < per; i0 += (size_t)32 * NTHR) { const size_t i = (size_t)xb_ * per + i0; const u32x4 a = DBL_LD(a4 + i), b = DBL_LD(b4 + i); bad |= ((a.x ^ b.x) | (a.y ^ b.y) | (a.z ^ b.z) | (a.w ^ b.w)) ? 1u : 0u; }
          if (bad) __hip_atomic_fetch_or((unsigned*)(ws + WS_CTL) + 16, 1u, __ATOMIC_RELAXED, __HIP_MEMORY_SCOPE_AGENT); }
        PH_END
        GRID_SYNC();
        }
#endif
#if defined(DBLMIX) && !defined(DBLMIX_AT_GATES)
        for (int rep = 0; rep < 2; ++rep) {
#endif
#ifndef NO_INPROJ
        PH_BEGIN
        { EpiQK E{ws, ss_attn, PQ->in[I_QNORM] + layer * 64, PQ->in[I_KNORM] + layer * 64};
          GEMM_PHASE(EpiQK, XB, ws + W_IN, MTOK, 2048, 1024, E, -1); }
        PH_END
        PH_BEGIN
        { EpiSeg E{ws, ss_attn};
          GEMM_PHASE(EpiSeg, XB, ws + W_IN + (size_t)2048 * 2048, MTOK, 4096, 1024, E, -1); }
        PH_END
#ifdef SEG_PROBE
        PH_BEGIN
        { EpiSeg E{ws, ss_attn};
          GEMM_PHASE(EpiSeg, XB, ws + W_IN + (size_t)2048 * 2048, MTOK, 4096, 1024, E, -1); }
        PH_END
#endif
        PH_BEGIN
        { EpiGB E{ws, ss_attn, PQ->in[I_ALOG] + layer * 8, PQ->in[I_DTB] + layer * 8};
          GEMM_PHASE(EpiGB, XB, ws + W_IN + (size_t)6144 * 2048, MTOK, 256, 1024, E, -1); }
        PH_END
        PH_BEGIN
        { EpiVt E{(bf16_t*)(ws + WS_VT), ss_attn};
          GEMM_PHASE(EpiVt, ws + W_V, XB, 1024, MTOK, 1024, E, -1); }
        PH_END
#endif
        GRID_SYNC();
#ifndef NO_ATTN
        PH_BEGIN
        { const float* lq = PQ->in[I_LAM] + layer * 256;
          const float a1 = wave_sum(lq[lane] * lq[64 + lane]), a2 = wave_sum(lq[128 + lane] * lq[192 + lane]);
          const float lam = __expf(a1) - __expf(a2) + lam_init;
#ifdef ATTN_PROBE
          for (int k = 0; k < 4; ++k) {
              const int pi = jb_ + 32 * k, hh = pi >> 4, s = pi & 15;
              attn_unit(lds, (const bf16_t*)(ws + WS_QA), (const bf16_t*)(ws + WS_KA), (const bf16_t*)(ws + WS_VT), (bf16_t*)(ws + WS_QA), xb_, hh, 31 - s, lam, 1.f - lam_init, PQ->in[I_SUBLN] + layer * 128, PQ->in[I_RELB], tid, false);
              attn_unit(lds, (const bf16_t*)(ws + WS_QA), (const bf16_t*)(ws + WS_KA), (const bf16_t*)(ws + WS_VT), (bf16_t*)(ws + WS_QA), xb_, hh, s, lam, 1.f - lam_init, PQ->in[I_SUBLN] + layer * 128, PQ->in[I_RELB], tid, false);
          }
          __syncthreads();
#endif
          for (int k = 0; k < 4; ++k) {
              const int pi = jb_ + 32 * k, hh = pi >> 4, s = pi & 15;
              attn_unit(lds, (const bf16_t*)(ws + WS_QA), (const bf16_t*)(ws + WS_KA), (const bf16_t*)(ws + WS_VT), (bf16_t*)(ws + WS_QA), xb_, hh, 31 - s, lam, 1.f - lam_init, PQ->in[I_SUBLN] + layer * 128, PQ->in[I_RELB], tid);
              attn_unit(lds, (const bf16_t*)(ws + WS_QA), (const bf16_t*)(ws + WS_KA), (const bf16_t*)(ws + WS_VT), (bf16_t*)(ws + WS_QA), xb_, hh, s, lam, 1.f - lam_init, PQ->in[I_SUBLN] + layer * 128, PQ->in[I_RELB], tid);
          }
        }
        PH_END
#endif
#ifndef NO_DN
        PH_BEGIN
#ifdef DN_NAIVE
        if (jb_ < 8) dn_naive(lds, ws, PQ->in[I_CONVB] + (size_t)layer * 4 * 3072, xb_, jb_, tid);
#else
#ifdef DN_FAST1
        dn_fast(lds, ws, PQ->in[I_CONVB] + (size_t)layer * 4 * 3072, xb_, jb_ >> 2, jb_ & 3, tid);
#else
#ifdef DN_PROBE
        dn_pc(lds, ws, PQ->in[I_CONVB] + (size_t)layer * 4 * 3072, xb_, jb_ >> 2, jb_ & 3, tid, false);
#endif
        dn_pc(lds, ws, PQ->in[I_CONVB] + (size_t)layer * 4 * 3072, xb_, jb_ >> 2, jb_ & 3, tid);
#endif
#endif
        PH_END
#endif
        GRID_SYNC();
#if defined(DBLMIX) && defined(DBLMIX_AT_GATES)
        for (int rep = 0; rep < 2; ++rep) {
#endif
#ifndef NO_GATES
        PH_BEGIN
        { EpiRowScale<1> E{(bf16_t*)(ws + WS_G), 2048, ss_attn, -1};
          GEMM_PHASE(EpiRowScale<1>, XB, ws + W_GL, MTOK, 2048, 1024, E, -1); }
        PH_END
#endif
#ifndef NO_OBNORM
        PH_BEGIN
        { const float* on = PQ->in[I_ONORM] + layer * 128;
          const float g0 = on[2 * lane], g1 = on[2 * lane + 1];
          unsigned* OB = (unsigned*)(ws + WS_QB) + (size_t)xb_ * SEQ * 512; const unsigned* OI = (const unsigned*)(ws + WS_OSRC) + (size_t)xb_ * SEQ * 512; const unsigned* ZB = (const unsigned*)(ws + WS_ZB) + (size_t)xb_ * SEQ * 512;
#pragma unroll 4
          for (int r = wj; r < SEQ * NH; r += 256) {
              const unsigned ov = OI[(size_t)r * 64 + lane], zv = ZB[(size_t)r * 64 + lane];
              const float o0 = bflo(ov), o1 = bfhi(ov);
              const float sq = wave_sum(o0 * o0 + o1 * o1);
              const float rr = rsqrtf(sq * (1.f / 128.f) + EPS);
              OB[(size_t)r * 64 + lane] = pk2(o0 * rr * g0 * siluf_(bflo(zv)), o1 * rr * g1 * siluf_(bfhi(zv)));
          }
        }
        PH_END
#endif
        GRID_SYNC();
#ifndef NO_TMPA
        PH_BEGIN
        { EpiGateMul E{(bf16_t*)(ws + WS_TMPA), (const bf16_t*)(ws + WS_G), 2048, 0, nullptr};
          GEMM_PHASE(EpiGateMul, ws + WS_QA, ws + W_BRA, MTOK, 1024, 1024, E, -1); }
        PH_END
#endif
        GRID_SYNC();
#ifndef NO_MIXED
        PH_BEGIN
        { EpiGateMul E{(bf16_t*)(ws + WS_MIXED), (const bf16_t*)(ws + WS_G), 2048, 1024, (const bf16_t*)(ws + WS_TMPA)};
          GEMM_PHASE(EpiGateMul, ws + WS_QB, ws + W_BRB, MTOK, 1024, 1024, E, -1); }
        PH_END
#endif
        GRID_SYNC();
#ifdef DBLMIX
        PH_BEGIN
        { const u32x4* t4 = (const u32x4*)(ws + (size_t)DBL_TGT + (size_t)xb_ * ((size_t)DBL_TGT_BYTES / 8)); u32x4* s4 = (u32x4*)(ws + WS_PB + (size_t)xb_ * 2 * MiB); unsigned bad = 0u;
          for (size_t i = (size_t)((jb_ + 5 * rep) & 31) * NTHR + tid; i < (size_t)2 * MiB / 16; i += (size_t)32 * NTHR) {
              const u32x4 a = t4[i];
              if (rep == 0) s4[i] = a; else { const u32x4 b = s4[i]; bad |= ((a.x ^ b.x) | (a.y ^ b.y) | (a.z ^ b.z) | (a.w ^ b.w)) ? 1u : 0u; } }
          if (bad) __hip_atomic_fetch_or((unsigned*)(ws + WS_CTL) + 16, 1u, __ATOMIC_RELAXED, __HIP_MEMORY_SCOPE_AGENT); }
        PH_END
        GRID_SYNC();
        }
#endif
#ifndef NO_OUTP
        PH_BEGIN
        { EpiResid E{X, XB, ss_ffn, nullptr, -1};
          GEMM_PHASE(EpiResid, ws + WS_MIXED, ws + W_OUT, MTOK, 1024, 1024, E, -1); }
        PH_END
#endif
        GRID_SYNC();
        for (int half = 0; half < 2; ++half) {
#ifndef NO_UP
        PH_BEGIN
            { EpiRowScale<0> E{U, 5632, ss_ffn, half};
              GEMM_PHASE(EpiRowScale<0>, XB, ws + W_UP, 16384, 5632, 1024, E, half); }
        PH_END
#endif
            GRID_SYNC();
#ifndef NO_ACT
        PH_BEGIN
            { const float* cw = PQ->in[I_CONVFF] + (size_t)layer * 3 * 5632; const float* cb = PQ->in[I_CONVFFB] + (size_t)layer * 5632;
              bf16_t* UH = (bf16_t*)(ws + WS_UHALO) + (size_t)xb_ * 2 * 5632;
              for (int it = jb_ * NTHR + tid; it < 128 * 352; it += 32 * NTHR) {
                  const int cc = it % 352, rg = it / 352, c0 = cc * 8;
                  const int lrow0 = xb_ * 2048 + rg * 16;
                  float wg[3][8], wv[3][8], bg[8], bv[8];
#pragma unroll
                  for (int jj = 0; jj < 3; ++jj)
#pragma unroll
                      for (int e = 0; e < 8; ++e) { wg[jj][e] = cw[jj * 5632 + c0 + e]; wv[jj][e] = cw[jj * 5632 + 2816 + c0 + e]; }
#pragma unroll
                  for (int e = 0; e < 8; ++e) { bg[e] = cb[c0 + e]; bv[e] = cb[2816 + c0 + e]; }
                  float g2[8], g1[8], v2[8], v1[8];
#pragma unroll
                  for (int e = 0; e < 8; ++e) { g2[e] = 0.f; g1[e] = 0.f; v2[e] = 0.f; v1[e] = 0.f; }
                  if (rg > 0 || half == 1) {
                      const bf16_t* r2p = rg > 0 ? U + (size_t)(lrow0 - 2) * 5632 : UH;
                      const bf16_t* r1p = rg > 0 ? U + (size_t)(lrow0 - 1) * 5632 : UH + 5632;
                      const u32x4 a = *(const u32x4*)(r2p + c0), bq = *(const u32x4*)(r1p + c0);
                      const u32x4 c = *(const u32x4*)(r2p + 2816 + c0), d = *(const u32x4*)(r1p + 2816 + c0);
                      g2[0] = bflo(a.x); g2[1] = bfhi(a.x); g2[2] = bflo(a.y); g2[3] = bfhi(a.y); g2[4] = bflo(a.z); g2[5] = bfhi(a.z); g2[6] = bflo(a.w); g2[7] = bfhi(a.w);
                      g1[0] = bflo(bq.x); g1[1] = bfhi(bq.x); g1[2] = bflo(bq.y); g1[3] = bfhi(bq.y); g1[4] = bflo(bq.z); g1[5] = bfhi(bq.z); g1[6] = bflo(bq.w); g1[7] = bfhi(bq.w);
                      v2[0] = bflo(c.x); v2[1] = bfhi(c.x); v2[2] = bflo(c.y); v2[3] = bfhi(c.y); v2[4] = bflo(c.z); v2[5] = bfhi(c.z); v2[6] = bflo(c.w); v2[7] = bfhi(c.w);
                      v1[0] = bflo(d.x); v1[1] = bfhi(d.x); v1[2] = bflo(d.y); v1[3] = bfhi(d.y); v1[4] = bflo(d.z); v1[5] = bfhi(d.z); v1[6] = bflo(d.w); v1[7] = bfhi(d.w);
                  }
#pragma unroll 4
                  for (int rr = 0; rr < 16; ++rr) {
                      const size_t row = (size_t)lrow0 + rr;
                      const u32x4 a = *(const u32x4*)(U + row * 5632 + c0), c = *(const u32x4*)(U + row * 5632 + 2816 + c0);
                      if (half == 0 && rg == 127 && rr >= 14) { *(u32x4*)(UH + (size_t)(rr - 14) * 5632 + c0) = a; *(u32x4*)(UH + (size_t)(rr - 14) * 5632 + 2816 + c0) = c; }
                      float g0[8], v0[8], ov[8];
                      g0[0] = bflo(a.x); g0[1] = bfhi(a.x); g0[2] = bflo(a.y); g0[3] = bfhi(a.y); g0[4] = bflo(a.z); g0[5] = bfhi(a.z); g0[6] = bflo(a.w); g0[7] = bfhi(a.w);
                      v0[0] = bflo(c.x); v0[1] = bfhi(c.x); v0[2] = bflo(c.y); v0[3] = bfhi(c.y); v0[4] = bflo(c.z); v0[5] = bfhi(c.z); v0[6] = bflo(c.w); v0[7] = bfhi(c.w);
#pragma unroll
                      for (int e = 0; e < 8; ++e) {
                          const float ug = wg[0][e] * g2[e] + wg[1][e] * g1[e] + wg[2][e] * g0[e] + bg[e];
                          const float uv = wv[0][e] * v2[e] + wv[1][e] * v1[e] + wv[2][e] * v0[e] + bv[e];
                          ov[e] = siluf_(ug) * uv; g2[e] = g1[e]; g1[e] = g0[e]; v2[e] = v1[e]; v1[e] = v0[e];
                      }
                      u32x4 w; w.x = pk2(ov[0], ov[1]); w.y = pk2(ov[2], ov[3]); w.z = pk2(ov[4], ov[5]); w.w = pk2(ov[6], ov[7]);
                      *(u32x4*)(ACT + row * 2816 + c0) = w;
                  }
              }
            }
        PH_END
#endif
            GRID_SYNC();
#ifndef NO_DOWN
        PH_BEGIN
            { EpiResid E{X, XB, ss_ple, nullptr, half};
              GEMM_PHASE(EpiResid, ACT, ws + W_DOWN, 16384, 1024, 2816, E, -1); }
        PH_END
#endif
            GRID_SYNC();
        }
#ifndef NO_PLEG
        PH_BEGIN
        { EpiRowScale<1> E{(bf16_t*)(ws + WS_MIX), 1024, ss_ple, -1};
          GEMM_PHASE(EpiRowScale<1>, XB, ws + W_PG, MTOK, 1024, 1024, E, -1); }
        PH_END
#endif
        GRID_SYNC();
#ifndef NO_PLE
        PH_BEGIN
        { EpiResid E{X, XB, ss_next, (const bf16_t*)(ws + WS_MIX), -1};
          GEMM_PHASE(EpiResid, ws + WS_PB, ws + W_PP, MTOK, 1024, 256, E, -1); }
        PH_END
#endif
        GRID_SYNC();
    }
#ifdef NANCHK
    { const int layer = 0; PH_BEGIN
      unsigned bad = 0u;
      for (size_t i = (size_t)bid * NTHR + tid; i < (size_t)MTOK * 256; i += (size_t)G * NTHR) { const f32x4 v = *(const f32x4*)(X + i * 4);
          for (int e = 0; e < 4; ++e) bad |= ((__float_as_uint(v[e]) & 0x7f800000u) == 0x7f800000u) ? 1u : 0u; }
#ifdef NANCHK_BF_LO
      { const unsigned* bp = (const unsigned*)(ws + (size_t)NANCHK_BF_LO); const size_t nw = ((size_t)NANCHK_BF_HI - (size_t)NANCHK_BF_LO) / 4;
        for (size_t i = (size_t)bid * NTHR + tid; i < nw; i += (size_t)G * NTHR) { const unsigned w = bp[i]; bad |= (((w & 0x7f80u) == 0x7f80u) || ((w & 0x7f800000u) == 0x7f800000u)) ? 1u : 0u; } }
#endif
      if (bad) __hip_atomic_fetch_or((unsigned*)(ws + WS_CTL) + 16, 1u, __ATOMIC_RELAXED, __HIP_MEMORY_SCOPE_AGENT);
      PH_END }
    GRID_SYNC();
    { const int layer = 0; PH_BEGIN
      const unsigned fl = __hip_atomic_fetch_or((unsigned*)(ws + WS_CTL) + 16, 0u, __ATOMIC_RELAXED, __HIP_MEMORY_SCOPE_AGENT);
      if (fl) for (size_t i = (size_t)bid * NTHR + tid; i < (size_t)MTOK * 256; i += (size_t)G * NTHR) *(f32x4*)(X + i * 4) = (f32x4){0.f, 0.f, 0.f, 0.f};
      PH_END }
#endif
#undef U
#undef ACT
}

extern "C" void kernel_launch(void* const* d_in, const int* in_sizes, int n_in, void* d_out, int out_size, void* d_ws, size_t ws_size, hipStream_t stream) {
    static int grid = 0;
    if (grid == 0) {
        if (n_in != 24 || out_size != MTOK * DM || ws_size < WS_TOTAL) { fprintf(stderr, "kernel_launch: unexpected shapes / workspace (n_in %d out %d ws %zu need %zu)\n", n_in, out_size, ws_size, (size_t)WS_TOTAL); grid = -1; return; }
        int dev = 0, cus = 0, per_cu = 0;
        hipGetDevice(&dev);
        hipDeviceGetAttribute(&cus, hipDeviceAttributeMultiprocessorCount, dev);
        hipFuncSetAttribute((const void*)fwd_mega, hipFuncAttributeMaxDynamicSharedMemorySize, LDS_BYTES);
        hipOccupancyMaxActiveBlocksPerMultiprocessor(&per_cu, (const void*)fwd_mega, NTHR, LDS_BYTES);
        if (per_cu < 1) { fprintf(stderr, "kernel_launch: occupancy query says %d blocks per CU\n", per_cu); per_cu = 1; }
        (void)hipGetLastError();
        grid = cus;
    }
    if (grid < 0) return;
    Params p{};
    for (int i = 0; i < 24; ++i) p.in[i] = (const float*)d_in[i];
    p.out = (float*)d_out; p.ws = (unsigned char*)d_ws;
    hipError_t e = hipSuccess;
#ifdef N_SEG_LAUNCH
    for (int sgi = 0; sgi < 60 && e == hipSuccess; sgi += N_SEG_LAUNCH) {
        p.seg_lo = sgi; p.seg_hi = sgi + N_SEG_LAUNCH;
        void* args[] = {&p};
        e = hipLaunchCooperativeKernel((const void*)fwd_mega, dim3(grid), dim3(NTHR), args, LDS_BYTES, stream);
    }
#else
    p.seg_lo = 0; p.seg_hi = 1000;
    void* args[] = {&p};
    e = hipLaunchCooperativeKernel((const void*)fwd_mega, dim3(grid), dim3(NTHR), args, LDS_BYTES, stream);
#endif
    if (e != hipSuccess) fprintf(stderr, "cooperative launch failed: %s (grid %d)\n", hipGetErrorString(e), grid);
}
```

```cpp
#include <hip/hip_runtime.h>
#include <hip/hip_cooperative_groups.h>
#include <cstdio>
#include <cstdint>
namespace cg = cooperative_groups;
namespace pg8 {
#define PG8_LAS __attribute__((address_space(3)))
typedef unsigned short bf16_t;
typedef short bf16x8 __attribute__((ext_vector_type(8)));
typedef float f32x4 __attribute__((ext_vector_type(4)));
typedef unsigned u32x4 __attribute__((ext_vector_type(4)));
constexpr int BM = 256, BK = 64, HALF = 128, HTB = HALF * BK * 2  , STAGE_BYTES = 8 * HTB, NXCD = 8, WGM = 8;

__host__ __device__ __forceinline__ int lds_byte(int r, int c) { const int st = (r >> 4) * 2 + (c >> 5), rr = r & 15, cc = c & 31, ob = rr * 64 + cc * 2; return st * 1024 + (ob ^ (((ob >> 9) & 1) << 5)); }
__host__ __device__ __forceinline__ void stage_rc(int b, int& R, int& C) { const int st = b / 1024, sb = b % 1024, swz = sb ^ (((sb >> 9) & 1) << 5); R = (st >> 1) * 16 + swz / 64; C = (st & 1) * 32 + (swz % 64) / 2; }
__host__ __device__ __forceinline__ int perm32(int rho) { const int n = rho >> 4, i = rho & 15; return 8 * (i >> 2) + 4 * n + (i & 3); }

struct Unit { int pm, pn; };
struct Gemm { const bf16_t* A; const bf16_t* Bt; int M, N, K; int hmap; };
__device__ __forceinline__ int amap(int pm, int hmap) { return hmap < 0 ? pm : ((pm >> 3) * 16 + 8 * hmap + (pm & 7)); }

struct StaticOrder {
    int nM, nN, nwg, G, c;
    __host__ __device__ void init(int M, int N, int G_, int c_) { nM = M / BM; nN = N / BM; nwg = nM * nN; G = G_; c = c_; }
    __host__ __device__ bool next(int i, Unit& u) const {
        const long L = (long)i * G + c; if (L >= nwg) return false;
        int wgid = (int)L; { const int q = nwg / NXCD, r = nwg % NXCD, xcd = wgid % NXCD, off = wgid / NXCD; wgid = (xcd < r ? xcd * (q + 1) : r * (q + 1) + (xcd - r) * q) + off; }
        const int nig = WGM * nN, gid = wgid / nig, fm = gid * WGM, gsz = (nM - fm) < WGM ? (nM - fm) : WGM;
        u.pm = fm + ((wgid % nig) % gsz); u.pn = (wgid % nig) / gsz; return true;
    }
    __device__ __forceinline__ void a_ready(const Unit&) const {}
    __device__ __forceinline__ void done(const Unit&) const {}
};
__device__ __forceinline__ unsigned cvt_pk_bf16(float lo, float hi) { unsigned r; asm volatile("v_cvt_pk_bf16_f32 %0, %1, %2" : "=v"(r) : "v"(lo), "v"(hi)); return r; }
#ifdef NO_UNI
__device__ __forceinline__ const char* uni(const char* p) { return p; }
#else
__device__ __forceinline__ const char* uni(const char* p) { const unsigned long long v = (unsigned long long)p; const unsigned lo = __builtin_amdgcn_readfirstlane((unsigned)v), hi = __builtin_amdgcn_readfirstlane((unsigned)(v >> 32)); return (const char*)(((unsigned long long)hi << 32) | lo); }
#endif
template <class Epi, class Sched, bool ALIGN_EPI = false, bool SP2 = false>
__device__ __forceinline__ void gemm_phase(PG8_LAS unsigned char* lds, const Gemm g, const Sched& S, const Epi& E) {
    int tid = threadIdx.x;
#ifndef NO_LAUNDER
    asm volatile("" : "+v"(tid));
#endif

    const int wid = __builtin_amdgcn_readfirstlane(tid >> 6), lane = tid & 63, wr = wid >> 2, wc = wid & 3, fr = lane & 15, fq = lane >> 4;
    const int K = g.K, nt = K / BK;
    unsigned voffA[2], voffB[2];
#pragma unroll
    for (int i = 0; i < 2; ++i) { int R, C; stage_rc(tid * 16 + i * 8192, R, C); const int Rb = Epi::PERM ? ((R & ~31) + perm32(R & 31)) : R;
        voffA[i] = (unsigned)(R * K + C) * 2u; voffB[i] = (unsigned)(Rb * K + C) * 2u; }
    const size_t kstep = (size_t)(BK * 2);
    const size_t hstep = (size_t)HALF * K * 2;
    const size_t tstep = 2 * hstep;
    const unsigned ldsw = (unsigned)wid * 1024u;
    const int aoff = lds_byte(wr * 64 + fr, fq * 8), boff = lds_byte(wc * 32 + fr, fq * 8);
#define PG8_SA(b, h) (((b) * 2 + (h)) * HTB)
#define PG8_SB(b, h) ((4 + (b) * 2 + (h)) * HTB)
#define PG8_STAGE(bufoff, gbase, voff) do { _Pragma("unroll") for (int _i = 0; _i < 2; ++_i) \
        __builtin_amdgcn_global_load_lds((const unsigned*)((const char*)(gbase) + (voff)[_i]), (PG8_LAS unsigned*)(lds + (bufoff) + ldsw + _i * 8192), 16, 0, 0); } while (0)
#define PG8_LDA(dst, b, h) do { _Pragma("unroll") for (int m = 0; m < 4; ++m) _Pragma("unroll") for (int k = 0; k < 2; ++k) dst[m][k] = *(const PG8_LAS bf16x8*)(lds + PG8_SA(b, h) + aoff + m * 2048 + k * 1024); } while (0)
#define PG8_LDB(dst, b, h) do { _Pragma("unroll") for (int n = 0; n < 2; ++n) _Pragma("unroll") for (int k = 0; k < 2; ++k) dst[n][k] = *(const PG8_LAS bf16x8*)(lds + PG8_SB(b, h) + boff + n * 2048 + k * 1024); } while (0)
#define PG8_MMA(ai, bj, At, Bt) do { __builtin_amdgcn_s_setprio(1); _Pragma("unroll") for (int m = 0; m < 4; ++m) _Pragma("unroll") for (int n = 0; n < 2; ++n) _Pragma("unroll") for (int k = 0; k < 2; ++k) \
        acc[ai][bj][m][n] = __builtin_amdgcn_mfma_f32_16x16x32_bf16(Bt[n][k], At[m][k], acc[ai][bj][m][n], 0, 0, 0); __builtin_amdgcn_s_setprio(0); } while (0)
#define PG8_WAIT_V(n) asm volatile("s_waitcnt vmcnt(" #n ")" ::: "memory")
#define PG8_WAIT_L(n) asm volatile("s_waitcnt lgkmcnt(" #n ")" ::: "memory")
#define PG8_BAR __builtin_amdgcn_s_barrier()
#define PG8_SCHED __builtin_amdgcn_sched_barrier(0)
    Unit cur, nxt; int ui = 0;
    if (!S.next(0, cur)) return;
    f32x4 acc[2][2][4][2];
#pragma unroll
    for (int a = 0; a < 2; ++a)
#pragma unroll
        for (int b = 0; b < 2; ++b)
#pragma unroll
            for (int m = 0; m < 4; ++m)
#pragma unroll
                for (int n = 0; n < 2; ++n) acc[a][b][m][n] = (f32x4){0.f, 0.f, 0.f, 0.f};
    bf16x8 At[4][2], B0[2][2], B1[2][2];
    const char* cA = uni((const char*)g.A + (size_t)amap(cur.pm, g.hmap) * tstep); const char* cB = uni((const char*)g.Bt + (size_t)cur.pn * tstep);
    S.a_ready(cur);
    if constexpr (SP2) {
        PG8_STAGE(PG8_SB(0, 0), cB, voffB); PG8_STAGE(PG8_SB(0, 1), cB + hstep, voffB); PG8_STAGE(PG8_SA(0, 0), cA, voffA); PG8_STAGE(PG8_SA(0, 1), cA + hstep, voffA);
        if (wr == 1) PG8_BAR;
        PG8_WAIT_V(2); PG8_BAR;
        PG8_STAGE(PG8_SB(1, 0), cB + kstep, voffB); PG8_STAGE(PG8_SA(1, 0), cA + kstep, voffA); PG8_STAGE(PG8_SB(1, 1), cB + hstep + kstep, voffB);
        PG8_WAIT_V(6); PG8_BAR;
    } else {
        PG8_STAGE(PG8_SB(0, 0), cB, voffB); PG8_STAGE(PG8_SA(0, 0), cA, voffA); PG8_STAGE(PG8_SB(0, 1), cB + hstep, voffB); PG8_STAGE(PG8_SA(0, 1), cA + hstep, voffA);
        if (wr == 1) PG8_BAR;
        PG8_WAIT_V(4); PG8_BAR;
        PG8_STAGE(PG8_SB(1, 0), cB + kstep, voffB); PG8_STAGE(PG8_SA(1, 0), cA + kstep, voffA); PG8_STAGE(PG8_SB(1, 1), cB + hstep + kstep, voffB);
        PG8_WAIT_V(6); PG8_BAR;
    }
    for (;;) {
        const bool has_next = S.next(ui + 1, nxt);
        const char* nA = uni(has_next ? (const char*)g.A + (size_t)amap(nxt.pm, g.hmap) * tstep : cA); const char* nB = uni(has_next ? (const char*)g.Bt + (size_t)nxt.pn * tstep : cB);
        for (int t = 0; t < nt; t += 2) {
            const bool last = (t == nt - 2);
            const char* a1 = cA + (size_t)(t + 1) * kstep;
            const char* a2 = last ? nA : cA + (size_t)(t + 2) * kstep; const char* b2 = last ? nB : cB + (size_t)(t + 2) * kstep;
            const char* a3 = a2 + kstep; const char* b3 = b2 + kstep;
            if (last && has_next) S.a_ready(nxt);
            if constexpr (SP2) {
            PG8_LDB(B0, 0, 0); PG8_LDB(B1, 0, 1); PG8_SCHED; PG8_LDA(At, 0, 0); PG8_STAGE(PG8_SA(1, 1), a1 + hstep, voffA);
            PG8_WAIT_V(8); PG8_WAIT_L(0); PG8_BAR; PG8_MMA(0, 0, At, B0); PG8_MMA(0, 1, At, B1); PG8_BAR; PG8_SCHED;
            PG8_LDA(At, 0, 1); PG8_STAGE(PG8_SB(0, 0), b2, voffB); PG8_STAGE(PG8_SB(0, 1), b2 + hstep, voffB); PG8_STAGE(PG8_SA(0, 0), a2, voffA);
            PG8_WAIT_V(8); PG8_WAIT_L(0); PG8_BAR; PG8_MMA(1, 0, At, B0); PG8_MMA(1, 1, At, B1); PG8_BAR; PG8_SCHED;
            PG8_LDB(B0, 1, 0); PG8_LDB(B1, 1, 1); PG8_SCHED; PG8_LDA(At, 1, 0); PG8_STAGE(PG8_SA(0, 1), a2 + hstep, voffA);
            PG8_WAIT_V(8); PG8_WAIT_L(0); PG8_BAR; PG8_MMA(0, 0, At, B0); PG8_MMA(0, 1, At, B1); PG8_BAR; PG8_SCHED;
            PG8_LDA(At, 1, 1); PG8_STAGE(PG8_SB(1, 0), b3, voffB); PG8_STAGE(PG8_SB(1, 1), b3 + hstep, voffB); PG8_STAGE(PG8_SA(1, 0), a3, voffA);
            PG8_WAIT_V(8); PG8_WAIT_L(0); PG8_BAR; PG8_MMA(1, 0, At, B0); PG8_MMA(1, 1, At, B1); PG8_BAR; PG8_SCHED;
            } else {
            PG8_LDB(B0, 0, 0); PG8_SCHED; PG8_LDA(At, 0, 0); PG8_STAGE(PG8_SA(1, 1), a1 + hstep, voffA);
            PG8_WAIT_L(8); PG8_BAR; PG8_WAIT_L(0); PG8_MMA(0, 0, At, B0); PG8_BAR; PG8_SCHED;
            PG8_LDB(B1, 0, 1); PG8_STAGE(PG8_SB(0, 0), b2, voffB);
            PG8_BAR; PG8_WAIT_L(0); PG8_MMA(0, 1, At, B1); PG8_BAR;
            PG8_LDA(At, 0, 1); PG8_STAGE(PG8_SA(0, 0), a2, voffA);
            PG8_BAR; PG8_WAIT_L(0); PG8_MMA(1, 0, At, B0); PG8_BAR; PG8_SCHED;
            PG8_STAGE(PG8_SB(0, 1), b2 + hstep, voffB);
            PG8_WAIT_V(6); PG8_BAR; PG8_MMA(1, 1, At, B1); PG8_BAR;
            PG8_LDB(B0, 1, 0); PG8_SCHED; PG8_LDA(At, 1, 0); PG8_STAGE(PG8_SA(0, 1), a2 + hstep, voffA);
            PG8_WAIT_L(8); PG8_BAR; PG8_WAIT_L(0); PG8_MMA(0, 0, At, B0); PG8_BAR; PG8_SCHED;
            PG8_LDB(B1, 1, 1); PG8_STAGE(PG8_SB(1, 0), b3, voffB);
            PG8_BAR; PG8_WAIT_L(0); PG8_MMA(0, 1, At, B1); PG8_BAR;
            PG8_LDA(At, 1, 1); PG8_STAGE(PG8_SA(1, 0), a3, voffA);
            PG8_BAR; PG8_WAIT_L(0); PG8_MMA(1, 0, At, B0); PG8_BAR; PG8_SCHED;
            PG8_STAGE(PG8_SB(1, 1), b3 + hstep, voffB);
            PG8_WAIT_V(6); PG8_BAR; PG8_MMA(1, 1, At, B1); PG8_BAR;
            }
        }
        if constexpr (ALIGN_EPI) { if (wr == 0) PG8_BAR; }
        if constexpr (!Epi::AFTER_DRAIN) { E(acc, cur, wr, wc, fr, fq); S.done(cur); }
        if (!has_next) break;
#pragma unroll
        for (int a = 0; a < 2; ++a)
#pragma unroll
            for (int b = 0; b < 2; ++b)
#pragma unroll
                for (int m = 0; m < 4; ++m)
#pragma unroll
                    for (int n = 0; n < 2; ++n) acc[a][b][m][n] = (f32x4){0.f, 0.f, 0.f, 0.f};
        cur = nxt; cA = nA; cB = nB; ++ui;
        if constexpr (ALIGN_EPI) { if (wr == 1) PG8_BAR; }
    }
    PG8_WAIT_V(0);
    if constexpr (!ALIGN_EPI) { if (wr == 0) PG8_BAR; }
    PG8_BAR;
    if constexpr (Epi::AFTER_DRAIN) { E.fused(acc, cur, wr, wc, fr, fq, lds, wid, lane); S.done(cur); }
#undef PG8_SA
#undef PG8_SB
#undef PG8_STAGE
#undef PG8_LDA
#undef PG8_LDB
#undef PG8_MMA
#undef PG8_WAIT_V
#undef PG8_WAIT_L
#undef PG8_BAR
#undef PG8_SCHED
}
}

#define GAS __attribute__((address_space(1)))
#define LAS __attribute__((address_space(3)))
typedef unsigned short bf16_t;
typedef float f32x4 __attribute__((ext_vector_type(4)));
typedef float f32x16 __attribute__((ext_vector_type(16)));
typedef short bf16x8 __attribute__((ext_vector_type(8)));
typedef unsigned u32x4 __attribute__((ext_vector_type(4)));
typedef unsigned u32x2 __attribute__((ext_vector_type(2)));

#ifndef NLAYER_V
#define NLAYER_V 4
#endif
constexpr int NW = 8, NTHR = 512;
constexpr int MTOK = 32768, DM = 1024, SEQ = 4096, NB = 8, NLAYER = NLAYER_V, NH = 8;
constexpr int DIN = 9232, DFF = 2816, DPLE = 256;
constexpr float EPS = 1e-6f;
constexpr float LOG2E = 1.4426950408889634f;
constexpr size_t MiB = 1u << 20;
constexpr size_t WS_SS = 0;
constexpr size_t WS_CTL = 1792 * 1024;
constexpr size_t WS_UHALO = 1856 * 1024;
constexpr size_t WS_GB = 2 * MiB;
constexpr size_t WS_HALO = 4 * MiB;
constexpr size_t WS_PB = 14 * MiB;
constexpr size_t WS_W = 30 * MiB;
constexpr size_t W_IN = WS_W, W_V = W_IN + (size_t)6400 * 1024 * 2, W_GL = W_V + 2 * MiB, W_BRA = W_GL + 4 * MiB, W_BRB = W_BRA + 2 * MiB,
                 W_OUT = W_BRB + 2 * MiB, W_UP = W_OUT + 2 * MiB, W_DOWN = W_UP + 11 * MiB, W_PG = W_DOWN + (size_t)1024 * 2816 * 2, W_PP = W_PG + 2 * MiB, W_END = W_PP + (size_t)1024 * 256 * 2;
static_assert(W_END <= 74 * MiB, "weights region");
constexpr size_t WS_XB = 74 * MiB;
constexpr size_t WS_MIX = 138 * MiB;
constexpr size_t S64 = 64 * MiB;
constexpr size_t WS_QA = WS_MIX, WS_KA = WS_MIX + S64, WS_VT = WS_MIX + 2 * S64, WS_QB = WS_MIX + 3 * S64, WS_KB = WS_MIX + 4 * S64, WS_VB = WS_MIX + 5 * S64, WS_ZB = WS_MIX + 6 * S64;
constexpr size_t WS_TOTAL = WS_MIX + 7 * S64;
#ifdef DN_NAIVE
constexpr size_t WS_G = WS_KB, WS_TMPA = WS_KA, WS_MIXED = WS_VT, WS_OSRC = WS_QB;
#else
constexpr size_t WS_G = WS_KA, WS_TMPA = WS_KB, WS_MIXED = WS_VB, WS_OSRC = WS_VB;
#endif
constexpr int LDS_BYTES = 147456, LDS_VB = 140032;

__device__ __forceinline__ float bflo(unsigned w) { return __uint_as_float(w << 16); }
__device__ __forceinline__ float bfhi(unsigned w) { return __uint_as_float(w & 0xffff0000u); }
__device__ __forceinline__ float bf2f(bf16_t v) { return __uint_as_float((unsigned)v << 16); }
typedef float f32x2_t __attribute__((ext_vector_type(2))); typedef __bf16 bf16x2_t __attribute__((ext_vector_type(2)));
__device__ __forceinline__ unsigned pk2(float lo, float hi) { const f32x2_t v = {lo, hi}; const bf16x2_t b = __builtin_convertvector(v, bf16x2_t); return __builtin_bit_cast(unsigned, b); }
__device__ __forceinline__ bf16_t f2bf(float f) { return (bf16_t)(pk2(f, 0.f) & 0xffffu); }
__device__ __forceinline__ float sigmoidf_(float x) { x = fminf(fmaxf(x, -60.f), 60.f); return __builtin_amdgcn_rcpf(1.f + __expf(-x)); }
__device__ __forceinline__ float siluf_(float x) { return x * sigmoidf_(x); }
__device__ __forceinline__ float wave_sum(float v) {
#pragma unroll
    for (int o = 1; o < 64; o <<= 1) v += __shfl_xor(v, o);
    return v;
}
__device__ __forceinline__ float ss_load(const float* p) { const f32x4 a = *(const f32x4*)p, b = *(const f32x4*)(p + 4), c = *(const f32x4*)(p + 8), d = *(const f32x4*)(p + 12);
    float s = (((a[0] + a[1]) + (a[2] + a[3])) + ((b[0] + b[1]) + (b[2] + b[3]))) + (((c[0] + c[1]) + (c[2] + c[3])) + ((d[0] + d[1]) + (d[2] + d[3])));
    asm volatile("" : "+v"(s) :: "memory");
    return s; }
__device__ __forceinline__ u32x4 ldc16(const void* p) { u32x4 v; asm volatile("global_load_dwordx4 %0, %1, off sc0 sc1\n\ts_waitcnt vmcnt(0)" : "=v"(v) : "v"(p) : "memory"); return v; }
__device__ __forceinline__ int crow(int r, int hi) { return (r & 3) + 8 * (r >> 2) + 4 * hi; }

__device__ __forceinline__ float ss_sum16(const f32x4 a, const f32x4 b, const f32x4 c, const f32x4 d) {
    return (((a[0] + a[1]) + (a[2] + a[3])) + ((b[0] + b[1]) + (b[2] + b[3]))) + (((c[0] + c[1]) + (c[2] + c[3])) + ((d[0] + d[1]) + (d[2] + d[3]))); }
__device__ __forceinline__ int gmap(int row, int h) { return h < 0 ? row : ((row >> 11) * 4096 + 2048 * h + (row & 2047)); }

__device__ __forceinline__ void load_rs8(const float* ss, int rowbase, int hmap, int lane, int fr, float (&rs)[2][4]) {
    const float* p0 = ss + (size_t)gmap(rowbase + lane, hmap) * 16; const float* p1 = ss + (size_t)gmap(rowbase + 128 + lane, hmap) * 16;
    const f32x4 a0 = *(const f32x4*)p0, b0 = *(const f32x4*)(p0 + 4), c0 = *(const f32x4*)(p0 + 8), d0 = *(const f32x4*)(p0 + 12);
    const f32x4 a1 = *(const f32x4*)p1, b1 = *(const f32x4*)(p1 + 4), c1 = *(const f32x4*)(p1 + 8), d1 = *(const f32x4*)(p1 + 12);
    const float r0 = rsqrtf(ss_sum16(a0, b0, c0, d0) * (1.f / 1024.f) + EPS), r1 = rsqrtf(ss_sum16(a1, b1, c1, d1) * (1.f / 1024.f) + EPS);
#pragma unroll
    for (int m = 0; m < 4; ++m) { rs[0][m] = __shfl(r0, m * 16 + fr); rs[1][m] = __shfl(r1, m * 16 + fr); }
    asm volatile("" ::: "memory");
}

using pg8::Unit;
typedef f32x4 AccT[2][2][4][2];

template <int ACT> struct EpiRowScale {
    static constexpr bool PERM = true, AFTER_DRAIN = false;
    bf16_t* O; int ldc; const float* ss; int hmap;
    __device__ __forceinline__ void operator()(const AccT& acc, const Unit& u, int wr, int wc, int fr, int fq) const {
        const int row0 = u.pm * 256 + wr * 64 + fr, col0 = u.pn * 256 + wc * 32 + 8 * fq;
        float rsv[2][4]; load_rs8(ss, u.pm * 256 + wr * 64, hmap, (int)(threadIdx.x & 63), fr, rsv);
#pragma unroll
        for (int ai = 0; ai < 2; ++ai)
#pragma unroll
            for (int m = 0; m < 4; ++m) {
                const int row = row0 + ai * 128 + m * 16;
                const float rs = rsv[ai][m];
                bf16_t* rowp = O + (size_t)row * ldc + col0;
#pragma unroll
                for (int bj = 0; bj < 2; ++bj) {
                    f32x4 v0 = acc[ai][bj][m][0] * rs, v1 = acc[ai][bj][m][1] * rs;
                    if (ACT == 1) {
#pragma unroll
                        for (int e = 0; e < 4; ++e) { v0[e] = sigmoidf_(v0[e]); v1[e] = sigmoidf_(v1[e]); }
                    }
                    u32x4 w; w.x = pk2(v0[0], v0[1]); w.y = pk2(v0[2], v0[3]); w.z = pk2(v1[0], v1[1]); w.w = pk2(v1[2], v1[3]);
                    *(u32x4*)(rowp + bj * 128) = w;
                    asm volatile("" ::: "memory");
                }
            }
    }
};

struct EpiVt {
    static constexpr bool PERM = true, AFTER_DRAIN = false;
    bf16_t* O; const float* ss;
    __device__ __forceinline__ void operator()(const AccT& acc, const Unit& u, int wr, int wc, int fr, int fq) const {
        const int row0 = u.pm * 256 + wr * 64 + fr, col0 = u.pn * 256 + wc * 32 + 8 * fq;
        float rs[2][8];
        { const int L = (int)(threadIdx.x & 63); const float* pc = ss + (size_t)(u.pn * 256 + (L >> 5) * 128 + wc * 32 + (L & 31)) * 16;
          const f32x4 a = *(const f32x4*)pc, b = *(const f32x4*)(pc + 4), c = *(const f32x4*)(pc + 8), d = *(const f32x4*)(pc + 12);
          const float r = rsqrtf(ss_sum16(a, b, c, d) * (1.f / 1024.f) + EPS);
#pragma unroll
          for (int bj = 0; bj < 2; ++bj)
#pragma unroll
              for (int e = 0; e < 8; ++e) rs[bj][e] = __shfl(r, bj * 32 + 8 * fq + e); }
#pragma unroll
        for (int ai = 0; ai < 2; ++ai)
#pragma unroll
            for (int m = 0; m < 4; ++m) {
                const int row = row0 + ai * 128 + m * 16;
                bf16_t* rowp = O + (size_t)row * MTOK + col0;
#pragma unroll
                for (int bj = 0; bj < 2; ++bj) {
                    const f32x4 v0 = acc[ai][bj][m][0], v1 = acc[ai][bj][m][1];
                    u32x4 w; w.x = pk2(v0[0] * rs[bj][0], v0[1] * rs[bj][1]); w.y = pk2(v0[2] * rs[bj][2], v0[3] * rs[bj][3]);
                    w.z = pk2(v1[0] * rs[bj][4], v1[1] * rs[bj][5]); w.w = pk2(v1[2] * rs[bj][6], v1[3] * rs[bj][7]);
                    *(u32x4*)(rowp + bj * 128) = w;
                }
                asm volatile("" ::: "memory");
            }
    }
};

struct EpiGateMul {
    static constexpr bool PERM = true, AFTER_DRAIN = false;
    bf16_t* O; const bf16_t* G; int ldg, goff; const bf16_t* Add;
    __device__ __forceinline__ void operator()(const AccT& acc, const Unit& u, int wr, int wc, int fr, int fq) const {
        const int row0 = u.pm * 256 + wr * 64 + fr, col0 = u.pn * 256 + wc * 32 + 8 * fq;
#pragma unroll
        for (int ai = 0; ai < 2; ++ai)
#pragma unroll
            for (int m = 0; m < 4; ++m) {
                const int row = row0 + ai * 128 + m * 16;
#pragma unroll
                for (int bj = 0; bj < 2; ++bj) {
                    const int c = col0 + bj * 128;
                    const u32x4 g = *(const u32x4*)(G + (size_t)row * ldg + goff + c);
                    u32x4 a = (u32x4){0u, 0u, 0u, 0u};
                    if (Add) a = *(const u32x4*)(Add + (size_t)row * 1024 + c);
                    const f32x4 v0 = acc[ai][bj][m][0], v1 = acc[ai][bj][m][1];
                    u32x4 w;
                    w.x = pk2(bflo(a.x) + bflo(g.x) * v0[0], bfhi(a.x) + bfhi(g.x) * v0[1]);
                    w.y = pk2(bflo(a.y) + bflo(g.y) * v0[2], bfhi(a.y) + bfhi(g.y) * v0[3]);
                    w.z = pk2(bflo(a.z) + bflo(g.z) * v1[0], bfhi(a.z) + bfhi(g.z) * v1[1]);
                    w.w = pk2(bflo(a.w) + bflo(g.w) * v1[2], bfhi(a.w) + bfhi(g.w) * v1[3]);
                    *(u32x4*)(O + (size_t)row * 1024 + c) = w;
                }
                asm volatile("" ::: "memory");
            }
    }
};

struct EpiResid {
    static constexpr bool PERM = true, AFTER_DRAIN = false;
    float* X; bf16_t* XB; float* ssn; const bf16_t* Mul; int hmap;
    __device__ __forceinline__ void operator()(const AccT& acc, const Unit& u, int wr, int wc, int fr, int fq) const {
        const int row0 = u.pm * 256 + wr * 64 + fr, col0 = u.pn * 256 + wc * 32 + 8 * fq;
#pragma unroll
        for (int ai = 0; ai < 2; ++ai)
#pragma unroll
            for (int m = 0; m < 4; ++m) {
                const int row = gmap(row0 + ai * 128 + m * 16, hmap);
                const size_t off0 = (size_t)row * 1024 + col0;
                f32x4 xa = *(const f32x4*)(X + off0), xb2 = *(const f32x4*)(X + off0 + 4), xc = *(const f32x4*)(X + off0 + 128), xd = *(const f32x4*)(X + off0 + 132);
                f32x4 va = acc[ai][0][m][0], vb2 = acc[ai][0][m][1], vc = acc[ai][1][m][0], vd = acc[ai][1][m][1];
                if (Mul) {
                    const u32x4 g0 = *(const u32x4*)(Mul + off0), g1 = *(const u32x4*)(Mul + off0 + 128);
                    va[0] *= bflo(g0.x); va[1] *= bfhi(g0.x); va[2] *= bflo(g0.y); va[3] *= bfhi(g0.y); vb2[0] *= bflo(g0.z); vb2[1] *= bfhi(g0.z); vb2[2] *= bflo(g0.w); vb2[3] *= bfhi(g0.w);
                    vc[0] *= bflo(g1.x); vc[1] *= bfhi(g1.x); vc[2] *= bflo(g1.y); vc[3] *= bfhi(g1.y); vd[0] *= bflo(g1.z); vd[1] *= bfhi(g1.z); vd[2] *= bflo(g1.w); vd[3] *= bfhi(g1.w);
                }
                xa += va; xb2 += vb2; xc += vc; xd += vd;
                *(f32x4*)(X + off0) = xa; *(f32x4*)(X + off0 + 4) = xb2; *(f32x4*)(X + off0 + 128) = xc; *(f32x4*)(X + off0 + 132) = xd;
                u32x4 w0; w0.x = pk2(xa[0], xa[1]); w0.y = pk2(xa[2], xa[3]); w0.z = pk2(xb2[0], xb2[1]); w0.w = pk2(xb2[2], xb2[3]);
                u32x4 w1; w1.x = pk2(xc[0], xc[1]); w1.y = pk2(xc[2], xc[3]); w1.z = pk2(xd[0], xd[1]); w1.w = pk2(xd[2], xd[3]);
                *(u32x4*)(XB + off0) = w0; *(u32x4*)(XB + off0 + 128) = w1;
                float sq = ((xa[0] * xa[0] + xa[1] * xa[1]) + (xa[2] * xa[2] + xa[3] * xa[3])) + ((xb2[0] * xb2[0] + xb2[1] * xb2[1]) + (xb2[2] * xb2[2] + xb2[3] * xb2[3]))
                         + ((xc[0] * xc[0] + xc[1] * xc[1]) + (xc[2] * xc[2] + xc[3] * xc[3])) + ((xd[0] * xd[0] + xd[1] * xd[1]) + (xd[2] * xd[2] + xd[3] * xd[3]));
                sq += __shfl_xor(sq, 16); sq += __shfl_xor(sq, 32);
                if (fq == 0) ssn[(size_t)row * 16 + u.pn * 4 + wc] = sq;
                asm volatile("" ::: "memory");
            }
    }
};

struct EpiQK {
    static constexpr bool PERM = true, AFTER_DRAIN = false;
    unsigned char* ws; const float* ss; const float* qg; const float* kg;
    __device__ __forceinline__ void operator()(const AccT& acc, const Unit& u, int wr, int wc, int fr, int fq) const {
        const int row0 = u.pm * 256 + wr * 64 + fr;
        const int seg = u.pn >> 2, tl = u.pn & 3;
        bf16_t* base = (bf16_t*)(ws + (seg == 0 ? WS_QA : WS_KA));
        const float* gp = seg == 0 ? qg : kg; const float osc = seg == 0 ? 0.125f * LOG2E : 1.0f;
        const int col0 = tl * 256 + 64 * wc + 8 * fq;
        float rsv[2][4]; load_rs8(ss, u.pm * 256 + wr * 64, -1, (int)(threadIdx.x & 63), fr, rsv);
#pragma unroll
        for (int ai = 0; ai < 2; ++ai)
#pragma unroll
            for (int m = 0; m < 4; ++m) {
                const int row = row0 + ai * 128 + m * 16;
                const float rs = rsv[ai][m];
                f32x4 v[2][2]; float sq = 0.f;
#pragma unroll
                for (int bj = 0; bj < 2; ++bj)
#pragma unroll
                    for (int n = 0; n < 2; ++n) { v[bj][n] = acc[ai][bj][m][n] * rs; const f32x4 t = v[bj][n]; sq += (t[0] * t[0] + t[1] * t[1]) + (t[2] * t[2] + t[3] * t[3]); }
                sq += __shfl_xor(sq, 16); sq += __shfl_xor(sq, 32);
                const float r2o = rsqrtf(sq * (1.f / 64.f) + EPS) * osc;
#pragma unroll
                for (int bj = 0; bj < 2; ++bj) {
                    const f32x4 ga = *(const f32x4*)(gp + 32 * bj + 8 * fq), gb = *(const f32x4*)(gp + 32 * bj + 8 * fq + 4);
                    u32x4 w;
                    w.x = pk2(v[bj][0][0] * r2o * ga[0], v[bj][0][1] * r2o * ga[1]); w.y = pk2(v[bj][0][2] * r2o * ga[2], v[bj][0][3] * r2o * ga[3]);
                    w.z = pk2(v[bj][1][0] * r2o * gb[0], v[bj][1][1] * r2o * gb[1]); w.w = pk2(v[bj][1][2] * r2o * gb[2], v[bj][1][3] * r2o * gb[3]);
                    *(u32x4*)(base + (size_t)row * 1024 + col0 + 32 * bj) = w;
                }
                asm volatile("" ::: "memory");
            }
    }
};
struct EpiSeg {
    static constexpr bool PERM = true, AFTER_DRAIN = false;
    unsigned char* ws; const float* ss;
    __device__ __forceinline__ void operator()(const AccT& acc, const Unit& u, int wr, int wc, int fr, int fq) const {
        const int row0 = u.pm * 256 + wr * 64 + fr;
        bf16_t* base = (bf16_t*)(ws + WS_QB + (size_t)(u.pn >> 2) * S64);
        const int col0 = (u.pn & 3) * 256 + wc * 32 + 8 * fq;
        float rsv[2][4]; load_rs8(ss, u.pm * 256 + wr * 64, -1, (int)(threadIdx.x & 63), fr, rsv);
#pragma unroll
        for (int ai = 0; ai < 2; ++ai)
#pragma unroll
            for (int m = 0; m < 4; ++m) {
                const int row = row0 + ai * 128 + m * 16;
                const float rs = rsv[ai][m];
#pragma unroll
                for (int bj = 0; bj < 2; ++bj) {
                    const f32x4 v0 = acc[ai][bj][m][0] * rs, v1 = acc[ai][bj][m][1] * rs;
                    u32x4 w; w.x = pk2(v0[0], v0[1]); w.y = pk2(v0[2], v0[3]); w.z = pk2(v1[0], v1[1]); w.w = pk2(v1[2], v1[3]);
                    *(u32x4*)(base + (size_t)row * 1024 + col0 + bj * 128) = w;
                }
                asm volatile("" ::: "memory");
            }
    }
};
struct EpiGB {
    static constexpr bool PERM = true, AFTER_DRAIN = false;
    unsigned char* ws; const float* ss; const float* a_log; const float* dt_bias;
    __device__ __forceinline__ void operator()(const AccT& acc, const Unit& u, int wr, int wc, int fr, int fq) const {
        const int row0 = u.pm * 256 + wr * 64 + fr;
        float rsv[2][4]; load_rs8(ss, u.pm * 256 + wr * 64, -1, (int)(threadIdx.x & 63), fr, rsv);
        if (wc == 0 && fq < 2) {
            float* GBp = (float*)(ws + WS_GB);
#pragma unroll
            for (int ai = 0; ai < 2; ++ai)
#pragma unroll
                for (int m = 0; m < 4; ++m) {
                    const int row = row0 + ai * 128 + m * 16;
                    const float rs = rsv[ai][m];
                    float v[8];
#pragma unroll
                    for (int e = 0; e < 4; ++e) { v[e] = acc[ai][0][m][0][e] * rs; v[4 + e] = acc[ai][0][m][1][e] * rs; }
                    if (fq == 0) {
#pragma unroll
                        for (int e = 0; e < 8; ++e) v[e] = sigmoidf_(v[e]);
                    } else {
#pragma unroll
                        for (int e = 0; e < 8; ++e) { const float z = v[e] + dt_bias[e]; const float sp = fmaxf(z, 0.f) + __logf(1.f + __expf(-fabsf(z))); v[e] = -__expf(a_log[e]) * sp; }
                    }
                    float* dst = GBp + (size_t)row * 16 + 8 * fq;
                    *(f32x4*)dst = (f32x4){v[0], v[1], v[2], v[3]}; *(f32x4*)(dst + 4) = (f32x4){v[4], v[5], v[6], v[7]};
                    asm volatile("" ::: "memory");
                }
        }
    }
};

__device__ __forceinline__ void cvt_item(const float* W, int ldw, int src_col0, int nvalid, const float* gain, bf16_t* WT, int K, int dst_row0, int k0, LAS float* scr, int lane) {
    const int nn = lane & 31;
#pragma unroll 8
    for (int i = 0; i < 32; ++i) {
        const int kk = 2 * i + (lane >> 5);
        float v = 0.f;
        if (nn < nvalid) { v = W[(size_t)(k0 + kk) * ldw + src_col0 + nn]; if (gain) v *= gain[k0 + kk]; }
        scr[kk * 33 + nn] = v;
    }
    asm volatile("s_waitcnt lgkmcnt(0)" ::: "memory");
    const int c = lane & 7;
#pragma unroll
    for (int j = 0; j < 4; ++j) {
        const int n = (lane >> 3) + 8 * j; const LAS float* s = scr + (8 * c) * 33 + n;
        u32x4 o; o.x = pk2(s[0 * 33], s[1 * 33]); o.y = pk2(s[2 * 33], s[3 * 33]); o.z = pk2(s[4 * 33], s[5 * 33]); o.w = pk2(s[6 * 33], s[7 * 33]);
        *(u32x4*)(WT + (size_t)(dst_row0 + n) * K + k0 + 8 * c) = o;
    }
    asm volatile("s_waitcnt lgkmcnt(0)" ::: "memory");
}

struct Params {
    const float* in[24];
    float* out;
    unsigned char* ws;
    int seg_lo, seg_hi;
};
enum { I_X = 0, I_P, I_WIN, I_ATTN_NORM, I_QNORM, I_KNORM, I_LAM, I_SUBLN, I_RELB, I_CONVB, I_ALOG, I_DTB, I_ONORM, I_WBRA, I_WBRB, I_WOUT, I_FFN_NORM, I_WUP, I_CONVFF, I_CONVFFB, I_WDOWN, I_PLE_NORM, I_WPG, I_WPP };

__device__ __forceinline__ void convert_weights(const Params* PQ, int layer, LAS unsigned char* lds, int gw, int NGW, int wave, int lane) {
    LAS float* scr = (LAS float*)(lds + wave * 16384);
    unsigned char* ws = PQ->ws;
    const float* w_in = PQ->in[I_WIN] + (size_t)layer * 1024 * DIN;
    const float* g_attn = PQ->in[I_ATTN_NORM] + layer * 1024;
    const float* g_ffn = PQ->in[I_FFN_NORM] + layer * 1024;
    const float* g_ple = PQ->in[I_PLE_NORM] + layer * 1024;
#define CVT_JOB(NITEMS, KB, SRCW, LDW, GAIN, DST, KK, SRCCOL, NVALID) \
    for (int it = gw; it < (NITEMS); it += NGW) { const int g = it / (KB), kb = it % (KB); (void)g; \
        cvt_item((SRCW), (LDW), (SRCCOL), (NVALID), (GAIN), (bf16_t*)(ws + (DST)), (KK), g * 32, kb * 64, scr, lane); } asm volatile("" ::: "memory");
    for (int it = gw; it < 200 * 16; it += NGW) {
        const int g = it >> 4, kb = it & 15, pn = g >> 3, gi = g & 7;
        int src, nv = 32;
        if (pn < 8) { const int bj = gi >> 2, wc = gi & 3; src = (pn >> 2) * 1024 + (pn & 3) * 256 + 64 * wc + 32 * bj; }
        else if (pn < 24) { src = 3072 + (pn - 8) * 256 + 32 * gi; }
        else { src = 7168; nv = (gi == 0) ? 16 : 0; }
        cvt_item(w_in, DIN, src, nv, g_attn, (bf16_t*)(ws + W_IN), 1024, g * 32, kb * 64, scr, lane);
    }
    asm volatile("" ::: "memory");
    CVT_JOB(32 * 16, 16, w_in, DIN, g_attn, W_V, 1024, 2048 + g * 32, 32)
    CVT_JOB(64 * 16, 16, w_in, DIN, g_attn, W_GL, 1024, 7184 + g * 32, 32)
    CVT_JOB(32 * 16, 16, PQ->in[I_WBRA] + (size_t)layer * 1024 * 1024, 1024, (const float*)nullptr, W_BRA, 1024, g * 32, 32)
    CVT_JOB(32 * 16, 16, PQ->in[I_WBRB] + (size_t)layer * 1024 * 1024, 1024, (const float*)nullptr, W_BRB, 1024, g * 32, 32)
    CVT_JOB(32 * 16, 16, PQ->in[I_WOUT] + (size_t)layer * 1024 * 1024, 1024, (const float*)nullptr, W_OUT, 1024, g * 32, 32)
    CVT_JOB(176 * 16, 16, PQ->in[I_WUP] + (size_t)layer * 1024 * 5632, 5632, g_ffn, W_UP, 1024, g * 32, 32)
    CVT_JOB(32 * 44, 44, PQ->in[I_WDOWN] + (size_t)layer * 2816 * 1024, 1024, (const float*)nullptr, W_DOWN, 2816, g * 32, 32)
    CVT_JOB(32 * 16, 16, PQ->in[I_WPG] + (size_t)layer * 1024 * 1024, 1024, g_ple, W_PG, 1024, g * 32, 32)
    CVT_JOB(32 * 4, 4, PQ->in[I_WPP] + (size_t)layer * 256 * 1024, 1024, (const float*)nullptr, W_PP, 256, g * 32, 32)
#undef CVT_JOB
}

constexpr int AT_KROW = 272, AT_VROW = 136  , AT_KBYTES = 64 * AT_KROW, AT_VBYTES = 128 * AT_VROW, AT_STAGE = AT_KBYTES + AT_VBYTES, AT_TB = 2 * AT_STAGE;
static_assert(AT_TB >= 65536 && AT_TB + 1024 <= LDS_BYTES, "attention LDS");
__device__ __forceinline__ void attn_unit(LAS unsigned char* lds, const bf16_t* QA, const bf16_t* KA, const bf16_t* VT, bf16_t* OA, int b, int h, int qb,
                                          float lam, float out_scale, const float* subln, const float* relb, int tid, bool do_store = true) {
    const int lane = tid & 63, wid = __builtin_amdgcn_readfirstlane(tid >> 6), j = wid >> 2, wq = wid & 3, r32 = lane & 31, hi = lane >> 5;
    const int Q0 = qb * 128, qrow = Q0 + 32 * wq + r32;
    const size_t tok = (size_t)b * SEQ + qrow;
    LAS float* TB = (LAS float*)(lds + AT_TB);
    for (int i = tid; i <= 128; i += NTHR) {
        float v = 0.f;
        if (i < 128) {
            int bk = i;
            if (i >= 16) { int lg = 16 + (int)(__logf((float)i * (1.f / 16.f)) / __logf(8.0f) * 16.f); bk = lg < 31 ? lg : 31; }
            v = (relb[bk * 8 + h] - relb[31 * 8 + h]) * LOG2E;
        }
        TB[i] = v;
    }
    bf16x8 qf[4];
#pragma unroll
    for (int d0 = 0; d0 < 4; ++d0) qf[d0] = *(const bf16x8*)(QA + tok * 1024 + h * 128 + 64 * j + 16 * d0 + 8 * hi);
    const int NT = (Q0 + 128) / 64;
    const int kr0 = tid >> 4, kc = tid & 15;
    const int vr0 = tid >> 3, vc = tid & 7;
    const bf16_t* kg = KA + ((size_t)b * SEQ + kr0) * 1024 + h * 128 + kc * 8;
    const bf16_t* vg = VT + (size_t)(h * 128 + vr0) * MTOK + (size_t)b * SEQ + vc * 8;
    u32x4 kreg0, kreg1, vreg0, vreg1;
#define AT_LOAD(t) do { kreg0 = *(const u32x4*)(kg + (size_t)(t) * 64 * 1024); kreg1 = *(const u32x4*)(kg + (size_t)((t) * 64 + 32) * 1024); \
        vreg0 = *(const u32x4*)(vg + (t) * 64); vreg1 = *(const u32x4*)(vg + (size_t)64 * MTOK + (t) * 64); } while (0)
#define AT_STORE(s) do { LAS unsigned char* kb_ = lds + (s) * AT_STAGE; LAS unsigned char* vb_ = kb_ + AT_KBYTES; \
        *(LAS u32x4*)(kb_ + kr0 * AT_KROW + kc * 16) = kreg0; *(LAS u32x4*)(kb_ + (kr0 + 32) * AT_KROW + kc * 16) = kreg1; \
        *(LAS u32x2*)(vb_ + vr0 * AT_VROW + vc * 16) = (u32x2){vreg0.x, vreg0.y}; *(LAS u32x2*)(vb_ + vr0 * AT_VROW + vc * 16 + 8) = (u32x2){vreg0.z, vreg0.w}; \
        *(LAS u32x2*)(vb_ + (vr0 + 64) * AT_VROW + vc * 16) = (u32x2){vreg1.x, vreg1.y}; *(LAS u32x2*)(vb_ + (vr0 + 64) * AT_VROW + vc * 16 + 8) = (u32x2){vreg1.z, vreg1.w}; } while (0)
    AT_LOAD(0); AT_STORE(0);
    __syncthreads();
    f32x16 o[4];
#pragma unroll
    for (int i = 0; i < 4; ++i)
#pragma unroll
        for (int r = 0; r < 16; ++r) o[i][r] = 0.f;
    float mrun = -INFINITY, lrun = 0.f;
    const int qmax_w = Q0 + 32 * wq + 31, qmin_w = Q0 + 32 * wq;
    for (int t = 0; t < NT; ++t) {
        if (t + 1 < NT) AT_LOAD(t + 1);
        const int kv0 = 64 * t;
        if (kv0 <= qmax_w) {
            const LAS unsigned char* Kb = lds + (t & 1) * AT_STAGE; const LAS unsigned char* Vb = Kb + AT_KBYTES;
            f32x16 s0, s1;
#pragma unroll
            for (int r = 0; r < 16; ++r) { s0[r] = 0.f; s1[r] = 0.f; }
#pragma unroll
            for (int d0 = 0; d0 < 4; ++d0) {
                const bf16x8 a0 = *(const LAS bf16x8*)(Kb + r32 * AT_KROW + (64 * j + 16 * d0 + 8 * hi) * 2);
                const bf16x8 a1 = *(const LAS bf16x8*)(Kb + (32 + r32) * AT_KROW + (64 * j + 16 * d0 + 8 * hi) * 2);
                s0 = __builtin_amdgcn_mfma_f32_32x32x16_bf16(a0, qf[d0], s0, 0, 0, 0);
                s1 = __builtin_amdgcn_mfma_f32_32x32x16_bf16(a1, qf[d0], s1, 0, 0, 0);
            }
            if (kv0 + 63 + 128 > qmin_w) {
#pragma unroll
                for (int r = 0; r < 16; ++r) {
                    const int rel0 = qrow - (kv0 + crow(r, hi)), rel1 = rel0 - 32;
                    s0[r] = rel0 < 0 ? -INFINITY : s0[r] + TB[rel0 < 128 ? rel0 : 128];
                    s1[r] = rel1 < 0 ? -INFINITY : s1[r] + TB[rel1 < 128 ? rel1 : 128];
                }
            }
            float mx = fmaxf(s0[0], s1[0]);
#pragma unroll
            for (int r = 1; r < 16; ++r) mx = fmaxf(mx, fmaxf(s0[r], s1[r]));
            mx = fmaxf(mx, __shfl_xor(mx, 32));
            const float mnew = fmaxf(mrun, mx);
            const float alpha = __builtin_amdgcn_exp2f(mrun - mnew);
            mrun = mnew;
            float ls = 0.f;
#pragma unroll
            for (int r = 0; r < 16; ++r) { s0[r] = __builtin_amdgcn_exp2f(s0[r] - mnew); s1[r] = __builtin_amdgcn_exp2f(s1[r] - mnew); ls += s0[r] + s1[r]; }
            lrun = lrun * alpha + ls;
#pragma unroll
            for (int i = 0; i < 4; ++i)
#pragma unroll
                for (int r = 0; r < 16; ++r) o[i][r] *= alpha;
            bf16x8 pf[4];
            { u32x4 w;
              w.x = pk2(s0[0], s0[1]); w.y = pk2(s0[2], s0[3]); w.z = pk2(s0[4], s0[5]); w.w = pk2(s0[6], s0[7]); pf[0] = __builtin_bit_cast(bf16x8, w);
              w.x = pk2(s0[8], s0[9]); w.y = pk2(s0[10], s0[11]); w.z = pk2(s0[12], s0[13]); w.w = pk2(s0[14], s0[15]); pf[1] = __builtin_bit_cast(bf16x8, w);
              w.x = pk2(s1[0], s1[1]); w.y = pk2(s1[2], s1[3]); w.z = pk2(s1[4], s1[5]); w.w = pk2(s1[6], s1[7]); pf[2] = __builtin_bit_cast(bf16x8, w);
              w.x = pk2(s1[8], s1[9]); w.y = pk2(s1[10], s1[11]); w.z = pk2(s1[12], s1[13]); w.w = pk2(s1[14], s1[15]); pf[3] = __builtin_bit_cast(bf16x8, w); }
#pragma unroll
            for (int blk = 0; blk < 4; ++blk)
#pragma unroll
                for (int s = 0; s < 4; ++s) {
                    const LAS unsigned char* vp = Vb + (32 * blk + r32) * AT_VROW + (16 * s + 4 * hi) * 2;
                    const u32x2 lo = *(const LAS u32x2*)vp, hh = *(const LAS u32x2*)(vp + 16);
                    const u32x4 w = (u32x4){lo.x, lo.y, hh.x, hh.y};
                    o[blk] = __builtin_amdgcn_mfma_f32_32x32x16_bf16(__builtin_bit_cast(bf16x8, w), pf[s], o[blk], 0, 0, 0);
                }
        }
        if (t + 1 < NT) AT_STORE((t + 1) & 1);
        __syncthreads();
    }
#undef AT_LOAD
#undef AT_STORE
    lrun += __shfl_xor(lrun, 32);
    const float inv = 1.f / lrun;
    LAS float* EX = (LAS float*)lds;
    if (j == 1) {
        const float sc = inv * lam;
#pragma unroll
        for (int blk = 0; blk < 4; ++blk)
#pragma unroll
            for (int r = 0; r < 16; ++r) EX[(wq * 64 + blk * 16 + r) * 64 + lane] = o[blk][r] * sc;
    }
    __syncthreads();
    if (j == 0) {
        float sq = 0.f;
#pragma unroll
        for (int blk = 0; blk < 4; ++blk)
#pragma unroll
            for (int r = 0; r < 16; ++r) { const float d = o[blk][r] * inv - EX[(wq * 64 + blk * 16 + r) * 64 + lane]; o[blk][r] = d; sq += d * d; }
        sq += __shfl_xor(sq, 32);
        const float rr = rsqrtf(sq * (1.f / 128.f) + EPS) * out_scale;
#pragma unroll
        for (int blk = 0; blk < 4; ++blk)
#pragma unroll
            for (int rq = 0; rq < 4; ++rq) {
                const int dv0 = 32 * blk + 8 * rq + 4 * hi;
                const f32x4 g = *(const f32x4*)(subln + dv0);
                u32x2 w; w.x = pk2(o[blk][4 * rq + 0] * rr * g[0], o[blk][4 * rq + 1] * rr * g[1]); w.y = pk2(o[blk][4 * rq + 2] * rr * g[2], o[blk][4 * rq + 3] * rr * g[3]);
                if (do_store) *(u32x2*)(OA + tok * 1024 + h * 128 + dv0) = w;
            }
    }
    __syncthreads();
}

__device__ __forceinline__ void dn_naive(LAS unsigned char* lds, unsigned char* ws, const float* convw  , int b, int h, int tid) {
    const int lane = tid & 63, wid = tid >> 6, dv = tid & 127, g4 = tid >> 7;
    LAS float* Y = (LAS float*)lds;
    LAS float* NR = Y + 384;
    LAS float* PT = NR + 8;
    LAS float* OP = PT + 512;
    float S[32];
#pragma unroll
    for (int i = 0; i < 32; ++i) S[i] = 0.f;
    bf16_t* QB = (bf16_t*)(ws + WS_QB); const bf16_t* KB = (const bf16_t*)(ws + WS_KB); const bf16_t* VB = (const bf16_t*)(ws + WS_VB);
    const float* GBp = (const float*)(ws + WS_GB);
    const int arr = tid >> 7;
    const bf16_t* src = (arr == 0 ? (const bf16_t*)QB : arr == 1 ? KB : VB) + h * 128 + dv;
    float w0 = 0.f, w1 = 0.f, w2 = 0.f, w3 = 0.f, x1 = 0.f, x2 = 0.f, x3 = 0.f;
    if (tid < 384) { const int ch = arr * 1024 + h * 128 + dv; w0 = convw[ch]; w1 = convw[3072 + ch]; w2 = convw[2 * 3072 + ch]; w3 = convw[3 * 3072 + ch]; }
    for (int t = 0; t < SEQ; ++t) {
        const size_t tok = (size_t)b * SEQ + t;
        if (tid < 384) {
            const float x0 = bf2f(src[tok * 1024]);
            float y = w0 * x3 + w1 * x2 + w2 * x1 + w3 * x0;
            y = siluf_(y); x3 = x2; x2 = x1; x1 = x0;
            Y[arr * 128 + dv] = y;
            const float sq = wave_sum(y * y);
            if (lane == 0) NR[wid] = sq;
        }
        __syncthreads();
        const float qn = rsqrtf(NR[0] + NR[1] + EPS) * 0.08838834764831845f, kn = rsqrtf(NR[2] + NR[3] + EPS);
        const float bt = GBp[tok * 16 + h], gt = GBp[tok * 16 + 8 + h], eg = __expf(gt);
        const float vv = Y[256 + dv];
        float ks = 0.f;
#pragma unroll
        for (int i = 0; i < 32; ++i) ks += Y[128 + 32 * g4 + i] * S[i];
        PT[g4 * 128 + dv] = ks * kn;
        __syncthreads();
        const float kS = (PT[dv] + PT[128 + dv]) + (PT[256 + dv] + PT[384 + dv]);
        const float c = bt * (vv - eg * kS);
        float op = 0.f;
#pragma unroll
        for (int i = 0; i < 32; ++i) { const float kk = Y[128 + 32 * g4 + i] * kn; S[i] = eg * S[i] + kk * c; op += Y[32 * g4 + i] * S[i]; }
        OP[g4 * 128 + dv] = op * qn;
        __syncthreads();
        if (g4 == 0) { const float ov = (OP[dv] + OP[128 + dv]) + (OP[256 + dv] + OP[384 + dv]); QB[tok * 1024 + h * 128 + dv] = f2bf(ov); }
    }
    __syncthreads();
}

__device__ __forceinline__ float row16_sum(float v) {
    v += __builtin_bit_cast(float, __builtin_amdgcn_update_dpp(0, __builtin_bit_cast(int, v), 0x128, 0xf, 0xf, false));
    v += __builtin_bit_cast(float, __builtin_amdgcn_update_dpp(0, __builtin_bit_cast(int, v), 0x124, 0xf, 0xf, false));
    v += __builtin_bit_cast(float, __builtin_amdgcn_update_dpp(0, __builtin_bit_cast(int, v), 0x122, 0xf, 0xf, false));
    v += __builtin_bit_cast(float, __builtin_amdgcn_update_dpp(0, __builtin_bit_cast(int, v), 0x121, 0xf, 0xf, false));
    return v;
}
__device__ __forceinline__ void dn_fast(LAS unsigned char* lds, unsigned char* ws, const float* convw  , int b, int h, int dvq, int tid) {
    const int lane = tid & 63, wid = tid >> 6, dvl = lane >> 4, grp = lane & 15;
    const int dvloc = 4 * wid + dvl, dv = 32 * dvq + dvloc;
    LAS float* Y = (LAS float*)lds;
    LAS float* NR = Y + 16 * 288;
    LAS float* GBs = NR + 16 * 16;
    LAS float* SC = GBs + 32;
    float S[8];
#pragma unroll
    for (int i = 0; i < 8; ++i) S[i] = 0.f;
    bf16_t* VB = (bf16_t*)(ws + WS_VB);
    const float* GBp = (const float*)(ws + WS_GB);
    const int arr = tid < 128 ? 0 : (tid < 256 ? 1 : 2);
    const int dch = arr == 2 ? 32 * dvq + ((tid - 256) & 31) : (tid & 127);
    const bf16_t* src = (const bf16_t*)(ws + (arr == 0 ? WS_QB : arr == 1 ? WS_KB : WS_VB)) + h * 128 + dch;
    float w0 = 0.f, w1 = 0.f, w2 = 0.f, w3 = 0.f, x1 = 0.f, x2 = 0.f, x3 = 0.f;
    if (tid < 288) { const int ch = arr * 1024 + h * 128 + dch; w0 = convw[ch]; w1 = convw[3072 + ch]; w2 = convw[2 * 3072 + ch]; w3 = convw[3 * 3072 + ch]; }
    for (int t0 = 0; t0 < SEQ; t0 += 16) {
        const size_t tokb = (size_t)b * SEQ + t0;
        if (tid < 288) {
            bf16_t xr[16];
#pragma unroll
            for (int tt = 0; tt < 16; ++tt) xr[tt] = src[(tokb + tt) * 1024];
#pragma unroll
            for (int tt = 0; tt < 16; ++tt) {
                const float x0 = bf2f(xr[tt]);
                float y = w0 * x3 + w1 * x2 + w2 * x1 + w3 * x0;
                y = siluf_(y); x3 = x2; x2 = x1; x1 = x0;
                Y[tt * 288 + tid] = y;
                if (tid < 256) { const float sq = row16_sum(y * y); if ((lane & 15) == 0) NR[tt * 16 + wid * 4 + (lane >> 4)] = sq; }
            }
        }
        if (tid >= 480) { const int i = tid - 480, tt = i >> 1, which = i & 1; GBs[tt * 2 + which] = GBp[(tokb + tt) * 16 + which * 8 + h]; }
        __syncthreads();
        if (tid < 16) {
            const f32x4 a = *(const LAS f32x4*)(NR + tid * 16), b2 = *(const LAS f32x4*)(NR + tid * 16 + 4), c2 = *(const LAS f32x4*)(NR + tid * 16 + 8), d2 = *(const LAS f32x4*)(NR + tid * 16 + 12);
            const float sq_q = ((a[0] + a[1]) + (a[2] + a[3])) + ((b2[0] + b2[1]) + (b2[2] + b2[3])), sq_k = ((c2[0] + c2[1]) + (c2[2] + c2[3])) + ((d2[0] + d2[1]) + (d2[2] + d2[3]));
            *(LAS f32x4*)(SC + tid * 4) = (f32x4){rsqrtf(sq_q + EPS) * 0.08838834764831845f, rsqrtf(sq_k + EPS), __expf(GBs[tid * 2 + 1]), GBs[tid * 2]};
        }
        __syncthreads();
#pragma unroll 4
        for (int tt = 0; tt < 16; ++tt) {
            const f32x4 sc = *(const LAS f32x4*)(SC + tt * 4);
            const float qn = sc[0], kn = sc[1], eg = sc[2], bt = sc[3];
            const f32x4 ka = *(const LAS f32x4*)(Y + tt * 288 + 128 + 8 * grp), kb = *(const LAS f32x4*)(Y + tt * 288 + 128 + 8 * grp + 4);
            const f32x4 qa = *(const LAS f32x4*)(Y + tt * 288 + 8 * grp), qb = *(const LAS f32x4*)(Y + tt * 288 + 8 * grp + 4);
            const float vv = Y[tt * 288 + 256 + dvloc];
            float ks = (ka[0] * S[0] + ka[1] * S[1]) + (ka[2] * S[2] + ka[3] * S[3]) + (kb[0] * S[4] + kb[1] * S[5]) + (kb[2] * S[6] + kb[3] * S[7]);
            ks = row16_sum(ks);
            const float c = bt * (vv - eg * ks * kn) * kn;
            float op = 0.f;
#pragma unroll
            for (int i = 0; i < 4; ++i) { S[i] = eg * S[i] + ka[i] * c; op += qa[i] * S[i]; S[4 + i] = eg * S[4 + i] + kb[i] * c; op += qb[i] * S[4 + i]; }
            op = row16_sum(op);
            if (grp == 0) VB[(tokb + tt) * 1024 + h * 128 + dv] = f2bf(op * qn);
        }
        __syncthreads();
    }
}

__device__ __forceinline__ float row8_sum(float v) {
    v += __builtin_bit_cast(float, __builtin_amdgcn_update_dpp(0, __builtin_bit_cast(int, v), 0x141, 0xf, 0xf, false));
    v += __builtin_bit_cast(float, __builtin_amdgcn_update_dpp(0, __builtin_bit_cast(int, v), 0x1B, 0xf, 0xf, false));
    v += __builtin_bit_cast(float, __builtin_amdgcn_update_dpp(0, __builtin_bit_cast(int, v), 0xB1, 0xf, 0xf, false));
    return v;
}
constexpr int DN_T = 32;
constexpr int DN2_YB = DN_T * 288 + DN_T * 16 + DN_T * 2 + DN_T * 4;
__device__ __forceinline__ void dn_pc(LAS unsigned char* lds, unsigned char* ws, const float* convw  , int b, int h, int dvq, int tid, bool do_store = true) {
    const int lane = tid & 63, wid = tid >> 6;
    const bool producer = tid >= 256;
    const int pt = tid - 256;
    LAS float* L = (LAS float*)lds;
    bf16_t* VB = (bf16_t*)(ws + WS_VB);
    const float* GBp = (const float*)(ws + WS_GB);
    const int parr = pt < 128 ? 0 : 1, pd = pt & 127;
    const bf16_t* src = (const bf16_t*)(ws + (parr == 0 ? WS_QB : WS_KB)) + h * 128 + pd;
    const bf16_t* srcv = (const bf16_t*)(ws + WS_VB) + h * 128 + 32 * dvq + (pt & 31);
    float w0 = 0.f, w1 = 0.f, w2 = 0.f, w3 = 0.f, x1 = 0.f, x2 = 0.f, x3 = 0.f, u0 = 0.f, u1 = 0.f, u2 = 0.f, u3 = 0.f, z1 = 0.f, z2 = 0.f, z3 = 0.f;
    if (producer) { const int ch = parr * 1024 + h * 128 + pd; w0 = convw[ch]; w1 = convw[3072 + ch]; w2 = convw[2 * 3072 + ch]; w3 = convw[3 * 3072 + ch];
        if (pt < 32) { const int cv = 2048 + h * 128 + 32 * dvq + pt; u0 = convw[cv]; u1 = convw[3072 + cv]; u2 = convw[2 * 3072 + cv]; u3 = convw[3 * 3072 + cv]; } }
    const int col = tid >> 3, grp = tid & 7;
    float S[16];
#pragma unroll
    for (int i = 0; i < 16; ++i) S[i] = 0.f;
#define DN2_PRODUCE(BUF, T0) do { LAS float* Yp = L + (BUF) * DN2_YB; LAS float* NRp = Yp + DN_T * 288; LAS float* GBsp = NRp + DN_T * 16; const size_t tb_ = (size_t)b * SEQ + (T0); \
        bf16_t xr[DN_T]; bf16_t vr[DN_T]; \
        _Pragma("unroll") for (int tt = 0; tt < DN_T; ++tt) xr[tt] = src[(tb_ + tt) * 1024]; \
        if (pt < 32) { _Pragma("unroll") for (int tt = 0; tt < DN_T; ++tt) vr[tt] = srcv[(tb_ + tt) * 1024]; } \
        if (pt >= 256 - 2 * DN_T) { const int i_ = pt - (256 - 2 * DN_T), tt_ = i_ >> 1, wh_ = i_ & 1; GBsp[tt_ * 2 + wh_] = GBp[(tb_ + tt_) * 16 + wh_ * 8 + h]; } \
        _Pragma("unroll") for (int tt = 0; tt < DN_T; ++tt) { const float x0 = bf2f(xr[tt]); float y = w0 * x3 + w1 * x2 + w2 * x1 + w3 * x0; y = siluf_(y); x3 = x2; x2 = x1; x1 = x0; \
            Yp[tt * 288 + pt] = y; const float sq = row16_sum(y * y); if ((lane & 15) == 0) NRp[tt * 16 + (wid - 4) * 4 + (lane >> 4)] = sq; } \
        if (pt < 32) { _Pragma("unroll") for (int tt = 0; tt < DN_T; ++tt) { const float x0 = bf2f(vr[tt]); float y = u0 * z3 + u1 * z2 + u2 * z1 + u3 * x0; y = siluf_(y); z3 = z2; z2 = z1; z1 = x0; Yp[tt * 288 + 256 + pt] = y; } } \
    } while (0)
    if (producer) DN2_PRODUCE(0, 0);
    for (int n = 0; n < SEQ / DN_T; ++n) {
        const int buf = n & 1;
        LAS float* Y = L + buf * DN2_YB; LAS float* NR = Y + DN_T * 288; LAS float* GBs = NR + DN_T * 16; LAS float* SC = GBs + DN_T * 2;
        __syncthreads();
        if (tid < DN_T) {
            const f32x4 a = *(const LAS f32x4*)(NR + tid * 16), b2 = *(const LAS f32x4*)(NR + tid * 16 + 4), c2 = *(const LAS f32x4*)(NR + tid * 16 + 8), d2 = *(const LAS f32x4*)(NR + tid * 16 + 12);
            const float sq_q = ((a[0] + a[1]) + (a[2] + a[3])) + ((b2[0] + b2[1]) + (b2[2] + b2[3])), sq_k = ((c2[0] + c2[1]) + (c2[2] + c2[3])) + ((d2[0] + d2[1]) + (d2[2] + d2[3]));
            *(LAS f32x4*)(SC + tid * 4) = (f32x4){rsqrtf(sq_q + EPS) * 0.08838834764831845f, rsqrtf(sq_k + EPS), __expf(GBs[tid * 2 + 1]), GBs[tid * 2]};
        }
        __syncthreads();
        if (producer) { if (n + 1 < SEQ / DN_T) DN2_PRODUCE(buf ^ 1, DN_T * (n + 1)); }
        else {
            const size_t tokb = (size_t)b * SEQ + DN_T * n;
#pragma unroll 8
            for (int tt = 0; tt < DN_T; ++tt) {
                const f32x4 sc = *(const LAS f32x4*)(SC + tt * 4);
                const float qn = sc[0], kn = sc[1], eg = sc[2], bt = sc[3];
                const LAS f32x4* kp = (const LAS f32x4*)(Y + tt * 288 + 128 + 16 * grp); const LAS f32x4* qp = (const LAS f32x4*)(Y + tt * 288 + 16 * grp);
                const f32x4 k0 = kp[0], k1 = kp[1], k2 = kp[2], k3 = kp[3], q0 = qp[0], q1 = qp[1], q2 = qp[2], q3 = qp[3];
                const float vv = Y[tt * 288 + 256 + col];
                float ks = ((k0[0] * S[0] + k0[1] * S[1]) + (k0[2] * S[2] + k0[3] * S[3])) + ((k1[0] * S[4] + k1[1] * S[5]) + (k1[2] * S[6] + k1[3] * S[7]))
                         + ((k2[0] * S[8] + k2[1] * S[9]) + (k2[2] * S[10] + k2[3] * S[11])) + ((k3[0] * S[12] + k3[1] * S[13]) + (k3[2] * S[14] + k3[3] * S[15]));
                ks = row8_sum(ks);
                const float c = bt * (vv - eg * ks * kn) * kn;
                float op0 = 0.f, op1 = 0.f;
#pragma unroll
                for (int i = 0; i < 4; ++i) { S[i] = eg * S[i] + k0[i] * c; op0 += q0[i] * S[i]; S[4 + i] = eg * S[4 + i] + k1[i] * c; op1 += q1[i] * S[4 + i];
                                              S[8 + i] = eg * S[8 + i] + k2[i] * c; op0 += q2[i] * S[8 + i]; S[12 + i] = eg * S[12 + i] + k3[i] * c; op1 += q3[i] * S[12 + i]; }
                const float op = row8_sum(op0 + op1);
                if (grp == 0 && do_store) VB[(tokb + tt) * 1024 + h * 128 + 32 * dvq + col] = f2bf(op * qn);
                if (!do_store) asm volatile("" :: "v"(op));
            }
        }
    }
    __syncthreads();
#undef DN2_PRODUCE
}

#define GEMM_PHASE(EPI, Aptr, Bptr, Mv, Nv, Kv, Eobj, HM) do { int m_ = (Mv), n_ = (Nv), k_ = (Kv); asm volatile("" : "+s"(m_), "+s"(n_), "+s"(k_)); pg8::Gemm g_{(const pg8::bf16_t*)(Aptr), (const pg8::bf16_t*)(Bptr), m_, n_, k_, (HM)}; pg8::StaticOrder S_; S_.init(m_, n_, G, bid); \
        pg8::gemm_phase<EPI, pg8::StaticOrder, true, true>(lds, g_, S_, (Eobj)); } while (0)

__global__ void __launch_bounds__(NTHR, 2) fwd_mega(Params P) {
    extern __shared__ __attribute__((aligned(16))) unsigned char lds_raw[];
    LAS unsigned char* lds = (LAS unsigned char*)lds_raw;
    cg::grid_group grid = cg::this_grid();
    if (threadIdx.x == 0) {
        const unsigned xcc = (unsigned)__builtin_amdgcn_s_getreg((3 << 11) | 20) & 7u;
        const unsigned loc = __hip_atomic_fetch_add((unsigned*)(P.ws + WS_CTL) + xcc, 1u, __ATOMIC_RELAXED, __HIP_MEMORY_SCOPE_AGENT);
        *(LAS int*)(lds + LDS_VB) = (int)((loc & 31u) * 8u + xcc);
    }
    __syncthreads();
    int seg = 0; const int seg_lo = P.seg_lo, seg_hi = P.seg_hi;
#ifdef L2FLUSH
#define L2_FLUSH() do { const Params* PF = (const Params*)__builtin_amdgcn_kernarg_segment_ptr(); asm volatile("" : "+s"(PF)); int tf_ = threadIdx.x; asm volatile("" : "+v"(tf_)); \
        const u32x4* jp = (const u32x4*)(PF->in[I_P]) + (size_t)blockIdx.x * (L2FLUSH * 64) + tf_; unsigned acc_ = 0u; \
        for (int q_ = 0; q_ < L2FLUSH * 64 / 512; ++q_) { const u32x4 v_ = __builtin_nontemporal_load(jp + (size_t)q_ * 512); acc_ |= v_.x & v_.y & v_.z & v_.w; asm volatile("" ::: "memory"); } \
        if (acc_ == 0x12345678u) PF->out[0] = 0.f; } while (0)
#else
#define L2_FLUSH() do {} while (0)
#endif
#ifdef NOSEG
#define SYNCCOND true
#else
#define SYNCCOND (seg >= seg_lo && seg + 1 < seg_hi)
#endif
#define GRID_SYNC() do { if (SYNCCOND) { asm volatile("s_waitcnt vmcnt(0) lgkmcnt(0)" ::: "memory");   grid.sync(); L2_FLUSH(); \
        if (threadIdx.x < 64) { __builtin_amdgcn_fence(__ATOMIC_ACQUIRE, "agent"); asm volatile("s_waitcnt vmcnt(0)" ::: "memory"); } __syncthreads();     \
        } ++seg; } while (0)
#ifdef NOSEG
#define SEGCOND true
#else
#define SEGCOND (seg >= seg_lo && seg < seg_hi)
#endif
#define PH_BEGIN if (SEGCOND) { const Params* PQ = (const Params*)__builtin_amdgcn_kernarg_segment_ptr(); asm volatile("" : "+s"(PQ)); int tid = threadIdx.x; asm volatile("" : "+v"(tid)); \
    const int lane = tid & 63, wave = __builtin_amdgcn_readfirstlane(tid >> 6); int bid = __builtin_amdgcn_readfirstlane(*(LAS int*)(lds + LDS_VB)), G = gridDim.x; asm volatile("" : "+s"(bid), "+s"(G)); \
    const int xb_ = bid & 7, jb_ = bid >> 3, wj = jb_ * NW + wave;     \
    unsigned char* ws = PQ->ws; float* X = PQ->out; float* SS = (float*)(ws + WS_SS); bf16_t* XB = (bf16_t*)(ws + WS_XB); \
    float* ss_attn = (float*)(ws + WS_HALO); float* ss_ffn = ss_attn + (size_t)MTOK * 16; float* ss_ple = ss_ffn + (size_t)MTOK * 16; float* ss_next = ss_attn; \
    (void)lane; (void)xb_; (void)jb_; (void)wj; (void)X; (void)XB; (void)ss_attn; (void)ss_ffn; (void)ss_ple; (void)ss_next; (void)G;
#define PH_END }
#define U ((bf16_t*)(ws + WS_MIX + (size_t)half * 176 * MiB))
#define ACT ((bf16_t*)(ws + WS_MIX + (half == 0 ? (size_t)352 * MiB : (size_t)0)))

    { const int layer = 0; PH_BEGIN
      if (bid == 0 && tid == 0) __hip_atomic_store((unsigned*)(ws + WS_CTL) + 16, 0u, __ATOMIC_RELAXED, __HIP_MEMORY_SCOPE_AGENT);
      const float* xin = PQ->in[I_X];
      for (int r = wj; r < SEQ; r += 256) {
          const int m = xb_ * SEQ + r;
          const f32x4* xr = (const f32x4*)(xin + (size_t)m * 1024) + lane;
          f32x4 v[4]; float s = 0.f;
#pragma unroll
          for (int jj = 0; jj < 4; ++jj) { v[jj] = xr[64 * jj]; s += (v[jj][0] * v[jj][0] + v[jj][1] * v[jj][1]) + (v[jj][2] * v[jj][2] + v[jj][3] * v[jj][3]); }
          s = wave_sum(s);
          if (lane < 16) ss_attn[(size_t)m * 16 + lane] = lane == 0 ? s : 0.f;
          f32x4* xo = (f32x4*)(X + (size_t)m * 1024) + lane;
          u32x2* bo = (u32x2*)(XB + (size_t)m * 1024) + lane;
#pragma unroll
          for (int jj = 0; jj < 4; ++jj) { xo[64 * jj] = v[jj]; u32x2 w; w.x = pk2(v[jj][0], v[jj][1]); w.y = pk2(v[jj][2], v[jj][3]); bo[64 * jj] = w; }
      }
    PH_END }

    for (int layer = 0; layer < NLAYER; ++layer) {
        asm volatile("" ::: "memory");
        const float lam_init = 0.8f - 0.6f * __expf(-0.3f * (float)layer);
        PH_BEGIN
        convert_weights(PQ, layer, lds, bid * NW + wave, G * NW, wave, lane);
        { const float* pl = PQ->in[I_P] + ((size_t)layer * MTOK + (size_t)xb_ * SEQ) * DPLE;
          bf16_t* pb = (bf16_t*)(ws + WS_PB) + (size_t)xb_ * SEQ * DPLE;
          for (int i = jb_ * NTHR + tid; i < SEQ * DPLE / 8; i += 32 * NTHR) {
              const f32x4 a = *(const f32x4*)(pl + (size_t)i * 8), b = *(const f32x4*)(pl + (size_t)i * 8 + 4);
              u32x4 w; w.x = pk2(a[0], a[1]); w.y = pk2(a[2], a[3]); w.z = pk2(b[0], b[1]); w.w = pk2(b[2], b[3]);
              *(u32x4*)(pb + (size_t)i * 8) = w;
          }
        }
        PH_END
        GRID_SYNC();
#ifdef DBLTEST
#ifdef DBL_SC
#define DBL_LD(p) ldc16(p)
#else
#define DBL_LD(p) (*(p))
#endif
        if (layer == 0) {
#ifdef DBL_OUTP
        PH_BEGIN
        { EpiResid E{X, XB, ss_ffn, nullptr, -1};
          GEMM_PHASE(EpiResid, ws + WS_VT, ws + W_OUT, MTOK, 1024, 1024, E, -1); }
        PH_END
        GRID_SYNC();
#endif
        for (int rep = 0; rep < 2; ++rep) {
        PH_BEGIN
#ifdef DBL_COPY
            { const u32x4* s4 = (const u32x4*)XB; u32x4* d4 = (u32x4*)(ws + WS_MIX + (size_t)rep * 176 * MiB);
              const size_t per = (size_t)DBL_M * DBL_N * 2 / 16 / 8;
              for (size_t i = (size_t)((jb_ + rep * 13) & 31) * NTHR + tid; i < per; i += (size_t)32 * NTHR) d4[(size_t)xb_ * per + i] = DBL_LD(s4 + (size_t)xb_ * per + i); }
#else
#ifndef DBL_W
#define DBL_W W_UP
#define DBL_ACT 0
#endif
            { EpiRowScale<DBL_ACT> E{(bf16_t*)(ws + WS_MIX + (size_t)rep * DBL_OFF * MiB), DBL_N, ss_attn, DBL_H};
              GEMM_PHASE(EpiRowScale<DBL_ACT>, XB, ws + DBL_W, DBL_M, DBL_N, 1024, E, DBL_H); }
#endif
        PH_END
        GRID_SYNC();
        }
        PH_BEGIN
        { const u32x4* a4 = (const u32x4*)(ws + WS_MIX); const u32x4* b4 = (const u32x4*)(ws + WS_MIX + (size_t)DBL_OFF * MiB); unsigned bad = 0u;
          const size_t per = (size_t)DBL_M * DBL_N * 2 / 16 / 8;
          for (size_t i0 = (size_t)((jb_ + 7) & 31) * NTHR + tid; i0 < per; i0 += (size_t)32 * NTHR) { const size_t i = (size_t)xb_ * per + i0; const u32x4 a = DBL_LD(a4 + i), b = DBL_LD(b4 + i); bad |= ((a.x ^ b.x) | (a.y ^ b.y) | (a.z ^ b.z) | (a.w ^ b.w)) ? 1u : 0u; }
          if (bad) __hip_atomic_fetch_or((unsigned*)(ws + WS_CTL) + 16, 1u, __ATOMIC_RELAXED, __HIP_MEMORY_SCOPE_AGENT); }
        PH_END
        GRID_SYNC();
        }
#endif
#if defined(DBLMIX) && !defined(DBLMIX_AT_GATES)
        for (int rep = 0; rep < 2; ++rep) {
#endif
#ifndef NO_INPROJ
        PH_BEGIN
        { EpiQK E{ws, ss_attn, PQ->in[I_QNORM] + layer * 64, PQ->in[I_KNORM] + layer * 64};
          GEMM_PHASE(EpiQK, XB, ws + W_IN, MTOK, 2048, 1024, E, -1); }
        PH_END
        PH_BEGIN
        { EpiSeg E{ws, ss_attn};
          GEMM_PHASE(EpiSeg, XB, ws + W_IN + (size_t)2048 * 2048, MTOK, 4096, 1024, E, -1); }
        PH_END
#ifdef SEG_PROBE
        PH_BEGIN
        { EpiSeg E{ws, ss_attn};
          GEMM_PHASE(EpiSeg, XB, ws + W_IN + (size_t)2048 * 2048, MTOK, 4096, 1024, E, -1); }
        PH_END
#endif
        PH_BEGIN
        { EpiGB E{ws, ss_attn, PQ->in[I_ALOG] + layer * 8, PQ->in[I_DTB] + layer * 8};
          GEMM_PHASE(EpiGB, XB, ws + W_IN + (size_t)6144 * 2048, MTOK, 256, 1024, E, -1); }
        PH_END
        PH_BEGIN
        { EpiVt E{(bf16_t*)(ws + WS_VT), ss_attn};
          GEMM_PHASE(EpiVt, ws + W_V, XB, 1024, MTOK, 1024, E, -1); }
        PH_END
#endif
        GRID_SYNC();
#ifndef NO_ATTN
        PH_BEGIN
        { const float* lq = PQ->in[I_LAM] + layer * 256;
          const float a1 = wave_sum(lq[lane] * lq[64 + lane]), a2 = wave_sum(lq[128 + lane] * lq[192 + lane]);
          const float lam = __expf(a1) - __expf(a2) + lam_init;
#ifdef ATTN_PROBE
          for (int k = 0; k < 4; ++k) {
              const int pi = jb_ + 32 * k, hh = pi >> 4, s = pi & 15;
              attn_unit(lds, (const bf16_t*)(ws + WS_QA), (const bf16_t*)(ws + WS_KA), (const bf16_t*)(ws + WS_VT), (bf16_t*)(ws + WS_QA), xb_, hh, 31 - s, lam, 1.f - lam_init, PQ->in[I_SUBLN] + layer * 128, PQ->in[I_RELB], tid, false);
              attn_unit(lds, (const bf16_t*)(ws + WS_QA), (const bf16_t*)(ws + WS_KA), (const bf16_t*)(ws + WS_VT), (bf16_t*)(ws + WS_QA), xb_, hh, s, lam, 1.f - lam_init, PQ->in[I_SUBLN] + layer * 128, PQ->in[I_RELB], tid, false);
          }
          __syncthreads();
#endif
          for (int k = 0; k < 4; ++k) {
              const int pi = jb_ + 32 * k, hh = pi >> 4, s = pi & 15;
              attn_unit(lds, (const bf16_t*)(ws + WS_QA), (const bf16_t*)(ws + WS_KA), (const bf16_t*)(ws + WS_VT), (bf16_t*)(ws + WS_QA), xb_, hh, 31 - s, lam, 1.f - lam_init, PQ->in[I_SUBLN] + layer * 128, PQ->in[I_RELB], tid);
              attn_unit(lds, (const bf16_t*)(ws + WS_QA), (const bf16_t*)(ws + WS_KA), (const bf16_t*)(ws + WS_VT), (bf16_t*)(ws + WS_QA), xb_, hh, s, lam, 1.f - lam_init, PQ->in[I_SUBLN] + layer * 128, PQ->in[I_RELB], tid);
          }
        }
        PH_END
#endif
#ifndef NO_DN
        PH_BEGIN
#ifdef DN_NAIVE
        if (jb_ < 8) dn_naive(lds, ws, PQ->in[I_CONVB] + (size_t)layer * 4 * 3072, xb_, jb_, tid);
#else
#ifdef DN_FAST1
        dn_fast(lds, ws, PQ->in[I_CONVB] + (size_t)layer * 4 * 3072, xb_, jb_ >> 2, jb_ & 3, tid);
#else
#ifdef DN_PROBE
        dn_pc(lds, ws, PQ->in[I_CONVB] + (size_t)layer * 4 * 3072, xb_, jb_ >> 2, jb_ & 3, tid, false);
#endif
        dn_pc(lds, ws, PQ->in[I_CONVB] + (size_t)layer * 4 * 3072, xb_, jb_ >> 2, jb_ & 3, tid);
#endif
#endif
        PH_END
#endif
        GRID_SYNC();
#if defined(DBLMIX) && defined(DBLMIX_AT_GATES)
        for (int rep = 0; rep < 2; ++rep) {
#endif
#ifndef NO_GATES
        PH_BEGIN
        { EpiRowScale<1> E{(bf16_t*)(ws + WS_G), 2048, ss_attn, -1};
          GEMM_PHASE(EpiRowScale<1>, XB, ws + W_GL, MTOK, 2048, 1024, E, -1); }
        PH_END
#endif
#ifndef NO_OBNORM
        PH_BEGIN
        { const float* on = PQ->in[I_ONORM] + layer * 128;
          const float g0 = on[2 * lane], g1 = on[2 * lane + 1];
          unsigned* OB = (unsigned*)(ws + WS_QB) + (size_t)xb_ * SEQ * 512; const unsigned* OI = (const unsigned*)(ws + WS_OSRC) + (size_t)xb_ * SEQ * 512; const unsigned* ZB = (const unsigned*)(ws + WS_ZB) + (size_t)xb_ * SEQ * 512;
#pragma unroll 4
          for (int r = wj; r < SEQ * NH; r += 256) {
              const unsigned ov = OI[(size_t)r * 64 + lane], zv = ZB[(size_t)r * 64 + lane];
              const float o0 = bflo(ov), o1 = bfhi(ov);
              const float sq = wave_sum(o0 * o0 + o1 * o1);
              const float rr = rsqrtf(sq * (1.f / 128.f) + EPS);
              OB[(size_t)r * 64 + lane] = pk2(o0 * rr * g0 * siluf_(bflo(zv)), o1 * rr * g1 * siluf_(bfhi(zv)));
          }
        }
        PH_END
#endif
        GRID_SYNC();
#ifndef NO_TMPA
        PH_BEGIN
        { EpiGateMul E{(bf16_t*)(ws + WS_TMPA), (const bf16_t*)(ws + WS_G), 2048, 0, nullptr};
          GEMM_PHASE(EpiGateMul, ws + WS_QA, ws + W_BRA, MTOK, 1024, 1024, E, -1); }
        PH_END
#endif
        GRID_SYNC();
#ifndef NO_MIXED
        PH_BEGIN
        { EpiGateMul E{(bf16_t*)(ws + WS_MIXED), (const bf16_t*)(ws + WS_G), 2048, 1024, (const bf16_t*)(ws + WS_TMPA)};
          GEMM_PHASE(EpiGateMul, ws + WS_QB, ws + W_BRB, MTOK, 1024, 1024, E, -1); }
        PH_END
#endif
        GRID_SYNC();
#ifdef DBLMIX
        PH_BEGIN
        { const u32x4* t4 = (const u32x4*)(ws + (size_t)DBL_TGT + (size_t)xb_ * ((size_t)DBL_TGT_BYTES / 8)); u32x4* s4 = (u32x4*)(ws + WS_PB + (size_t)xb_ * 2 * MiB); unsigned bad = 0u;
          for (size_t i = (size_t)((jb_ + 5 * rep) & 31) * NTHR + tid; i < (size_t)2 * MiB / 16; i += (size_t)32 * NTHR) {
              const u32x4 a = t4[i];
              if (rep == 0) s4[i] = a; else { const u32x4 b = s4[i]; bad |= ((a.x ^ b.x) | (a.y ^ b.y) | (a.z ^ b.z) | (a.w ^ b.w)) ? 1u : 0u; } }
          if (bad) __hip_atomic_fetch_or((unsigned*)(ws + WS_CTL) + 16, 1u, __ATOMIC_RELAXED, __HIP_MEMORY_SCOPE_AGENT); }
        PH_END
        GRID_SYNC();
        }
#endif
#ifndef NO_OUTP
        PH_BEGIN
        { EpiResid E{X, XB, ss_ffn, nullptr, -1};
          GEMM_PHASE(EpiResid, ws + WS_MIXED, ws + W_OUT, MTOK, 1024, 1024, E, -1); }
        PH_END
#endif
        GRID_SYNC();
        for (int step = 0; step < 4; ++step) {
        if (step < 2) { const int half = step;
#ifndef NO_UP
        PH_BEGIN
            { EpiRowScale<0> E{U, 5632, ss_ffn, half};
              GEMM_PHASE(EpiRowScale<0>, XB, ws + W_UP, 16384, 5632, 1024, E, half); }
        PH_END
#endif
        }
        if (step >= 1 && step <= 2) { const int half = step - 1;
#ifndef NO_ACT
        PH_BEGIN
            { const float* cw = PQ->in[I_CONVFF] + (size_t)layer * 3 * 5632; const float* cb = PQ->in[I_CONVFFB] + (size_t)layer * 5632;
              bf16_t* UH = (bf16_t*)(ws + WS_UHALO) + (size_t)xb_ * 2 * 5632;
              for (int it = jb_ * NTHR + tid; it < 128 * 352; it += 32 * NTHR) {
                  const int cc = it % 352, rg = it / 352, c0 = cc * 8;
                  const int lrow0 = xb_ * 2048 + rg * 16;
                  float wg[3][8], wv[3][8], bg[8], bv[8];
#pragma unroll
                  for (int jj = 0; jj < 3; ++jj)
#pragma unroll
                      for (int e = 0; e < 8; ++e) { wg[jj][e] = cw[jj * 5632 + c0 + e]; wv[jj][e] = cw[jj * 5632 + 2816 + c0 + e]; }
#pragma unroll
                  for (int e = 0; e < 8; ++e) { bg[e] = cb[c0 + e]; bv[e] = cb[2816 + c0 + e]; }
                  float g2[8], g1[8], v2[8], v1[8];
#pragma unroll
                  for (int e = 0; e < 8; ++e) { g2[e] = 0.f; g1[e] = 0.f; v2[e] = 0.f; v1[e] = 0.f; }
                  if (rg > 0 || half == 1) {
                      const bf16_t* r2p = rg > 0 ? U + (size_t)(lrow0 - 2) * 5632 : UH;
                      const bf16_t* r1p = rg > 0 ? U + (size_t)(lrow0 - 1) * 5632 : UH + 5632;
                      const u32x4 a = *(const u32x4*)(r2p + c0), bq = *(const u32x4*)(r1p + c0);
                      const u32x4 c = *(const u32x4*)(r2p + 2816 + c0), d = *(const u32x4*)(r1p + 2816 + c0);
                      g2[0] = bflo(a.x); g2[1] = bfhi(a.x); g2[2] = bflo(a.y); g2[3] = bfhi(a.y); g2[4] = bflo(a.z); g2[5] = bfhi(a.z); g2[6] = bflo(a.w); g2[7] = bfhi(a.w);
                      g1[0] = bflo(bq.x); g1[1] = bfhi(bq.x); g1[2] = bflo(bq.y); g1[3] = bfhi(bq.y); g1[4] = bflo(bq.z); g1[5] = bfhi(bq.z); g1[6] = bflo(bq.w); g1[7] = bfhi(bq.w);
                      v2[0] = bflo(c.x); v2[1] = bfhi(c.x); v2[2] = bflo(c.y); v2[3] = bfhi(c.y); v2[4] = bflo(c.z); v2[5] = bfhi(c.z); v2[6] = bflo(c.w); v2[7] = bfhi(c.w);
                      v1[0] = bflo(d.x); v1[1] = bfhi(d.x); v1[2] = bflo(d.y); v1[3] = bfhi(d.y); v1[4] = bflo(d.z); v1[5] = bfhi(d.z); v1[6] = bflo(d.w); v1[7] = bfhi(d.w);
                  }
#pragma unroll 4
                  for (int rr = 0; rr < 16; ++rr) {
                      const size_t row = (size_t)lrow0 + rr;
                      const u32x4 a = *(const u32x4*)(U + row * 5632 + c0), c = *(const u32x4*)(U + row * 5632 + 2816 + c0);
                      if (half == 0 && rg == 127 && rr >= 14) { *(u32x4*)(UH + (size_t)(rr - 14) * 5632 + c0) = a; *(u32x4*)(UH + (size_t)(rr - 14) * 5632 + 2816 + c0) = c; }
                      float g0[8], v0[8], ov[8];
                      g0[0] = bflo(a.x); g0[1] = bfhi(a.x); g0[2] = bflo(a.y); g0[3] = bfhi(a.y); g0[4] = bflo(a.z); g0[5] = bfhi(a.z); g0[6] = bflo(a.w); g0[7] = bfhi(a.w);
                      v0[0] = bflo(c.x); v0[1] = bfhi(c.x); v0[2] = bflo(c.y); v0[3] = bfhi(c.y); v0[4] = bflo(c.z); v0[5] = bfhi(c.z); v0[6] = bflo(c.w); v0[7] = bfhi(c.w);
#pragma unroll
                      for (int e = 0; e < 8; ++e) {
                          const float ug = wg[0][e] * g2[e] + wg[1][e] * g1[e] + wg[2][e] * g0[e] + bg[e];
                          const float uv = wv[0][e] * v2[e] + wv[1][e] * v1[e] + wv[2][e] * v0[e] + bv[e];
                          ov[e] = siluf_(ug) * uv; g2[e] = g1[e]; g1[e] = g0[e]; v2[e] = v1[e]; v1[e] = v0[e];
                      }
                      u32x4 w; w.x = pk2(ov[0], ov[1]); w.y = pk2(ov[2], ov[3]); w.z = pk2(ov[4], ov[5]); w.w = pk2(ov[6], ov[7]);
                      *(u32x4*)(ACT + row * 2816 + c0) = w;
                  }
              }
            }
        PH_END
#endif
        }
        if (step >= 2) { const int half = step - 2;
#ifndef NO_DOWN
        PH_BEGIN
            { EpiResid E{X, XB, ss_ple, nullptr, half};
              GEMM_PHASE(EpiResid, ACT, ws + W_DOWN, 16384, 1024, 2816, E, -1); }
        PH_END
#endif
        }
            GRID_SYNC();
        }
#ifndef NO_PLEG
        PH_BEGIN
        { EpiRowScale<1> E{(bf16_t*)(ws + WS_MIX), 1024, ss_ple, -1};
          GEMM_PHASE(EpiRowScale<1>, XB, ws + W_PG, MTOK, 1024, 1024, E, -1); }
        PH_END
#endif
        GRID_SYNC();
#ifndef NO_PLE
        PH_BEGIN
        { EpiResid E{X, XB, ss_next, (const bf16_t*)(ws + WS_MIX), -1};
          GEMM_PHASE(EpiResid, ws + WS_PB, ws + W_PP, MTOK, 1024, 256, E, -1); }
        PH_END
#endif
        GRID_SYNC();
    }
#ifdef NANCHK
    { const int layer = 0; PH_BEGIN
      unsigned bad = 0u;
      for (size_t i = (size_t)bid * NTHR + tid; i < (size_t)MTOK * 256; i += (size_t)G * NTHR) { const f32x4 v = *(const f32x4*)(X + i * 4);
          for (int e = 0; e < 4; ++e) bad |= ((__float_as_uint(v[e]) & 0x7f800000u) == 0x7f800000u) ? 1u : 0u; }
#ifdef NANCHK_BF_LO
      { const unsigned* bp = (const unsigned*)(ws + (size_t)NANCHK_BF_LO); const size_t nw = ((size_t)NANCHK_BF_HI - (size_t)NANCHK_BF_LO) / 4;
        for (size_t i = (size_t)bid * NTHR + tid; i < nw; i += (size_t)G * NTHR) { const unsigned w = bp[i]; bad |= (((w & 0x7f80u) == 0x7f80u) || ((w & 0x7f800000u) == 0x7f800000u)) ? 1u : 0u; } }
#endif
      if (bad) __hip_atomic_fetch_or((unsigned*)(ws + WS_CTL) + 16, 1u, __ATOMIC_RELAXED, __HIP_MEMORY_SCOPE_AGENT);
      PH_END }
    GRID_SYNC();
    { const int layer = 0; PH_BEGIN
      const unsigned fl = __hip_atomic_fetch_or((unsigned*)(ws + WS_CTL) + 16, 0u, __ATOMIC_RELAXED, __HIP_MEMORY_SCOPE_AGENT);
      if (fl) for (size_t i = (size_t)bid * NTHR + tid; i < (size_t)MTOK * 256; i += (size_t)G * NTHR) *(f32x4*)(X + i * 4) = (f32x4){0.f, 0.f, 0.f, 0.f};
      PH_END }
#endif
#undef U
#undef ACT
}

extern "C" void kernel_launch(void* const* d_in, const int* in_sizes, int n_in, void* d_out, int out_size, void* d_ws, size_t ws_size, hipStream_t stream) {
    static int grid = 0;
    if (grid == 0) {
        if (n_in != 24 || out_size != MTOK * DM || ws_size < WS_TOTAL) { fprintf(stderr, "kernel_launch: unexpected shapes / workspace (n_in %d out %d ws %zu need %zu)\n", n_in, out_size, ws_size, (size_t)WS_TOTAL); grid = -1; return; }
        int dev = 0, cus = 0, per_cu = 0;
        hipGetDevice(&dev);
        hipDeviceGetAttribute(&cus, hipDeviceAttributeMultiprocessorCount, dev);
        hipFuncSetAttribute((const void*)fwd_mega, hipFuncAttributeMaxDynamicSharedMemorySize, LDS_BYTES);
        hipOccupancyMaxActiveBlocksPerMultiprocessor(&per_cu, (const void*)fwd_mega, NTHR, LDS_BYTES);
        if (per_cu < 1) { fprintf(stderr, "kernel_launch: occupancy query says %d blocks per CU\n", per_cu); per_cu = 1; }
        (void)hipGetLastError();
        grid = cus;
    }
    if (grid < 0) return;
    Params p{};
    for (int i = 0; i < 24; ++i) p.in[i] = (const float*)d_in[i];
    p.out = (float*)d_out; p.ws = (unsigned char*)d_ws;
    hipError_t e = hipSuccess;
#ifdef N_SEG_LAUNCH
    for (int sgi = 0; sgi < 60 && e == hipSuccess; sgi += N_SEG_LAUNCH) {
        p.seg_lo = sgi; p.seg_hi = sgi + N_SEG_LAUNCH;
        void* args[] = {&p};
        e = hipLaunchCooperativeKernel((const void*)fwd_mega, dim3(grid), dim3(NTHR), args, LDS_BYTES, stream);
    }
#else
    p.seg_lo = 0; p.seg_hi = 1000;
    void* args[] = {&p};
    e = hipLaunchCooperativeKernel((const void*)fwd_mega, dim3(grid), dim3(NTHR), args, LDS_BYTES, stream);
#endif
    if (e != hipSuccess) fprintf(stderr, "cooperative launch failed: %s (grid %d)\n", hipGetErrorString(e), grid);
}
```

```cpp
#include <hip/hip_runtime.h>
#include <hip/hip_cooperative_groups.h>
#include <cstdio>
#include <cstdint>
namespace cg = cooperative_groups;
namespace pg8 {
#define PG8_LAS __attribute__((address_space(3)))
typedef unsigned short bf16_t;
typedef short bf16x8 __attribute__((ext_vector_type(8)));
typedef float f32x4 __attribute__((ext_vector_type(4)));
typedef unsigned u32x4 __attribute__((ext_vector_type(4)));
constexpr int BM = 256, BK = 64, HALF = 128, HTB = HALF * BK * 2  , STAGE_BYTES = 8 * HTB, NXCD = 8, WGM = 8;

__host__ __device__ __forceinline__ int lds_byte(int r, int c) { const int st = (r >> 4) * 2 + (c >> 5), rr = r & 15, cc = c & 31, ob = rr * 64 + cc * 2; return st * 1024 + (ob ^ (((ob >> 9) & 1) << 5)); }
__host__ __device__ __forceinline__ void stage_rc(int b, int& R, int& C) { const int st = b / 1024, sb = b % 1024, swz = sb ^ (((sb >> 9) & 1) << 5); R = (st >> 1) * 16 + swz / 64; C = (st & 1) * 32 + (swz % 64) / 2; }
__host__ __device__ __forceinline__ int perm32(int rho) { const int n = rho >> 4, i = rho & 15; return 8 * (i >> 2) + 4 * n + (i & 3); }

struct Unit { int pm, pn; };
struct Gemm { const bf16_t* A; const bf16_t* Bt; int M, N, K; int hmap; };
__device__ __forceinline__ int amap(int pm, int hmap) { return hmap < 0 ? pm : ((pm >> 3) * 16 + 8 * hmap + (pm & 7)); }

struct StaticOrder {
    int nM, nN, nwg, G, c;
    __host__ __device__ void init(int M, int N, int G_, int c_) { nM = M / BM; nN = N / BM; nwg = nM * nN; G = G_; c = c_; }
    __host__ __device__ bool next(int i, Unit& u) const {
        const long L = (long)i * G + c; if (L >= nwg) return false;
        int wgid = (int)L; { const int q = nwg / NXCD, r = nwg % NXCD, xcd = wgid % NXCD, off = wgid / NXCD; wgid = (xcd < r ? xcd * (q + 1) : r * (q + 1) + (xcd - r) * q) + off; }
        const int nig = WGM * nN, gid = wgid / nig, fm = gid * WGM, gsz = (nM - fm) < WGM ? (nM - fm) : WGM;
        u.pm = fm + ((wgid % nig) % gsz); u.pn = (wgid % nig) / gsz; return true;
    }
    __device__ __forceinline__ void a_ready(const Unit&) const {}
    __device__ __forceinline__ void done(const Unit&) const {}
};
__device__ __forceinline__ unsigned cvt_pk_bf16(float lo, float hi) { unsigned r; asm volatile("v_cvt_pk_bf16_f32 %0, %1, %2" : "=v"(r) : "v"(lo), "v"(hi)); return r; }
#ifdef NO_UNI
__device__ __forceinline__ const char* uni(const char* p) { return p; }
#else
__device__ __forceinline__ const char* uni(const char* p) { const unsigned long long v = (unsigned long long)p; const unsigned lo = __builtin_amdgcn_readfirstlane((unsigned)v), hi = __builtin_amdgcn_readfirstlane((unsigned)(v >> 32)); return (const char*)(((unsigned long long)hi << 32) | lo); }
#endif
template <class Epi, class Sched, bool ALIGN_EPI = false, bool SP2 = false>
__device__ __forceinline__ void gemm_phase(PG8_LAS unsigned char* lds, const Gemm g, const Sched& S, const Epi& E) {
    int tid = threadIdx.x;
#ifndef NO_LAUNDER
    asm volatile("" : "+v"(tid));
#endif

    const int wid = __builtin_amdgcn_readfirstlane(tid >> 6), lane = tid & 63, wr = wid >> 2, wc = wid & 3, fr = lane & 15, fq = lane >> 4;
    const int K = g.K, nt = K / BK;
    unsigned voffA[2], voffB[2];
#pragma unroll
    for (int i = 0; i < 2; ++i) { int R, C; stage_rc(tid * 16 + i * 8192, R, C); const int Rb = Epi::PERM ? ((R & ~31) + perm32(R & 31)) : R;
        voffA[i] = (unsigned)(R * K + C) * 2u; voffB[i] = (unsigned)(Rb * K + C) * 2u; }
    const size_t kstep = (size_t)(BK * 2);
    const size_t hstep = (size_t)HALF * K * 2;
    const size_t tstep = 2 * hstep;
    const unsigned ldsw = (unsigned)wid * 1024u;
    const int aoff = lds_byte(wr * 64 + fr, fq * 8), boff = lds_byte(wc * 32 + fr, fq * 8);
#define PG8_SA(b, h) (((b) * 2 + (h)) * HTB)
#define PG8_SB(b, h) ((4 + (b) * 2 + (h)) * HTB)
#define PG8_STAGE(bufoff, gbase, voff) do { _Pragma("unroll") for (int _i = 0; _i < 2; ++_i) \
        __builtin_amdgcn_global_load_lds((const unsigned*)((const char*)(gbase) + (voff)[_i]), (PG8_LAS unsigned*)(lds + (bufoff) + ldsw + _i * 8192), 16, 0, 0); } while (0)
#define PG8_LDA(dst, b, h) do { _Pragma("unroll") for (int m = 0; m < 4; ++m) _Pragma("unroll") for (int k = 0; k < 2; ++k) dst[m][k] = *(const PG8_LAS bf16x8*)(lds + PG8_SA(b, h) + aoff + m * 2048 + k * 1024); } while (0)
#define PG8_LDB(dst, b, h) do { _Pragma("unroll") for (int n = 0; n < 2; ++n) _Pragma("unroll") for (int k = 0; k < 2; ++k) dst[n][k] = *(const PG8_LAS bf16x8*)(lds + PG8_SB(b, h) + boff + n * 2048 + k * 1024); } while (0)
#define PG8_MMA(ai, bj, At, Bt) do { __builtin_amdgcn_s_setprio(1); _Pragma("unroll") for (int m = 0; m < 4; ++m) _Pragma("unroll") for (int n = 0; n < 2; ++n) _Pragma("unroll") for (int k = 0; k < 2; ++k) \
        acc[ai][bj][m][n] = __builtin_amdgcn_mfma_f32_16x16x32_bf16(Bt[n][k], At[m][k], acc[ai][bj][m][n], 0, 0, 0); __builtin_amdgcn_s_setprio(0); } while (0)
#define PG8_WAIT_V(n) asm volatile("s_waitcnt vmcnt(" #n ")" ::: "memory")
#define PG8_WAIT_L(n) asm volatile("s_waitcnt lgkmcnt(" #n ")" ::: "memory")
#define PG8_BAR __builtin_amdgcn_s_barrier()
#define PG8_SCHED __builtin_amdgcn_sched_barrier(0)
    Unit cur, nxt; int ui = 0;
    if (!S.next(0, cur)) return;
    f32x4 acc[2][2][4][2];
#pragma unroll
    for (int a = 0; a < 2; ++a)
#pragma unroll
        for (int b = 0; b < 2; ++b)
#pragma unroll
            for (int m = 0; m < 4; ++m)
#pragma unroll
                for (int n = 0; n < 2; ++n) acc[a][b][m][n] = (f32x4){0.f, 0.f, 0.f, 0.f};
    bf16x8 At[4][2], B0[2][2], B1[2][2];
    const char* cA = uni((const char*)g.A + (size_t)amap(cur.pm, g.hmap) * tstep); const char* cB = uni((const char*)g.Bt + (size_t)cur.pn * tstep);
    S.a_ready(cur);
    if constexpr (SP2) {
        PG8_STAGE(PG8_SB(0, 0), cB, voffB); PG8_STAGE(PG8_SB(0, 1), cB + hstep, voffB); PG8_STAGE(PG8_SA(0, 0), cA, voffA); PG8_STAGE(PG8_SA(0, 1), cA + hstep, voffA);
        if (wr == 1) PG8_BAR;
        PG8_WAIT_V(2); PG8_BAR;
        PG8_STAGE(PG8_SB(1, 0), cB + kstep, voffB); PG8_STAGE(PG8_SA(1, 0), cA + kstep, voffA); PG8_STAGE(PG8_SB(1, 1), cB + hstep + kstep, voffB);
        PG8_WAIT_V(6); PG8_BAR;
    } else {
        PG8_STAGE(PG8_SB(0, 0), cB, voffB); PG8_STAGE(PG8_SA(0, 0), cA, voffA); PG8_STAGE(PG8_SB(0, 1), cB + hstep, voffB); PG8_STAGE(PG8_SA(0, 1), cA + hstep, voffA);
        if (wr == 1) PG8_BAR;
        PG8_WAIT_V(4); PG8_BAR;
        PG8_STAGE(PG8_SB(1, 0), cB + kstep, voffB); PG8_STAGE(PG8_SA(1, 0), cA + kstep, voffA); PG8_STAGE(PG8_SB(1, 1), cB + hstep + kstep, voffB);
        PG8_WAIT_V(6); PG8_BAR;
    }
    for (;;) {
        const bool has_next = S.next(ui + 1, nxt);
        const char* nA = uni(has_next ? (const char*)g.A + (size_t)amap(nxt.pm, g.hmap) * tstep : cA); const char* nB = uni(has_next ? (const char*)g.Bt + (size_t)nxt.pn * tstep : cB);
        for (int t = 0; t < nt; t += 2) {
            const bool last = (t == nt - 2);
            const char* a1 = cA + (size_t)(t + 1) * kstep;
            const char* a2 = last ? nA : cA + (size_t)(t + 2) * kstep; const char* b2 = last ? nB : cB + (size_t)(t + 2) * kstep;
            const char* a3 = a2 + kstep; const char* b3 = b2 + kstep;
            if (last && has_next) S.a_ready(nxt);
            if constexpr (SP2) {
            PG8_LDB(B0, 0, 0); PG8_LDB(B1, 0, 1); PG8_SCHED; PG8_LDA(At, 0, 0); PG8_STAGE(PG8_SA(1, 1), a1 + hstep, voffA);
            PG8_WAIT_V(8); PG8_WAIT_L(0); PG8_BAR; PG8_MMA(0, 0, At, B0); PG8_MMA(0, 1, At, B1); PG8_BAR; PG8_SCHED;
            PG8_LDA(At, 0, 1); PG8_STAGE(PG8_SB(0, 0), b2, voffB); PG8_STAGE(PG8_SB(0, 1), b2 + hstep, voffB); PG8_STAGE(PG8_SA(0, 0), a2, voffA);
            PG8_WAIT_V(8); PG8_WAIT_L(0); PG8_BAR; PG8_MMA(1, 0, At, B0); PG8_MMA(1, 1, At, B1); PG8_BAR; PG8_SCHED;
            PG8_LDB(B0, 1, 0); PG8_LDB(B1, 1, 1); PG8_SCHED; PG8_LDA(At, 1, 0); PG8_STAGE(PG8_SA(0, 1), a2 + hstep, voffA);
            PG8_WAIT_V(8); PG8_WAIT_L(0); PG8_BAR; PG8_MMA(0, 0, At, B0); PG8_MMA(0, 1, At, B1); PG8_BAR; PG8_SCHED;
            PG8_LDA(At, 1, 1); PG8_STAGE(PG8_SB(1, 0), b3, voffB); PG8_STAGE(PG8_SB(1, 1), b3 + hstep, voffB); PG8_STAGE(PG8_SA(1, 0), a3, voffA);
            PG8_WAIT_V(8); PG8_WAIT_L(0); PG8_BAR; PG8_MMA(1, 0, At, B0); PG8_MMA(1, 1, At, B1); PG8_BAR; PG8_SCHED;
            } else {
            PG8_LDB(B0, 0, 0); PG8_SCHED; PG8_LDA(At, 0, 0); PG8_STAGE(PG8_SA(1, 1), a1 + hstep, voffA);
            PG8_WAIT_L(8); PG8_BAR; PG8_WAIT_L(0); PG8_MMA(0, 0, At, B0); PG8_BAR; PG8_SCHED;
            PG8_LDB(B1, 0, 1); PG8_STAGE(PG8_SB(0, 0), b2, voffB);
            PG8_BAR; PG8_WAIT_L(0); PG8_MMA(0, 1, At, B1); PG8_BAR;
            PG8_LDA(At, 0, 1); PG8_STAGE(PG8_SA(0, 0), a2, voffA);
            PG8_BAR; PG8_WAIT_L(0); PG8_MMA(1, 0, At, B0); PG8_BAR; PG8_SCHED;
            PG8_STAGE(PG8_SB(0, 1), b2 + hstep, voffB);
            PG8_WAIT_V(6); PG8_BAR; PG8_MMA(1, 1, At, B1); PG8_BAR;
            PG8_LDB(B0, 1, 0); PG8_SCHED; PG8_LDA(At, 1, 0); PG8_STAGE(PG8_SA(0, 1), a2 + hstep, voffA);
            PG8_WAIT_L(8); PG8_BAR; PG8_WAIT_L(0); PG8_MMA(0, 0, At, B0); PG8_BAR; PG8_SCHED;
            PG8_LDB(B1, 1, 1); PG8_STAGE(PG8_SB(1, 0), b3, voffB);
            PG8_BAR; PG8_WAIT_L(0); PG8_MMA(0, 1, At, B1); PG8_BAR;
            PG8_LDA(At, 1, 1); PG8_STAGE(PG8_SA(1, 0), a3, voffA);
            PG8_BAR; PG8_WAIT_L(0); PG8_MMA(1, 0, At, B0); PG8_BAR; PG8_SCHED;
            PG8_STAGE(PG8_SB(1, 1), b3 + hstep, voffB);
            PG8_WAIT_V(6); PG8_BAR; PG8_MMA(1, 1, At, B1); PG8_BAR;
            }
        }
        if constexpr (ALIGN_EPI) { if (wr == 0) PG8_BAR; }
        if constexpr (!Epi::AFTER_DRAIN) { E(acc, cur, wr, wc, fr, fq); S.done(cur); }
        if (!has_next) break;
#pragma unroll
        for (int a = 0; a < 2; ++a)
#pragma unroll
            for (int b = 0; b < 2; ++b)
#pragma unroll
                for (int m = 0; m < 4; ++m)
#pragma unroll
                    for (int n = 0; n < 2; ++n) acc[a][b][m][n] = (f32x4){0.f, 0.f, 0.f, 0.f};
        cur = nxt; cA = nA; cB = nB; ++ui;
        if constexpr (ALIGN_EPI) { if (wr == 1) PG8_BAR; }
    }
    PG8_WAIT_V(0);
    if constexpr (!ALIGN_EPI) { if (wr == 0) PG8_BAR; }
    PG8_BAR;
    if constexpr (Epi::AFTER_DRAIN) { E.fused(acc, cur, wr, wc, fr, fq, lds, wid, lane); S.done(cur); }
#undef PG8_SA
#undef PG8_SB
#undef PG8_STAGE
#undef PG8_LDA
#undef PG8_LDB
#undef PG8_MMA
#undef PG8_WAIT_V
#undef PG8_WAIT_L
#undef PG8_BAR
#undef PG8_SCHED
}
}

#define GAS __attribute__((address_space(1)))
#define LAS __attribute__((address_space(3)))
typedef unsigned short bf16_t;
typedef float f32x4 __attribute__((ext_vector_type(4)));
typedef float f32x16 __attribute__((ext_vector_type(16)));
typedef short bf16x8 __attribute__((ext_vector_type(8)));
typedef unsigned u32x4 __attribute__((ext_vector_type(4)));
typedef unsigned u32x2 __attribute__((ext_vector_type(2)));

#ifndef NLAYER_V
#define NLAYER_V 4
#endif
constexpr int NW = 8, NTHR = 512;
constexpr int MTOK = 32768, DM = 1024, SEQ = 4096, NB = 8, NLAYER = NLAYER_V, NH = 8;
constexpr int DIN = 9232, DFF = 2816, DPLE = 256;
constexpr float EPS = 1e-6f;
constexpr float LOG2E = 1.4426950408889634f;
constexpr size_t MiB = 1u << 20;
constexpr size_t WS_SS = 0;
constexpr size_t WS_CTL = 1792 * 1024;
constexpr size_t WS_UHALO = 1856 * 1024;
constexpr size_t WS_GB = 2 * MiB;
constexpr size_t WS_HALO = 4 * MiB;
constexpr size_t WS_PB = 14 * MiB;
constexpr size_t WS_W = 30 * MiB;
constexpr size_t W_IN = WS_W, W_V = W_IN + (size_t)6400 * 1024 * 2, W_GL = W_V + 2 * MiB, W_BRA = W_GL + 4 * MiB, W_BRB = W_BRA + 2 * MiB,
                 W_OUT = W_BRB + 2 * MiB, W_UP = W_OUT + 2 * MiB, W_DOWN = W_UP + 11 * MiB, W_PG = W_DOWN + (size_t)1024 * 2816 * 2, W_PP = W_PG + 2 * MiB, W_END = W_PP + (size_t)1024 * 256 * 2;
static_assert(W_END <= 74 * MiB, "weights region");
constexpr size_t WS_XB = 74 * MiB;
constexpr size_t WS_MIX = 138 * MiB;
constexpr size_t S64 = 64 * MiB;
constexpr size_t WS_QA = WS_MIX, WS_KA = WS_MIX + S64, WS_VT = WS_MIX + 2 * S64, WS_QB = WS_MIX + 3 * S64, WS_KB = WS_MIX + 4 * S64, WS_VB = WS_MIX + 5 * S64, WS_ZB = WS_MIX + 6 * S64;
constexpr size_t WS_TOTAL = WS_MIX + 7 * S64;
#ifdef DN_NAIVE
constexpr size_t WS_G = WS_KB, WS_TMPA = WS_KA, WS_MIXED = WS_VT, WS_OSRC = WS_QB;
#else
constexpr size_t WS_G = WS_KA, WS_TMPA = WS_KB, WS_MIXED = WS_VB, WS_OSRC = WS_VB;
#endif
constexpr int LDS_BYTES = 147456, LDS_VB = 140032;

__device__ __forceinline__ float bflo(unsigned w) { return __uint_as_float(w << 16); }
__device__ __forceinline__ float bfhi(unsigned w) { return __uint_as_float(w & 0xffff0000u); }
__device__ __forceinline__ float bf2f(bf16_t v) { return __uint_as_float((unsigned)v << 16); }
typedef float f32x2_t __attribute__((ext_vector_type(2))); typedef __bf16 bf16x2_t __attribute__((ext_vector_type(2)));
__device__ __forceinline__ unsigned pk2(float lo, float hi) { const f32x2_t v = {lo, hi}; const bf16x2_t b = __builtin_convertvector(v, bf16x2_t); return __builtin_bit_cast(unsigned, b); }
__device__ __forceinline__ bf16_t f2bf(float f) { return (bf16_t)(pk2(f, 0.f) & 0xffffu); }
__device__ __forceinline__ float sigmoidf_(float x) { x = fminf(fmaxf(x, -60.f), 60.f); return __builtin_amdgcn_rcpf(1.f + __expf(-x)); }
__device__ __forceinline__ float siluf_(float x) { return x * sigmoidf_(x); }
__device__ __forceinline__ float wave_sum(float v) {
#pragma unroll
    for (int o = 1; o < 64; o <<= 1) v += __shfl_xor(v, o);
    return v;
}
__device__ __forceinline__ float ss_load(const float* p) { const f32x4 a = *(const f32x4*)p, b = *(const f32x4*)(p + 4), c = *(const f32x4*)(p + 8), d = *(const f32x4*)(p + 12);
    float s = (((a[0] + a[1]) + (a[2] + a[3])) + ((b[0] + b[1]) + (b[2] + b[3]))) + (((c[0] + c[1]) + (c[2] + c[3])) + ((d[0] + d[1]) + (d[2] + d[3])));
    asm volatile("" : "+v"(s) :: "memory");
    return s; }
__device__ __forceinline__ u32x4 ldc16(const void* p) { u32x4 v; asm volatile("global_load_dwordx4 %0, %1, off sc0 sc1\n\ts_waitcnt vmcnt(0)" : "=v"(v) : "v"(p) : "memory"); return v; }
__device__ __forceinline__ int crow(int r, int hi) { return (r & 3) + 8 * (r >> 2) + 4 * hi; }

__device__ __forceinline__ float ss_sum16(const f32x4 a, const f32x4 b, const f32x4 c, const f32x4 d) {
    return (((a[0] + a[1]) + (a[2] + a[3])) + ((b[0] + b[1]) + (b[2] + b[3]))) + (((c[0] + c[1]) + (c[2] + c[3])) + ((d[0] + d[1]) + (d[2] + d[3]))); }
__device__ __forceinline__ int gmap(int row, int h) { return h < 0 ? row : ((row >> 11) * 4096 + 2048 * h + (row & 2047)); }

__device__ __forceinline__ void load_rs8(const float* ss, int rowbase, int hmap, int lane, int fr, float (&rs)[2][4]) {
    const float* p0 = ss + (size_t)gmap(rowbase + lane, hmap) * 16; const float* p1 = ss + (size_t)gmap(rowbase + 128 + lane, hmap) * 16;
    const f32x4 a0 = *(const f32x4*)p0, b0 = *(const f32x4*)(p0 + 4), c0 = *(const f32x4*)(p0 + 8), d0 = *(const f32x4*)(p0 + 12);
    const f32x4 a1 = *(const f32x4*)p1, b1 = *(const f32x4*)(p1 + 4), c1 = *(const f32x4*)(p1 + 8), d1 = *(const f32x4*)(p1 + 12);
    const float r0 = rsqrtf(ss_sum16(a0, b0, c0, d0) * (1.f / 1024.f) + EPS), r1 = rsqrtf(ss_sum16(a1, b1, c1, d1) * (1.f / 1024.f) + EPS);
#pragma unroll
    for (int m = 0; m < 4; ++m) { rs[0][m] = __shfl(r0, m * 16 + fr); rs[1][m] = __shfl(r1, m * 16 + fr); }
    asm volatile("" ::: "memory");
}

using pg8::Unit;
typedef f32x4 AccT[2][2][4][2];

template <int ACT> struct EpiRowScale {
    static constexpr bool PERM = true, AFTER_DRAIN = false;
    bf16_t* O; int ldc; const float* ss; int hmap;
    __device__ __forceinline__ void operator()(const AccT& acc, const Unit& u, int wr, int wc, int fr, int fq) const {
        const int row0 = u.pm * 256 + wr * 64 + fr, col0 = u.pn * 256 + wc * 32 + 8 * fq;
        float rsv[2][4]; load_rs8(ss, u.pm * 256 + wr * 64, hmap, (int)(threadIdx.x & 63), fr, rsv);
#pragma unroll
        for (int ai = 0; ai < 2; ++ai)
#pragma unroll
            for (int m = 0; m < 4; ++m) {
                const int row = row0 + ai * 128 + m * 16;
                const float rs = rsv[ai][m];
                bf16_t* rowp = O + (size_t)row * ldc + col0;
#pragma unroll
                for (int bj = 0; bj < 2; ++bj) {
                    f32x4 v0 = acc[ai][bj][m][0] * rs, v1 = acc[ai][bj][m][1] * rs;
                    if (ACT == 1) {
#pragma unroll
                        for (int e = 0; e < 4; ++e) { v0[e] = sigmoidf_(v0[e]); v1[e] = sigmoidf_(v1[e]); }
                    }
                    u32x4 w; w.x = pk2(v0[0], v0[1]); w.y = pk2(v0[2], v0[3]); w.z = pk2(v1[0], v1[1]); w.w = pk2(v1[2], v1[3]);
                    *(u32x4*)(rowp + bj * 128) = w;
                    asm volatile("" ::: "memory");
                }
            }
    }
};

struct EpiVt {
    static constexpr bool PERM = true, AFTER_DRAIN = false;
    bf16_t* O; const float* ss;
    __device__ __forceinline__ void operator()(const AccT& acc, const Unit& u, int wr, int wc, int fr, int fq) const {
        const int row0 = u.pm * 256 + wr * 64 + fr, col0 = u.pn * 256 + wc * 32 + 8 * fq;
        float rs[2][8];
        { const int L = (int)(threadIdx.x & 63); const float* pc = ss + (size_t)(u.pn * 256 + (L >> 5) * 128 + wc * 32 + (L & 31)) * 16;
          const f32x4 a = *(const f32x4*)pc, b = *(const f32x4*)(pc + 4), c = *(const f32x4*)(pc + 8), d = *(const f32x4*)(pc + 12);
          const float r = rsqrtf(ss_sum16(a, b, c, d) * (1.f / 1024.f) + EPS);
#pragma unroll
          for (int bj = 0; bj < 2; ++bj)
#pragma unroll
              for (int e = 0; e < 8; ++e) rs[bj][e] = __shfl(r, bj * 32 + 8 * fq + e); }
#pragma unroll
        for (int ai = 0; ai < 2; ++ai)
#pragma unroll
            for (int m = 0; m < 4; ++m) {
                const int row = row0 + ai * 128 + m * 16;
                bf16_t* rowp = O + (size_t)row * MTOK + col0;
#pragma unroll
                for (int bj = 0; bj < 2; ++bj) {
                    const f32x4 v0 = acc[ai][bj][m][0], v1 = acc[ai][bj][m][1];
                    u32x4 w; w.x = pk2(v0[0] * rs[bj][0], v0[1] * rs[bj][1]); w.y = pk2(v0[2] * rs[bj][2], v0[3] * rs[bj][3]);
                    w.z = pk2(v1[0] * rs[bj][4], v1[1] * rs[bj][5]); w.w = pk2(v1[2] * rs[bj][6], v1[3] * rs[bj][7]);
                    *(u32x4*)(rowp + bj * 128) = w;
                }
                asm volatile("" ::: "memory");
            }
    }
};

struct EpiGateMul {
    static constexpr bool PERM = true, AFTER_DRAIN = false;
    bf16_t* O; const bf16_t* G; int ldg, goff; const bf16_t* Add;
    __device__ __forceinline__ void operator()(const AccT& acc, const Unit& u, int wr, int wc, int fr, int fq) const {
        const int row0 = u.pm * 256 + wr * 64 + fr, col0 = u.pn * 256 + wc * 32 + 8 * fq;
#pragma unroll
        for (int ai = 0; ai < 2; ++ai)
#pragma unroll
            for (int m = 0; m < 4; ++m) {
                const int row = row0 + ai * 128 + m * 16;
#pragma unroll
                for (int bj = 0; bj < 2; ++bj) {
                    const int c = col0 + bj * 128;
                    const u32x4 g = *(const u32x4*)(G + (size_t)row * ldg + goff + c);
                    u32x4 a = (u32x4){0u, 0u, 0u, 0u};
                    if (Add) a = *(const u32x4*)(Add + (size_t)row * 1024 + c);
                    const f32x4 v0 = acc[ai][bj][m][0], v1 = acc[ai][bj][m][1];
                    u32x4 w;
                    w.x = pk2(bflo(a.x) + bflo(g.x) * v0[0], bfhi(a.x) + bfhi(g.x) * v0[1]);
                    w.y = pk2(bflo(a.y) + bflo(g.y) * v0[2], bfhi(a.y) + bfhi(g.y) * v0[3]);
                    w.z = pk2(bflo(a.z) + bflo(g.z) * v1[0], bfhi(a.z) + bfhi(g.z) * v1[1]);
                    w.w = pk2(bflo(a.w) + bflo(g.w) * v1[2], bfhi(a.w) + bfhi(g.w) * v1[3]);
                    *(u32x4*)(O + (size_t)row * 1024 + c) = w;
                }
                asm volatile("" ::: "memory");
            }
    }
};

struct EpiResid {
    static constexpr bool PERM = true, AFTER_DRAIN = false;
    float* X; bf16_t* XB; float* ssn; const bf16_t* Mul; int hmap;
    __device__ __forceinline__ void operator()(const AccT& acc, const Unit& u, int wr, int wc, int fr, int fq) const {
        const int row0 = u.pm * 256 + wr * 64 + fr, col0 = u.pn * 256 + wc * 32 + 8 * fq;
#pragma unroll
        for (int ai = 0; ai < 2; ++ai)
#pragma unroll
            for (int m = 0; m < 4; ++m) {
                const int row = gmap(row0 + ai * 128 + m * 16, hmap);
                const size_t off0 = (size_t)row * 1024 + col0;
                f32x4 xa = *(const f32x4*)(X + off0), xb2 = *(const f32x4*)(X + off0 + 4), xc = *(const f32x4*)(X + off0 + 128), xd = *(const f32x4*)(X + off0 + 132);
                f32x4 va = acc[ai][0][m][0], vb2 = acc[ai][0][m][1], vc = acc[ai][1][m][0], vd = acc[ai][1][m][1];
                if (Mul) {
                    const u32x4 g0 = *(const u32x4*)(Mul + off0), g1 = *(const u32x4*)(Mul + off0 + 128);
                    va[0] *= bflo(g0.x); va[1] *= bfhi(g0.x); va[2] *= bflo(g0.y); va[3] *= bfhi(g0.y); vb2[0] *= bflo(g0.z); vb2[1] *= bfhi(g0.z); vb2[2] *= bflo(g0.w); vb2[3] *= bfhi(g0.w);
                    vc[0] *= bflo(g1.x); vc[1] *= bfhi(g1.x); vc[2] *= bflo(g1.y); vc[3] *= bfhi(g1.y); vd[0] *= bflo(g1.z); vd[1] *= bfhi(g1.z); vd[2] *= bflo(g1.w); vd[3] *= bfhi(g1.w);
                }
                xa += va; xb2 += vb2; xc += vc; xd += vd;
                *(f32x4*)(X + off0) = xa; *(f32x4*)(X + off0 + 4) = xb2; *(f32x4*)(X + off0 + 128) = xc; *(f32x4*)(X + off0 + 132) = xd;
                u32x4 w0; w0.x = pk2(xa[0], xa[1]); w0.y = pk2(xa[2], xa[3]); w0.z = pk2(xb2[0], xb2[1]); w0.w = pk2(xb2[2], xb2[3]);
                u32x4 w1; w1.x = pk2(xc[0], xc[1]); w1.y = pk2(xc[2], xc[3]); w1.z = pk2(xd[0], xd[1]); w1.w = pk2(xd[2], xd[3]);
                *(u32x4*)(XB + off0) = w0; *(u32x4*)(XB + off0 + 128) = w1;
                float sq = ((xa[0] * xa[0] + xa[1] * xa[1]) + (xa[2] * xa[2] + xa[3] * xa[3])) + ((xb2[0] * xb2[0] + xb2[1] * xb2[1]) + (xb2[2] * xb2[2] + xb2[3] * xb2[3]))
                         + ((xc[0] * xc[0] + xc[1] * xc[1]) + (xc[2] * xc[2] + xc[3] * xc[3])) + ((xd[0] * xd[0] + xd[1] * xd[1]) + (xd[2] * xd[2] + xd[3] * xd[3]));
                sq += __shfl_xor(sq, 16); sq += __shfl_xor(sq, 32);
                if (fq == 0) ssn[(size_t)row * 16 + u.pn * 4 + wc] = sq;
                asm volatile("" ::: "memory");
            }
    }
};

struct EpiQK {
    static constexpr bool PERM = true, AFTER_DRAIN = false;
    unsigned char* ws; const float* ss; const float* qg; const float* kg;
    __device__ __forceinline__ void operator()(const AccT& acc, const Unit& u, int wr, int wc, int fr, int fq) const {
        const int row0 = u.pm * 256 + wr * 64 + fr;
        const int seg = u.pn >> 2, tl = u.pn & 3;
        bf16_t* base = (bf16_t*)(ws + (seg == 0 ? WS_QA : WS_KA));
        const float* gp = seg == 0 ? qg : kg; const float osc = seg == 0 ? 0.125f * LOG2E : 1.0f;
        const int col0 = tl * 256 + 64 * wc + 8 * fq;
        float rsv[2][4]; load_rs8(ss, u.pm * 256 + wr * 64, -1, (int)(threadIdx.x & 63), fr, rsv);
#pragma unroll
        for (int ai = 0; ai < 2; ++ai)
#pragma unroll
            for (int m = 0; m < 4; ++m) {
                const int row = row0 + ai * 128 + m * 16;
                const float rs = rsv[ai][m];
                f32x4 v[2][2]; float sq = 0.f;
#pragma unroll
                for (int bj = 0; bj < 2; ++bj)
#pragma unroll
                    for (int n = 0; n < 2; ++n) { v[bj][n] = acc[ai][bj][m][n] * rs; const f32x4 t = v[bj][n]; sq += (t[0] * t[0] + t[1] * t[1]) + (t[2] * t[2] + t[3] * t[3]); }
                sq += __shfl_xor(sq, 16); sq += __shfl_xor(sq, 32);
                const float r2o = rsqrtf(sq * (1.f / 64.f) + EPS) * osc;
#pragma unroll
                for (int bj = 0; bj < 2; ++bj) {
                    const f32x4 ga = *(const f32x4*)(gp + 32 * bj + 8 * fq), gb = *(const f32x4*)(gp + 32 * bj + 8 * fq + 4);
                    u32x4 w;
                    w.x = pk2(v[bj][0][0] * r2o * ga[0], v[bj][0][1] * r2o * ga[1]); w.y = pk2(v[bj][0][2] * r2o * ga[2], v[bj][0][3] * r2o * ga[3]);
                    w.z = pk2(v[bj][1][0] * r2o * gb[0], v[bj][1][1] * r2o * gb[1]); w.w = pk2(v[bj][1][2] * r2o * gb[2], v[bj][1][3] * r2o * gb[3]);
                    *(u32x4*)(base + (size_t)row * 1024 + col0 + 32 * bj) = w;
                }
                asm volatile("" ::: "memory");
            }
    }
};
struct EpiSeg {
    static constexpr bool PERM = true, AFTER_DRAIN = false;
    unsigned char* ws; const float* ss;
    __device__ __forceinline__ void operator()(const AccT& acc, const Unit& u, int wr, int wc, int fr, int fq) const {
        const int row0 = u.pm * 256 + wr * 64 + fr;
        bf16_t* base = (bf16_t*)(ws + WS_QB + (size_t)(u.pn >> 2) * S64);
        const int col0 = (u.pn & 3) * 256 + wc * 32 + 8 * fq;
        float rsv[2][4]; load_rs8(ss, u.pm * 256 + wr * 64, -1, (int)(threadIdx.x & 63), fr, rsv);
#pragma unroll
        for (int ai = 0; ai < 2; ++ai)
#pragma unroll
            for (int m = 0; m < 4; ++m) {
                const int row = row0 + ai * 128 + m * 16;
                const float rs = rsv[ai][m];
#pragma unroll
                for (int bj = 0; bj < 2; ++bj) {
                    const f32x4 v0 = acc[ai][bj][m][0] * rs, v1 = acc[ai][bj][m][1] * rs;
                    u32x4 w; w.x = pk2(v0[0], v0[1]); w.y = pk2(v0[2], v0[3]); w.z = pk2(v1[0], v1[1]); w.w = pk2(v1[2], v1[3]);
                    *(u32x4*)(base + (size_t)row * 1024 + col0 + bj * 128) = w;
                }
                asm volatile("" ::: "memory");
            }
    }
};
struct EpiGB {
    static constexpr bool PERM = true, AFTER_DRAIN = false;
    unsigned char* ws; const float* ss; const float* a_log; const float* dt_bias;
    __device__ __forceinline__ void operator()(const AccT& acc, const Unit& u, int wr, int wc, int fr, int fq) const {
        const int row0 = u.pm * 256 + wr * 64 + fr;
        float rsv[2][4]; load_rs8(ss, u.pm * 256 + wr * 64, -1, (int)(threadIdx.x & 63), fr, rsv);
        if (wc == 0 && fq < 2) {
            float* GBp = (float*)(ws + WS_GB);
#pragma unroll
            for (int ai = 0; ai < 2; ++ai)
#pragma unroll
                for (int m = 0; m < 4; ++m) {
                    const int row = row0 + ai * 128 + m * 16;
                    const float rs = rsv[ai][m];
                    float v[8];
#pragma unroll
                    for (int e = 0; e < 4; ++e) { v[e] = acc[ai][0][m][0][e] * rs; v[4 + e] = acc[ai][0][m][1][e] * rs; }
                    if (fq == 0) {
#pragma unroll
                        for (int e = 0; e < 8; ++e) v[e] = sigmoidf_(v[e]);
                    } else {
#pragma unroll
                        for (int e = 0; e < 8; ++e) { const float z = v[e] + dt_bias[e]; const float sp = fmaxf(z, 0.f) + __logf(1.f + __expf(-fabsf(z))); v[e] = -__expf(a_log[e]) * sp; }
                    }
                    float* dst = GBp + (size_t)row * 16 + 8 * fq;
                    *(f32x4*)dst = (f32x4){v[0], v[1], v[2], v[3]}; *(f32x4*)(dst + 4) = (f32x4){v[4], v[5], v[6], v[7]};
                    asm volatile("" ::: "memory");
                }
        }
    }
};

__device__ __forceinline__ void cvt_item(const float* W, int ldw, int src_col0, int nvalid, const float* gain, bf16_t* WT, int K, int dst_row0, int k0, LAS float* scr, int lane) {
    const int nn = lane & 31;
#pragma unroll 8
    for (int i = 0; i < 32; ++i) {
        const int kk = 2 * i + (lane >> 5);
        float v = 0.f;
        if (nn < nvalid) { v = W[(size_t)(k0 + kk) * ldw + src_col0 + nn]; if (gain) v *= gain[k0 + kk]; }
        scr[kk * 33 + nn] = v;
    }
    asm volatile("s_waitcnt lgkmcnt(0)" ::: "memory");
    const int c = lane & 7;
#pragma unroll
    for (int j = 0; j < 4; ++j) {
        const int n = (lane >> 3) + 8 * j; const LAS float* s = scr + (8 * c) * 33 + n;
        u32x4 o; o.x = pk2(s[0 * 33], s[1 * 33]); o.y = pk2(s[2 * 33], s[3 * 33]); o.z = pk2(s[4 * 33], s[5 * 33]); o.w = pk2(s[6 * 33], s[7 * 33]);
        *(u32x4*)(WT + (size_t)(dst_row0 + n) * K + k0 + 8 * c) = o;
    }
    asm volatile("s_waitcnt lgkmcnt(0)" ::: "memory");
}

struct Params {
    const float* in[24];
    float* out;
    unsigned char* ws;
    int seg_lo, seg_hi;
};
enum { I_X = 0, I_P, I_WIN, I_ATTN_NORM, I_QNORM, I_KNORM, I_LAM, I_SUBLN, I_RELB, I_CONVB, I_ALOG, I_DTB, I_ONORM, I_WBRA, I_WBRB, I_WOUT, I_FFN_NORM, I_WUP, I_CONVFF, I_CONVFFB, I_WDOWN, I_PLE_NORM, I_WPG, I_WPP };

__device__ __forceinline__ void convert_weights(const Params* PQ, int layer, LAS unsigned char* lds, int gw, int NGW, int wave, int lane) {
    LAS float* scr = (LAS float*)(lds + wave * 16384);
    unsigned char* ws = PQ->ws;
    const float* w_in = PQ->in[I_WIN] + (size_t)layer * 1024 * DIN;
    const float* g_attn = PQ->in[I_ATTN_NORM] + layer * 1024;
    const float* g_ffn = PQ->in[I_FFN_NORM] + layer * 1024;
    const float* g_ple = PQ->in[I_PLE_NORM] + layer * 1024;
#define CVT_JOB(NITEMS, KB, SRCW, LDW, GAIN, DST, KK, SRCCOL, NVALID) \
    for (int it = gw; it < (NITEMS); it += NGW) { const int g = it / (KB), kb = it % (KB); (void)g; \
        cvt_item((SRCW), (LDW), (SRCCOL), (NVALID), (GAIN), (bf16_t*)(ws + (DST)), (KK), g * 32, kb * 64, scr, lane); } asm volatile("" ::: "memory");
    for (int it = gw; it < 200 * 16; it += NGW) {
        const int g = it >> 4, kb = it & 15, pn = g >> 3, gi = g & 7;
        int src, nv = 32;
        if (pn < 8) { const int bj = gi >> 2, wc = gi & 3; src = (pn >> 2) * 1024 + (pn & 3) * 256 + 64 * wc + 32 * bj; }
        else if (pn < 24) { src = 3072 + (pn - 8) * 256 + 32 * gi; }
        else { src = 7168; nv = (gi == 0) ? 16 : 0; }
        cvt_item(w_in, DIN, src, nv, g_attn, (bf16_t*)(ws + W_IN), 1024, g * 32, kb * 64, scr, lane);
    }
    asm volatile("" ::: "memory");
    CVT_JOB(32 * 16, 16, w_in, DIN, g_attn, W_V, 1024, 2048 + g * 32, 32)
    CVT_JOB(64 * 16, 16, w_in, DIN, g_attn, W_GL, 1024, 7184 + g * 32, 32)
    CVT_JOB(32 * 16, 16, PQ->in[I_WBRA] + (size_t)layer * 1024 * 1024, 1024, (const float*)nullptr, W_BRA, 1024, g * 32, 32)
    CVT_JOB(32 * 16, 16, PQ->in[I_WBRB] + (size_t)layer * 1024 * 1024, 1024, (const float*)nullptr, W_BRB, 1024, g * 32, 32)
    CVT_JOB(32 * 16, 16, PQ->in[I_WOUT] + (size_t)layer * 1024 * 1024, 1024, (const float*)nullptr, W_OUT, 1024, g * 32, 32)
    CVT_JOB(176 * 16, 16, PQ->in[I_WUP] + (size_t)layer * 1024 * 5632, 5632, g_ffn, W_UP, 1024, g * 32, 32)
    CVT_JOB(32 * 44, 44, PQ->in[I_WDOWN] + (size_t)layer * 2816 * 1024, 1024, (const float*)nullptr, W_DOWN, 2816, g * 32, 32)
    CVT_JOB(32 * 16, 16, PQ->in[I_WPG] + (size_t)layer * 1024 * 1024, 1024, g_ple, W_PG, 1024, g * 32, 32)
    CVT_JOB(32 * 4, 4, PQ->in[I_WPP] + (size_t)layer * 256 * 1024, 1024, (const float*)nullptr, W_PP, 256, g * 32, 32)
#undef CVT_JOB
}

constexpr int AT_KROW = 272, AT_VROW = 136  , AT_KBYTES = 64 * AT_KROW, AT_VBYTES = 128 * AT_VROW, AT_STAGE = AT_KBYTES + AT_VBYTES, AT_TB = 2 * AT_STAGE;
static_assert(AT_TB >= 65536 && AT_TB + 1024 <= LDS_BYTES, "attention LDS");
__device__ __forceinline__ void attn_unit(LAS unsigned char* lds, const bf16_t* QA, const bf16_t* KA, const bf16_t* VT, bf16_t* OA, int b, int h, int qb,
                                          float lam, float out_scale, const float* subln, const float* relb, int tid, bool do_store = true) {
    const int lane = tid & 63, wid = __builtin_amdgcn_readfirstlane(tid >> 6), j = wid >> 2, wq = wid & 3, r32 = lane & 31, hi = lane >> 5;
    const int Q0 = qb * 128, qrow = Q0 + 32 * wq + r32;
    const size_t tok = (size_t)b * SEQ + qrow;
    LAS float* TB = (LAS float*)(lds + AT_TB);
    for (int i = tid; i <= 128; i += NTHR) {
        float v = 0.f;
        if (i < 128) {
            int bk = i;
            if (i >= 16) { int lg = 16 + (int)(__logf((float)i * (1.f / 16.f)) / __logf(8.0f) * 16.f); bk = lg < 31 ? lg : 31; }
            v = (relb[bk * 8 + h] - relb[31 * 8 + h]) * LOG2E;
        }
        TB[i] = v;
    }
    bf16x8 qf[4];
#pragma unroll
    for (int d0 = 0; d0 < 4; ++d0) qf[d0] = *(const bf16x8*)(QA + tok * 1024 + h * 128 + 64 * j + 16 * d0 + 8 * hi);
    const int NT = (Q0 + 128) / 64;
    const int kr0 = tid >> 4, kc = tid & 15;
    const int vr0 = tid >> 3, vc = tid & 7;
    const bf16_t* kg = KA + ((size_t)b * SEQ + kr0) * 1024 + h * 128 + kc * 8;
    const bf16_t* vg = VT + (size_t)(h * 128 + vr0) * MTOK + (size_t)b * SEQ + vc * 8;
    u32x4 kreg0, kreg1, vreg0, vreg1;
#define AT_LOAD(t) do { kreg0 = *(const u32x4*)(kg + (size_t)(t) * 64 * 1024); kreg1 = *(const u32x4*)(kg + (size_t)((t) * 64 + 32) * 1024); \
        vreg0 = *(const u32x4*)(vg + (t) * 64); vreg1 = *(const u32x4*)(vg + (size_t)64 * MTOK + (t) * 64); } while (0)
#define AT_STORE(s) do { LAS unsigned char* kb_ = lds + (s) * AT_STAGE; LAS unsigned char* vb_ = kb_ + AT_KBYTES; \
        *(LAS u32x4*)(kb_ + kr0 * AT_KROW + kc * 16) = kreg0; *(LAS u32x4*)(kb_ + (kr0 + 32) * AT_KROW + kc * 16) = kreg1; \
        *(LAS u32x2*)(vb_ + vr0 * AT_VROW + vc * 16) = (u32x2){vreg0.x, vreg0.y}; *(LAS u32x2*)(vb_ + vr0 * AT_VROW + vc * 16 + 8) = (u32x2){vreg0.z, vreg0.w}; \
        *(LAS u32x2*)(vb_ + (vr0 + 64) * AT_VROW + vc * 16) = (u32x2){vreg1.x, vreg1.y}; *(LAS u32x2*)(vb_ + (vr0 + 64) * AT_VROW + vc * 16 + 8) = (u32x2){vreg1.z, vreg1.w}; } while (0)
    AT_LOAD(0); AT_STORE(0);
    __syncthreads();
    f32x16 o[4];
#pragma unroll
    for (int i = 0; i < 4; ++i)
#pragma unroll
        for (int r = 0; r < 16; ++r) o[i][r] = 0.f;
    float mrun = -INFINITY, lrun = 0.f;
    const int qmax_w = Q0 + 32 * wq + 31, qmin_w = Q0 + 32 * wq;
    for (int t = 0; t < NT; ++t) {
        if (t + 1 < NT) AT_LOAD(t + 1);
        const int kv0 = 64 * t;
        if (kv0 <= qmax_w) {
            const LAS unsigned char* Kb = lds + (t & 1) * AT_STAGE; const LAS unsigned char* Vb = Kb + AT_KBYTES;
            f32x16 s0, s1;
#pragma unroll
            for (int r = 0; r < 16; ++r) { s0[r] = 0.f; s1[r] = 0.f; }
#pragma unroll
            for (int d0 = 0; d0 < 4; ++d0) {
                const bf16x8 a0 = *(const LAS bf16x8*)(Kb + r32 * AT_KROW + (64 * j + 16 * d0 + 8 * hi) * 2);
                const bf16x8 a1 = *(const LAS bf16x8*)(Kb + (32 + r32) * AT_KROW + (64 * j + 16 * d0 + 8 * hi) * 2);
                s0 = __builtin_amdgcn_mfma_f32_32x32x16_bf16(a0, qf[d0], s0, 0, 0, 0);
                s1 = __builtin_amdgcn_mfma_f32_32x32x16_bf16(a1, qf[d0], s1, 0, 0, 0);
            }
            if (kv0 + 63 + 128 > qmin_w) {
#pragma unroll
                for (int r = 0; r < 16; ++r) {
                    const int rel0 = qrow - (kv0 + crow(r, hi)), rel1 = rel0 - 32;
                    s0[r] = rel0 < 0 ? -INFINITY : s0[r] + TB[rel0 < 128 ? rel0 : 128];
                    s1[r] = rel1 < 0 ? -INFINITY : s1[r] + TB[rel1 < 128 ? rel1 : 128];
                }
            }
            float mx = fmaxf(s0[0], s1[0]);
#pragma unroll
            for (int r = 1; r < 16; ++r) mx = fmaxf(mx, fmaxf(s0[r], s1[r]));
            mx = fmaxf(mx, __shfl_xor(mx, 32));
            const float mnew = fmaxf(mrun, mx);
            const float alpha = __builtin_amdgcn_exp2f(mrun - mnew);
            mrun = mnew;
            float ls = 0.f;
#pragma unroll
            for (int r = 0; r < 16; ++r) { s0[r] = __builtin_amdgcn_exp2f(s0[r] - mnew); s1[r] = __builtin_amdgcn_exp2f(s1[r] - mnew); ls += s0[r] + s1[r]; }
            lrun = lrun * alpha + ls;
#pragma unroll
            for (int i = 0; i < 4; ++i)
#pragma unroll
                for (int r = 0; r < 16; ++r) o[i][r] *= alpha;
            bf16x8 pf[4];
            { u32x4 w;
              w.x = pk2(s0[0], s0[1]); w.y = pk2(s0[2], s0[3]); w.z = pk2(s0[4], s0[5]); w.w = pk2(s0[6], s0[7]); pf[0] = __builtin_bit_cast(bf16x8, w);
              w.x = pk2(s0[8], s0[9]); w.y = pk2(s0[10], s0[11]); w.z = pk2(s0[12], s0[13]); w.w = pk2(s0[14], s0[15]); pf[1] = __builtin_bit_cast(bf16x8, w);
              w.x = pk2(s1[0], s1[1]); w.y = pk2(s1[2], s1[3]); w.z = pk2(s1[4], s1[5]); w.w = pk2(s1[6], s1[7]); pf[2] = __builtin_bit_cast(bf16x8, w);
              w.x = pk2(s1[8], s1[9]); w.y = pk2(s1[10], s1[11]); w.z = pk2(s1[12], s1[13]); w.w = pk2(s1[14], s1[15]); pf[3] = __builtin_bit_cast(bf16x8, w); }
#pragma unroll
            for (int blk = 0; blk < 4; ++blk)
#pragma unroll
                for (int s = 0; s < 4; ++s) {
                    const LAS unsigned char* vp = Vb + (32 * blk + r32) * AT_VROW + (16 * s + 4 * hi) * 2;
                    const u32x2 lo = *(const LAS u32x2*)vp, hh = *(const LAS u32x2*)(vp + 16);
                    const u32x4 w = (u32x4){lo.x, lo.y, hh.x, hh.y};
                    o[blk] = __builtin_amdgcn_mfma_f32_32x32x16_bf16(__builtin_bit_cast(bf16x8, w), pf[s], o[blk], 0, 0, 0);
                }
        }
        if (t + 1 < NT) AT_STORE((t + 1) & 1);
        __syncthreads();
    }
#undef AT_LOAD
#undef AT_STORE
    lrun += __shfl_xor(lrun, 32);
    const float inv = 1.f / lrun;
    LAS float* EX = (LAS float*)lds;
    if (j == 1) {
        const float sc = inv * lam;
#pragma unroll
        for (int blk = 0; blk < 4; ++blk)
#pragma unroll
            for (int r = 0; r < 16; ++r) EX[(wq * 64 + blk * 16 + r) * 64 + lane] = o[blk][r] * sc;
    }
    __syncthreads();
    if (j == 0) {
        float sq = 0.f;
#pragma unroll
        for (int blk = 0; blk < 4; ++blk)
#pragma unroll
            for (int r = 0; r < 16; ++r) { const float d = o[blk][r] * inv - EX[(wq * 64 + blk * 16 + r) * 64 + lane]; o[blk][r] = d; sq += d * d; }
        sq += __shfl_xor(sq, 32);
        const float rr = rsqrtf(sq * (1.f / 128.f) + EPS) * out_scale;
#pragma unroll
        for (int blk = 0; blk < 4; ++blk)
#pragma unroll
            for (int rq = 0; rq < 4; ++rq) {
                const int dv0 = 32 * blk + 8 * rq + 4 * hi;
                const f32x4 g = *(const f32x4*)(subln + dv0);
                u32x2 w; w.x = pk2(o[blk][4 * rq + 0] * rr * g[0], o[blk][4 * rq + 1] * rr * g[1]); w.y = pk2(o[blk][4 * rq + 2] * rr * g[2], o[blk][4 * rq + 3] * rr * g[3]);
                if (do_store) *(u32x2*)(OA + tok * 1024 + h * 128 + dv0) = w;
            }
    }
    __syncthreads();
}

__device__ __forceinline__ void dn_naive(LAS unsigned char* lds, unsigned char* ws, const float* convw  , int b, int h, int tid) {
    const int lane = tid & 63, wid = tid >> 6, dv = tid & 127, g4 = tid >> 7;
    LAS float* Y = (LAS float*)lds;
    LAS float* NR = Y + 384;
    LAS float* PT = NR + 8;
    LAS float* OP = PT + 512;
    float S[32];
#pragma unroll
    for (int i = 0; i < 32; ++i) S[i] = 0.f;
    bf16_t* QB = (bf16_t*)(ws + WS_QB); const bf16_t* KB = (const bf16_t*)(ws + WS_KB); const bf16_t* VB = (const bf16_t*)(ws + WS_VB);
    const float* GBp = (const float*)(ws + WS_GB);
    const int arr = tid >> 7;
    const bf16_t* src = (arr == 0 ? (const bf16_t*)QB : arr == 1 ? KB : VB) + h * 128 + dv;
    float w0 = 0.f, w1 = 0.f, w2 = 0.f, w3 = 0.f, x1 = 0.f, x2 = 0.f, x3 = 0.f;
    if (tid < 384) { const int ch = arr * 1024 + h * 128 + dv; w0 = convw[ch]; w1 = convw[3072 + ch]; w2 = convw[2 * 3072 + ch]; w3 = convw[3 * 3072 + ch]; }
    for (int t = 0; t < SEQ; ++t) {
        const size_t tok = (size_t)b * SEQ + t;
        if (tid < 384) {
            const float x0 = bf2f(src[tok * 1024]);
            float y = w0 * x3 + w1 * x2 + w2 * x1 + w3 * x0;
            y = siluf_(y); x3 = x2; x2 = x1; x1 = x0;
            Y[arr * 128 + dv] = y;
            const float sq = wave_sum(y * y);
            if (lane == 0) NR[wid] = sq;
        }
        __syncthreads();
        const float qn = rsqrtf(NR[0] + NR[1] + EPS) * 0.08838834764831845f, kn = rsqrtf(NR[2] + NR[3] + EPS);
        const float bt = GBp[tok * 16 + h], gt = GBp[tok * 16 + 8 + h], eg = __expf(gt);
        const float vv = Y[256 + dv];
        float ks = 0.f;
#pragma unroll
        for (int i = 0; i < 32; ++i) ks += Y[128 + 32 * g4 + i] * S[i];
        PT[g4 * 128 + dv] = ks * kn;
        __syncthreads();
        const float kS = (PT[dv] + PT[128 + dv]) + (PT[256 + dv] + PT[384 + dv]);
        const float c = bt * (vv - eg * kS);
        float op = 0.f;
#pragma unroll
        for (int i = 0; i < 32; ++i) { const float kk = Y[128 + 32 * g4 + i] * kn; S[i] = eg * S[i] + kk * c; op += Y[32 * g4 + i] * S[i]; }
        OP[g4 * 128 + dv] = op * qn;
        __syncthreads();
        if (g4 == 0) { const float ov = (OP[dv] + OP[128 + dv]) + (OP[256 + dv] + OP[384 + dv]); QB[tok * 1024 + h * 128 + dv] = f2bf(ov); }
    }
    __syncthreads();
}

__device__ __forceinline__ float row16_sum(float v) {
    v += __builtin_bit_cast(float, __builtin_amdgcn_update_dpp(0, __builtin_bit_cast(int, v), 0x128, 0xf, 0xf, false));
    v += __builtin_bit_cast(float, __builtin_amdgcn_update_dpp(0, __builtin_bit_cast(int, v), 0x124, 0xf, 0xf, false));
    v += __builtin_bit_cast(float, __builtin_amdgcn_update_dpp(0, __builtin_bit_cast(int, v), 0x122, 0xf, 0xf, false));
    v += __builtin_bit_cast(float, __builtin_amdgcn_update_dpp(0, __builtin_bit_cast(int, v), 0x121, 0xf, 0xf, false));
    return v;
}
__device__ __forceinline__ void dn_fast(LAS unsigned char* lds, unsigned char* ws, const float* convw  , int b, int h, int dvq, int tid) {
    const int lane = tid & 63, wid = tid >> 6, dvl = lane >> 4, grp = lane & 15;
    const int dvloc = 4 * wid + dvl, dv = 32 * dvq + dvloc;
    LAS float* Y = (LAS float*)lds;
    LAS float* NR = Y + 16 * 288;
    LAS float* GBs = NR + 16 * 16;
    LAS float* SC = GBs + 32;
    float S[8];
#pragma unroll
    for (int i = 0; i < 8; ++i) S[i] = 0.f;
    bf16_t* VB = (bf16_t*)(ws + WS_VB);
    const float* GBp = (const float*)(ws + WS_GB);
    const int arr = tid < 128 ? 0 : (tid < 256 ? 1 : 2);
    const int dch = arr == 2 ? 32 * dvq + ((tid - 256) & 31) : (tid & 127);
    const bf16_t* src = (const bf16_t*)(ws + (arr == 0 ? WS_QB : arr == 1 ? WS_KB : WS_VB)) + h * 128 + dch;
    float w0 = 0.f, w1 = 0.f, w2 = 0.f, w3 = 0.f, x1 = 0.f, x2 = 0.f, x3 = 0.f;
    if (tid < 288) { const int ch = arr * 1024 + h * 128 + dch; w0 = convw[ch]; w1 = convw[3072 + ch]; w2 = convw[2 * 3072 + ch]; w3 = convw[3 * 3072 + ch]; }
    for (int t0 = 0; t0 < SEQ; t0 += 16) {
        const size_t tokb = (size_t)b * SEQ + t0;
        if (tid < 288) {
            bf16_t xr[16];
#pragma unroll
            for (int tt = 0; tt < 16; ++tt) xr[tt] = src[(tokb + tt) * 1024];
#pragma unroll
            for (int tt = 0; tt < 16; ++tt) {
                const float x0 = bf2f(xr[tt]);
                float y = w0 * x3 + w1 * x2 + w2 * x1 + w3 * x0;
                y = siluf_(y); x3 = x2; x2 = x1; x1 = x0;
                Y[tt * 288 + tid] = y;
                if (tid < 256) { const float sq = row16_sum(y * y); if ((lane & 15) == 0) NR[tt * 16 + wid * 4 + (lane >> 4)] = sq; }
            }
        }
        if (tid >= 480) { const int i = tid - 480, tt = i >> 1, which = i & 1; GBs[tt * 2 + which] = GBp[(tokb + tt) * 16 + which * 8 + h]; }
        __syncthreads();
        if (tid < 16) {
            const f32x4 a = *(const LAS f32x4*)(NR + tid * 16), b2 = *(const LAS f32x4*)(NR + tid * 16 + 4), c2 = *(const LAS f32x4*)(NR + tid * 16 + 8), d2 = *(const LAS f32x4*)(NR + tid * 16 + 12);
            const float sq_q = ((a[0] + a[1]) + (a[2] + a[3])) + ((b2[0] + b2[1]) + (b2[2] + b2[3])), sq_k = ((c2[0] + c2[1]) + (c2[2] + c2[3])) + ((d2[0] + d2[1]) + (d2[2] + d2[3]));
            *(LAS f32x4*)(SC + tid * 4) = (f32x4){rsqrtf(sq_q + EPS) * 0.08838834764831845f, rsqrtf(sq_k + EPS), __expf(GBs[tid * 2 + 1]), GBs[tid * 2]};
        }
        __syncthreads();
#pragma unroll 4
        for (int tt = 0; tt < 16; ++tt) {
            const f32x4 sc = *(const LAS f32x4*)(SC + tt * 4);
            const float qn = sc[0], kn = sc[1], eg = sc[2], bt = sc[3];
            const f32x4 ka = *(const LAS f32x4*)(Y + tt * 288 + 128 + 8 * grp), kb = *(const LAS f32x4*)(Y + tt * 288 + 128 + 8 * grp + 4);
            const f32x4 qa = *(const LAS f32x4*)(Y + tt * 288 + 8 * grp), qb = *(const LAS f32x4*)(Y + tt * 288 + 8 * grp + 4);
            const float vv = Y[tt * 288 + 256 + dvloc];
            float ks = (ka[0] * S[0] + ka[1] * S[1]) + (ka[2] * S[2] + ka[3] * S[3]) + (kb[0] * S[4] + kb[1] * S[5]) + (kb[2] * S[6] + kb[3] * S[7]);
            ks = row16_sum(ks);
            const float c = bt * (vv - eg * ks * kn) * kn;
            float op = 0.f;
#pragma unroll
            for (int i = 0; i < 4; ++i) { S[i] = eg * S[i] + ka[i] * c; op += qa[i] * S[i]; S[4 + i] = eg * S[4 + i] + kb[i] * c; op += qb[i] * S[4 + i]; }
            op = row16_sum(op);
            if (grp == 0) VB[(tokb + tt) * 1024 + h * 128 + dv] = f2bf(op * qn);
        }
        __syncthreads();
    }
}

__device__ __forceinline__ float row8_sum(float v) {
    v += __builtin_bit_cast(float, __builtin_amdgcn_update_dpp(0, __builtin_bit_cast(int, v), 0x141, 0xf, 0xf, false));
    v += __builtin_bit_cast(float, __builtin_amdgcn_update_dpp(0, __builtin_bit_cast(int, v), 0x1B, 0xf, 0xf, false));
    v += __builtin_bit_cast(float, __builtin_amdgcn_update_dpp(0, __builtin_bit_cast(int, v), 0xB1, 0xf, 0xf, false));
    return v;
}
constexpr int DN_T = 32;
constexpr int DN2_YB = DN_T * 288 + DN_T * 16 + DN_T * 2 + DN_T * 4;
__device__ __forceinline__ void dn_pc(LAS unsigned char* lds, unsigned char* ws, const float* convw  , int b, int h, int dvq, int tid, bool do_store = true) {
    const int lane = tid & 63, wid = tid >> 6;
    const bool producer = tid >= 256;
    const int pt = tid - 256;
    LAS float* L = (LAS float*)lds;
    bf16_t* VB = (bf16_t*)(ws + WS_VB);
    const float* GBp = (const float*)(ws + WS_GB);
    const int parr = pt < 128 ? 0 : 1, pd = pt & 127;
    const bf16_t* src = (const bf16_t*)(ws + (parr == 0 ? WS_QB : WS_KB)) + h * 128 + pd;
    const bf16_t* srcv = (const bf16_t*)(ws + WS_VB) + h * 128 + 32 * dvq + (pt & 31);
    float w0 = 0.f, w1 = 0.f, w2 = 0.f, w3 = 0.f, x1 = 0.f, x2 = 0.f, x3 = 0.f, u0 = 0.f, u1 = 0.f, u2 = 0.f, u3 = 0.f, z1 = 0.f, z2 = 0.f, z3 = 0.f;
    if (producer) { const int ch = parr * 1024 + h * 128 + pd; w0 = convw[ch]; w1 = convw[3072 + ch]; w2 = convw[2 * 3072 + ch]; w3 = convw[3 * 3072 + ch];
        if (pt < 32) { const int cv = 2048 + h * 128 + 32 * dvq + pt; u0 = convw[cv]; u1 = convw[3072 + cv]; u2 = convw[2 * 3072 + cv]; u3 = convw[3 * 3072 + cv]; } }
    const int col = tid >> 3, grp = tid & 7;
    float S[16];
#pragma unroll
    for (int i = 0; i < 16; ++i) S[i] = 0.f;
#define DN2_PRODUCE(BUF, T0) do { LAS float* Yp = L + (BUF) * DN2_YB; LAS float* NRp = Yp + DN_T * 288; LAS float* GBsp = NRp + DN_T * 16; const size_t tb_ = (size_t)b * SEQ + (T0); \
        bf16_t xr[DN_T]; bf16_t vr[DN_T]; \
        _Pragma("unroll") for (int tt = 0; tt < DN_T; ++tt) xr[tt] = src[(tb_ + tt) * 1024]; \
        if (pt < 32) { _Pragma("unroll") for (int tt = 0; tt < DN_T; ++tt) vr[tt] = srcv[(tb_ + tt) * 1024]; } \
        if (pt >= 256 - 2 * DN_T) { const int i_ = pt - (256 - 2 * DN_T), tt_ = i_ >> 1, wh_ = i_ & 1; GBsp[tt_ * 2 + wh_] = GBp[(tb_ + tt_) * 16 + wh_ * 8 + h]; } \
        _Pragma("unroll") for (int tt = 0; tt < DN_T; ++tt) { const float x0 = bf2f(xr[tt]); float y = w0 * x3 + w1 * x2 + w2 * x1 + w3 * x0; y = siluf_(y); x3 = x2; x2 = x1; x1 = x0; \
            Yp[tt * 288 + pt] = y; const float sq = row16_sum(y * y); if ((lane & 15) == 0) NRp[tt * 16 + (wid - 4) * 4 + (lane >> 4)] = sq; } \
        if (pt < 32) { _Pragma("unroll") for (int tt = 0; tt < DN_T; ++tt) { const float x0 = bf2f(vr[tt]); float y = u0 * z3 + u1 * z2 + u2 * z1 + u3 * x0; y = siluf_(y); z3 = z2; z2 = z1; z1 = x0; Yp[tt * 288 + 256 + pt] = y; } } \
    } while (0)
    if (producer) DN2_PRODUCE(0, 0);
    for (int n = 0; n < SEQ / DN_T; ++n) {
        const int buf = n & 1;
        LAS float* Y = L + buf * DN2_YB; LAS float* NR = Y + DN_T * 288; LAS float* GBs = NR + DN_T * 16; LAS float* SC = GBs + DN_T * 2;
        __syncthreads();
        if (tid < DN_T) {
            const f32x4 a = *(const LAS f32x4*)(NR + tid * 16), b2 = *(const LAS f32x4*)(NR + tid * 16 + 4), c2 = *(const LAS f32x4*)(NR + tid * 16 + 8), d2 = *(const LAS f32x4*)(NR + tid * 16 + 12);
            const float sq_q = ((a[0] + a[1]) + (a[2] + a[3])) + ((b2[0] + b2[1]) + (b2[2] + b2[3])), sq_k = ((c2[0] + c2[1]) + (c2[2] + c2[3])) + ((d2[0] + d2[1]) + (d2[2] + d2[3]));
            *(LAS f32x4*)(SC + tid * 4) = (f32x4){rsqrtf(sq_q + EPS) * 0.08838834764831845f, rsqrtf(sq_k + EPS), __expf(GBs[tid * 2 + 1]), GBs[tid * 2]};
        }
        __syncthreads();
        if (producer) { if (n + 1 < SEQ / DN_T) DN2_PRODUCE(buf ^ 1, DN_T * (n + 1)); }
        else {
            const size_t tokb = (size_t)b * SEQ + DN_T * n;
#pragma unroll 8
            for (int tt = 0; tt < DN_T; ++tt) {
                const f32x4 sc = *(const LAS f32x4*)(SC + tt * 4);
                const float qn = sc[0], kn = sc[1], eg = sc[2], bt = sc[3];
                const LAS f32x4* kp = (const LAS f32x4*)(Y + tt * 288 + 128 + 16 * grp); const LAS f32x4* qp = (const LAS f32x4*)(Y + tt * 288 + 16 * grp);
                const f32x4 k0 = kp[0], k1 = kp[1], k2 = kp[2], k3 = kp[3], q0 = qp[0], q1 = qp[1], q2 = qp[2], q3 = qp[3];
                const float vv = Y[tt * 288 + 256 + col];
                float ks = ((k0[0] * S[0] + k0[1] * S[1]) + (k0[2] * S[2] + k0[3] * S[3])) + ((k1[0] * S[4] + k1[1] * S[5]) + (k1[2] * S[6] + k1[3] * S[7]))
                         + ((k2[0] * S[8] + k2[1] * S[9]) + (k2[2] * S[10] + k2[3] * S[11])) + ((k3[0] * S[12] + k3[1] * S[13]) + (k3[2] * S[14] + k3[3] * S[15]));
                ks = row8_sum(ks);
                const float c = bt * (vv - eg * ks * kn) * kn;
                float op0 = 0.f, op1 = 0.f;
#pragma unroll
                for (int i = 0; i < 4; ++i) { S[i] = eg * S[i] + k0[i] * c; op0 += q0[i] * S[i]; S[4 + i] = eg * S[4 + i] + k1[i] * c; op1 += q1[i] * S[4 + i];
                                              S[8 + i] = eg * S[8 + i] + k2[i] * c; op0 += q2[i] * S[8 + i]; S[12 + i] = eg * S[12 + i] + k3[i] * c; op1 += q3[i] * S[12 + i]; }
                const float op = row8_sum(op0 + op1);
                if (grp == 0 && do_store) VB[(tokb + tt) * 1024 + h * 128 + 32 * dvq + col] = f2bf(op * qn);
                if (!do_store) asm volatile("" :: "v"(op));
            }
        }
    }
    __syncthreads();
#undef DN2_PRODUCE
}

#define GEMM_PHASE(EPI, Aptr, Bptr, Mv, Nv, Kv, Eobj, HM) do { int m_ = (Mv), n_ = (Nv), k_ = (Kv); asm volatile("" : "+s"(m_), "+s"(n_), "+s"(k_)); pg8::Gemm g_{(const pg8::bf16_t*)(Aptr), (const pg8::bf16_t*)(Bptr), m_, n_, k_, (HM)}; pg8::StaticOrder S_; S_.init(m_, n_, G, bid); \
        pg8::gemm_phase<EPI, pg8::StaticOrder, true, true>(lds, g_, S_, (Eobj)); } while (0)

__global__ void __launch_bounds__(NTHR, 2) fwd_mega(Params P) {
    extern __shared__ __attribute__((aligned(16))) unsigned char lds_raw[];
    LAS unsigned char* lds = (LAS unsigned char*)lds_raw;
    cg::grid_group grid = cg::this_grid();
    if (threadIdx.x == 0) {
        const unsigned xcc = (unsigned)__builtin_amdgcn_s_getreg((3 << 11) | 20) & 7u;
        const unsigned loc = __hip_atomic_fetch_add((unsigned*)(P.ws + WS_CTL) + xcc, 1u, __ATOMIC_RELAXED, __HIP_MEMORY_SCOPE_AGENT);
        *(LAS int*)(lds + LDS_VB) = (int)((loc & 31u) * 8u + xcc);
    }
    __syncthreads();
    int seg = 0; const int seg_lo = P.seg_lo, seg_hi = P.seg_hi;
#ifdef L2FLUSH
#define L2_FLUSH() do { const Params* PF = (const Params*)__builtin_amdgcn_kernarg_segment_ptr(); asm volatile("" : "+s"(PF)); int tf_ = threadIdx.x; asm volatile("" : "+v"(tf_)); \
        const u32x4* jp = (const u32x4*)(PF->in[I_P]) + (size_t)blockIdx.x * (L2FLUSH * 64) + tf_; unsigned acc_ = 0u; \
        for (int q_ = 0; q_ < L2FLUSH * 64 / 512; ++q_) { const u32x4 v_ = __builtin_nontemporal_load(jp + (size_t)q_ * 512); acc_ |= v_.x & v_.y & v_.z & v_.w; asm volatile("" ::: "memory"); } \
        if (acc_ == 0x12345678u) PF->out[0] = 0.f; } while (0)
#else
#define L2_FLUSH() do {} while (0)
#endif
#ifdef NOSEG
#define SYNCCOND true
#else
#define SYNCCOND (seg >= seg_lo && seg + 1 < seg_hi)
#endif
#define GRID_SYNC() do { if (SYNCCOND) { asm volatile("s_waitcnt vmcnt(0) lgkmcnt(0)" ::: "memory");   grid.sync(); L2_FLUSH(); \
        if (threadIdx.x < 64) { __builtin_amdgcn_fence(__ATOMIC_ACQUIRE, "agent"); asm volatile("s_waitcnt vmcnt(0)" ::: "memory"); } __syncthreads();     \
        } ++seg; } while (0)
#ifdef NOSEG
#define SEGCOND true
#else
#define SEGCOND (seg >= seg_lo && seg < seg_hi)
#endif
#define PH_BEGIN if (SEGCOND) { const Params* PQ = (const Params*)__builtin_amdgcn_kernarg_segment_ptr(); asm volatile("" : "+s"(PQ)); int tid = threadIdx.x; asm volatile("" : "+v"(tid)); \
    const int lane = tid & 63, wave = __builtin_amdgcn_readfirstlane(tid >> 6); int bid = __builtin_amdgcn_readfirstlane(*(LAS int*)(lds + LDS_VB)), G = gridDim.x; asm volatile("" : "+s"(bid), "+s"(G)); \
    const int xb_ = bid & 7, jb_ = bid >> 3, wj = jb_ * NW + wave;     \
    unsigned char* ws = PQ->ws; float* X = PQ->out; float* SS = (float*)(ws + WS_SS); bf16_t* XB = (bf16_t*)(ws + WS_XB); \
    float* ss_attn = (float*)(ws + WS_HALO); float* ss_ffn = ss_attn + (size_t)MTOK * 16; float* ss_ple = ss_ffn + (size_t)MTOK * 16; float* ss_next = ss_attn; \
    (void)lane; (void)xb_; (void)jb_; (void)wj; (void)X; (void)XB; (void)ss_attn; (void)ss_ffn; (void)ss_ple; (void)ss_next; (void)G;
#define PH_END }
#define U ((bf16_t*)(ws + WS_MIX + (size_t)half * 176 * MiB))
#define ACT ((bf16_t*)(ws + WS_MIX + (half == 0 ? (size_t)352 * MiB : (size_t)0)))

    { const int layer = 0; PH_BEGIN
      if (bid == 0 && tid == 0) __hip_atomic_store((unsigned*)(ws + WS_CTL) + 16, 0u, __ATOMIC_RELAXED, __HIP_MEMORY_SCOPE_AGENT);
      const float* xin = PQ->in[I_X];
      for (int r = wj; r < SEQ; r += 256) {
          const int m = xb_ * SEQ + r;
          const f32x4* xr = (const f32x4*)(xin + (size_t)m * 1024) + lane;
          f32x4 v[4]; float s = 0.f;
#pragma unroll
          for (int jj = 0; jj < 4; ++jj) { v[jj] = xr[64 * jj]; s += (v[jj][0] * v[jj][0] + v[jj][1] * v[jj][1]) + (v[jj][2] * v[jj][2] + v[jj][3] * v[jj][3]); }
          s = wave_sum(s);
          if (lane < 16) ss_attn[(size_t)m * 16 + lane] = lane == 0 ? s : 0.f;
          f32x4* xo = (f32x4*)(X + (size_t)m * 1024) + lane;
          u32x2* bo = (u32x2*)(XB + (size_t)m * 1024) + lane;
#pragma unroll
          for (int jj = 0; jj < 4; ++jj) { xo[64 * jj] = v[jj]; u32x2 w; w.x = pk2(v[jj][0], v[jj][1]); w.y = pk2(v[jj][2], v[jj][3]); bo[64 * jj] = w; }
      }
    PH_END }

    for (int layer = 0; layer < NLAYER; ++layer) {
        asm volatile("" ::: "memory");
        const float lam_init = 0.8f - 0.6f * __expf(-0.3f * (float)layer);
        PH_BEGIN
        convert_weights(PQ, layer, lds, bid * NW + wave, G * NW, wave, lane);
        { const float* pl = PQ->in[I_P] + ((size_t)layer * MTOK + (size_t)xb_ * SEQ) * DPLE;
          bf16_t* pb = (bf16_t*)(ws + WS_PB) + (size_t)xb_ * SEQ * DPLE;
          for (int i = jb_ * NTHR + tid; i < SEQ * DPLE / 8; i += 32 * NTHR) {
              const f32x4 a = *(const f32x4*)(pl + (size_t)i * 8), b = *(const f32x4*)(pl + (size_t)i * 8 + 4);
              u32x4 w; w.x = pk2(a[0], a[1]); w.y = pk2(a[2], a[3]); w.z = pk2(b[0], b[1]); w.w = pk2(b[2], b[3]);
              *(u32x4*)(pb + (size_t)i * 8) = w;
          }
        }
        PH_END
        GRID_SYNC();
#ifdef DBLTEST
#ifdef DBL_SC
#define DBL_LD(p) ldc16(p)
#else
#define DBL_LD(p) (*(p))
#endif
        if (layer == 0) {
#ifdef DBL_OUTP
        PH_BEGIN
        { EpiResid E{X, XB, ss_ffn, nullptr, -1};
          GEMM_PHASE(EpiResid, ws + WS_VT, ws + W_OUT, MTOK, 1024, 1024, E, -1); }
        PH_END
        GRID_SYNC();
#endif
        for (int rep = 0; rep < 2; ++rep) {
        PH_BEGIN
#ifdef DBL_COPY
            { const u32x4* s4 = (const u32x4*)XB; u32x4* d4 = (u32x4*)(ws + WS_MIX + (size_t)rep * 176 * MiB);
              const size_t per = (size_t)DBL_M * DBL_N * 2 / 16 / 8;
              for (size_t i = (size_t)((jb_ + rep * 13) & 31) * NTHR + tid; i < per; i += (size_t)32 * NTHR) d4[(size_t)xb_ * per + i] = DBL_LD(s4 + (size_t)xb_ * per + i); }
#else
#ifndef DBL_W
#define DBL_W W_UP
#define DBL_ACT 0
#endif
            { EpiRowScale<DBL_ACT> E{(bf16_t*)(ws + WS_MIX + (size_t)rep * DBL_OFF * MiB), DBL_N, ss_attn, DBL_H};
              GEMM_PHASE(EpiRowScale<DBL_ACT>, XB, ws + DBL_W, DBL_M, DBL_N, 1024, E, DBL_H); }
#endif
        PH_END
        GRID_SYNC();
        }
        PH_BEGIN
        { const u32x4* a4 = (const u32x4*)(ws + WS_MIX); const u32x4* b4 = (const u32x4*)(ws + WS_MIX + (size_t)DBL_OFF * MiB); unsigned bad = 0u;
          const size_t per = (size_t)DBL_M * DBL_N * 2 / 16 / 8;
          for (size_t i0 = (size_t)((jb_ + 7) & 31) * NTHR + tid; i0 < per; i0 += (size_t)32 * NTHR) { const size_t i = (size_t)xb_ * per + i0; const u32x4 a = DBL_LD(a4 + i), b = DBL_LD(b4 + i); bad |= ((a.x ^ b.x) | (a.y ^ b.y) | (a.z ^ b.z) | (a.w ^ b.w)) ? 1u : 0u; }
          if (bad) __hip_atomic_fetch_or((unsigned*)(ws + WS_CTL) + 16, 1u, __ATOMIC_RELAXED, __HIP_MEMORY_SCOPE_AGENT); }
        PH_END
        GRID_SYNC();
        }
#endif
#if defined(DBLMIX) && !defined(DBLMIX_AT_GATES)
        for (int rep = 0; rep < 2; ++rep) {
#endif
#ifndef NO_INPROJ
        PH_BEGIN
        { EpiQK E{ws, ss_attn, PQ->in[I_QNORM] + layer * 64, PQ->in[I_KNORM] + layer * 64};
          GEMM_PHASE(EpiQK, XB, ws + W_IN, MTOK, 2048, 1024, E, -1); }
        PH_END
        PH_BEGIN
        { EpiSeg E{ws, ss_attn};
          GEMM_PHASE(EpiSeg, XB, ws + W_IN + (size_t)2048 * 2048, MTOK, 4096, 1024, E, -1); }
        PH_END
#ifdef SEG_PROBE
        PH_BEGIN
        { EpiSeg E{ws, ss_attn};
          GEMM_PHASE(EpiSeg, XB, ws + W_IN + (size_t)2048 * 2048, MTOK, 4096, 1024, E, -1); }
        PH_END
#endif
        PH_BEGIN
        { EpiGB E{ws, ss_attn, PQ->in[I_ALOG] + layer * 8, PQ->in[I_DTB] + layer * 8};
          GEMM_PHASE(EpiGB, XB, ws + W_IN + (size_t)6144 * 2048, MTOK, 256, 1024, E, -1); }
        PH_END
        PH_BEGIN
        { EpiVt E{(bf16_t*)(ws + WS_VT), ss_attn};
          GEMM_PHASE(EpiVt, ws + W_V, XB, 1024, MTOK, 1024, E, -1); }
        PH_END
#endif
        GRID_SYNC();
#ifndef NO_ATTN
        PH_BEGIN
        { const float* lq = PQ->in[I_LAM] + layer * 256;
          const float a1 = wave_sum(lq[lane] * lq[64 + lane]), a2 = wave_sum(lq[128 + lane] * lq[192 + lane]);
          const float lam = __expf(a1) - __expf(a2) + lam_init;
#ifdef ATTN_PROBE
          for (int k = 0; k < 4; ++k) {
              const int pi = jb_ + 32 * k, hh = pi >> 4, s = pi & 15;
              attn_unit(lds, (const bf16_t*)(ws + WS_QA), (const bf16_t*)(ws + WS_KA), (const bf16_t*)(ws + WS_VT), (bf16_t*)(ws + WS_QA), xb_, hh, 31 - s, lam, 1.f - lam_init, PQ->in[I_SUBLN] + layer * 128, PQ->in[I_RELB], tid, false);
              attn_unit(lds, (const bf16_t*)(ws + WS_QA), (const bf16_t*)(ws + WS_KA), (const bf16_t*)(ws + WS_VT), (bf16_t*)(ws + WS_QA), xb_, hh, s, lam, 1.f - lam_init, PQ->in[I_SUBLN] + layer * 128, PQ->in[I_RELB], tid, false);
          }
          __syncthreads();
#endif
          for (int k = 0; k < 4; ++k) {
              const int pi = jb_ + 32 * k, hh = pi >> 4, s = pi & 15;
              attn_unit(lds, (const bf16_t*)(ws + WS_QA), (const bf16_t*)(ws + WS_KA), (const bf16_t*)(ws + WS_VT), (bf16_t*)(ws + WS_QA), xb_, hh, 31 - s, lam, 1.f - lam_init, PQ->in[I_SUBLN] + layer * 128, PQ->in[I_RELB], tid);
              attn_unit(lds, (const bf16_t*)(ws + WS_QA), (const bf16_t*)(ws + WS_KA), (const bf16_t*)(ws + WS_VT), (bf16_t*)(ws + WS_QA), xb_, hh, s, lam, 1.f - lam_init, PQ->in[I_SUBLN] + layer * 128, PQ->in[I_RELB], tid);
          }
        }
        PH_END
#endif
#ifndef NO_DN
        PH_BEGIN
#ifdef DN_NAIVE
        if (jb_ < 8) dn_naive(lds, ws, PQ->in[I_CONVB] + (size_t)layer * 4 * 3072, xb_, jb_, tid);
#else
#ifdef DN_FAST1
        dn_fast(lds, ws, PQ->in[I_CONVB] + (size_t)layer * 4 * 3072, xb_, jb_ >> 2, jb_ & 3, tid);
#else
#ifdef DN_PROBE
        dn_pc(lds, ws, PQ->in[I_CONVB] + (size_t)layer * 4 * 3072, xb_, jb_ >> 2, jb_ & 3, tid, false);
#endif
        dn_pc(lds, ws, PQ->in[I_CONVB] + (size_t)layer * 4 * 3072, xb_, jb_ >> 2, jb_ & 3, tid);
#endif
#endif
        PH_END
#endif
        GRID_SYNC();
#if defined(DBLMIX) && defined(DBLMIX_AT_GATES)
        for (int rep = 0; rep < 2; ++rep) {
#endif
#ifndef NO_GATES
        PH_BEGIN
        { EpiRowScale<1> E{(bf16_t*)(ws + WS_G), 2048, ss_attn, -1};
          GEMM_PHASE(EpiRowScale<1>, XB, ws + W_GL, MTOK, 1024, 1024, E, -1); }
        PH_END
        PH_BEGIN
        { EpiRowScale<1> E{(bf16_t*)(ws + WS_G) + 1024, 2048, ss_attn, -1};
          GEMM_PHASE(EpiRowScale<1>, XB, ws + W_GL + (size_t)1024 * 2048, MTOK, 1024, 1024, E, -1); }
        PH_END
#endif
#ifndef NO_OBNORM
        PH_BEGIN
        { const float* on = PQ->in[I_ONORM] + layer * 128;
          const float g0 = on[2 * lane], g1 = on[2 * lane + 1];
          unsigned* OB = (unsigned*)(ws + WS_QB) + (size_t)xb_ * SEQ * 512; const unsigned* OI = (const unsigned*)(ws + WS_OSRC) + (size_t)xb_ * SEQ * 512; const unsigned* ZB = (const unsigned*)(ws + WS_ZB) + (size_t)xb_ * SEQ * 512;
#pragma unroll 4
          for (int r = wj; r < SEQ * NH; r += 256) {
              const unsigned ov = OI[(size_t)r * 64 + lane], zv = ZB[(size_t)r * 64 + lane];
              const float o0 = bflo(ov), o1 = bfhi(ov);
              const float sq = wave_sum(o0 * o0 + o1 * o1);
              const float rr = rsqrtf(sq * (1.f / 128.f) + EPS);
              OB[(size_t)r * 64 + lane] = pk2(o0 * rr * g0 * siluf_(bflo(zv)), o1 * rr * g1 * siluf_(bfhi(zv)));
          }
        }
        PH_END
#endif
#ifndef NO_TMPA
        PH_BEGIN
        { EpiGateMul E{(bf16_t*)(ws + WS_TMPA), (const bf16_t*)(ws + WS_G), 2048, 0, nullptr};
          GEMM_PHASE(EpiGateMul, ws + WS_QA, ws + W_BRA, MTOK, 1024, 1024, E, -1); }
        PH_END
#endif
        GRID_SYNC();
#ifndef NO_MIXED
        PH_BEGIN
        { EpiGateMul E{(bf16_t*)(ws + WS_MIXED), (const bf16_t*)(ws + WS_G), 2048, 1024, (const bf16_t*)(ws + WS_TMPA)};
          GEMM_PHASE(EpiGateMul, ws + WS_QB, ws + W_BRB, MTOK, 1024, 1024, E, -1); }
        PH_END
#endif
        GRID_SYNC();
#ifdef DBLMIX
        PH_BEGIN
        { const u32x4* t4 = (const u32x4*)(ws + (size_t)DBL_TGT + (size_t)xb_ * ((size_t)DBL_TGT_BYTES / 8)); u32x4* s4 = (u32x4*)(ws + WS_PB + (size_t)xb_ * 2 * MiB); unsigned bad = 0u;
          for (size_t i = (size_t)((jb_ + 5 * rep) & 31) * NTHR + tid; i < (size_t)2 * MiB / 16; i += (size_t)32 * NTHR) {
              const u32x4 a = t4[i];
              if (rep == 0) s4[i] = a; else { const u32x4 b = s4[i]; bad |= ((a.x ^ b.x) | (a.y ^ b.y) | (a.z ^ b.z) | (a.w ^ b.w)) ? 1u : 0u; } }
          if (bad) __hip_atomic_fetch_or((unsigned*)(ws + WS_CTL) + 16, 1u, __ATOMIC_RELAXED, __HIP_MEMORY_SCOPE_AGENT); }
        PH_END
        GRID_SYNC();
        }
#endif
#ifndef NO_OUTP
        PH_BEGIN
        { EpiResid E{X, XB, ss_ffn, nullptr, -1};
          GEMM_PHASE(EpiResid, ws + WS_MIXED, ws + W_OUT, MTOK, 1024, 1024, E, -1); }
        PH_END
#endif
        GRID_SYNC();
        for (int step = 0; step < 4; ++step) {
        if (step < 2) { const int half = step;
#ifndef NO_UP
        PH_BEGIN
            { EpiRowScale<0> E{U, 5632, ss_ffn, half};
              GEMM_PHASE(EpiRowScale<0>, XB, ws + W_UP, 16384, 5632, 1024, E, half); }
        PH_END
#endif
        }
        if (step >= 1 && step <= 2) { const int half = step - 1;
#ifndef NO_ACT
        PH_BEGIN
            { const float* cw = PQ->in[I_CONVFF] + (size_t)layer * 3 * 5632; const float* cb = PQ->in[I_CONVFFB] + (size_t)layer * 5632;
              bf16_t* UH = (bf16_t*)(ws + WS_UHALO) + (size_t)xb_ * 2 * 5632;
              for (int it = jb_ * NTHR + tid; it < 128 * 352; it += 32 * NTHR) {
                  const int cc = it % 352, rg = it / 352, c0 = cc * 8;
                  const int lrow0 = xb_ * 2048 + rg * 16;
                  float wg[3][8], wv[3][8], bg[8], bv[8];
#pragma unroll
                  for (int jj = 0; jj < 3; ++jj)
#pragma unroll
                      for (int e = 0; e < 8; ++e) { wg[jj][e] = cw[jj * 5632 + c0 + e]; wv[jj][e] = cw[jj * 5632 + 2816 + c0 + e]; }
#pragma unroll
                  for (int e = 0; e < 8; ++e) { bg[e] = cb[c0 + e]; bv[e] = cb[2816 + c0 + e]; }
                  float g2[8], g1[8], v2[8], v1[8];
#pragma unroll
                  for (int e = 0; e < 8; ++e) { g2[e] = 0.f; g1[e] = 0.f; v2[e] = 0.f; v1[e] = 0.f; }
                  if (rg > 0 || half == 1) {
                      const bf16_t* r2p = rg > 0 ? U + (size_t)(lrow0 - 2) * 5632 : UH;
                      const bf16_t* r1p = rg > 0 ? U + (size_t)(lrow0 - 1) * 5632 : UH + 5632;
                      const u32x4 a = *(const u32x4*)(r2p + c0), bq = *(const u32x4*)(r1p + c0);
                      const u32x4 c = *(const u32x4*)(r2p + 2816 + c0), d = *(const u32x4*)(r1p + 2816 + c0);
                      g2[0] = bflo(a.x); g2[1] = bfhi(a.x); g2[2] = bflo(a.y); g2[3] = bfhi(a.y); g2[4] = bflo(a.z); g2[5] = bfhi(a.z); g2[6] = bflo(a.w); g2[7] = bfhi(a.w);
                      g1[0] = bflo(bq.x); g1[1] = bfhi(bq.x); g1[2] = bflo(bq.y); g1[3] = bfhi(bq.y); g1[4] = bflo(bq.z); g1[5] = bfhi(bq.z); g1[6] = bflo(bq.w); g1[7] = bfhi(bq.w);
                      v2[0] = bflo(c.x); v2[1] = bfhi(c.x); v2[2] = bflo(c.y); v2[3] = bfhi(c.y); v2[4] = bflo(c.z); v2[5] = bfhi(c.z); v2[6] = bflo(c.w); v2[7] = bfhi(c.w);
                      v1[0] = bflo(d.x); v1[1] = bfhi(d.x); v1[2] = bflo(d.y); v1[3] = bfhi(d.y); v1[4] = bflo(d.z); v1[5] = bfhi(d.z); v1[6] = bflo(d.w); v1[7] = bfhi(d.w);
                  }
#pragma unroll 4
                  for (int rr = 0; rr < 16; ++rr) {
                      const size_t row = (size_t)lrow0 + rr;
                      const u32x4 a = *(const u32x4*)(U + row * 5632 + c0), c = *(const u32x4*)(U + row * 5632 + 2816 + c0);
                      if (half == 0 && rg == 127 && rr >= 14) { *(u32x4*)(UH + (size_t)(rr - 14) * 5632 + c0) = a; *(u32x4*)(UH + (size_t)(rr - 14) * 5632 + 2816 + c0) = c; }
                      float g0[8], v0[8], ov[8];
                      g0[0] = bflo(a.x); g0[1] = bfhi(a.x); g0[2] = bflo(a.y); g0[3] = bfhi(a.y); g0[4] = bflo(a.z); g0[5] = bfhi(a.z); g0[6] = bflo(a.w); g0[7] = bfhi(a.w);
                      v0[0] = bflo(c.x); v0[1] = bfhi(c.x); v0[2] = bflo(c.y); v0[3] = bfhi(c.y); v0[4] = bflo(c.z); v0[5] = bfhi(c.z); v0[6] = bflo(c.w); v0[7] = bfhi(c.w);
#pragma unroll
                      for (int e = 0; e < 8; ++e) {
                          const float ug = wg[0][e] * g2[e] + wg[1][e] * g1[e] + wg[2][e] * g0[e] + bg[e];
                          const float uv = wv[0][e] * v2[e] + wv[1][e] * v1[e] + wv[2][e] * v0[e] + bv[e];
                          ov[e] = siluf_(ug) * uv; g2[e] = g1[e]; g1[e] = g0[e]; v2[e] = v1[e]; v1[e] = v0[e];
                      }
                      u32x4 w; w.x = pk2(ov[0], ov[1]); w.y = pk2(ov[2], ov[3]); w.z = pk2(ov[4], ov[5]); w.w = pk2(ov[6], ov[7]);
                      *(u32x4*)(ACT + row * 2816 + c0) = w;
                  }
              }
            }
        PH_END
#endif
        }
        if (step >= 2) { const int half = step - 2;
#ifndef NO_DOWN
        PH_BEGIN
            { EpiResid E{X, XB, ss_ple, nullptr, half};
              GEMM_PHASE(EpiResid, ACT, ws + W_DOWN, 16384, 1024, 2816, E, -1); }
        PH_END
#endif
        }
            GRID_SYNC();
        }
#ifndef NO_PLEG
        PH_BEGIN
        { EpiRowScale<1> E{(bf16_t*)(ws + WS_MIX), 1024, ss_ple, -1};
          GEMM_PHASE(EpiRowScale<1>, XB, ws + W_PG, MTOK, 1024, 1024, E, -1); }
        PH_END
#endif
        GRID_SYNC();
#ifndef NO_PLE
        PH_BEGIN
        { EpiResid E{X, XB, ss_next, (const bf16_t*)(ws + WS_MIX), -1};
          GEMM_PHASE(EpiResid, ws + WS_PB, ws + W_PP, MTOK, 1024, 256, E, -1); }
        PH_END
#endif
        GRID_SYNC();
    }
#ifdef NANCHK
    { const int layer = 0; PH_BEGIN
      unsigned bad = 0u;
      for (size_t i = (size_t)bid * NTHR + tid; i < (size_t)MTOK * 256; i += (size_t)G * NTHR) { const f32x4 v = *(const f32x4*)(X + i * 4);
          for (int e = 0; e < 4; ++e) bad |= ((__float_as_uint(v[e]) & 0x7f800000u) == 0x7f800000u) ? 1u : 0u; }
#ifdef NANCHK_BF_LO
      { const unsigned* bp = (const unsigned*)(ws + (size_t)NANCHK_BF_LO); const size_t nw = ((size_t)NANCHK_BF_HI - (size_t)NANCHK_BF_LO) / 4;
        for (size_t i = (size_t)bid * NTHR + tid; i < nw; i += (size_t)G * NTHR) { const unsigned w = bp[i]; bad |= (((w & 0x7f80u) == 0x7f80u) || ((w & 0x7f800000u) == 0x7f800000u)) ? 1u : 0u; } }
#endif
      if (bad) __hip_atomic_fetch_or((unsigned*)(ws + WS_CTL) + 16, 1u, __ATOMIC_RELAXED, __HIP_MEMORY_SCOPE_AGENT);
      PH_END }
    GRID_SYNC();
    { const int layer = 0; PH_BEGIN
      const unsigned fl = __hip_atomic_fetch_or((unsigned*)(ws + WS_CTL) + 16, 0u, __ATOMIC_RELAXED, __HIP_MEMORY_SCOPE_AGENT);
      if (fl) for (size_t i = (size_t)bid * NTHR + tid; i < (size_t)MTOK * 256; i += (size_t)G * NTHR) *(f32x4*)(X + i * 4) = (f32x4){0.f, 0.f, 0.f, 0.f};
      PH_END }
#endif
#undef U
#undef ACT
}

extern "C" void kernel_launch(void* const* d_in, const int* in_sizes, int n_in, void* d_out, int out_size, void* d_ws, size_t ws_size, hipStream_t stream) {
    static int grid = 0;
    if (grid == 0) {
        if (n_in != 24 || out_size != MTOK * DM || ws_size < WS_TOTAL) { fprintf(stderr, "kernel_launch: unexpected shapes / workspace (n_in %d out %d ws %zu need %zu)\n", n_in, out_size, ws_size, (size_t)WS_TOTAL); grid = -1; return; }
        int dev = 0, cus = 0, per_cu = 0;
        hipGetDevice(&dev);
        hipDeviceGetAttribute(&cus, hipDeviceAttributeMultiprocessorCount, dev);
        hipFuncSetAttribute((const void*)fwd_mega, hipFuncAttributeMaxDynamicSharedMemorySize, LDS_BYTES);
        hipOccupancyMaxActiveBlocksPerMultiprocessor(&per_cu, (const void*)fwd_mega, NTHR, LDS_BYTES);
        if (per_cu < 1) { fprintf(stderr, "kernel_launch: occupancy query says %d blocks per CU\n", per_cu); per_cu = 1; }
        (void)hipGetLastError();
        grid = cus;
    }
    if (grid < 0) return;
    Params p{};
    for (int i = 0; i < 24; ++i) p.in[i] = (const float*)d_in[i];
    p.out = (float*)d_out; p.ws = (unsigned char*)d_ws;
    hipError_t e = hipSuccess;
#ifdef N_SEG_LAUNCH
    for (int sgi = 0; sgi < 60 && e == hipSuccess; sgi += N_SEG_LAUNCH) {
        p.seg_lo = sgi; p.seg_hi = sgi + N_SEG_LAUNCH;
        void* args[] = {&p};
        e = hipLaunchCooperativeKernel((const void*)fwd_mega, dim3(grid), dim3(NTHR), args, LDS_BYTES, stream);
    }
#else
    p.seg_lo = 0; p.seg_hi = 1000;
    void* args[] = {&p};
    e = hipLaunchCooperativeKernel((const void*)fwd_mega, dim3(grid), dim3(NTHR), args, LDS_BYTES, stream);
#endif
    if (e != hipSuccess) fprintf(stderr, "cooperative launch failed: %s (grid %d)\n", hipGetErrorString(e), grid);
}
```

```cpp
#include <hip/hip_runtime.h>
#include <hip/hip_cooperative_groups.h>
#include <cstdio>
#include <cstdint>
namespace cg = cooperative_groups;
namespace pg8 {
#define PG8_LAS __attribute__((address_space(3)))
typedef unsigned short bf16_t;
typedef short bf16x8 __attribute__((ext_vector_type(8)));
typedef float f32x4 __attribute__((ext_vector_type(4)));
typedef unsigned u32x4 __attribute__((ext_vector_type(4)));
constexpr int BM = 256, BK = 64, HALF = 128, HTB = HALF * BK * 2  , STAGE_BYTES = 8 * HTB, NXCD = 8, WGM = 8;

__host__ __device__ __forceinline__ int lds_byte(int r, int c) { const int st = (r >> 4) * 2 + (c >> 5), rr = r & 15, cc = c & 31, ob = rr * 64 + cc * 2; return st * 1024 + (ob ^ (((ob >> 9) & 1) << 5)); }
__host__ __device__ __forceinline__ void stage_rc(int b, int& R, int& C) { const int st = b / 1024, sb = b % 1024, swz = sb ^ (((sb >> 9) & 1) << 5); R = (st >> 1) * 16 + swz / 64; C = (st & 1) * 32 + (swz % 64) / 2; }
__host__ __device__ __forceinline__ int perm32(int rho) { const int n = rho >> 4, i = rho & 15; return 8 * (i >> 2) + 4 * n + (i & 3); }

struct Unit { int pm, pn; };
struct Gemm { const bf16_t* A; const bf16_t* Bt; int M, N, K; int hmap; };
__device__ __forceinline__ int amap(int pm, int hmap) { return hmap < 0 ? pm : ((pm >> 3) * 16 + 8 * hmap + (pm & 7)); }

struct StaticOrder {
    int nM, nN, nwg, G, c;
    __host__ __device__ void init(int M, int N, int G_, int c_) { nM = M / BM; nN = N / BM; nwg = nM * nN; G = G_; c = c_; }
    __host__ __device__ bool next(int i, Unit& u) const {
        const long L = (long)i * G + c; if (L >= nwg) return false;
        int wgid = (int)L; { const int q = nwg / NXCD, r = nwg % NXCD, xcd = wgid % NXCD, off = wgid / NXCD; wgid = (xcd < r ? xcd * (q + 1) : r * (q + 1) + (xcd - r) * q) + off; }
        const int nig = WGM * nN, gid = wgid / nig, fm = gid * WGM, gsz = (nM - fm) < WGM ? (nM - fm) : WGM;
        u.pm = fm + ((wgid % nig) % gsz); u.pn = (wgid % nig) / gsz; return true;
    }
    __device__ __forceinline__ void a_ready(const Unit&) const {}
    __device__ __forceinline__ void done(const Unit&) const {}
};
__device__ __forceinline__ unsigned cvt_pk_bf16(float lo, float hi) { unsigned r; asm volatile("v_cvt_pk_bf16_f32 %0, %1, %2" : "=v"(r) : "v"(lo), "v"(hi)); return r; }
#ifdef NO_UNI
__device__ __forceinline__ const char* uni(const char* p) { return p; }
#else
__device__ __forceinline__ const char* uni(const char* p) { const unsigned long long v = (unsigned long long)p; const unsigned lo = __builtin_amdgcn_readfirstlane((unsigned)v), hi = __builtin_amdgcn_readfirstlane((unsigned)(v >> 32)); return (const char*)(((unsigned long long)hi << 32) | lo); }
#endif
template <class Epi, class Sched, bool ALIGN_EPI = false, bool SP2 = false>
__device__ __forceinline__ void gemm_phase(PG8_LAS unsigned char* lds, const Gemm g, const Sched& S, const Epi& E) {
    int tid = threadIdx.x;
#ifndef NO_LAUNDER
    asm volatile("" : "+v"(tid));
#endif

    const int wid = __builtin_amdgcn_readfirstlane(tid >> 6), lane = tid & 63, wr = wid >> 2, wc = wid & 3, fr = lane & 15, fq = lane >> 4;
    const int K = g.K, nt = K / BK;
    unsigned voffA[2], voffB[2];
#pragma unroll
    for (int i = 0; i < 2; ++i) { int R, C; stage_rc(tid * 16 + i * 8192, R, C); const int Rb = Epi::PERM ? ((R & ~31) + perm32(R & 31)) : R;
        voffA[i] = (unsigned)(R * K + C) * 2u; voffB[i] = (unsigned)(Rb * K + C) * 2u; }
    const size_t kstep = (size_t)(BK * 2);
    const size_t hstep = (size_t)HALF * K * 2;
    const size_t tstep = 2 * hstep;
    const unsigned ldsw = (unsigned)wid * 1024u;
    const int aoff = lds_byte(wr * 64 + fr, fq * 8), boff = lds_byte(wc * 32 + fr, fq * 8);
#define PG8_SA(b, h) (((b) * 2 + (h)) * HTB)
#define PG8_SB(b, h) ((4 + (b) * 2 + (h)) * HTB)
#define PG8_STAGE(bufoff, gbase, voff) do { _Pragma("unroll") for (int _i = 0; _i < 2; ++_i) \
        __builtin_amdgcn_global_load_lds((const unsigned*)((const char*)(gbase) + (voff)[_i]), (PG8_LAS unsigned*)(lds + (bufoff) + ldsw + _i * 8192), 16, 0, 0); } while (0)
#define PG8_LDA(dst, b, h) do { _Pragma("unroll") for (int m = 0; m < 4; ++m) _Pragma("unroll") for (int k = 0; k < 2; ++k) dst[m][k] = *(const PG8_LAS bf16x8*)(lds + PG8_SA(b, h) + aoff + m * 2048 + k * 1024); } while (0)
#define PG8_LDB(dst, b, h) do { _Pragma("unroll") for (int n = 0; n < 2; ++n) _Pragma("unroll") for (int k = 0; k < 2; ++k) dst[n][k] = *(const PG8_LAS bf16x8*)(lds + PG8_SB(b, h) + boff + n * 2048 + k * 1024); } while (0)
#define PG8_MMA(ai, bj, At, Bt) do { __builtin_amdgcn_s_setprio(1); _Pragma("unroll") for (int m = 0; m < 4; ++m) _Pragma("unroll") for (int n = 0; n < 2; ++n) _Pragma("unroll") for (int k = 0; k < 2; ++k) \
        acc[ai][bj][m][n] = __builtin_amdgcn_mfma_f32_16x16x32_bf16(Bt[n][k], At[m][k], acc[ai][bj][m][n], 0, 0, 0); __builtin_amdgcn_s_setprio(0); } while (0)
#define PG8_WAIT_V(n) asm volatile("s_waitcnt vmcnt(" #n ")" ::: "memory")
#define PG8_WAIT_L(n) asm volatile("s_waitcnt lgkmcnt(" #n ")" ::: "memory")
#define PG8_BAR __builtin_amdgcn_s_barrier()
#define PG8_SCHED __builtin_amdgcn_sched_barrier(0)
    Unit cur, nxt; int ui = 0;
    if (!S.next(0, cur)) return;
    f32x4 acc[2][2][4][2];
#pragma unroll
    for (int a = 0; a < 2; ++a)
#pragma unroll
        for (int b = 0; b < 2; ++b)
#pragma unroll
            for (int m = 0; m < 4; ++m)
#pragma unroll
                for (int n = 0; n < 2; ++n) acc[a][b][m][n] = (f32x4){0.f, 0.f, 0.f, 0.f};
    bf16x8 At[4][2], B0[2][2], B1[2][2];
    const char* cA = uni((const char*)g.A + (size_t)amap(cur.pm, g.hmap) * tstep); const char* cB = uni((const char*)g.Bt + (size_t)cur.pn * tstep);
    S.a_ready(cur);
    if constexpr (SP2) {
        PG8_STAGE(PG8_SB(0, 0), cB, voffB); PG8_STAGE(PG8_SB(0, 1), cB + hstep, voffB); PG8_STAGE(PG8_SA(0, 0), cA, voffA); PG8_STAGE(PG8_SA(0, 1), cA + hstep, voffA);
        if (wr == 1) PG8_BAR;
        PG8_WAIT_V(2); PG8_BAR;
        PG8_STAGE(PG8_SB(1, 0), cB + kstep, voffB); PG8_STAGE(PG8_SA(1, 0), cA + kstep, voffA); PG8_STAGE(PG8_SB(1, 1), cB + hstep + kstep, voffB);
        PG8_WAIT_V(6); PG8_BAR;
    } else {
        PG8_STAGE(PG8_SB(0, 0), cB, voffB); PG8_STAGE(PG8_SA(0, 0), cA, voffA); PG8_STAGE(PG8_SB(0, 1), cB + hstep, voffB); PG8_STAGE(PG8_SA(0, 1), cA + hstep, voffA);
        if (wr == 1) PG8_BAR;
        PG8_WAIT_V(4); PG8_BAR;
        PG8_STAGE(PG8_SB(1, 0), cB + kstep, voffB); PG8_STAGE(PG8_SA(1, 0), cA + kstep, voffA); PG8_STAGE(PG8_SB(1, 1), cB + hstep + kstep, voffB);
        PG8_WAIT_V(6); PG8_BAR;
    }
    for (;;) {
        const bool has_next = S.next(ui + 1, nxt);
        const char* nA = uni(has_next ? (const char*)g.A + (size_t)amap(nxt.pm, g.hmap) * tstep : cA); const char* nB = uni(has_next ? (const char*)g.Bt + (size_t)nxt.pn * tstep : cB);
        for (int t = 0; t < nt; t += 2) {
            const bool last = (t == nt - 2);
            const char* a1 = cA + (size_t)(t + 1) * kstep;
            const char* a2 = last ? nA : cA + (size_t)(t + 2) * kstep; const char* b2 = last ? nB : cB + (size_t)(t + 2) * kstep;
            const char* a3 = a2 + kstep; const char* b3 = b2 + kstep;
            if (last && has_next) S.a_ready(nxt);
            if constexpr (SP2) {
            PG8_LDB(B0, 0, 0); PG8_LDB(B1, 0, 1); PG8_SCHED; PG8_LDA(At, 0, 0); PG8_STAGE(PG8_SA(1, 1), a1 + hstep, voffA);
            PG8_WAIT_V(8); PG8_WAIT_L(0); PG8_BAR; PG8_MMA(0, 0, At, B0); PG8_MMA(0, 1, At, B1); PG8_BAR; PG8_SCHED;
            PG8_LDA(At, 0, 1); PG8_STAGE(PG8_SB(0, 0), b2, voffB); PG8_STAGE(PG8_SB(0, 1), b2 + hstep, voffB); PG8_STAGE(PG8_SA(0, 0), a2, voffA);
            PG8_WAIT_V(8); PG8_WAIT_L(0); PG8_BAR; PG8_MMA(1, 0, At, B0); PG8_MMA(1, 1, At, B1); PG8_BAR; PG8_SCHED;
            PG8_LDB(B0, 1, 0); PG8_LDB(B1, 1, 1); PG8_SCHED; PG8_LDA(At, 1, 0); PG8_STAGE(PG8_SA(0, 1), a2 + hstep, voffA);
            PG8_WAIT_V(8); PG8_WAIT_L(0); PG8_BAR; PG8_MMA(0, 0, At, B0); PG8_MMA(0, 1, At, B1); PG8_BAR; PG8_SCHED;
            PG8_LDA(At, 1, 1); PG8_STAGE(PG8_SB(1, 0), b3, voffB); PG8_STAGE(PG8_SB(1, 1), b3 + hstep, voffB); PG8_STAGE(PG8_SA(1, 0), a3, voffA);
            PG8_WAIT_V(8); PG8_WAIT_L(0); PG8_BAR; PG8_MMA(1, 0, At, B0); PG8_MMA(1, 1, At, B1); PG8_BAR; PG8_SCHED;
            } else {
            PG8_LDB(B0, 0, 0); PG8_SCHED; PG8_LDA(At, 0, 0); PG8_STAGE(PG8_SA(1, 1), a1 + hstep, voffA);
            PG8_WAIT_L(8); PG8_BAR; PG8_WAIT_L(0); PG8_MMA(0, 0, At, B0); PG8_BAR; PG8_SCHED;
            PG8_LDB(B1, 0, 1); PG8_STAGE(PG8_SB(0, 0), b2, voffB);
            PG8_BAR; PG8_WAIT_L(0); PG8_MMA(0, 1, At, B1); PG8_BAR;
            PG8_LDA(At, 0, 1); PG8_STAGE(PG8_SA(0, 0), a2, voffA);
            PG8_BAR; PG8_WAIT_L(0); PG8_MMA(1, 0, At, B0); PG8_BAR; PG8_SCHED;
            PG8_STAGE(PG8_SB(0, 1), b2 + hstep, voffB);
            PG8_WAIT_V(6); PG8_BAR; PG8_MMA(1, 1, At, B1); PG8_BAR;
            PG8_LDB(B0, 1, 0); PG8_SCHED; PG8_LDA(At, 1, 0); PG8_STAGE(PG8_SA(0, 1), a2 + hstep, voffA);
            PG8_WAIT_L(8); PG8_BAR; PG8_WAIT_L(0); PG8_MMA(0, 0, At, B0); PG8_BAR; PG8_SCHED;
            PG8_LDB(B1, 1, 1); PG8_STAGE(PG8_SB(1, 0), b3, voffB);
            PG8_BAR; PG8_WAIT_L(0); PG8_MMA(0, 1, At, B1); PG8_BAR;
            PG8_LDA(At, 1, 1); PG8_STAGE(PG8_SA(1, 0), a3, voffA);
            PG8_BAR; PG8_WAIT_L(0); PG8_MMA(1, 0, At, B0); PG8_BAR; PG8_SCHED;
            PG8_STAGE(PG8_SB(1, 1), b3 + hstep, voffB);
            PG8_WAIT_V(6); PG8_BAR; PG8_MMA(1, 1, At, B1); PG8_BAR;
            }
        }
        if constexpr (ALIGN_EPI) { if (wr == 0) PG8_BAR; }
        if constexpr (!Epi::AFTER_DRAIN) { E(acc, cur, wr, wc, fr, fq); S.done(cur); }
        if (!has_next) break;
#pragma unroll
        for (int a = 0; a < 2; ++a)
#pragma unroll
            for (int b = 0; b < 2; ++b)
#pragma unroll
                for (int m = 0; m < 4; ++m)
#pragma unroll
                    for (int n = 0; n < 2; ++n) acc[a][b][m][n] = (f32x4){0.f, 0.f, 0.f, 0.f};
        cur = nxt; cA = nA; cB = nB; ++ui;
        if constexpr (ALIGN_EPI) { if (wr == 1) PG8_BAR; }
    }
    PG8_WAIT_V(0);
    if constexpr (!ALIGN_EPI) { if (wr == 0) PG8_BAR; }
    PG8_BAR;
    if constexpr (Epi::AFTER_DRAIN) { E.fused(acc, cur, wr, wc, fr, fq, lds, wid, lane); S.done(cur); }
#undef PG8_SA
#undef PG8_SB
#undef PG8_STAGE
#undef PG8_LDA
#undef PG8_LDB
#undef PG8_MMA
#undef PG8_WAIT_V
#undef PG8_WAIT_L
#undef PG8_BAR
#undef PG8_SCHED
}
}

#define GAS __attribute__((address_space(1)))
#define LAS __attribute__((address_space(3)))
typedef unsigned short bf16_t;
typedef float f32x4 __attribute__((ext_vector_type(4)));
typedef float f32x16 __attribute__((ext_vector_type(16)));
typedef short bf16x8 __attribute__((ext_vector_type(8)));
typedef unsigned u32x4 __attribute__((ext_vector_type(4)));
typedef unsigned u32x2 __attribute__((ext_vector_type(2)));

#ifndef NLAYER_V
#define NLAYER_V 4
#endif
constexpr int NW = 8, NTHR = 512;
constexpr int MTOK = 32768, DM = 1024, SEQ = 4096, NB = 8, NLAYER = NLAYER_V, NH = 8;
constexpr int DIN = 9232, DFF = 2816, DPLE = 256;
constexpr float EPS = 1e-6f;
constexpr float LOG2E = 1.4426950408889634f;
constexpr size_t MiB = 1u << 20;
constexpr size_t WS_SS = 0;
constexpr size_t WS_CTL = 1792 * 1024;
constexpr size_t WS_UHALO = 1856 * 1024;
constexpr size_t WS_GB = 2 * MiB;
constexpr size_t WS_HALO = 4 * MiB;
constexpr size_t WS_PB = 14 * MiB;
constexpr size_t WS_W = 30 * MiB;
constexpr size_t W_IN = WS_W, W_V = W_IN + (size_t)6400 * 1024 * 2, W_GL = W_V + 2 * MiB, W_BRA = W_GL + 4 * MiB, W_BRB = W_BRA + 2 * MiB,
                 W_OUT = W_BRB + 2 * MiB, W_UP = W_OUT + 2 * MiB, W_DOWN = W_UP + 11 * MiB, W_PG = W_DOWN + (size_t)1024 * 2816 * 2, W_PP = W_PG + 2 * MiB, W_END = W_PP + (size_t)1024 * 256 * 2;
static_assert(W_END <= 74 * MiB, "weights region");
constexpr size_t WS_XB = 74 * MiB;
constexpr size_t WS_MIX = 138 * MiB;
constexpr size_t S64 = 64 * MiB;
constexpr size_t WS_QA = WS_MIX, WS_KA = WS_MIX + S64, WS_VT = WS_MIX + 2 * S64, WS_QB = WS_MIX + 3 * S64, WS_KB = WS_MIX + 4 * S64, WS_VB = WS_MIX + 5 * S64, WS_ZB = WS_MIX + 6 * S64;
constexpr size_t WS_TOTAL = WS_MIX + 7 * S64;
#ifdef DN_NAIVE
constexpr size_t WS_G = WS_KB, WS_TMPA = WS_KA, WS_MIXED = WS_VT, WS_OSRC = WS_QB;
#else
constexpr size_t WS_G = WS_KA, WS_TMPA = WS_KB, WS_MIXED = WS_VB, WS_OSRC = WS_VB;
#endif
constexpr int LDS_BYTES = 147456, LDS_VB = 140032;

__device__ __forceinline__ float bflo(unsigned w) { return __uint_as_float(w << 16); }
__device__ __forceinline__ float bfhi(unsigned w) { return __uint_as_float(w & 0xffff0000u); }
__device__ __forceinline__ float bf2f(bf16_t v) { return __uint_as_float((unsigned)v << 16); }
typedef float f32x2_t __attribute__((ext_vector_type(2))); typedef __bf16 bf16x2_t __attribute__((ext_vector_type(2)));
__device__ __forceinline__ unsigned pk2(float lo, float hi) { const f32x2_t v = {lo, hi}; const bf16x2_t b = __builtin_convertvector(v, bf16x2_t); return __builtin_bit_cast(unsigned, b); }
__device__ __forceinline__ bf16_t f2bf(float f) { return (bf16_t)(pk2(f, 0.f) & 0xffffu); }
__device__ __forceinline__ float sigmoidf_(float x) { x = fminf(fmaxf(x, -60.f), 60.f); return __builtin_amdgcn_rcpf(1.f + __expf(-x)); }
__device__ __forceinline__ float siluf_(float x) { return x * sigmoidf_(x); }
__device__ __forceinline__ float wave_sum(float v) {
#pragma unroll
    for (int o = 1; o < 64; o <<= 1) v += __shfl_xor(v, o);
    return v;
}
__device__ __forceinline__ float ss_load(const float* p) { const f32x4 a = *(const f32x4*)p, b = *(const f32x4*)(p + 4), c = *(const f32x4*)(p + 8), d = *(const f32x4*)(p + 12);
    float s = (((a[0] + a[1]) + (a[2] + a[3])) + ((b[0] + b[1]) + (b[2] + b[3]))) + (((c[0] + c[1]) + (c[2] + c[3])) + ((d[0] + d[1]) + (d[2] + d[3])));
    asm volatile("" : "+v"(s) :: "memory");
    return s; }
__device__ __forceinline__ u32x4 ldc16(const void* p) { u32x4 v; asm volatile("global_load_dwordx4 %0, %1, off sc0 sc1\n\ts_waitcnt vmcnt(0)" : "=v"(v) : "v"(p) : "memory"); return v; }
__device__ __forceinline__ int crow(int r, int hi) { return (r & 3) + 8 * (r >> 2) + 4 * hi; }

__device__ __forceinline__ float ss_sum16(const f32x4 a, const f32x4 b, const f32x4 c, const f32x4 d) {
    return (((a[0] + a[1]) + (a[2] + a[3])) + ((b[0] + b[1]) + (b[2] + b[3]))) + (((c[0] + c[1]) + (c[2] + c[3])) + ((d[0] + d[1]) + (d[2] + d[3]))); }
__device__ __forceinline__ int gmap(int row, int h) { return h < 0 ? row : ((row >> 11) * 4096 + 2048 * h + (row & 2047)); }

__device__ __forceinline__ void load_rs8(const float* ss, int rowbase, int hmap, int lane, int fr, float (&rs)[2][4]) {
    const float* p0 = ss + (size_t)gmap(rowbase + lane, hmap) * 16; const float* p1 = ss + (size_t)gmap(rowbase + 128 + lane, hmap) * 16;
    const f32x4 a0 = *(const f32x4*)p0, b0 = *(const f32x4*)(p0 + 4), c0 = *(const f32x4*)(p0 + 8), d0 = *(const f32x4*)(p0 + 12);
    const f32x4 a1 = *(const f32x4*)p1, b1 = *(const f32x4*)(p1 + 4), c1 = *(const f32x4*)(p1 + 8), d1 = *(const f32x4*)(p1 + 12);
    const float r0 = rsqrtf(ss_sum16(a0, b0, c0, d0) * (1.f / 1024.f) + EPS), r1 = rsqrtf(ss_sum16(a1, b1, c1, d1) * (1.f / 1024.f) + EPS);
#pragma unroll
    for (int m = 0; m < 4; ++m) { rs[0][m] = __shfl(r0, m * 16 + fr); rs[1][m] = __shfl(r1, m * 16 + fr); }
    asm volatile("" ::: "memory");
}

using pg8::Unit;
typedef f32x4 AccT[2][2][4][2];

template <int ACT> struct EpiRowScale {
    static constexpr bool PERM = true, AFTER_DRAIN = false;
    bf16_t* O; int ldc; const float* ss; int hmap;
    __device__ __forceinline__ void operator()(const AccT& acc, const Unit& u, int wr, int wc, int fr, int fq) const {
        const int row0 = u.pm * 256 + wr * 64 + fr, col0 = u.pn * 256 + wc * 32 + 8 * fq;
        float rsv[2][4]; load_rs8(ss, u.pm * 256 + wr * 64, hmap, (int)(threadIdx.x & 63), fr, rsv);
#pragma unroll
        for (int ai = 0; ai < 2; ++ai)
#pragma unroll
            for (int m = 0; m < 4; ++m) {
                const int row = row0 + ai * 128 + m * 16;
                const float rs = rsv[ai][m];
                bf16_t* rowp = O + (size_t)row * ldc + col0;
#pragma unroll
                for (int bj = 0; bj < 2; ++bj) {
                    f32x4 v0 = acc[ai][bj][m][0] * rs, v1 = acc[ai][bj][m][1] * rs;
                    if (ACT == 1) {
#pragma unroll
                        for (int e = 0; e < 4; ++e) { v0[e] = sigmoidf_(v0[e]); v1[e] = sigmoidf_(v1[e]); }
                    }
                    u32x4 w; w.x = pk2(v0[0], v0[1]); w.y = pk2(v0[2], v0[3]); w.z = pk2(v1[0], v1[1]); w.w = pk2(v1[2], v1[3]);
                    *(u32x4*)(rowp + bj * 128) = w;
                    asm volatile("" ::: "memory");
                }
            }
    }
};

struct EpiVt {
    static constexpr bool PERM = true, AFTER_DRAIN = false;
    bf16_t* O; const float* ss;
    __device__ __forceinline__ void operator()(const AccT& acc, const Unit& u, int wr, int wc, int fr, int fq) const {
        const int row0 = u.pm * 256 + wr * 64 + fr, col0 = u.pn * 256 + wc * 32 + 8 * fq;
        float rs[2][8];
        { const int L = (int)(threadIdx.x & 63); const float* pc = ss + (size_t)(u.pn * 256 + (L >> 5) * 128 + wc * 32 + (L & 31)) * 16;
          const f32x4 a = *(const f32x4*)pc, b = *(const f32x4*)(pc + 4), c = *(const f32x4*)(pc + 8), d = *(const f32x4*)(pc + 12);
          const float r = rsqrtf(ss_sum16(a, b, c, d) * (1.f / 1024.f) + EPS);
#pragma unroll
          for (int bj = 0; bj < 2; ++bj)
#pragma unroll
              for (int e = 0; e < 8; ++e) rs[bj][e] = __shfl(r, bj * 32 + 8 * fq + e); }
#pragma unroll
        for (int ai = 0; ai < 2; ++ai)
#pragma unroll
            for (int m = 0; m < 4; ++m) {
                const int row = row0 + ai * 128 + m * 16;
                bf16_t* rowp = O + (size_t)row * MTOK + col0;
#pragma unroll
                for (int bj = 0; bj < 2; ++bj) {
                    const f32x4 v0 = acc[ai][bj][m][0], v1 = acc[ai][bj][m][1];
                    u32x4 w; w.x = pk2(v0[0] * rs[bj][0], v0[1] * rs[bj][1]); w.y = pk2(v0[2] * rs[bj][2], v0[3] * rs[bj][3]);
                    w.z = pk2(v1[0] * rs[bj][4], v1[1] * rs[bj][5]); w.w = pk2(v1[2] * rs[bj][6], v1[3] * rs[bj][7]);
                    *(u32x4*)(rowp + bj * 128) = w;
                }
                asm volatile("" ::: "memory");
            }
    }
};

struct EpiGateMul {
    static constexpr bool PERM = true, AFTER_DRAIN = false;
    bf16_t* O; const bf16_t* G; int ldg, goff; const bf16_t* Add;
    __device__ __forceinline__ void operator()(const AccT& acc, const Unit& u, int wr, int wc, int fr, int fq) const {
        const int row0 = u.pm * 256 + wr * 64 + fr, col0 = u.pn * 256 + wc * 32 + 8 * fq;
#pragma unroll
        for (int ai = 0; ai < 2; ++ai)
#pragma unroll
            for (int m = 0; m < 4; ++m) {
                const int row = row0 + ai * 128 + m * 16;
#pragma unroll
                for (int bj = 0; bj < 2; ++bj) {
                    const int c = col0 + bj * 128;
                    const u32x4 g = *(const u32x4*)(G + (size_t)row * ldg + goff + c);
                    u32x4 a = (u32x4){0u, 0u, 0u, 0u};
                    if (Add) a = *(const u32x4*)(Add + (size_t)row * 1024 + c);
                    const f32x4 v0 = acc[ai][bj][m][0], v1 = acc[ai][bj][m][1];
                    u32x4 w;
                    w.x = pk2(bflo(a.x) + bflo(g.x) * v0[0], bfhi(a.x) + bfhi(g.x) * v0[1]);
                    w.y = pk2(bflo(a.y) + bflo(g.y) * v0[2], bfhi(a.y) + bfhi(g.y) * v0[3]);
                    w.z = pk2(bflo(a.z) + bflo(g.z) * v1[0], bfhi(a.z) + bfhi(g.z) * v1[1]);
                    w.w = pk2(bflo(a.w) + bflo(g.w) * v1[2], bfhi(a.w) + bfhi(g.w) * v1[3]);
                    *(u32x4*)(O + (size_t)row * 1024 + c) = w;
                }
                asm volatile("" ::: "memory");
            }
    }
};

struct EpiResid {
    static constexpr bool PERM = true, AFTER_DRAIN = false;
    float* X; bf16_t* XB; float* ssn; const bf16_t* Mul; int hmap;
    __device__ __forceinline__ void operator()(const AccT& acc, const Unit& u, int wr, int wc, int fr, int fq) const {
        const int row0 = u.pm * 256 + wr * 64 + fr, col0 = u.pn * 256 + wc * 32 + 8 * fq;
#pragma unroll
        for (int ai = 0; ai < 2; ++ai)
#pragma unroll
            for (int m = 0; m < 4; ++m) {
                const int row = gmap(row0 + ai * 128 + m * 16, hmap);
                const size_t off0 = (size_t)row * 1024 + col0;
                f32x4 xa = *(const f32x4*)(X + off0), xb2 = *(const f32x4*)(X + off0 + 4), xc = *(const f32x4*)(X + off0 + 128), xd = *(const f32x4*)(X + off0 + 132);
                f32x4 va = acc[ai][0][m][0], vb2 = acc[ai][0][m][1], vc = acc[ai][1][m][0], vd = acc[ai][1][m][1];
                if (Mul) {
                    const u32x4 g0 = *(const u32x4*)(Mul + off0), g1 = *(const u32x4*)(Mul + off0 + 128);
                    va[0] *= bflo(g0.x); va[1] *= bfhi(g0.x); va[2] *= bflo(g0.y); va[3] *= bfhi(g0.y); vb2[0] *= bflo(g0.z); vb2[1] *= bfhi(g0.z); vb2[2] *= bflo(g0.w); vb2[3] *= bfhi(g0.w);
                    vc[0] *= bflo(g1.x); vc[1] *= bfhi(g1.x); vc[2] *= bflo(g1.y); vc[3] *= bfhi(g1.y); vd[0] *= bflo(g1.z); vd[1] *= bfhi(g1.z); vd[2] *= bflo(g1.w); vd[3] *= bfhi(g1.w);
                }
                xa += va; xb2 += vb2; xc += vc; xd += vd;
                *(f32x4*)(X + off0) = xa; *(f32x4*)(X + off0 + 4) = xb2; *(f32x4*)(X + off0 + 128) = xc; *(f32x4*)(X + off0 + 132) = xd;
                u32x4 w0; w0.x = pk2(xa[0], xa[1]); w0.y = pk2(xa[2], xa[3]); w0.z = pk2(xb2[0], xb2[1]); w0.w = pk2(xb2[2], xb2[3]);
                u32x4 w1; w1.x = pk2(xc[0], xc[1]); w1.y = pk2(xc[2], xc[3]); w1.z = pk2(xd[0], xd[1]); w1.w = pk2(xd[2], xd[3]);
                *(u32x4*)(XB + off0) = w0; *(u32x4*)(XB + off0 + 128) = w1;
                float sq = ((xa[0] * xa[0] + xa[1] * xa[1]) + (xa[2] * xa[2] + xa[3] * xa[3])) + ((xb2[0] * xb2[0] + xb2[1] * xb2[1]) + (xb2[2] * xb2[2] + xb2[3] * xb2[3]))
                         + ((xc[0] * xc[0] + xc[1] * xc[1]) + (xc[2] * xc[2] + xc[3] * xc[3])) + ((xd[0] * xd[0] + xd[1] * xd[1]) + (xd[2] * xd[2] + xd[3] * xd[3]));
                sq += __shfl_xor(sq, 16); sq += __shfl_xor(sq, 32);
                if (fq == 0) ssn[(size_t)row * 16 + u.pn * 4 + wc] = sq;
                asm volatile("" ::: "memory");
            }
    }
};

struct EpiQK {
    static constexpr bool PERM = true, AFTER_DRAIN = false;
    unsigned char* ws; const float* ss; const float* qg; const float* kg;
    __device__ __forceinline__ void operator()(const AccT& acc, const Unit& u, int wr, int wc, int fr, int fq) const {
        const int row0 = u.pm * 256 + wr * 64 + fr;
        const int seg = u.pn >> 2, tl = u.pn & 3;
        bf16_t* base = (bf16_t*)(ws + (seg == 0 ? WS_QA : WS_KA));
        const float* gp = seg == 0 ? qg : kg; const float osc = seg == 0 ? 0.125f * LOG2E : 1.0f;
        const int col0 = tl * 256 + 64 * wc + 8 * fq;
        float rsv[2][4]; load_rs8(ss, u.pm * 256 + wr * 64, -1, (int)(threadIdx.x & 63), fr, rsv);
#pragma unroll
        for (int ai = 0; ai < 2; ++ai)
#pragma unroll
            for (int m = 0; m < 4; ++m) {
                const int row = row0 + ai * 128 + m * 16;
                const float rs = rsv[ai][m];
                f32x4 v[2][2]; float sq = 0.f;
#pragma unroll
                for (int bj = 0; bj < 2; ++bj)
#pragma unroll
                    for (int n = 0; n < 2; ++n) { v[bj][n] = acc[ai][bj][m][n] * rs; const f32x4 t = v[bj][n]; sq += (t[0] * t[0] + t[1] * t[1]) + (t[2] * t[2] + t[3] * t[3]); }
                sq += __shfl_xor(sq, 16); sq += __shfl_xor(sq, 32);
                const float r2o = rsqrtf(sq * (1.f / 64.f) + EPS) * osc;
#pragma unroll
                for (int bj = 0; bj < 2; ++bj) {
                    const f32x4 ga = *(const f32x4*)(gp + 32 * bj + 8 * fq), gb = *(const f32x4*)(gp + 32 * bj + 8 * fq + 4);
                    u32x4 w;
                    w.x = pk2(v[bj][0][0] * r2o * ga[0], v[bj][0][1] * r2o * ga[1]); w.y = pk2(v[bj][0][2] * r2o * ga[2], v[bj][0][3] * r2o * ga[3]);
                    w.z = pk2(v[bj][1][0] * r2o * gb[0], v[bj][1][1] * r2o * gb[1]); w.w = pk2(v[bj][1][2] * r2o * gb[2], v[bj][1][3] * r2o * gb[3]);
                    *(u32x4*)(base + (size_t)row * 1024 + col0 + 32 * bj) = w;
                }
                asm volatile("" ::: "memory");
            }
    }
};
struct EpiSeg {
    static constexpr bool PERM = true, AFTER_DRAIN = false;
    unsigned char* ws; const float* ss;
    __device__ __forceinline__ void operator()(const AccT& acc, const Unit& u, int wr, int wc, int fr, int fq) const {
        const int row0 = u.pm * 256 + wr * 64 + fr;
        bf16_t* base = (bf16_t*)(ws + WS_QB + (size_t)(u.pn >> 2) * S64);
        const int col0 = (u.pn & 3) * 256 + wc * 32 + 8 * fq;
        float rsv[2][4]; load_rs8(ss, u.pm * 256 + wr * 64, -1, (int)(threadIdx.x & 63), fr, rsv);
#pragma unroll
        for (int ai = 0; ai < 2; ++ai)
#pragma unroll
            for (int m = 0; m < 4; ++m) {
                const int row = row0 + ai * 128 + m * 16;
                const float rs = rsv[ai][m];
#pragma unroll
                for (int bj = 0; bj < 2; ++bj) {
                    const f32x4 v0 = acc[ai][bj][m][0] * rs, v1 = acc[ai][bj][m][1] * rs;
                    u32x4 w; w.x = pk2(v0[0], v0[1]); w.y = pk2(v0[2], v0[3]); w.z = pk2(v1[0], v1[1]); w.w = pk2(v1[2], v1[3]);
                    *(u32x4*)(base + (size_t)row * 1024 + col0 + bj * 128) = w;
                }
                asm volatile("" ::: "memory");
            }
    }
};
struct EpiGB {
    static constexpr bool PERM = true, AFTER_DRAIN = false;
    unsigned char* ws; const float* ss; const float* a_log; const float* dt_bias;
    __device__ __forceinline__ void operator()(const AccT& acc, const Unit& u, int wr, int wc, int fr, int fq) const {
        const int row0 = u.pm * 256 + wr * 64 + fr;
        float rsv[2][4]; load_rs8(ss, u.pm * 256 + wr * 64, -1, (int)(threadIdx.x & 63), fr, rsv);
        if (wc == 0 && fq < 2) {
            float* GBp = (float*)(ws + WS_GB);
#pragma unroll
            for (int ai = 0; ai < 2; ++ai)
#pragma unroll
                for (int m = 0; m < 4; ++m) {
                    const int row = row0 + ai * 128 + m * 16;
                    const float rs = rsv[ai][m];
                    float v[8];
#pragma unroll
                    for (int e = 0; e < 4; ++e) { v[e] = acc[ai][0][m][0][e] * rs; v[4 + e] = acc[ai][0][m][1][e] * rs; }
                    if (fq == 0) {
#pragma unroll
                        for (int e = 0; e < 8; ++e) v[e] = sigmoidf_(v[e]);
                    } else {
#pragma unroll
                        for (int e = 0; e < 8; ++e) { const float z = v[e] + dt_bias[e]; const float sp = fmaxf(z, 0.f) + __logf(1.f + __expf(-fabsf(z))); v[e] = -__expf(a_log[e]) * sp; }
                    }
                    float* dst = GBp + (size_t)row * 16 + 8 * fq;
                    *(f32x4*)dst = (f32x4){v[0], v[1], v[2], v[3]}; *(f32x4*)(dst + 4) = (f32x4){v[4], v[5], v[6], v[7]};
                    asm volatile("" ::: "memory");
                }
        }
    }
};

__device__ __forceinline__ void cvt_item(const float* W, int ldw, int src_col0, int nvalid, const float* gain, bf16_t* WT, int K, int dst_row0, int k0, LAS float* scr, int lane) {
    const int nn = lane & 31;
#pragma unroll 8
    for (int i = 0; i < 32; ++i) {
        const int kk = 2 * i + (lane >> 5);
        float v = 0.f;
        if (nn < nvalid) { v = W[(size_t)(k0 + kk) * ldw + src_col0 + nn]; if (gain) v *= gain[k0 + kk]; }
        scr[kk * 33 + nn] = v;
    }
    asm volatile("s_waitcnt lgkmcnt(0)" ::: "memory");
    const int c = lane & 7;
#pragma unroll
    for (int j = 0; j < 4; ++j) {
        const int n = (lane >> 3) + 8 * j; const LAS float* s = scr + (8 * c) * 33 + n;
        u32x4 o; o.x = pk2(s[0 * 33], s[1 * 33]); o.y = pk2(s[2 * 33], s[3 * 33]); o.z = pk2(s[4 * 33], s[5 * 33]); o.w = pk2(s[6 * 33], s[7 * 33]);
        *(u32x4*)(WT + (size_t)(dst_row0 + n) * K + k0 + 8 * c) = o;
    }
    asm volatile("s_waitcnt lgkmcnt(0)" ::: "memory");
}

struct Params {
    const float* in[24];
    float* out;
    unsigned char* ws;
    int seg_lo, seg_hi;
};
enum { I_X = 0, I_P, I_WIN, I_ATTN_NORM, I_QNORM, I_KNORM, I_LAM, I_SUBLN, I_RELB, I_CONVB, I_ALOG, I_DTB, I_ONORM, I_WBRA, I_WBRB, I_WOUT, I_FFN_NORM, I_WUP, I_CONVFF, I_CONVFFB, I_WDOWN, I_PLE_NORM, I_WPG, I_WPP };

__device__ __forceinline__ void convert_weights(const Params* PQ, int layer, LAS unsigned char* lds, int gw, int NGW, int wave, int lane, int mode  ) {
    LAS float* scr = (LAS float*)(lds + wave * 16384);
    unsigned char* ws = PQ->ws;
    const float* w_in = PQ->in[I_WIN] + (size_t)layer * 1024 * DIN;
    const float* g_attn = PQ->in[I_ATTN_NORM] + layer * 1024;
    const float* g_ffn = PQ->in[I_FFN_NORM] + layer * 1024;
    const float* g_ple = PQ->in[I_PLE_NORM] + layer * 1024;
#define CVT_JOB(NITEMS, KB, SRCW, LDW, GAIN, DST, KK, SRCCOL, NVALID) \
    for (int it = gw; it < (NITEMS); it += NGW) { const int g = it / (KB), kb = it % (KB); (void)g; \
        cvt_item((SRCW), (LDW), (SRCCOL), (NVALID), (GAIN), (bf16_t*)(ws + (DST)), (KK), g * 32, kb * 64, scr, lane); } asm volatile("" ::: "memory");
    if (mode != 2) {
    for (int it = gw; it < 200 * 16; it += NGW) {
        const int g = it >> 4, kb = it & 15, pn = g >> 3, gi = g & 7;
        int src, nv = 32;
        if (pn < 8) { const int bj = gi >> 2, wc = gi & 3; src = (pn >> 2) * 1024 + (pn & 3) * 256 + 64 * wc + 32 * bj; }
        else if (pn < 24) { src = 3072 + (pn - 8) * 256 + 32 * gi; }
        else { src = 7168; nv = (gi == 0) ? 16 : 0; }
        cvt_item(w_in, DIN, src, nv, g_attn, (bf16_t*)(ws + W_IN), 1024, g * 32, kb * 64, scr, lane);
    }
    asm volatile("" ::: "memory");
    CVT_JOB(32 * 16, 16, w_in, DIN, g_attn, W_V, 1024, 2048 + g * 32, 32)
    CVT_JOB(64 * 16, 16, w_in, DIN, g_attn, W_GL, 1024, 7184 + g * 32, 32)
    CVT_JOB(32 * 16, 16, PQ->in[I_WBRA] + (size_t)layer * 1024 * 1024, 1024, (const float*)nullptr, W_BRA, 1024, g * 32, 32)
    CVT_JOB(32 * 16, 16, PQ->in[I_WBRB] + (size_t)layer * 1024 * 1024, 1024, (const float*)nullptr, W_BRB, 1024, g * 32, 32)
    CVT_JOB(32 * 16, 16, PQ->in[I_WOUT] + (size_t)layer * 1024 * 1024, 1024, (const float*)nullptr, W_OUT, 1024, g * 32, 32)
    CVT_JOB(176 * 16, 16, PQ->in[I_WUP] + (size_t)layer * 1024 * 5632, 5632, g_ffn, W_UP, 1024, g * 32, 32)
    CVT_JOB(32 * 44, 44, PQ->in[I_WDOWN] + (size_t)layer * 2816 * 1024, 1024, (const float*)nullptr, W_DOWN, 2816, g * 32, 32)
    }
    if (mode != 1) {
    CVT_JOB(32 * 16, 16, PQ->in[I_WPG] + (size_t)layer * 1024 * 1024, 1024, g_ple, W_PG, 1024, g * 32, 32)
    CVT_JOB(32 * 4, 4, PQ->in[I_WPP] + (size_t)layer * 256 * 1024, 1024, (const float*)nullptr, W_PP, 256, g * 32, 32)
    }
#undef CVT_JOB
}

constexpr int AT_KROW = 272, AT_VROW = 136  , AT_KBYTES = 64 * AT_KROW, AT_VBYTES = 128 * AT_VROW, AT_STAGE = AT_KBYTES + AT_VBYTES, AT_TB = 2 * AT_STAGE;
static_assert(AT_TB >= 65536 && AT_TB + 1024 <= LDS_BYTES, "attention LDS");
__device__ __forceinline__ void attn_unit(LAS unsigned char* lds, const bf16_t* QA, const bf16_t* KA, const bf16_t* VT, bf16_t* OA, int b, int h, int qb,
                                          float lam, float out_scale, const float* subln, const float* relb, int tid, bool do_store = true) {
    const int lane = tid & 63, wid = __builtin_amdgcn_readfirstlane(tid >> 6), j = wid >> 2, wq = wid & 3, r32 = lane & 31, hi = lane >> 5;
    const int Q0 = qb * 128, qrow = Q0 + 32 * wq + r32;
    const size_t tok = (size_t)b * SEQ + qrow;
    LAS float* TB = (LAS float*)(lds + AT_TB);
    for (int i = tid; i <= 128; i += NTHR) {
        float v = 0.f;
        if (i < 128) {
            int bk = i;
            if (i >= 16) { int lg = 16 + (int)(__logf((float)i * (1.f / 16.f)) / __logf(8.0f) * 16.f); bk = lg < 31 ? lg : 31; }
            v = (relb[bk * 8 + h] - relb[31 * 8 + h]) * LOG2E;
        }
        TB[i] = v;
    }
    bf16x8 qf[4];
#pragma unroll
    for (int d0 = 0; d0 < 4; ++d0) qf[d0] = *(const bf16x8*)(QA + tok * 1024 + h * 128 + 64 * j + 16 * d0 + 8 * hi);
    const int NT = (Q0 + 128) / 64;
    const int kr0 = tid >> 4, kc = tid & 15;
    const int vr0 = tid >> 3, vc = tid & 7;
    const bf16_t* kg = KA + ((size_t)b * SEQ + kr0) * 1024 + h * 128 + kc * 8;
    const bf16_t* vg = VT + (size_t)(h * 128 + vr0) * MTOK + (size_t)b * SEQ + vc * 8;
    u32x4 kreg0, kreg1, vreg0, vreg1;
#define AT_LOAD(t) do { kreg0 = *(const u32x4*)(kg + (size_t)(t) * 64 * 1024); kreg1 = *(const u32x4*)(kg + (size_t)((t) * 64 + 32) * 1024); \
        vreg0 = *(const u32x4*)(vg + (t) * 64); vreg1 = *(const u32x4*)(vg + (size_t)64 * MTOK + (t) * 64); } while (0)
#define AT_STORE(s) do { LAS unsigned char* kb_ = lds + (s) * AT_STAGE; LAS unsigned char* vb_ = kb_ + AT_KBYTES; \
        *(LAS u32x4*)(kb_ + kr0 * AT_KROW + kc * 16) = kreg0; *(LAS u32x4*)(kb_ + (kr0 + 32) * AT_KROW + kc * 16) = kreg1; \
        *(LAS u32x2*)(vb_ + vr0 * AT_VROW + vc * 16) = (u32x2){vreg0.x, vreg0.y}; *(LAS u32x2*)(vb_ + vr0 * AT_VROW + vc * 16 + 8) = (u32x2){vreg0.z, vreg0.w}; \
        *(LAS u32x2*)(vb_ + (vr0 + 64) * AT_VROW + vc * 16) = (u32x2){vreg1.x, vreg1.y}; *(LAS u32x2*)(vb_ + (vr0 + 64) * AT_VROW + vc * 16 + 8) = (u32x2){vreg1.z, vreg1.w}; } while (0)
    AT_LOAD(0); AT_STORE(0);
    __syncthreads();
    f32x16 o[4];
#pragma unroll
    for (int i = 0; i < 4; ++i)
#pragma unroll
        for (int r = 0; r < 16; ++r) o[i][r] = 0.f;
    float mrun = -INFINITY, lrun = 0.f;
    const int qmax_w = Q0 + 32 * wq + 31, qmin_w = Q0 + 32 * wq;
    for (int t = 0; t < NT; ++t) {
        if (t + 1 < NT) AT_LOAD(t + 1);
        const int kv0 = 64 * t;
        if (kv0 <= qmax_w) {
            const LAS unsigned char* Kb = lds + (t & 1) * AT_STAGE; const LAS unsigned char* Vb = Kb + AT_KBYTES;
            f32x16 s0, s1;
#pragma unroll
            for (int r = 0; r < 16; ++r) { s0[r] = 0.f; s1[r] = 0.f; }
#pragma unroll
            for (int d0 = 0; d0 < 4; ++d0) {
                const bf16x8 a0 = *(const LAS bf16x8*)(Kb + r32 * AT_KROW + (64 * j + 16 * d0 + 8 * hi) * 2);
                const bf16x8 a1 = *(const LAS bf16x8*)(Kb + (32 + r32) * AT_KROW + (64 * j + 16 * d0 + 8 * hi) * 2);
                s0 = __builtin_amdgcn_mfma_f32_32x32x16_bf16(a0, qf[d0], s0, 0, 0, 0);
                s1 = __builtin_amdgcn_mfma_f32_32x32x16_bf16(a1, qf[d0], s1, 0, 0, 0);
            }
            if (kv0 + 63 + 128 > qmin_w) {
#pragma unroll
                for (int r = 0; r < 16; ++r) {
                    const int rel0 = qrow - (kv0 + crow(r, hi)), rel1 = rel0 - 32;
                    s0[r] = rel0 < 0 ? -INFINITY : s0[r] + TB[rel0 < 128 ? rel0 : 128];
                    s1[r] = rel1 < 0 ? -INFINITY : s1[r] + TB[rel1 < 128 ? rel1 : 128];
                }
            }
            float mx = fmaxf(s0[0], s1[0]);
#pragma unroll
            for (int r = 1; r < 16; ++r) mx = fmaxf(mx, fmaxf(s0[r], s1[r]));
            mx = fmaxf(mx, __shfl_xor(mx, 32));
            const float mnew = fmaxf(mrun, mx);
            const float alpha = __builtin_amdgcn_exp2f(mrun - mnew);
            mrun = mnew;
            float ls = 0.f;
#pragma unroll
            for (int r = 0; r < 16; ++r) { s0[r] = __builtin_amdgcn_exp2f(s0[r] - mnew); s1[r] = __builtin_amdgcn_exp2f(s1[r] - mnew); ls += s0[r] + s1[r]; }
            lrun = lrun * alpha + ls;
#pragma unroll
            for (int i = 0; i < 4; ++i)
#pragma unroll
                for (int r = 0; r < 16; ++r) o[i][r] *= alpha;
            bf16x8 pf[4];
            { u32x4 w;
              w.x = pk2(s0[0], s0[1]); w.y = pk2(s0[2], s0[3]); w.z = pk2(s0[4], s0[5]); w.w = pk2(s0[6], s0[7]); pf[0] = __builtin_bit_cast(bf16x8, w);
              w.x = pk2(s0[8], s0[9]); w.y = pk2(s0[10], s0[11]); w.z = pk2(s0[12], s0[13]); w.w = pk2(s0[14], s0[15]); pf[1] = __builtin_bit_cast(bf16x8, w);
              w.x = pk2(s1[0], s1[1]); w.y = pk2(s1[2], s1[3]); w.z = pk2(s1[4], s1[5]); w.w = pk2(s1[6], s1[7]); pf[2] = __builtin_bit_cast(bf16x8, w);
              w.x = pk2(s1[8], s1[9]); w.y = pk2(s1[10], s1[11]); w.z = pk2(s1[12], s1[13]); w.w = pk2(s1[14], s1[15]); pf[3] = __builtin_bit_cast(bf16x8, w); }
#pragma unroll
            for (int blk = 0; blk < 4; ++blk)
#pragma unroll
                for (int s = 0; s < 4; ++s) {
                    const LAS unsigned char* vp = Vb + (32 * blk + r32) * AT_VROW + (16 * s + 4 * hi) * 2;
                    const u32x2 lo = *(const LAS u32x2*)vp, hh = *(const LAS u32x2*)(vp + 16);
                    const u32x4 w = (u32x4){lo.x, lo.y, hh.x, hh.y};
                    o[blk] = __builtin_amdgcn_mfma_f32_32x32x16_bf16(__builtin_bit_cast(bf16x8, w), pf[s], o[blk], 0, 0, 0);
                }
        }
        if (t + 1 < NT) AT_STORE((t + 1) & 1);
        __syncthreads();
    }
#undef AT_LOAD
#undef AT_STORE
    lrun += __shfl_xor(lrun, 32);
    const float inv = 1.f / lrun;
    LAS float* EX = (LAS float*)lds;
    if (j == 1) {
        const float sc = inv * lam;
#pragma unroll
        for (int blk = 0; blk < 4; ++blk)
#pragma unroll
            for (int r = 0; r < 16; ++r) EX[(wq * 64 + blk * 16 + r) * 64 + lane] = o[blk][r] * sc;
    }
    __syncthreads();
    if (j == 0) {
        float sq = 0.f;
#pragma unroll
        for (int blk = 0; blk < 4; ++blk)
#pragma unroll
            for (int r = 0; r < 16; ++r) { const float d = o[blk][r] * inv - EX[(wq * 64 + blk * 16 + r) * 64 + lane]; o[blk][r] = d; sq += d * d; }
        sq += __shfl_xor(sq, 32);
        const float rr = rsqrtf(sq * (1.f / 128.f) + EPS) * out_scale;
#pragma unroll
        for (int blk = 0; blk < 4; ++blk)
#pragma unroll
            for (int rq = 0; rq < 4; ++rq) {
                const int dv0 = 32 * blk + 8 * rq + 4 * hi;
                const f32x4 g = *(const f32x4*)(subln + dv0);
                u32x2 w; w.x = pk2(o[blk][4 * rq + 0] * rr * g[0], o[blk][4 * rq + 1] * rr * g[1]); w.y = pk2(o[blk][4 * rq + 2] * rr * g[2], o[blk][4 * rq + 3] * rr * g[3]);
                if (do_store) *(u32x2*)(OA + tok * 1024 + h * 128 + dv0) = w;
            }
    }
    __syncthreads();
}

__device__ __forceinline__ void dn_naive(LAS unsigned char* lds, unsigned char* ws, const float* convw  , int b, int h, int tid) {
    const int lane = tid & 63, wid = tid >> 6, dv = tid & 127, g4 = tid >> 7;
    LAS float* Y = (LAS float*)lds;
    LAS float* NR = Y + 384;
    LAS float* PT = NR + 8;
    LAS float* OP = PT + 512;
    float S[32];
#pragma unroll
    for (int i = 0; i < 32; ++i) S[i] = 0.f;
    bf16_t* QB = (bf16_t*)(ws + WS_QB); const bf16_t* KB = (const bf16_t*)(ws + WS_KB); const bf16_t* VB = (const bf16_t*)(ws + WS_VB);
    const float* GBp = (const float*)(ws + WS_GB);
    const int arr = tid >> 7;
    const bf16_t* src = (arr == 0 ? (const bf16_t*)QB : arr == 1 ? KB : VB) + h * 128 + dv;
    float w0 = 0.f, w1 = 0.f, w2 = 0.f, w3 = 0.f, x1 = 0.f, x2 = 0.f, x3 = 0.f;
    if (tid < 384) { const int ch = arr * 1024 + h * 128 + dv; w0 = convw[ch]; w1 = convw[3072 + ch]; w2 = convw[2 * 3072 + ch]; w3 = convw[3 * 3072 + ch]; }
    for (int t = 0; t < SEQ; ++t) {
        const size_t tok = (size_t)b * SEQ + t;
        if (tid < 384) {
            const float x0 = bf2f(src[tok * 1024]);
            float y = w0 * x3 + w1 * x2 + w2 * x1 + w3 * x0;
            y = siluf_(y); x3 = x2; x2 = x1; x1 = x0;
            Y[arr * 128 + dv] = y;
            const float sq = wave_sum(y * y);
            if (lane == 0) NR[wid] = sq;
        }
        __syncthreads();
        const float qn = rsqrtf(NR[0] + NR[1] + EPS) * 0.08838834764831845f, kn = rsqrtf(NR[2] + NR[3] + EPS);
        const float bt = GBp[tok * 16 + h], gt = GBp[tok * 16 + 8 + h], eg = __expf(gt);
        const float vv = Y[256 + dv];
        float ks = 0.f;
#pragma unroll
        for (int i = 0; i < 32; ++i) ks += Y[128 + 32 * g4 + i] * S[i];
        PT[g4 * 128 + dv] = ks * kn;
        __syncthreads();
        const float kS = (PT[dv] + PT[128 + dv]) + (PT[256 + dv] + PT[384 + dv]);
        const float c = bt * (vv - eg * kS);
        float op = 0.f;
#pragma unroll
        for (int i = 0; i < 32; ++i) { const float kk = Y[128 + 32 * g4 + i] * kn; S[i] = eg * S[i] + kk * c; op += Y[32 * g4 + i] * S[i]; }
        OP[g4 * 128 + dv] = op * qn;
        __syncthreads();
        if (g4 == 0) { const float ov = (OP[dv] + OP[128 + dv]) + (OP[256 + dv] + OP[384 + dv]); QB[tok * 1024 + h * 128 + dv] = f2bf(ov); }
    }
    __syncthreads();
}

__device__ __forceinline__ float row16_sum(float v) {
    v += __builtin_bit_cast(float, __builtin_amdgcn_update_dpp(0, __builtin_bit_cast(int, v), 0x128, 0xf, 0xf, false));
    v += __builtin_bit_cast(float, __builtin_amdgcn_update_dpp(0, __builtin_bit_cast(int, v), 0x124, 0xf, 0xf, false));
    v += __builtin_bit_cast(float, __builtin_amdgcn_update_dpp(0, __builtin_bit_cast(int, v), 0x122, 0xf, 0xf, false));
    v += __builtin_bit_cast(float, __builtin_amdgcn_update_dpp(0, __builtin_bit_cast(int, v), 0x121, 0xf, 0xf, false));
    return v;
}
__device__ __forceinline__ void dn_fast(LAS unsigned char* lds, unsigned char* ws, const float* convw  , int b, int h, int dvq, int tid) {
    const int lane = tid & 63, wid = tid >> 6, dvl = lane >> 4, grp = lane & 15;
    const int dvloc = 4 * wid + dvl, dv = 32 * dvq + dvloc;
    LAS float* Y = (LAS float*)lds;
    LAS float* NR = Y + 16 * 288;
    LAS float* GBs = NR + 16 * 16;
    LAS float* SC = GBs + 32;
    float S[8];
#pragma unroll
    for (int i = 0; i < 8; ++i) S[i] = 0.f;
    bf16_t* VB = (bf16_t*)(ws + WS_VB);
    const float* GBp = (const float*)(ws + WS_GB);
    const int arr = tid < 128 ? 0 : (tid < 256 ? 1 : 2);
    const int dch = arr == 2 ? 32 * dvq + ((tid - 256) & 31) : (tid & 127);
    const bf16_t* src = (const bf16_t*)(ws + (arr == 0 ? WS_QB : arr == 1 ? WS_KB : WS_VB)) + h * 128 + dch;
    float w0 = 0.f, w1 = 0.f, w2 = 0.f, w3 = 0.f, x1 = 0.f, x2 = 0.f, x3 = 0.f;
    if (tid < 288) { const int ch = arr * 1024 + h * 128 + dch; w0 = convw[ch]; w1 = convw[3072 + ch]; w2 = convw[2 * 3072 + ch]; w3 = convw[3 * 3072 + ch]; }
    for (int t0 = 0; t0 < SEQ; t0 += 16) {
        const size_t tokb = (size_t)b * SEQ + t0;
        if (tid < 288) {
            bf16_t xr[16];
#pragma unroll
            for (int tt = 0; tt < 16; ++tt) xr[tt] = src[(tokb + tt) * 1024];
#pragma unroll
            for (int tt = 0; tt < 16; ++tt) {
                const float x0 = bf2f(xr[tt]);
                float y = w0 * x3 + w1 * x2 + w2 * x1 + w3 * x0;
                y = siluf_(y); x3 = x2; x2 = x1; x1 = x0;
                Y[tt * 288 + tid] = y;
                if (tid < 256) { const float sq = row16_sum(y * y); if ((lane & 15) == 0) NR[tt * 16 + wid * 4 + (lane >> 4)] = sq; }
            }
        }
        if (tid >= 480) { const int i = tid - 480, tt = i >> 1, which = i & 1; GBs[tt * 2 + which] = GBp[(tokb + tt) * 16 + which * 8 + h]; }
        __syncthreads();
        if (tid < 16) {
            const f32x4 a = *(const LAS f32x4*)(NR + tid * 16), b2 = *(const LAS f32x4*)(NR + tid * 16 + 4), c2 = *(const LAS f32x4*)(NR + tid * 16 + 8), d2 = *(const LAS f32x4*)(NR + tid * 16 + 12);
            const float sq_q = ((a[0] + a[1]) + (a[2] + a[3])) + ((b2[0] + b2[1]) + (b2[2] + b2[3])), sq_k = ((c2[0] + c2[1]) + (c2[2] + c2[3])) + ((d2[0] + d2[1]) + (d2[2] + d2[3]));
            *(LAS f32x4*)(SC + tid * 4) = (f32x4){rsqrtf(sq_q + EPS) * 0.08838834764831845f, rsqrtf(sq_k + EPS), __expf(GBs[tid * 2 + 1]), GBs[tid * 2]};
        }
        __syncthreads();
#pragma unroll 4
        for (int tt = 0; tt < 16; ++tt) {
            const f32x4 sc = *(const LAS f32x4*)(SC + tt * 4);
            const float qn = sc[0], kn = sc[1], eg = sc[2], bt = sc[3];
            const f32x4 ka = *(const LAS f32x4*)(Y + tt * 288 + 128 + 8 * grp), kb = *(const LAS f32x4*)(Y + tt * 288 + 128 + 8 * grp + 4);
            const f32x4 qa = *(const LAS f32x4*)(Y + tt * 288 + 8 * grp), qb = *(const LAS f32x4*)(Y + tt * 288 + 8 * grp + 4);
            const float vv = Y[tt * 288 + 256 + dvloc];
            float ks = (ka[0] * S[0] + ka[1] * S[1]) + (ka[2] * S[2] + ka[3] * S[3]) + (kb[0] * S[4] + kb[1] * S[5]) + (kb[2] * S[6] + kb[3] * S[7]);
            ks = row16_sum(ks);
            const float c = bt * (vv - eg * ks * kn) * kn;
            float op = 0.f;
#pragma unroll
            for (int i = 0; i < 4; ++i) { S[i] = eg * S[i] + ka[i] * c; op += qa[i] * S[i]; S[4 + i] = eg * S[4 + i] + kb[i] * c; op += qb[i] * S[4 + i]; }
            op = row16_sum(op);
            if (grp == 0) VB[(tokb + tt) * 1024 + h * 128 + dv] = f2bf(op * qn);
        }
        __syncthreads();
    }
}

__device__ __forceinline__ float row8_sum(float v) {
    v += __builtin_bit_cast(float, __builtin_amdgcn_update_dpp(0, __builtin_bit_cast(int, v), 0x141, 0xf, 0xf, false));
    v += __builtin_bit_cast(float, __builtin_amdgcn_update_dpp(0, __builtin_bit_cast(int, v), 0x1B, 0xf, 0xf, false));
    v += __builtin_bit_cast(float, __builtin_amdgcn_update_dpp(0, __builtin_bit_cast(int, v), 0xB1, 0xf, 0xf, false));
    return v;
}
constexpr int DN_T = 32;
constexpr int DN2_YB = DN_T * 288 + DN_T * 16 + DN_T * 2 + DN_T * 4;
__device__ __forceinline__ void dn_pc(LAS unsigned char* lds, unsigned char* ws, const float* convw  , int b, int h, int dvq, int tid, bool do_store = true) {
    const int lane = tid & 63, wid = tid >> 6;
    const bool producer = tid >= 256;
    const int pt = tid - 256;
    LAS float* L = (LAS float*)lds;
    bf16_t* VB = (bf16_t*)(ws + WS_VB);
    const float* GBp = (const float*)(ws + WS_GB);
    const int parr = pt < 128 ? 0 : 1, pd = pt & 127;
    const bf16_t* src = (const bf16_t*)(ws + (parr == 0 ? WS_QB : WS_KB)) + h * 128 + pd;
    const bf16_t* srcv = (const bf16_t*)(ws + WS_VB) + h * 128 + 32 * dvq + (pt & 31);
    float w0 = 0.f, w1 = 0.f, w2 = 0.f, w3 = 0.f, x1 = 0.f, x2 = 0.f, x3 = 0.f, u0 = 0.f, u1 = 0.f, u2 = 0.f, u3 = 0.f, z1 = 0.f, z2 = 0.f, z3 = 0.f;
    if (producer) { const int ch = parr * 1024 + h * 128 + pd; w0 = convw[ch]; w1 = convw[3072 + ch]; w2 = convw[2 * 3072 + ch]; w3 = convw[3 * 3072 + ch];
        if (pt < 32) { const int cv = 2048 + h * 128 + 32 * dvq + pt; u0 = convw[cv]; u1 = convw[3072 + cv]; u2 = convw[2 * 3072 + cv]; u3 = convw[3 * 3072 + cv]; } }
    const int col = tid >> 3, grp = tid & 7;
    float S[16];
#pragma unroll
    for (int i = 0; i < 16; ++i) S[i] = 0.f;
#define DN2_PRODUCE(BUF, T0) do { LAS float* Yp = L + (BUF) * DN2_YB; LAS float* NRp = Yp + DN_T * 288; LAS float* GBsp = NRp + DN_T * 16; const size_t tb_ = (size_t)b * SEQ + (T0); \
        bf16_t xr[DN_T]; bf16_t vr[DN_T]; \
        _Pragma("unroll") for (int tt = 0; tt < DN_T; ++tt) xr[tt] = src[(tb_ + tt) * 1024]; \
        if (pt < 32) { _Pragma("unroll") for (int tt = 0; tt < DN_T; ++tt) vr[tt] = srcv[(tb_ + tt) * 1024]; } \
        if (pt >= 256 - 2 * DN_T) { const int i_ = pt - (256 - 2 * DN_T), tt_ = i_ >> 1, wh_ = i_ & 1; GBsp[tt_ * 2 + wh_] = GBp[(tb_ + tt_) * 16 + wh_ * 8 + h]; } \
        _Pragma("unroll") for (int tt = 0; tt < DN_T; ++tt) { const float x0 = bf2f(xr[tt]); float y = w0 * x3 + w1 * x2 + w2 * x1 + w3 * x0; y = siluf_(y); x3 = x2; x2 = x1; x1 = x0; \
            Yp[tt * 288 + pt] = y; const float sq = row16_sum(y * y); if ((lane & 15) == 0) NRp[tt * 16 + (wid - 4) * 4 + (lane >> 4)] = sq; } \
        if (pt < 32) { _Pragma("unroll") for (int tt = 0; tt < DN_T; ++tt) { const float x0 = bf2f(vr[tt]); float y = u0 * z3 + u1 * z2 + u2 * z1 + u3 * x0; y = siluf_(y); z3 = z2; z2 = z1; z1 = x0; Yp[tt * 288 + 256 + pt] = y; } } \
    } while (0)
    if (producer) DN2_PRODUCE(0, 0);
    for (int n = 0; n < SEQ / DN_T; ++n) {
        const int buf = n & 1;
        LAS float* Y = L + buf * DN2_YB; LAS float* NR = Y + DN_T * 288; LAS float* GBs = NR + DN_T * 16; LAS float* SC = GBs + DN_T * 2;
        __syncthreads();
        if (tid < DN_T) {
            const f32x4 a = *(const LAS f32x4*)(NR + tid * 16), b2 = *(const LAS f32x4*)(NR + tid * 16 + 4), c2 = *(const LAS f32x4*)(NR + tid * 16 + 8), d2 = *(const LAS f32x4*)(NR + tid * 16 + 12);
            const float sq_q = ((a[0] + a[1]) + (a[2] + a[3])) + ((b2[0] + b2[1]) + (b2[2] + b2[3])), sq_k = ((c2[0] + c2[1]) + (c2[2] + c2[3])) + ((d2[0] + d2[1]) + (d2[2] + d2[3]));
            *(LAS f32x4*)(SC + tid * 4) = (f32x4){rsqrtf(sq_q + EPS) * 0.08838834764831845f, rsqrtf(sq_k + EPS), __expf(GBs[tid * 2 + 1]), GBs[tid * 2]};
        }
        __syncthreads();
        if (producer) { if (n + 1 < SEQ / DN_T) DN2_PRODUCE(buf ^ 1, DN_T * (n + 1)); }
        else {
            const size_t tokb = (size_t)b * SEQ + DN_T * n;
#pragma unroll 8
            for (int tt = 0; tt < DN_T; ++tt) {
                const f32x4 sc = *(const LAS f32x4*)(SC + tt * 4);
                const float qn = sc[0], kn = sc[1], eg = sc[2], bt = sc[3];
                const LAS f32x4* kp = (const LAS f32x4*)(Y + tt * 288 + 128 + 16 * grp); const LAS f32x4* qp = (const LAS f32x4*)(Y + tt * 288 + 16 * grp);
                const f32x4 k0 = kp[0], k1 = kp[1], k2 = kp[2], k3 = kp[3], q0 = qp[0], q1 = qp[1], q2 = qp[2], q3 = qp[3];
                const float vv = Y[tt * 288 + 256 + col];
                float ks = ((k0[0] * S[0] + k0[1] * S[1]) + (k0[2] * S[2] + k0[3] * S[3])) + ((k1[0] * S[4] + k1[1] * S[5]) + (k1[2] * S[6] + k1[3] * S[7]))
                         + ((k2[0] * S[8] + k2[1] * S[9]) + (k2[2] * S[10] + k2[3] * S[11])) + ((k3[0] * S[12] + k3[1] * S[13]) + (k3[2] * S[14] + k3[3] * S[15]));
                ks = row8_sum(ks);
                const float c = bt * (vv - eg * ks * kn) * kn;
                float op0 = 0.f, op1 = 0.f;
#pragma unroll
                for (int i = 0; i < 4; ++i) { S[i] = eg * S[i] + k0[i] * c; op0 += q0[i] * S[i]; S[4 + i] = eg * S[4 + i] + k1[i] * c; op1 += q1[i] * S[4 + i];
                                              S[8 + i] = eg * S[8 + i] + k2[i] * c; op0 += q2[i] * S[8 + i]; S[12 + i] = eg * S[12 + i] + k3[i] * c; op1 += q3[i] * S[12 + i]; }
                const float op = row8_sum(op0 + op1);
                if (grp == 0 && do_store) VB[(tokb + tt) * 1024 + h * 128 + 32 * dvq + col] = f2bf(op * qn);
                if (!do_store) asm volatile("" :: "v"(op));
            }
        }
    }
    __syncthreads();
#undef DN2_PRODUCE
}

#define GEMM_PHASE(EPI, Aptr, Bptr, Mv, Nv, Kv, Eobj, HM) do { int m_ = (Mv), n_ = (Nv), k_ = (Kv); asm volatile("" : "+s"(m_), "+s"(n_), "+s"(k_)); pg8::Gemm g_{(const pg8::bf16_t*)(Aptr), (const pg8::bf16_t*)(Bptr), m_, n_, k_, (HM)}; pg8::StaticOrder S_; S_.init(m_, n_, G, bid); \
        pg8::gemm_phase<EPI, pg8::StaticOrder, true, true>(lds, g_, S_, (Eobj)); } while (0)

__global__ void __launch_bounds__(NTHR, 2) fwd_mega(Params P) {
    extern __shared__ __attribute__((aligned(16))) unsigned char lds_raw[];
    LAS unsigned char* lds = (LAS unsigned char*)lds_raw;
    cg::grid_group grid = cg::this_grid();
    if (threadIdx.x == 0) {
        const unsigned xcc = (unsigned)__builtin_amdgcn_s_getreg((3 << 11) | 20) & 7u;
        const unsigned loc = __hip_atomic_fetch_add((unsigned*)(P.ws + WS_CTL) + xcc, 1u, __ATOMIC_RELAXED, __HIP_MEMORY_SCOPE_AGENT);
        *(LAS int*)(lds + LDS_VB) = (int)((loc & 31u) * 8u + xcc);
    }
    __syncthreads();
    int seg = 0; const int seg_lo = P.seg_lo, seg_hi = P.seg_hi;
#ifdef L2FLUSH
#define L2_FLUSH() do { const Params* PF = (const Params*)__builtin_amdgcn_kernarg_segment_ptr(); asm volatile("" : "+s"(PF)); int tf_ = threadIdx.x; asm volatile("" : "+v"(tf_)); \
        const u32x4* jp = (const u32x4*)(PF->in[I_P]) + (size_t)blockIdx.x * (L2FLUSH * 64) + tf_; unsigned acc_ = 0u; \
        for (int q_ = 0; q_ < L2FLUSH * 64 / 512; ++q_) { const u32x4 v_ = __builtin_nontemporal_load(jp + (size_t)q_ * 512); acc_ |= v_.x & v_.y & v_.z & v_.w; asm volatile("" ::: "memory"); } \
        if (acc_ == 0x12345678u) PF->out[0] = 0.f; } while (0)
#else
#define L2_FLUSH() do {} while (0)
#endif
#ifdef NOSEG
#define SYNCCOND true
#else
#define SYNCCOND (seg >= seg_lo && seg + 1 < seg_hi)
#endif
#define GRID_SYNC() do { if (SYNCCOND) { asm volatile("s_waitcnt vmcnt(0) lgkmcnt(0)" ::: "memory");   grid.sync(); L2_FLUSH(); \
        if (threadIdx.x < 64) { __builtin_amdgcn_fence(__ATOMIC_ACQUIRE, "agent"); asm volatile("s_waitcnt vmcnt(0)" ::: "memory"); } __syncthreads();     \
        } ++seg; } while (0)
#ifdef NOSEG
#define SEGCOND true
#else
#define SEGCOND (seg >= seg_lo && seg < seg_hi)
#endif
#define PH_BEGIN if (SEGCOND) { const Params* PQ = (const Params*)__builtin_amdgcn_kernarg_segment_ptr(); asm volatile("" : "+s"(PQ)); int tid = threadIdx.x; asm volatile("" : "+v"(tid)); \
    const int lane = tid & 63, wave = __builtin_amdgcn_readfirstlane(tid >> 6); int bid = __builtin_amdgcn_readfirstlane(*(LAS int*)(lds + LDS_VB)), G = gridDim.x; asm volatile("" : "+s"(bid), "+s"(G)); \
    const int xb_ = bid & 7, jb_ = bid >> 3, wj = jb_ * NW + wave;     \
    unsigned char* ws = PQ->ws; float* X = PQ->out; float* SS = (float*)(ws + WS_SS); bf16_t* XB = (bf16_t*)(ws + WS_XB); \
    float* ss_attn = (float*)(ws + WS_HALO); float* ss_ffn = ss_attn + (size_t)MTOK * 16; float* ss_ple = ss_ffn + (size_t)MTOK * 16; float* ss_next = ss_attn; \
    (void)lane; (void)xb_; (void)jb_; (void)wj; (void)X; (void)XB; (void)ss_attn; (void)ss_ffn; (void)ss_ple; (void)ss_next; (void)G;
#define PH_END }
#define U ((bf16_t*)(ws + WS_MIX + (size_t)half * 176 * MiB))
#define ACT ((bf16_t*)(ws + WS_MIX + (half == 0 ? (size_t)352 * MiB : (size_t)0)))

    { const int layer = 0; PH_BEGIN
      if (bid == 0 && tid == 0) __hip_atomic_store((unsigned*)(ws + WS_CTL) + 16, 0u, __ATOMIC_RELAXED, __HIP_MEMORY_SCOPE_AGENT);
      const float* xin = PQ->in[I_X];
      for (int r = wj; r < SEQ; r += 256) {
          const int m = xb_ * SEQ + r;
          const f32x4* xr = (const f32x4*)(xin + (size_t)m * 1024) + lane;
          f32x4 v[4]; float s = 0.f;
#pragma unroll
          for (int jj = 0; jj < 4; ++jj) { v[jj] = xr[64 * jj]; s += (v[jj][0] * v[jj][0] + v[jj][1] * v[jj][1]) + (v[jj][2] * v[jj][2] + v[jj][3] * v[jj][3]); }
          s = wave_sum(s);
          if (lane < 16) ss_attn[(size_t)m * 16 + lane] = lane == 0 ? s : 0.f;
          f32x4* xo = (f32x4*)(X + (size_t)m * 1024) + lane;
          u32x2* bo = (u32x2*)(XB + (size_t)m * 1024) + lane;
#pragma unroll
          for (int jj = 0; jj < 4; ++jj) { xo[64 * jj] = v[jj]; u32x2 w; w.x = pk2(v[jj][0], v[jj][1]); w.y = pk2(v[jj][2], v[jj][3]); bo[64 * jj] = w; }
      }
    PH_END }

    for (int layer = 0; layer < NLAYER; ++layer) {
        asm volatile("" ::: "memory");
        const float lam_init = 0.8f - 0.6f * __expf(-0.3f * (float)layer);
        if (layer == 0) {
        PH_BEGIN
        convert_weights(PQ, layer, lds, bid * NW + wave, G * NW, wave, lane, 0);
        { const float* pl = PQ->in[I_P] + ((size_t)layer * MTOK + (size_t)xb_ * SEQ) * DPLE;
          bf16_t* pb = (bf16_t*)(ws + WS_PB) + (size_t)xb_ * SEQ * DPLE;
          for (int i = jb_ * NTHR + tid; i < SEQ * DPLE / 8; i += 32 * NTHR) {
              const f32x4 a = *(const f32x4*)(pl + (size_t)i * 8), b = *(const f32x4*)(pl + (size_t)i * 8 + 4);
              u32x4 w; w.x = pk2(a[0], a[1]); w.y = pk2(a[2], a[3]); w.z = pk2(b[0], b[1]); w.w = pk2(b[2], b[3]);
              *(u32x4*)(pb + (size_t)i * 8) = w;
          }
        }
        PH_END
        GRID_SYNC();
        } else {
        PH_BEGIN
        convert_weights(PQ, layer, lds, bid * NW + wave, G * NW, wave, lane, 2);
        { const float* pl = PQ->in[I_P] + ((size_t)layer * MTOK + (size_t)xb_ * SEQ) * DPLE;
          bf16_t* pb = (bf16_t*)(ws + WS_PB) + (size_t)xb_ * SEQ * DPLE;
          for (int i = jb_ * NTHR + tid; i < SEQ * DPLE / 8; i += 32 * NTHR) {
              const f32x4 a = *(const f32x4*)(pl + (size_t)i * 8), b = *(const f32x4*)(pl + (size_t)i * 8 + 4);
              u32x4 w; w.x = pk2(a[0], a[1]); w.y = pk2(a[2], a[3]); w.z = pk2(b[0], b[1]); w.w = pk2(b[2], b[3]);
              *(u32x4*)(pb + (size_t)i * 8) = w;
          }
        }
        __syncthreads();
        PH_END
        }
#ifdef DBLTEST
#ifdef DBL_SC
#define DBL_LD(p) ldc16(p)
#else
#define DBL_LD(p) (*(p))
#endif
        if (layer == 0) {
#ifdef DBL_OUTP
        PH_BEGIN
        { EpiResid E{X, XB, ss_ffn, nullptr, -1};
          GEMM_PHASE(EpiResid, ws + WS_VT, ws + W_OUT, MTOK, 1024, 1024, E, -1); }
        PH_END
        GRID_SYNC();
#endif
        for (int rep = 0; rep < 2; ++rep) {
        PH_BEGIN
#ifdef DBL_COPY
            { const u32x4* s4 = (const u32x4*)XB; u32x4* d4 = (u32x4*)(ws + WS_MIX + (size_t)rep * 176 * MiB);
              const size_t per = (size_t)DBL_M * DBL_N * 2 / 16 / 8;
              for (size_t i = (size_t)((jb_ + rep * 13) & 31) * NTHR + tid; i < per; i += (size_t)32 * NTHR) d4[(size_t)xb_ * per + i] = DBL_LD(s4 + (size_t)xb_ * per + i); }
#else
#ifndef DBL_W
#define DBL_W W_UP
#define DBL_ACT 0
#endif
            { EpiRowScale<DBL_ACT> E{(bf16_t*)(ws + WS_MIX + (size_t)rep * DBL_OFF * MiB), DBL_N, ss_attn, DBL_H};
              GEMM_PHASE(EpiRowScale<DBL_ACT>, XB, ws + DBL_W, DBL_M, DBL_N, 1024, E, DBL_H); }
#endif
        PH_END
        GRID_SYNC();
        }
        PH_BEGIN
        { const u32x4* a4 = (const u32x4*)(ws + WS_MIX); const u32x4* b4 = (const u32x4*)(ws + WS_MIX + (size_t)DBL_OFF * MiB); unsigned bad = 0u;
          const size_t per = (size_t)DBL_M * DBL_N * 2 / 16 / 8;
          for (size_t i0 = (size_t)((jb_ + 7) & 31) * NTHR + tid; i0 < per; i0 += (size_t)32 * NTHR) { const size_t i = (size_t)xb_ * per + i0; const u32x4 a = DBL_LD(a4 + i), b = DBL_LD(b4 + i); bad |= ((a.x ^ b.x) | (a.y ^ b.y) | (a.z ^ b.z) | (a.w ^ b.w)) ? 1u : 0u; }
          if (bad) __hip_atomic_fetch_or((unsigned*)(ws + WS_CTL) + 16, 1u, __ATOMIC_RELAXED, __HIP_MEMORY_SCOPE_AGENT); }
        PH_END
        GRID_SYNC();
        }
#endif
#if defined(DBLMIX) && !defined(DBLMIX_AT_GATES)
        for (int rep = 0; rep < 2; ++rep) {
#endif
#ifndef NO_INPROJ
        PH_BEGIN
        { EpiQK E{ws, ss_attn, PQ->in[I_QNORM] + layer * 64, PQ->in[I_KNORM] + layer * 64};
          GEMM_PHASE(EpiQK, XB, ws + W_IN, MTOK, 2048, 1024, E, -1); }
        PH_END
        PH_BEGIN
        { EpiSeg E{ws, ss_attn};
          GEMM_PHASE(EpiSeg, XB, ws + W_IN + (size_t)2048 * 2048, MTOK, 4096, 1024, E, -1); }
        PH_END
#ifdef SEG_PROBE
        PH_BEGIN
        { EpiSeg E{ws, ss_attn};
          GEMM_PHASE(EpiSeg, XB, ws + W_IN + (size_t)2048 * 2048, MTOK, 4096, 1024, E, -1); }
        PH_END
#endif
        PH_BEGIN
        { EpiGB E{ws, ss_attn, PQ->in[I_ALOG] + layer * 8, PQ->in[I_DTB] + layer * 8};
          GEMM_PHASE(EpiGB, XB, ws + W_IN + (size_t)6144 * 2048, MTOK, 256, 1024, E, -1); }
        PH_END
        PH_BEGIN
        { EpiVt E{(bf16_t*)(ws + WS_VT), ss_attn};
          GEMM_PHASE(EpiVt, ws + W_V, XB, 1024, MTOK, 1024, E, -1); }
        PH_END
#endif
        GRID_SYNC();
#ifndef NO_ATTN
        PH_BEGIN
        { const float* lq = PQ->in[I_LAM] + layer * 256;
          const float a1 = wave_sum(lq[lane] * lq[64 + lane]), a2 = wave_sum(lq[128 + lane] * lq[192 + lane]);
          const float lam = __expf(a1) - __expf(a2) + lam_init;
#ifdef ATTN_PROBE
          for (int k = 0; k < 4; ++k) {
              const int pi = jb_ + 32 * k, hh = pi >> 4, s = pi & 15;
              attn_unit(lds, (const bf16_t*)(ws + WS_QA), (const bf16_t*)(ws + WS_KA), (const bf16_t*)(ws + WS_VT), (bf16_t*)(ws + WS_QA), xb_, hh, 31 - s, lam, 1.f - lam_init, PQ->in[I_SUBLN] + layer * 128, PQ->in[I_RELB], tid, false);
              attn_unit(lds, (const bf16_t*)(ws + WS_QA), (const bf16_t*)(ws + WS_KA), (const bf16_t*)(ws + WS_VT), (bf16_t*)(ws + WS_QA), xb_, hh, s, lam, 1.f - lam_init, PQ->in[I_SUBLN] + layer * 128, PQ->in[I_RELB], tid, false);
          }
          __syncthreads();
#endif
          for (int k = 0; k < 4; ++k) {
              const int pi = jb_ + 32 * k, hh = pi >> 4, s = pi & 15;
              attn_unit(lds, (const bf16_t*)(ws + WS_QA), (const bf16_t*)(ws + WS_KA), (const bf16_t*)(ws + WS_VT), (bf16_t*)(ws + WS_QA), xb_, hh, 31 - s, lam, 1.f - lam_init, PQ->in[I_SUBLN] + layer * 128, PQ->in[I_RELB], tid);
              attn_unit(lds, (const bf16_t*)(ws + WS_QA), (const bf16_t*)(ws + WS_KA), (const bf16_t*)(ws + WS_VT), (bf16_t*)(ws + WS_QA), xb_, hh, s, lam, 1.f - lam_init, PQ->in[I_SUBLN] + layer * 128, PQ->in[I_RELB], tid);
          }
        }
        PH_END
#endif
#ifndef NO_DN
        PH_BEGIN
#ifdef DN_NAIVE
        if (jb_ < 8) dn_naive(lds, ws, PQ->in[I_CONVB] + (size_t)layer * 4 * 3072, xb_, jb_, tid);
#else
#ifdef DN_FAST1
        dn_fast(lds, ws, PQ->in[I_CONVB] + (size_t)layer * 4 * 3072, xb_, jb_ >> 2, jb_ & 3, tid);
#else
#ifdef DN_PROBE
        dn_pc(lds, ws, PQ->in[I_CONVB] + (size_t)layer * 4 * 3072, xb_, jb_ >> 2, jb_ & 3, tid, false);
#endif
        dn_pc(lds, ws, PQ->in[I_CONVB] + (size_t)layer * 4 * 3072, xb_, jb_ >> 2, jb_ & 3, tid);
#endif
#endif
        PH_END
#endif
        GRID_SYNC();
#if defined(DBLMIX) && defined(DBLMIX_AT_GATES)
        for (int rep = 0; rep < 2; ++rep) {
#endif
#ifndef NO_GATES
        PH_BEGIN
        { EpiRowScale<1> E{(bf16_t*)(ws + WS_G), 2048, ss_attn, -1};
          GEMM_PHASE(EpiRowScale<1>, XB, ws + W_GL, MTOK, 1024, 1024, E, -1); }
        PH_END
        PH_BEGIN
        { EpiRowScale<1> E{(bf16_t*)(ws + WS_G) + 1024, 2048, ss_attn, -1};
          GEMM_PHASE(EpiRowScale<1>, XB, ws + W_GL + (size_t)1024 * 2048, MTOK, 1024, 1024, E, -1); }
        PH_END
#endif
#ifndef NO_OBNORM
        PH_BEGIN
        { const float* on = PQ->in[I_ONORM] + layer * 128;
          const float g0 = on[2 * lane], g1 = on[2 * lane + 1];
          unsigned* OB = (unsigned*)(ws + WS_QB) + (size_t)xb_ * SEQ * 512; const unsigned* OI = (const unsigned*)(ws + WS_OSRC) + (size_t)xb_ * SEQ * 512; const unsigned* ZB = (const unsigned*)(ws + WS_ZB) + (size_t)xb_ * SEQ * 512;
#pragma unroll 4
          for (int r = wj; r < SEQ * NH; r += 256) {
              const unsigned ov = OI[(size_t)r * 64 + lane], zv = ZB[(size_t)r * 64 + lane];
              const float o0 = bflo(ov), o1 = bfhi(ov);
              const float sq = wave_sum(o0 * o0 + o1 * o1);
              const float rr = rsqrtf(sq * (1.f / 128.f) + EPS);
              OB[(size_t)r * 64 + lane] = pk2(o0 * rr * g0 * siluf_(bflo(zv)), o1 * rr * g1 * siluf_(bfhi(zv)));
          }
        }
        PH_END
#endif
#ifndef NO_TMPA
        PH_BEGIN
        { EpiGateMul E{(bf16_t*)(ws + WS_TMPA), (const bf16_t*)(ws + WS_G), 2048, 0, nullptr};
          GEMM_PHASE(EpiGateMul, ws + WS_QA, ws + W_BRA, MTOK, 1024, 1024, E, -1); }
        PH_END
#endif
        GRID_SYNC();
#ifndef NO_MIXED
        PH_BEGIN
        { EpiGateMul E{(bf16_t*)(ws + WS_MIXED), (const bf16_t*)(ws + WS_G), 2048, 1024, (const bf16_t*)(ws + WS_TMPA)};
          GEMM_PHASE(EpiGateMul, ws + WS_QB, ws + W_BRB, MTOK, 1024, 1024, E, -1); }
        PH_END
#endif
        GRID_SYNC();
#ifdef DBLMIX
        PH_BEGIN
        { const u32x4* t4 = (const u32x4*)(ws + (size_t)DBL_TGT + (size_t)xb_ * ((size_t)DBL_TGT_BYTES / 8)); u32x4* s4 = (u32x4*)(ws + WS_PB + (size_t)xb_ * 2 * MiB); unsigned bad = 0u;
          for (size_t i = (size_t)((jb_ + 5 * rep) & 31) * NTHR + tid; i < (size_t)2 * MiB / 16; i += (size_t)32 * NTHR) {
              const u32x4 a = t4[i];
              if (rep == 0) s4[i] = a; else { const u32x4 b = s4[i]; bad |= ((a.x ^ b.x) | (a.y ^ b.y) | (a.z ^ b.z) | (a.w ^ b.w)) ? 1u : 0u; } }
          if (bad) __hip_atomic_fetch_or((unsigned*)(ws + WS_CTL) + 16, 1u, __ATOMIC_RELAXED, __HIP_MEMORY_SCOPE_AGENT); }
        PH_END
        GRID_SYNC();
        }
#endif
#ifndef NO_OUTP
        PH_BEGIN
        { EpiResid E{X, XB, ss_ffn, nullptr, -1};
          GEMM_PHASE(EpiResid, ws + WS_MIXED, ws + W_OUT, MTOK, 1024, 1024, E, -1); }
        PH_END
#endif
        GRID_SYNC();
        for (int step = 0; step < 4; ++step) {
        if (step < 2) { const int half = step;
#ifndef NO_UP
        PH_BEGIN
            { EpiRowScale<0> E{U, 5632, ss_ffn, half};
              GEMM_PHASE(EpiRowScale<0>, XB, ws + W_UP, 16384, 5632, 1024, E, half); }
        PH_END
#endif
        }
        if (step >= 1 && step <= 2) { const int half = step - 1;
#ifndef NO_ACT
        PH_BEGIN
            { const float* cw = PQ->in[I_CONVFF] + (size_t)layer * 3 * 5632; const float* cb = PQ->in[I_CONVFFB] + (size_t)layer * 5632;
              bf16_t* UH = (bf16_t*)(ws + WS_UHALO) + (size_t)xb_ * 2 * 5632;
              for (int it = jb_ * NTHR + tid; it < 128 * 352; it += 32 * NTHR) {
                  const int cc = it % 352, rg = it / 352, c0 = cc * 8;
                  const int lrow0 = xb_ * 2048 + rg * 16;
                  float wg[3][8], wv[3][8], bg[8], bv[8];
#pragma unroll
                  for (int jj = 0; jj < 3; ++jj)
#pragma unroll
                      for (int e = 0; e < 8; ++e) { wg[jj][e] = cw[jj * 5632 + c0 + e]; wv[jj][e] = cw[jj * 5632 + 2816 + c0 + e]; }
#pragma unroll
                  for (int e = 0; e < 8; ++e) { bg[e] = cb[c0 + e]; bv[e] = cb[2816 + c0 + e]; }
                  float g2[8], g1[8], v2[8], v1[8];
#pragma unroll
                  for (int e = 0; e < 8; ++e) { g2[e] = 0.f; g1[e] = 0.f; v2[e] = 0.f; v1[e] = 0.f; }
                  if (rg > 0 || half == 1) {
                      const bf16_t* r2p = rg > 0 ? U + (size_t)(lrow0 - 2) * 5632 : UH;
                      const bf16_t* r1p = rg > 0 ? U + (size_t)(lrow0 - 1) * 5632 : UH + 5632;
                      const u32x4 a = *(const u32x4*)(r2p + c0), bq = *(const u32x4*)(r1p + c0);
                      const u32x4 c = *(const u32x4*)(r2p + 2816 + c0), d = *(const u32x4*)(r1p + 2816 + c0);
                      g2[0] = bflo(a.x); g2[1] = bfhi(a.x); g2[2] = bflo(a.y); g2[3] = bfhi(a.y); g2[4] = bflo(a.z); g2[5] = bfhi(a.z); g2[6] = bflo(a.w); g2[7] = bfhi(a.w);
                      g1[0] = bflo(bq.x); g1[1] = bfhi(bq.x); g1[2] = bflo(bq.y); g1[3] = bfhi(bq.y); g1[4] = bflo(bq.z); g1[5] = bfhi(bq.z); g1[6] = bflo(bq.w); g1[7] = bfhi(bq.w);
                      v2[0] = bflo(c.x); v2[1] = bfhi(c.x); v2[2] = bflo(c.y); v2[3] = bfhi(c.y); v2[4] = bflo(c.z); v2[5] = bfhi(c.z); v2[6] = bflo(c.w); v2[7] = bfhi(c.w);
                      v1[0] = bflo(d.x); v1[1] = bfhi(d.x); v1[2] = bflo(d.y); v1[3] = bfhi(d.y); v1[4] = bflo(d.z); v1[5] = bfhi(d.z); v1[6] = bflo(d.w); v1[7] = bfhi(d.w);
                  }
#pragma unroll 4
                  for (int rr = 0; rr < 16; ++rr) {
                      const size_t row = (size_t)lrow0 + rr;
                      const u32x4 a = *(const u32x4*)(U + row * 5632 + c0), c = *(const u32x4*)(U + row * 5632 + 2816 + c0);
                      if (half == 0 && rg == 127 && rr >= 14) { *(u32x4*)(UH + (size_t)(rr - 14) * 5632 + c0) = a; *(u32x4*)(UH + (size_t)(rr - 14) * 5632 + 2816 + c0) = c; }
                      float g0[8], v0[8], ov[8];
                      g0[0] = bflo(a.x); g0[1] = bfhi(a.x); g0[2] = bflo(a.y); g0[3] = bfhi(a.y); g0[4] = bflo(a.z); g0[5] = bfhi(a.z); g0[6] = bflo(a.w); g0[7] = bfhi(a.w);
                      v0[0] = bflo(c.x); v0[1] = bfhi(c.x); v0[2] = bflo(c.y); v0[3] = bfhi(c.y); v0[4] = bflo(c.z); v0[5] = bfhi(c.z); v0[6] = bflo(c.w); v0[7] = bfhi(c.w);
#pragma unroll
                      for (int e = 0; e < 8; ++e) {
                          const float ug = wg[0][e] * g2[e] + wg[1][e] * g1[e] + wg[2][e] * g0[e] + bg[e];
                          const float uv = wv[0][e] * v2[e] + wv[1][e] * v1[e] + wv[2][e] * v0[e] + bv[e];
                          ov[e] = siluf_(ug) * uv; g2[e] = g1[e]; g1[e] = g0[e]; v2[e] = v1[e]; v1[e] = v0[e];
                      }
                      u32x4 w; w.x = pk2(ov[0], ov[1]); w.y = pk2(ov[2], ov[3]); w.z = pk2(ov[4], ov[5]); w.w = pk2(ov[6], ov[7]);
                      *(u32x4*)(ACT + row * 2816 + c0) = w;
                  }
              }
            }
        PH_END
#endif
        }
        if (step >= 2) { const int half = step - 2;
#ifndef NO_DOWN
        PH_BEGIN
            { EpiResid E{X, XB, ss_ple, nullptr, half};
              GEMM_PHASE(EpiResid, ACT, ws + W_DOWN, 16384, 1024, 2816, E, -1); }
        PH_END
#endif
        }
            GRID_SYNC();
        }
#ifndef NO_PLEG
        PH_BEGIN
        { EpiRowScale<1> E{(bf16_t*)(ws + WS_MIX), 1024, ss_ple, -1};
          GEMM_PHASE(EpiRowScale<1>, XB, ws + W_PG, MTOK, 1024, 1024, E, -1); }
        PH_END
#endif
        GRID_SYNC();
#ifndef NO_PLE
        PH_BEGIN
        { EpiResid E{X, XB, ss_next, (const bf16_t*)(ws + WS_MIX), -1};
          GEMM_PHASE(EpiResid, ws + WS_PB, ws + W_PP, MTOK, 1024, 256, E, -1); }
        PH_END
#endif
        if (layer + 1 < NLAYER) {
        PH_BEGIN
        convert_weights(PQ, layer + 1, lds, bid * NW + wave, G * NW, wave, lane, 1);
        PH_END
        }
        GRID_SYNC();
    }
#ifdef NANCHK
    { const int layer = 0; PH_BEGIN
      unsigned bad = 0u;
      for (size_t i = (size_t)bid * NTHR + tid; i < (size_t)MTOK * 256; i += (size_t)G * NTHR) { const f32x4 v = *(const f32x4*)(X + i * 4);
          for (int e = 0; e < 4; ++e) bad |= ((__float_as_uint(v[e]) & 0x7f800000u) == 0x7f800000u) ? 1u : 0u; }
#ifdef NANCHK_BF_LO
      { const unsigned* bp = (const unsigned*)(ws + (size_t)NANCHK_BF_LO); const size_t nw = ((size_t)NANCHK_BF_HI - (size_t)NANCHK_BF_LO) / 4;
        for (size_t i = (size_t)bid * NTHR + tid; i < nw; i += (size_t)G * NTHR) { const unsigned w = bp[i]; bad |= (((w & 0x7f80u) == 0x7f80u) || ((w & 0x7f800000u) == 0x7f800000u)) ? 1u : 0u; } }
#endif
      if (bad) __hip_atomic_fetch_or((unsigned*)(ws + WS_CTL) + 16, 1u, __ATOMIC_RELAXED, __HIP_MEMORY_SCOPE_AGENT);
      PH_END }
    GRID_SYNC();
    { const int layer = 0; PH_BEGIN
      const unsigned fl = __hip_atomic_fetch_or((unsigned*)(ws + WS_CTL) + 16, 0u, __ATOMIC_RELAXED, __HIP_MEMORY_SCOPE_AGENT);
      if (fl) for (size_t i = (size_t)bid * NTHR + tid; i < (size_t)MTOK * 256; i += (size_t)G * NTHR) *(f32x4*)(X + i * 4) = (f32x4){0.f, 0.f, 0.f, 0.f};
      PH_END }
#endif
#undef U
#undef ACT
}

extern "C" void kernel_launch(void* const* d_in, const int* in_sizes, int n_in, void* d_out, int out_size, void* d_ws, size_t ws_size, hipStream_t stream) {
    static int grid = 0;
    if (grid == 0) {
        if (n_in != 24 || out_size != MTOK * DM || ws_size < WS_TOTAL) { fprintf(stderr, "kernel_launch: unexpected shapes / workspace (n_in %d out %d ws %zu need %zu)\n", n_in, out_size, ws_size, (size_t)WS_TOTAL); grid = -1; return; }
        int dev = 0, cus = 0, per_cu = 0;
        hipGetDevice(&dev);
        hipDeviceGetAttribute(&cus, hipDeviceAttributeMultiprocessorCount, dev);
        hipFuncSetAttribute((const void*)fwd_mega, hipFuncAttributeMaxDynamicSharedMemorySize, LDS_BYTES);
        hipOccupancyMaxActiveBlocksPerMultiprocessor(&per_cu, (const void*)fwd_mega, NTHR, LDS_BYTES);
        if (per_cu < 1) { fprintf(stderr, "kernel_launch: occupancy query says %d blocks per CU\n", per_cu); per_cu = 1; }
        (void)hipGetLastError();
        grid = cus;
    }
    if (grid < 0) return;
    Params p{};
    for (int i = 0; i < 24; ++i) p.in[i] = (const float*)d_in[i];
    p.out = (float*)d_out; p.ws = (unsigned char*)d_ws;
    hipError_t e = hipSuccess;
#ifdef N_SEG_LAUNCH
    for (int sgi = 0; sgi < 60 && e == hipSuccess; sgi += N_SEG_LAUNCH) {
        p.seg_lo = sgi; p.seg_hi = sgi + N_SEG_LAUNCH;
        void* args[] = {&p};
        e = hipLaunchCooperativeKernel((const void*)fwd_mega, dim3(grid), dim3(NTHR), args, LDS_BYTES, stream);
    }
#else
    p.seg_lo = 0; p.seg_hi = 1000;
    void* args[] = {&p};
    e = hipLaunchCooperativeKernel((const void*)fwd_mega, dim3(grid), dim3(NTHR), args, LDS_BYTES, stream);
#endif
    if (e != hipSuccess) fprintf(stderr, "cooperative launch failed: %s (grid %d)\n", hipGetErrorString(e), grid);
}
```
